# Optimizing an MI355X kernel written in HIP

```python
import jax, jax.numpy as jnp
from jax import lax
import numpy as np

D_MODEL = 1024
BATCH = 16
SEQ = 4096
DEPTH = 2
DEC_BATCH = 8
DEC_SEQ = 64
PAST_LEN = 2048

CHUNK = 64
EPS = 1e-6
SSD_HEADS = 16
SSD_HEAD_DIM = 64
SSD_INNER = SSD_HEADS * SSD_HEAD_DIM
SSD_GROUPS = 2
SSD_STATE = 128
SSD_CONV = 4
SSD_CONV_DIM = SSD_INNER + 2 * SSD_GROUPS * SSD_STATE
SC_WIDTH = 1024
SC_CONV = 3
AB_PROJ = SSD_INNER + SSD_CONV_DIM + SSD_HEADS + 3 * SC_WIDTH
AB_OUT = SSD_INNER + SC_WIDTH
LRU_WIDTH = 1024
LRU_HEADS = 4
LRU_BW = LRU_WIDTH // LRU_HEADS
LRU_CONV = 4
LRU_C = 8.0
D_FF = 2816
FFN_CONV = 3

kernel_name = "hybrid_ssd_shortconv_rglru_stream_step"


def rmsnorm(x, g):
    xf = x.astype(jnp.float32)
    y = xf * lax.rsqrt(jnp.mean(xf * xf, axis=-1, keepdims=True) + EPS)
    return (y * g.astype(jnp.float32)).astype(x.dtype)


def causal_dwconv(x, w, b, buf):
    K = w.shape[0]
    L = x.shape[1]
    xp = jnp.concatenate([buf.astype(x.dtype), x], axis=1)
    y = b + sum(xp[:, k:k + L] * w[k] for k in range(K))
    return y, xp[:, L:]


def ssd_scan(x, dt, A, Bm, Cm, h0):
    b, L, H, P = x.shape
    G, N = Bm.shape[2], Bm.shape[3]
    K = H // G
    cl = CHUNK if L % CHUNK == 0 else L
    nc = L // cl
    X = (x * dt[..., None]).reshape(b, nc, cl, G, K, P)
    dA = (dt * A).reshape(b, nc, cl, G, K)
    Bc = Bm.reshape(b, nc, cl, G, N)
    Cc = Cm.reshape(b, nc, cl, G, N)
    At = jnp.moveaxis(jnp.cumsum(dA, axis=2), 2, -1)
    mask = jnp.tril(jnp.ones((cl, cl), dtype=bool))
    seg = At[..., :, None] - At[..., None, :]
    Lmat = jnp.where(mask, jnp.exp(jnp.where(mask, seg, 0.0)), 0.0)
    CB = jnp.einsum('bclgn,bcsgn->bcgls', Cc, Bc)
    y_diag = jnp.einsum('bcgls,bcgkls,bcsgkp->bclgkp', CB, Lmat, X)
    decay_states = jnp.exp(At[..., -1:] - At)
    states = jnp.einsum('bclgn,bcgkl,bclgkp->bcgkpn', Bc, decay_states, X)
    chunk_decay = jnp.exp(At[..., -1])

    def step(h, inp):
        dec, s = inp
        return dec[..., None, None] * h + s, h

    h_fin, h_enter = lax.scan(step, h0.reshape(b, G, K, P, N),
                              (jnp.moveaxis(chunk_decay, 1, 0), jnp.moveaxis(states, 1, 0)))
    h_enter = jnp.moveaxis(h_enter, 0, 1)
    y_off = jnp.einsum('bclgn,bcgkpn,bcgkl->bclgkp', Cc, h_enter, jnp.exp(At))
    y = (y_diag + y_off).reshape(b, L, H, P)
    return y, h_fin.reshape(b, H, P, N)


def mixer_ab(h, st_conv, st_ssd, st_sc, w_in, conv_w, conv_b, dt_bias, a_log, d_skip, gnorm,
             sc_conv_w, sc_conv_b, w_out):
    b, L, _ = h.shape
    dtype = h.dtype
    proj = h @ w_in
    s1 = SSD_INNER
    s2 = s1 + SSD_CONV_DIM
    s3 = s2 + SSD_HEADS
    s4 = s3 + SC_WIDTH
    s5 = s4 + SC_WIDTH
    z, xbc, dt_raw = proj[..., :s1], proj[..., s1:s2], proj[..., s2:s3]
    g_b, g_c, sh = proj[..., s3:s4], proj[..., s4:s5], proj[..., s5:]
    xbc, new_conv = causal_dwconv(xbc, conv_w, conv_b, st_conv)
    xbc = jax.nn.silu(xbc).astype(jnp.float32)
    gn = SSD_GROUPS * SSD_STATE
    xs = xbc[..., :SSD_INNER].reshape(b, L, SSD_HEADS, SSD_HEAD_DIM)
    Bm = xbc[..., SSD_INNER:SSD_INNER + gn].reshape(b, L, SSD_GROUPS, SSD_STATE)
    Cm = xbc[..., SSD_INNER + gn:].reshape(b, L, SSD_GROUPS, SSD_STATE)
    dt = jax.nn.softplus(dt_raw.astype(jnp.float32) + dt_bias.astype(jnp.float32))
    A = -jnp.exp(a_log.astype(jnp.float32))
    y, new_ssd = ssd_scan(xs, dt, A, Bm, Cm, st_ssd.astype(jnp.float32))
    y = (y + d_skip.astype(jnp.float32)[:, None] * xs).reshape(b, L, SSD_INNER)
    y = rmsnorm((y * jax.nn.silu(z.astype(jnp.float32))), gnorm).astype(dtype)
    u, new_sc = causal_dwconv(g_c * sh, sc_conv_w, sc_conv_b, st_sc)
    ysc = g_b * u
    out = jnp.concatenate([y, ysc], axis=-1) @ w_out
    return out, new_conv, new_ssd.astype(dtype), new_sc


def mixer_c(h, st_conv, st_lru, w_in, conv_w, conv_b, wa, ba, wx, bx, lam, w_out):
    b, L, _ = h.shape
    dtype = h.dtype
    proj = h @ w_in
    gate, xb = proj[..., :LRU_WIDTH], proj[..., LRU_WIDTH:]
    xb, new_conv = causal_dwconv(xb, conv_w, conv_b, st_conv)
    xh = xb.reshape(b, L, LRU_HEADS, LRU_BW)
    r = jax.nn.sigmoid(jnp.einsum('blhi,hij->blhj', xh, wa) + ba).reshape(b, L, LRU_WIDTH)
    i = jax.nn.sigmoid(jnp.einsum('blhi,hij->blhj', xh, wx) + bx).reshape(b, L, LRU_WIDTH)
    log_a = -LRU_C * r.astype(jnp.float32) * jax.nn.softplus(-lam.astype(jnp.float32))
    a = jnp.exp(log_a)
    mult = jnp.sqrt(-jnp.expm1(2.0 * log_a))
    u = mult * (i * xb).astype(jnp.float32)
    u = u.at[:, 0].add(a[:, 0] * st_lru.astype(jnp.float32))

    def comb(left, right):
        a1, b1 = left
        a2, b2 = right
        return a1 * a2, a2 * b1 + b2

    _, hs = lax.associative_scan(comb, (a, u), axis=1)
    out = (jax.nn.gelu(gate) * hs.astype(dtype)) @ w_out
    return out, new_conv, hs[:, -1].astype(dtype)


def conv_ffn(h, st, w_in, conv_w, conv_b, w_out):
    gu = h @ w_in
    g, u = gu[..., :D_FF], gu[..., D_FF:]
    g, new_st = causal_dwconv(g, conv_w, conv_b, st)
    return (jax.nn.gelu(g) * u) @ w_out, new_st


def setup_inputs(seed: int = 0) -> dict:
    key = jax.random.key(seed)
    it = iter(list(jax.random.split(key, 48)))
    f32 = jnp.float32

    def nrm(shape, s):
        return jax.random.normal(next(it), shape, f32) * s

    def uni(shape, lo, hi):
        return jax.random.uniform(next(it), shape, f32, lo, hi)

    dt0 = jnp.exp(uni((SSD_HEADS,), float(np.log(1e-3)), float(np.log(1e-1))))
    a0 = uni((LRU_WIDTH,), 0.9, 0.999)
    return {
        "x_prompt": nrm((BATCH, SEQ, D_MODEL), 1.0),
        "x_sample": nrm((DEC_BATCH, DEC_SEQ, D_MODEL), 1.0),
        "state_ssd_conv": nrm((DEC_BATCH, SSD_CONV - 1, SSD_CONV_DIM), 1.0),
        "state_ssd": nrm((DEC_BATCH, SSD_HEADS, SSD_HEAD_DIM, SSD_STATE), 0.1),
        "state_sconv": nrm((DEC_BATCH, SC_CONV - 1, SC_WIDTH), 1.0),
        "state_lru_conv": nrm((DEC_BATCH, LRU_CONV - 1, LRU_WIDTH), 1.0),
        "state_lru": nrm((DEC_BATCH, LRU_WIDTH), 0.5),
        "state_ffn_conv": nrm((DEPTH, DEC_BATCH, FFN_CONV - 1, D_FF), 1.0),
        "norm_mix": 1.0 + nrm((DEPTH, D_MODEL), 0.02),
        "norm_ffn": 1.0 + nrm((DEPTH, D_MODEL), 0.02),
        "norm_final": 1.0 + nrm((D_MODEL,), 0.02),
        "ab_w_in": nrm((D_MODEL, AB_PROJ), D_MODEL ** -0.5),
        "ssd_conv_w": nrm((SSD_CONV, SSD_CONV_DIM), SSD_CONV ** -0.5),
        "ssd_conv_b": nrm((SSD_CONV_DIM,), 0.02),
        "ssd_dt_bias": dt0 + jnp.log(-jnp.expm1(-dt0)),
        "ssd_a_log": jnp.log(uni((SSD_HEADS,), 1.0, 16.0)),
        "ssd_d": 1.0 + nrm((SSD_HEADS,), 0.1),
        "ssd_norm": 1.0 + nrm((SSD_INNER,), 0.02),
        "sc_conv_w": nrm((SC_CONV, SC_WIDTH), SC_CONV ** -0.5),
        "sc_conv_b": nrm((SC_WIDTH,), 0.02),
        "ab_w_out": nrm((AB_OUT, D_MODEL), AB_OUT ** -0.5),
        "lru_w_in": nrm((D_MODEL, 2 * LRU_WIDTH), D_MODEL ** -0.5),
        "lru_conv_w": nrm((LRU_CONV, LRU_WIDTH), LRU_CONV ** -0.5),
        "lru_conv_b": nrm((LRU_WIDTH,), 0.02),
        "lru_wa": nrm((LRU_HEADS, LRU_BW, LRU_BW), LRU_BW ** -0.5),
        "lru_ba": nrm((LRU_HEADS, LRU_BW), 0.02),
        "lru_wx": nrm((LRU_HEADS, LRU_BW, LRU_BW), LRU_BW ** -0.5),
        "lru_bx": nrm((LRU_HEADS, LRU_BW), 0.02),
        "lru_lambda": jnp.log(a0) - jnp.log1p(-a0),
        "lru_w_out": nrm((LRU_WIDTH, D_MODEL), LRU_WIDTH ** -0.5),
        "ffn_w_in": nrm((DEPTH, D_MODEL, 2 * D_FF), D_MODEL ** -0.5),
        "ffn_conv_w": nrm((DEPTH, FFN_CONV, D_FF), FFN_CONV ** -0.5),
        "ffn_conv_b": nrm((DEPTH, D_FF), 0.02),
        "ffn_w_out": nrm((DEPTH, D_FF, D_MODEL), D_FF ** -0.5),
    }


def reference(x_prompt, x_sample, state_ssd_conv, state_ssd, state_sconv, state_lru_conv, state_lru,
              state_ffn_conv, norm_mix, norm_ffn, norm_final, ab_w_in, ssd_conv_w, ssd_conv_b,
              ssd_dt_bias, ssd_a_log, ssd_d, ssd_norm, sc_conv_w, sc_conv_b, ab_w_out, lru_w_in,
              lru_conv_w, lru_conv_b, lru_wa, lru_ba, lru_wx, lru_bx, lru_lambda, lru_w_out,
              ffn_w_in, ffn_conv_w, ffn_conv_b, ffn_w_out):

    def run(x, s_ssd_conv, s_ssd, s_sc, s_lru_conv, s_lru, s_ffn):
        ffn_new = []
        for l in range(DEPTH):
            hn = rmsnorm(x, norm_mix[l])
            if l % 2 == 0:
                m, n_ssd_conv, n_ssd, n_sc = mixer_ab(
                    hn, s_ssd_conv, s_ssd, s_sc, ab_w_in, ssd_conv_w, ssd_conv_b, ssd_dt_bias,
                    ssd_a_log, ssd_d, ssd_norm, sc_conv_w, sc_conv_b, ab_w_out)
            else:
                m, n_lru_conv, n_lru = mixer_c(
                    hn, s_lru_conv, s_lru, lru_w_in, lru_conv_w, lru_conv_b, lru_wa, lru_ba,
                    lru_wx, lru_bx, lru_lambda, lru_w_out)
            x = x + m
            f, nf = conv_ffn(rmsnorm(x, norm_ffn[l]), s_ffn[l], ffn_w_in[l], ffn_conv_w[l],
                             ffn_conv_b[l], ffn_w_out[l])
            x = x + f
            ffn_new.append(nf)
        return (rmsnorm(x, norm_final), n_ssd_conv, n_ssd, n_sc, n_lru_conv, n_lru,
                jnp.stack(ffn_new, axis=0))

    bp = x_prompt.shape[0]
    dtp = x_prompt.dtype
    y_prompt, p_ssd_conv, p_ssd, p_sconv, p_lru_conv, p_lru, p_ffn_conv = run(
        x_prompt,
        jnp.zeros((bp, SSD_CONV - 1, SSD_CONV_DIM), dtp),
        jnp.zeros((bp, SSD_HEADS, SSD_HEAD_DIM, SSD_STATE), dtp),
        jnp.zeros((bp, SC_CONV - 1, SC_WIDTH), dtp),
        jnp.zeros((bp, LRU_CONV - 1, LRU_WIDTH), dtp),
        jnp.zeros((bp, LRU_WIDTH), dtp),
        jnp.zeros((DEPTH, bp, FFN_CONV - 1, D_FF), dtp))
    y_sample, s_ssd_conv, s_ssd, s_sconv, s_lru_conv, s_lru, s_ffn_conv = run(
        x_sample, state_ssd_conv, state_ssd, state_sconv, state_lru_conv, state_lru,
        state_ffn_conv)
    return (y_prompt, y_sample, p_ssd_conv, p_ssd, p_sconv, p_lru_conv, p_lru, p_ffn_conv,
            s_ssd_conv, s_ssd, s_sconv, s_lru_conv, s_lru, s_ffn_conv)
```

```cpp
#include <hip/hip_runtime.h>
#include <hip/hip_cooperative_groups.h>
#include <cstdio>
namespace cg = cooperative_groups;

#define LAS __attribute__((address_space(3)))
typedef unsigned short bf16_t;
typedef short bf16x8 __attribute__((ext_vector_type(8)));
typedef float f32x4 __attribute__((ext_vector_type(4)));
typedef unsigned u32x4 __attribute__((ext_vector_type(4)));
typedef unsigned u32x2 __attribute__((ext_vector_type(2)));

constexpr int TP = 65536;
constexpr int TS = 512;
constexpr int T = TP + TS;
constexpr int DM = 1024;
constexpr int DFF = 2816;
constexpr int XBC = 1536;
constexpr int N1 = 5888;
constexpr float EPS = 1e-6f;
constexpr int NTHREADS = 512;
constexpr int LDS_BYTES = 131072 + 4096;

constexpr size_t O_Y = 0;
constexpr size_t O_P_SSDCONV = (size_t)T * DM;
constexpr size_t O_P_SSD = O_P_SSDCONV + 16 * 3 * XBC;
constexpr size_t O_P_SCONV = O_P_SSD + (size_t)16 * 16 * 64 * 128;
constexpr size_t O_P_LRUCONV = O_P_SCONV + 16 * 2 * 1024;
constexpr size_t O_P_LRU = O_P_LRUCONV + 16 * 3 * 1024;
constexpr size_t O_P_FFNCONV = O_P_LRU + 16 * 1024;
constexpr size_t O_S_SSDCONV = O_P_FFNCONV + 2 * 16 * 2 * DFF;
constexpr size_t O_S_SSD = O_S_SSDCONV + 8 * 3 * XBC;
constexpr size_t O_S_SCONV = O_S_SSD + (size_t)8 * 16 * 64 * 128;
constexpr size_t O_S_LRUCONV = O_S_SCONV + 8 * 2 * 1024;
constexpr size_t O_S_LRU = O_S_LRUCONV + 8 * 3 * 1024;
constexpr size_t O_S_FFNCONV = O_S_LRU + 8 * 1024;
constexpr size_t O_END = O_S_FFNCONV + 2 * 8 * 2 * DFF;

constexpr size_t al256(size_t x) { return (x + 255) & ~(size_t)255; }
constexpr size_t WS_W1 = 0;
constexpr size_t WS_W2 = WS_W1 + (size_t)N1 * 1024 * 2;
constexpr size_t WS_W3 = WS_W2 + (size_t)1024 * 2048 * 2;
constexpr size_t WS_W4 = WS_W3 + (size_t)2 * 5632 * 1024 * 2;
constexpr size_t WS_W5 = WS_W4 + (size_t)2 * 1024 * 2816 * 2;
constexpr size_t WS_W6 = WS_W5 + (size_t)2048 * 1024 * 2;
constexpr size_t WS_W7 = WS_W6 + (size_t)2048 * 256 * 2;
constexpr size_t WS_SP = WS_W7 + (size_t)1024 * 1024 * 2;
constexpr size_t WS_SSQ = WS_SP + 4096;
constexpr size_t WS_SL = al256(WS_SSQ + (size_t)T * 4);
constexpr size_t WS_HH = WS_SL + (size_t)1032 * 1024 * 4;
constexpr size_t WS_CIN = WS_HH + (size_t)1032 * 1024 * 4;
constexpr size_t WS_XN = al256(WS_CIN + (size_t)1032 * 1024 * 4);
constexpr size_t WS_ARENA = al256(WS_XN + (size_t)T * 1024 * 2);
constexpr size_t WS_A2 = WS_ARENA;
constexpr size_t WS_XBCP = WS_A2 + (size_t)T * 2048 * 2;
constexpr size_t WS_XBCA = WS_XBCP + (size_t)T * XBC * 2;
constexpr size_t WS_V = WS_XBCA + (size_t)T * XBC * 2;
constexpr size_t WS_DT = WS_V + (size_t)T * 1024 * 2;
constexpr size_t WS_END0 = WS_DT + (size_t)T * 16 * 4;
constexpr size_t WS_GP = WS_ARENA;
constexpr size_t WS_U = WS_GP + (size_t)T * DFF * 2;
constexpr size_t WS_END1 = WS_U + (size_t)T * DFF * 2;
constexpr size_t WS_GATE = WS_ARENA;
constexpr size_t WS_XBP = WS_GATE + (size_t)T * 1024 * 2;
constexpr size_t WS_XBC2 = WS_XBP + (size_t)T * 1024 * 2;
constexpr size_t WS_LA = WS_XBC2 + (size_t)T * 1024 * 2;
constexpr size_t WS_UU = WS_LA + (size_t)T * 1024 * 2;
constexpr size_t WS_END2 = WS_UU + (size_t)T * 1024 * 2;
constexpr size_t WS_NEED = WS_END0 > WS_END1 ? (WS_END0 > WS_END2 ? WS_END0 : WS_END2) : (WS_END1 > WS_END2 ? WS_END1 : WS_END2);

struct Params {
    const float* ptr[36];
};
__device__ __forceinline__ const float* IN(const Params& p, int i) { asm volatile("" : "+s"(i)); return p.ptr[i]; }
#define P_OUT(p) ((float*)IN(p, 34))
#define P_WS(p) ((unsigned char*)IN(p, 35))
enum { I_XP = 0, I_XS, I_ST_SSDCONV, I_ST_SSD, I_ST_SCONV, I_ST_LRUCONV, I_ST_LRU, I_ST_FFNCONV, I_NORM_MIX, I_NORM_FFN, I_NORM_FINAL,
       I_AB_WIN, I_SSD_CONVW, I_SSD_CONVB, I_DT_BIAS, I_A_LOG, I_SSD_D, I_SSD_NORM, I_SC_CONVW, I_SC_CONVB, I_AB_WOUT, I_LRU_WIN,
       I_LRU_CONVW, I_LRU_CONVB, I_LRU_WA, I_LRU_BA, I_LRU_WX, I_LRU_BX, I_LRU_LAMBDA, I_LRU_WOUT, I_FFN_WIN, I_FFN_CONVW, I_FFN_CONVB, I_FFN_WOUT };

struct Ctx { int bid, nblk, tid; };
__device__ __forceinline__ unsigned cvt_pk_bf16(float lo, float hi) { unsigned r; asm("v_cvt_pk_bf16_f32 %0, %1, %2" : "=v"(r) : "v"(lo), "v"(hi)); return r; }
__device__ __forceinline__ float bf_lo(unsigned w) { return __uint_as_float(w << 16); }
__device__ __forceinline__ float bf_hi(unsigned w) { return __uint_as_float(w & 0xffff0000u); }
__device__ __forceinline__ float sigmoidf_(float x) { return 1.0f / (1.0f + __expf(-x)); }
__device__ __forceinline__ float siluf_(float x) { return x / (1.0f + __expf(-x)); }
__device__ __forceinline__ float geluf_(float x) { const float u = 1.5957691216f * (x + 0.044715f * x * x * x); return x / (1.0f + __expf(-u)); }
__device__ __forceinline__ float softplusf_(float x) { return fmaxf(x, 0.0f) + log1pf(__expf(-fabsf(x))); }
__device__ __forceinline__ void unpack8(const u32x4 w, float (&f)[8]) {
    f[0] = bf_lo(w.x); f[1] = bf_hi(w.x); f[2] = bf_lo(w.y); f[3] = bf_hi(w.y); f[4] = bf_lo(w.z); f[5] = bf_hi(w.z); f[6] = bf_lo(w.w); f[7] = bf_hi(w.w);
}
__device__ __forceinline__ u32x4 pack8(const float (&f)[8]) {
    u32x4 w; w.x = cvt_pk_bf16(f[0], f[1]); w.y = cvt_pk_bf16(f[2], f[3]); w.z = cvt_pk_bf16(f[4], f[5]); w.w = cvt_pk_bf16(f[6], f[7]); return w;
}
__device__ __forceinline__ u32x4 pack44(const f32x4 a, const f32x4 b) {
    u32x4 w; w.x = cvt_pk_bf16(a[0], a[1]); w.y = cvt_pk_bf16(a[2], a[3]); w.z = cvt_pk_bf16(b[0], b[1]); w.w = cvt_pk_bf16(b[2], b[3]); return w;
}

constexpr int BM = 256, BK = 64, HALF = 128, HTB = HALF * BK * 2, NXCD = 8, WGM = 8;
__device__ __forceinline__ int lds_byte(int r, int c) { const int st = (r >> 4) * 2 + (c >> 5), rr = r & 15, cc = c & 31, ob = rr * 64 + cc * 2; return st * 1024 + (ob ^ (((ob >> 9) & 1) << 5)); }
__device__ __forceinline__ void stage_rc(int b, int& R, int& C) { const int st = b / 1024, sb = b % 1024, swz = sb ^ (((sb >> 9) & 1) << 5); R = (st >> 1) * 16 + swz / 64; C = (st & 1) * 32 + (swz % 64) / 2; }
__device__ __forceinline__ int perm32(int rho) { const int n = rho >> 4, i = rho & 15; return 8 * (i >> 2) + 4 * n + (i & 3); }

struct Unit { int pm, pn; };
struct Gemm { const bf16_t* A; const bf16_t* Bt; int M, N, K, lda, a_shift, a_koff; };

struct StaticOrder {
    int nM, nN, nwg, G, c;
    __device__ void init(int M, int N, int G_, int c_) { nM = M / BM; nN = N / BM; nwg = nM * nN; G = G_; c = c_; }
    __device__ bool next(int i, Unit& u) const {
        const long L = (long)i * G + c; if (L >= nwg) return false;
        int wgid = (int)L; { const int q = nwg / NXCD, r = nwg % NXCD, xcd = wgid % NXCD, off = wgid / NXCD; wgid = (xcd < r ? xcd * (q + 1) : r * (q + 1) + (xcd - r) * q) + off; }
        const int nig = WGM * nN, gid = wgid / nig, fm = gid * WGM, gsz = (nM - fm) < WGM ? (nM - fm) : WGM;
        u.pm = fm + ((wgid % nig) % gsz); u.pn = (wgid % nig) / gsz; return true;
    }
};

template <class Epi, bool MIDSCALE>
__device__ __forceinline__ void gemm_phase(const Ctx cx, LAS unsigned char* lds, const Gemm g, const Epi& E, const float* ssq) {
    const int tid = cx.tid, wid = __builtin_amdgcn_readfirstlane(tid >> 6), lane = tid & 63, wr = wid >> 2, wc = wid & 3, fr = lane & 15, fq = lane >> 4;
    int K_ = g.K; asm volatile("" : "+s"(K_));
    const int K = K_, nt = K / BK;
    StaticOrder S; S.init(g.M, g.N, cx.nblk, cx.bid);
    unsigned voffA[2], voffB[2];
#pragma unroll
    for (int i = 0; i < 2; ++i) { int R, C; stage_rc(tid * 16 + i * 8192, R, C); const int Rb = Epi::PERM ? ((R & ~31) + perm32(R & 31)) : R;
        voffA[i] = (unsigned)(R * g.lda + C) * 2u; voffB[i] = (unsigned)(Rb * K + C) * 2u; }
    const size_t kstep = (size_t)(BK * 2);
    const size_t hsA = (size_t)HALF * g.lda * 2, hsB = (size_t)HALF * K * 2;
    const size_t tsA = 2 * hsA, tsB = 2 * hsB;
    const unsigned ldsw = (unsigned)wid * 1024u;
    const int aoff = lds_byte(wr * 64 + fr, fq * 8), boff = lds_byte(wc * 32 + fr, fq * 8);
#define SA_(b, h) (((b) * 2 + (h)) * HTB)
#define SB_(b, h) ((4 + (b) * 2 + (h)) * HTB)
#define STAGE_(bufoff, gbase, voff) do { _Pragma("unroll") for (int _i = 0; _i < 2; ++_i) \
        __builtin_amdgcn_global_load_lds((const unsigned*)((const char*)(gbase) + (voff)[_i]), (LAS unsigned*)(lds + (bufoff) + ldsw + _i * 8192), 16, 0, 0); } while (0)
#define LDA_(dst, b, h) do { _Pragma("unroll") for (int m = 0; m < 4; ++m) _Pragma("unroll") for (int k = 0; k < 2; ++k) dst[m][k] = *(const LAS bf16x8*)(lds + SA_(b, h) + aoff + m * 2048 + k * 1024); } while (0)
#define LDB_(dst, b, h) do { _Pragma("unroll") for (int n = 0; n < 2; ++n) _Pragma("unroll") for (int k = 0; k < 2; ++k) dst[n][k] = *(const LAS bf16x8*)(lds + SB_(b, h) + boff + n * 2048 + k * 1024); } while (0)
#define MMA_(ai, bj, At, Bt) do { __builtin_amdgcn_s_setprio(1); _Pragma("unroll") for (int m = 0; m < 4; ++m) _Pragma("unroll") for (int n = 0; n < 2; ++n) _Pragma("unroll") for (int k = 0; k < 2; ++k) \
        acc[ai][bj][m][n] = __builtin_amdgcn_mfma_f32_16x16x32_bf16(Bt[n][k], At[m][k], acc[ai][bj][m][n], 0, 0, 0); __builtin_amdgcn_s_setprio(0); } while (0)
#define WAIT_V_(n) asm volatile("s_waitcnt vmcnt(" #n ")" ::: "memory")
#define WAIT_L_(n) asm volatile("s_waitcnt lgkmcnt(" #n ")" ::: "memory")
#define BAR_ __builtin_amdgcn_s_barrier()
#define SCHED_ __builtin_amdgcn_sched_barrier(0)
    Unit cur, nxt; int ui = 0;
    if (!S.next(0, cur)) return;
    f32x4 acc[2][2][4][2];
#pragma unroll
    for (int a = 0; a < 2; ++a)
#pragma unroll
        for (int b = 0; b < 2; ++b)
#pragma unroll
            for (int m = 0; m < 4; ++m)
#pragma unroll
                for (int n = 0; n < 2; ++n) acc[a][b][m][n] = (f32x4){0.f, 0.f, 0.f, 0.f};
    bf16x8 At[4][2], B0[2][2], B1[2][2];
    const char* cA = (const char*)g.A + (size_t)cur.pm * tsA + (size_t)((cur.pn >> g.a_shift) * g.a_koff) * 2;
    const char* cB = (const char*)g.Bt + (size_t)cur.pn * tsB;
    STAGE_(SB_(0, 0), cB, voffB); STAGE_(SA_(0, 0), cA, voffA); STAGE_(SB_(0, 1), cB + hsB, voffB); STAGE_(SA_(0, 1), cA + hsA, voffA);
    if (wr == 1) BAR_;
    WAIT_V_(4); BAR_;
    STAGE_(SB_(1, 0), cB + kstep, voffB); STAGE_(SA_(1, 0), cA + kstep, voffA); STAGE_(SB_(1, 1), cB + hsB + kstep, voffB);
    WAIT_V_(6); BAR_;
    for (;;) {
        const bool has_next = S.next(ui + 1, nxt);
        const char* nA = has_next ? (const char*)g.A + (size_t)nxt.pm * tsA + (size_t)((nxt.pn >> g.a_shift) * g.a_koff) * 2 : cA;
        const char* nB = has_next ? (const char*)g.Bt + (size_t)nxt.pn * tsB : cB;
        for (int t = 0; t < nt; t += 2) {
            const bool last = (t == nt - 2);
            const char* a1 = cA + (size_t)(t + 1) * kstep;
            const char* a2 = last ? nA : cA + (size_t)(t + 2) * kstep; const char* b2 = last ? nB : cB + (size_t)(t + 2) * kstep;
            const char* a3 = a2 + kstep; const char* b3 = b2 + kstep;
            if (MIDSCALE && t == 16) {
                int rb = cur.pm * BM + wr * 64 + fr; asm volatile("" : "+v"(rb));
#pragma unroll
                for (int ai = 0; ai < 2; ++ai)
#pragma unroll
                    for (int m = 0; m < 4; ++m) {
                        const float sc = rsqrtf(ssq[rb + ai * HALF + m * 16] * (1.0f / 1024.0f) + EPS);
#pragma unroll
                        for (int bj = 0; bj < 2; ++bj)
#pragma unroll
                            for (int n = 0; n < 2; ++n) acc[ai][bj][m][n] *= sc;
                    }
            }
            LDB_(B0, 0, 0); SCHED_; LDA_(At, 0, 0); STAGE_(SA_(1, 1), a1 + hsA, voffA);
            WAIT_L_(8); BAR_; WAIT_L_(0); MMA_(0, 0, At, B0); BAR_; SCHED_;
            LDB_(B1, 0, 1); STAGE_(SB_(0, 0), b2, voffB);
            BAR_; WAIT_L_(0); MMA_(0, 1, At, B1); BAR_;
            LDA_(At, 0, 1); STAGE_(SA_(0, 0), a2, voffA);
            BAR_; WAIT_L_(0); MMA_(1, 0, At, B0); BAR_; SCHED_;
            STAGE_(SB_(0, 1), b2 + hsB, voffB);
            WAIT_V_(6); BAR_; MMA_(1, 1, At, B1); BAR_;
            LDB_(B0, 1, 0); SCHED_; LDA_(At, 1, 0); STAGE_(SA_(0, 1), a2 + hsA, voffA);
            WAIT_L_(8); BAR_; WAIT_L_(0); MMA_(0, 0, At, B0); BAR_; SCHED_;
            LDB_(B1, 1, 1); STAGE_(SB_(1, 0), b3, voffB);
            BAR_; WAIT_L_(0); MMA_(0, 1, At, B1); BAR_;
            LDA_(At, 1, 1); STAGE_(SA_(1, 0), a3, voffA);
            BAR_; WAIT_L_(0); MMA_(1, 0, At, B0); BAR_; SCHED_;
            STAGE_(SB_(1, 1), b3 + hsB, voffB);
            WAIT_V_(6); BAR_; MMA_(1, 1, At, B1); BAR_;
        }
        E(acc, cur, wr, wc, fr, fq);
        if (!has_next) break;
#pragma unroll
        for (int a = 0; a < 2; ++a)
#pragma unroll
            for (int b = 0; b < 2; ++b)
#pragma unroll
                for (int m = 0; m < 4; ++m)
#pragma unroll
                    for (int n = 0; n < 2; ++n) acc[a][b][m][n] = (f32x4){0.f, 0.f, 0.f, 0.f};
        cur = nxt; cA = nA; cB = nB; ++ui;
    }
    WAIT_V_(0);
    if (wr == 0) BAR_;
    BAR_;
#undef SA_
#undef SB_
#undef STAGE_
#undef LDA_
#undef LDB_
#undef MMA_
}

struct EpiG1 {
    static constexpr bool PERM = true;
    bf16_t* A2; bf16_t* XBCP; bf16_t* V; float* DT; const float* dt_bias;
    __device__ __forceinline__ void operator()(const f32x4 (&acc)[2][2][4][2], const Unit& u, int wr, int wc, int fr, int fq) const {
        const int row0 = u.pm * BM + wr * 64 + fr, lc = wc * 32 + 8 * fq;
        if (u.pn < 14) {
            bf16_t* base; int ld, colt;
            if (u.pn < 4) { base = A2; ld = 2048; colt = u.pn * 256; }
            else if (u.pn < 10) { base = XBCP; ld = XBC; colt = (u.pn - 4) * 256; }
            else { base = A2; ld = 2048; colt = 1024 + (u.pn - 10) * 256; }
#pragma unroll
            for (int ai = 0; ai < 2; ++ai)
#pragma unroll
                for (int m = 0; m < 4; ++m) { bf16_t* rowp = base + (size_t)(row0 + ai * HALF + m * 16) * ld + colt + lc;
#pragma unroll
                    for (int bj = 0; bj < 2; ++bj) *(u32x4*)(rowp + bj * HALF) = pack44(acc[ai][bj][m][0], acc[ai][bj][m][1]); }
        } else if (u.pn < 22) {
            const int ch0 = (u.pn - 14) * 128 + lc;
#pragma unroll
            for (int ai = 0; ai < 2; ++ai)
#pragma unroll
                for (int m = 0; m < 4; ++m) { bf16_t* rowp = V + (size_t)(row0 + ai * HALF + m * 16) * 1024 + ch0;
                    *(u32x4*)rowp = pack44(acc[ai][0][m][0] * acc[ai][1][m][0], acc[ai][0][m][1] * acc[ai][1][m][1]); }
        } else {
            if (wc == 0 && fq < 2) {
                const f32x4 b0 = *(const f32x4*)(dt_bias + 8 * fq), b1 = *(const f32x4*)(dt_bias + 8 * fq + 4);
#pragma unroll
                for (int ai = 0; ai < 2; ++ai)
#pragma unroll
                    for (int m = 0; m < 4; ++m) { float* rowp = DT + (size_t)(row0 + ai * HALF + m * 16) * 16 + 8 * fq;
                        f32x4 v0 = acc[ai][0][m][0] + b0, v1 = acc[ai][0][m][1] + b1;
#pragma unroll
                        for (int j = 0; j < 4; ++j) { v0[j] = softplusf_(v0[j]); v1[j] = softplusf_(v1[j]); }
                        *(f32x4*)rowp = v0; *(f32x4*)(rowp + 4) = v1; }
            }
        }
    }
};
struct EpiRes {
    static constexpr bool PERM = false;
    const float* xp; const float* xs; float* out;
    __device__ __forceinline__ void operator()(const f32x4 (&acc)[2][2][4][2], const Unit& u, int wr, int wc, int fr, int fq) const {
        const int row0 = u.pm * BM + wr * 64 + fr, col0 = u.pn * BM + wc * 32 + 4 * fq;
#pragma unroll
        for (int ai = 0; ai < 2; ++ai)
#pragma unroll
            for (int m = 0; m < 4; ++m) { const int row = row0 + ai * HALF + m * 16;
                const float* src = row < TP ? xp + (size_t)row * DM : xs + (size_t)(row - TP) * DM;
                float* dstp = out + (size_t)row * DM + col0;
#pragma unroll
                for (int bj = 0; bj < 2; ++bj)
#pragma unroll
                    for (int n = 0; n < 2; ++n) *(f32x4*)(dstp + bj * HALF + n * 16) = *(const f32x4*)(src + col0 + bj * HALF + n * 16) + acc[ai][bj][m][n]; }
    }
};
struct EpiFfnIn {
    static constexpr bool PERM = true;
    bf16_t* GP; bf16_t* U;
    __device__ __forceinline__ void operator()(const f32x4 (&acc)[2][2][4][2], const Unit& u, int wr, int wc, int fr, int fq) const {
        const int row0 = u.pm * BM + wr * 64 + fr, ch0 = u.pn * 128 + wc * 32 + 8 * fq;
#pragma unroll
        for (int ai = 0; ai < 2; ++ai)
#pragma unroll
            for (int m = 0; m < 4; ++m) { const size_t o = (size_t)(row0 + ai * HALF + m * 16) * DFF + ch0;
                *(u32x4*)(GP + o) = pack44(acc[ai][0][m][0], acc[ai][0][m][1]); *(u32x4*)(U + o) = pack44(acc[ai][1][m][0], acc[ai][1][m][1]); }
    }
};
struct EpiLruIn {
    static constexpr bool PERM = true;
    bf16_t* GATE; bf16_t* XBP;
    __device__ __forceinline__ void operator()(const f32x4 (&acc)[2][2][4][2], const Unit& u, int wr, int wc, int fr, int fq) const {
        const int row0 = u.pm * BM + wr * 64 + fr, lc = wc * 32 + 8 * fq;
        const bool isgate = u.pn < 4;
        bf16_t* base = isgate ? GATE : XBP; const int colt = (isgate ? u.pn : u.pn - 4) * 256 + lc;
#pragma unroll
        for (int ai = 0; ai < 2; ++ai)
#pragma unroll
            for (int m = 0; m < 4; ++m) { bf16_t* rowp = base + (size_t)(row0 + ai * HALF + m * 16) * 1024 + colt;
#pragma unroll
                for (int bj = 0; bj < 2; ++bj) { f32x4 v0 = acc[ai][bj][m][0], v1 = acc[ai][bj][m][1];
                    if (isgate) {
#pragma unroll
                        for (int j = 0; j < 4; ++j) { v0[j] = geluf_(v0[j]); v1[j] = geluf_(v1[j]); } }
                    *(u32x4*)(rowp + bj * HALF) = pack44(v0, v1); } }
    }
};
struct EpiLruGate {
    static constexpr bool PERM = true;
    const bf16_t* XBC2; bf16_t* LA; bf16_t* UU; const float* ba; const float* bx; const float* sp;
    __device__ __forceinline__ void operator()(const f32x4 (&acc)[2][2][4][2], const Unit& u, int wr, int wc, int fr, int fq) const {
        const int row0 = u.pm * BM + wr * 64 + fr, ch0 = (u.pn >> 1) * 256 + (u.pn & 1) * 128 + wc * 32 + 8 * fq;
#pragma unroll
        for (int ai = 0; ai < 2; ++ai)
#pragma unroll
            for (int m = 0; m < 4; ++m) {
#pragma unroll
                for (int n = 0; n < 2; ++n) { const size_t o = (size_t)(row0 + ai * HALF + m * 16) * 1024 + ch0 + 4 * n;
                    const u32x2 xw = *(const u32x2*)(XBC2 + o);
                    const f32x4 vba = *(const f32x4*)(ba + ch0 + 4 * n), vbx = *(const f32x4*)(bx + ch0 + 4 * n), vsp = *(const f32x4*)(sp + ch0 + 4 * n);
                    const float xb[4] = {bf_lo(xw.x), bf_hi(xw.x), bf_lo(xw.y), bf_hi(xw.y)};
                    float la[4], uu[4];
#pragma unroll
                    for (int j = 0; j < 4; ++j) {
                        const float r = sigmoidf_(acc[ai][0][m][n][j] + vba[j]), ig = sigmoidf_(acc[ai][1][m][n][j] + vbx[j]);
                        const float l = -8.0f * r * vsp[j]; la[j] = l;
                        const float mult = sqrtf(fmaxf(0.0f, 1.0f - __expf(2.0f * l)));
                        uu[j] = mult * ig * xb[j]; }
                    u32x2 w1, w2; w1.x = cvt_pk_bf16(la[0], la[1]); w1.y = cvt_pk_bf16(la[2], la[3]); w2.x = cvt_pk_bf16(uu[0], uu[1]); w2.y = cvt_pk_bf16(uu[2], uu[3]);
                    *(u32x2*)(LA + o) = w1; *(u32x2*)(UU + o) = w2; }
                asm volatile("" ::: "memory"); }
    }
};

__device__ __forceinline__ void wconv_tile(const Ctx cx, const float* src, int ld_src, int nvalid, const float* gain, int k0, bf16_t* dst, int K, LAS unsigned char* lds) {
    const int tid = cx.tid; LAS bf16_t* L = (LAS bf16_t*)lds;
    { const int j = tid & 63, kk = tid >> 6;
#pragma unroll
      for (int i = 0; i < 8; ++i) { const int k = kk + 8 * i; float v = 0.f; if (j < nvalid) { v = src[(size_t)k * ld_src + j]; if (gain) v *= gain[k0 + k]; }
          L[j * 66 + k] = (bf16_t)(cvt_pk_bf16(v, 0.f) & 0xffffu); } }
    __syncthreads();
    { const int n = tid >> 3, kq = tid & 7; const LAS unsigned* q = (const LAS unsigned*)(L + n * 66 + kq * 8);
      u32x4 w; w.x = q[0]; w.y = q[1]; w.z = q[2]; w.w = q[3];
      *(u32x4*)(dst + (size_t)n * K + kq * 8) = w; }
    __syncthreads();
}
__device__ __forceinline__ void phase_prep(const Ctx cx, const Params& p, LAS unsigned char* lds) {
    unsigned char* ws = P_WS(p);
    constexpr int NT1 = 92 * 16, NT2 = 16 * 32, NT3 = 88 * 16, NT4 = 16 * 44, NT5 = 32 * 16, NT6 = 32 * 4, NT7 = 16 * 16;
    constexpr int NTASK = NT1 + NT2 + 2 * NT3 + 2 * NT4 + NT5 + NT6 + NT7;
    for (int task = cx.bid; task < NTASK; task += cx.nblk) {
        int id = task;
        if (id < NT1) { const int ntile = id / 16, kt = id % 16, n0 = ntile * 64, k0 = kt * 64, pn = n0 >> 8, lc0 = n0 & 255;
            int col, nv = 64;
            if (pn < 10) col = n0; else if (pn < 14) col = 2576 + (n0 - 2560);
            else if (pn < 22) col = (lc0 < 128 ? 3600 : 4624) + (pn - 14) * 128 + (lc0 & 127);
            else { col = 2560; nv = (lc0 == 0) ? 16 : 0; }
            wconv_tile(cx, IN(p, I_AB_WIN) + (size_t)k0 * 5648 + col, 5648, nv, IN(p, I_NORM_MIX), k0, (bf16_t*)(ws + WS_W1) + (size_t)n0 * 1024 + k0, 1024, lds); continue; }
        id -= NT1;
        if (id < NT2) { const int ntile = id / 32, kt = id % 32, n0 = ntile * 64, k0 = kt * 64;
            wconv_tile(cx, IN(p, I_AB_WOUT) + (size_t)k0 * 1024 + n0, 1024, 64, k0 < 1024 ? IN(p, I_SSD_NORM) : nullptr, k0, (bf16_t*)(ws + WS_W2) + (size_t)n0 * 2048 + k0, 2048, lds); continue; }
        id -= NT2;
        if (id < 2 * NT3) { const int l = id / NT3; id -= l * NT3; const int ntile = id / 16, kt = id % 16, n0 = ntile * 64, k0 = kt * 64, pn = n0 >> 8, lc0 = n0 & 255;
            const int col = (lc0 < 128 ? 0 : DFF) + pn * 128 + (lc0 & 127);
            wconv_tile(cx, IN(p, I_FFN_WIN) + (size_t)l * 1024 * 5632 + (size_t)k0 * 5632 + col, 5632, 64, IN(p, I_NORM_FFN) + l * 1024, k0, (bf16_t*)(ws + WS_W3) + (size_t)l * 5632 * 1024 + (size_t)n0 * 1024 + k0, 1024, lds); continue; }
        id -= 2 * NT3;
        if (id < 2 * NT4) { const int l = id / NT4; id -= l * NT4; const int ntile = id / 44, kt = id % 44, n0 = ntile * 64, k0 = kt * 64;
            wconv_tile(cx, IN(p, I_FFN_WOUT) + (size_t)l * DFF * 1024 + (size_t)k0 * 1024 + n0, 1024, 64, nullptr, k0, (bf16_t*)(ws + WS_W4) + (size_t)l * 1024 * DFF + (size_t)n0 * DFF + k0, DFF, lds); continue; }
        id -= 2 * NT4;
        if (id < NT5) { const int ntile = id / 16, kt = id % 16, n0 = ntile * 64, k0 = kt * 64;
            wconv_tile(cx, IN(p, I_LRU_WIN) + (size_t)k0 * 2048 + n0, 2048, 64, IN(p, I_NORM_MIX) + 1024, k0, (bf16_t*)(ws + WS_W5) + (size_t)n0 * 1024 + k0, 1024, lds); continue; }
        id -= NT5;
        if (id < NT6) { const int ntile = id / 4, kt = id % 4, n0 = ntile * 64, k0 = kt * 64, head = n0 >> 9, within = n0 & 511, pnl = within >> 8, lc0 = within & 255;
            const int ch = pnl * 128 + (lc0 & 127);
            const float* srcm = (lc0 < 128 ? IN(p, I_LRU_WA) : IN(p, I_LRU_WX)) + (size_t)head * 65536;
            wconv_tile(cx, srcm + (size_t)k0 * 256 + ch, 256, 64, nullptr, k0, (bf16_t*)(ws + WS_W6) + (size_t)n0 * 256 + k0, 256, lds); continue; }
        id -= NT6;
        { const int ntile = id / 16, kt = id % 16, n0 = ntile * 64, k0 = kt * 64;
            wconv_tile(cx, IN(p, I_LRU_WOUT) + (size_t)k0 * 1024 + n0, 1024, 64, nullptr, k0, (bf16_t*)(ws + WS_W7) + (size_t)n0 * 1024 + k0, 1024, lds); }
    }
    const int gt = cx.bid * NTHREADS + cx.tid, gs = cx.nblk * NTHREADS;
    for (int i = gt; i < 1024; i += gs) ((float*)(ws + WS_SP))[i] = softplusf_(-IN(p, I_LRU_LAMBDA)[i]);
    for (int i = gt; i < T; i += gs) ((float*)(ws + WS_SSQ))[i] = 0.f;
}

__device__ __forceinline__ void phase_norm(const Ctx cx, const float* xp, const float* xs, bf16_t* XN) {
    const int wid = cx.tid >> 6, lane = cx.tid & 63;
    for (int row = cx.bid * 8 + wid; row < T; row += cx.nblk * 8) {
        const float* src = row < TP ? xp + (size_t)row * DM : xs + (size_t)(row - TP) * DM;
        f32x4 v[4]; float s = 0.f;
#pragma unroll
        for (int j = 0; j < 4; ++j) { v[j] = *(const f32x4*)(src + lane * 4 + j * 256); s += v[j][0] * v[j][0] + v[j][1] * v[j][1] + v[j][2] * v[j][2] + v[j][3] * v[j][3]; }
#pragma unroll
        for (int o = 32; o >= 1; o >>= 1) s += __shfl_xor(s, o);
        const float rs = rsqrtf(s * (1.0f / 1024.0f) + EPS);
#pragma unroll
        for (int j = 0; j < 4; ++j) { u32x2 w; w.x = cvt_pk_bf16(v[j][0] * rs, v[j][1] * rs); w.y = cvt_pk_bf16(v[j][2] * rs, v[j][3] * rs);
            *(u32x2*)(XN + (size_t)row * DM + lane * 4 + j * 256) = w; }
    }
}
__device__ __forceinline__ void phase_final_norm(const Ctx cx, float* x, const float* gain) {
    const int wid = cx.tid >> 6, lane = cx.tid & 63;
    f32x4 gv[4];
#pragma unroll
    for (int j = 0; j < 4; ++j) gv[j] = *(const f32x4*)(gain + lane * 4 + j * 256);
    for (int row = cx.bid * 8 + wid; row < T; row += cx.nblk * 8) {
        float* src = x + (size_t)row * DM;
        f32x4 v[4]; float s = 0.f;
#pragma unroll
        for (int j = 0; j < 4; ++j) { v[j] = *(const f32x4*)(src + lane * 4 + j * 256); s += v[j][0] * v[j][0] + v[j][1] * v[j][1] + v[j][2] * v[j][2] + v[j][3] * v[j][3]; }
#pragma unroll
        for (int o = 32; o >= 1; o >>= 1) s += __shfl_xor(s, o);
        const float rs = rsqrtf(s * (1.0f / 1024.0f) + EPS);
#pragma unroll
        for (int j = 0; j < 4; ++j) *(f32x4*)(src + lane * 4 + j * 256) = v[j] * rs * gv[j];
    }
}

template <int KW, int MODE>
__device__ __forceinline__ void phase_conv(const Ctx cx, const bf16_t* src, int ld_src, int NC, const float* w, const float* bias, bf16_t* dst, int ld_dst,
                           const float* st_in, float* out_p, float* out_s) {
    const int ncg = NC >> 3, total = (T / 16) * ncg;
    for (int item = cx.bid * NTHREADS + cx.tid; item < total; item += cx.nblk * NTHREADS) {
        const int cgi = item % ncg, seg = item / ncg, c0 = cgi * 8, r0 = seg * 16;
        int seq, t0, L; if (r0 < TP) { seq = r0 >> 12; t0 = r0 & 4095; L = 4096; } else { seq = 16 + ((r0 - TP) >> 6); t0 = (r0 - TP) & 63; L = 64; }
        float wv[KW][8], bv[8];
#pragma unroll
        for (int k = 0; k < KW; ++k) { const f32x4 a = *(const f32x4*)(w + (size_t)k * NC + c0), b = *(const f32x4*)(w + (size_t)k * NC + c0 + 4);
#pragma unroll
            for (int j = 0; j < 4; ++j) { wv[k][j] = a[j]; wv[k][4 + j] = b[j]; } }
        { const f32x4 a = *(const f32x4*)(bias + c0), b = *(const f32x4*)(bias + c0 + 4);
#pragma unroll
          for (int j = 0; j < 4; ++j) { bv[j] = a[j]; bv[4 + j] = b[j]; } }
        float win[KW - 1][8];
#pragma unroll
        for (int k = 0; k < KW - 1; ++k) {
            if (t0 > 0) unpack8(*(const u32x4*)(src + (size_t)(r0 - (KW - 1) + k) * ld_src + c0), win[k]);
            else if (seq >= 16) { const float* sp_ = st_in + ((size_t)(seq - 16) * (KW - 1) + k) * NC + c0; const f32x4 a = *(const f32x4*)sp_, b = *(const f32x4*)(sp_ + 4);
#pragma unroll
                for (int j = 0; j < 4; ++j) { win[k][j] = a[j]; win[k][4 + j] = b[j]; } }
            else {
#pragma unroll
                for (int j = 0; j < 8; ++j) win[k][j] = 0.f; }
        }
#pragma unroll
        for (int h = 0; h < 2; ++h) {
            u32x4 rows[8], aux[8];
#pragma unroll
            for (int i = 0; i < 8; ++i) { rows[i] = *(const u32x4*)(src + (size_t)(r0 + h * 8 + i) * ld_src + c0);
                if (MODE == 1 || MODE == 2) aux[i] = *(const u32x4*)(dst + (size_t)(r0 + h * 8 + i) * ld_dst + c0); }
#pragma unroll
            for (int i = 0; i < 8; ++i) {
                float cur[8], y[8]; unpack8(rows[i], cur);
#pragma unroll
                for (int j = 0; j < 8; ++j) { float a = bv[j] + wv[KW - 1][j] * cur[j];
#pragma unroll
                    for (int k = 0; k < KW - 1; ++k) a += wv[k][j] * win[k][j];
                    y[j] = a; }
#pragma unroll
                for (int j = 0; j < 8; ++j) {
#pragma unroll
                    for (int k = 0; k < KW - 2; ++k) win[k][j] = win[k + 1][j];
                    win[KW - 2][j] = cur[j]; }
                if (MODE == 0) {
#pragma unroll
                    for (int j = 0; j < 8; ++j) y[j] = siluf_(y[j]); }
                if (MODE == 1) { float gq[8]; unpack8(aux[i], gq);
#pragma unroll
                    for (int j = 0; j < 8; ++j) y[j] = y[j] * gq[j]; }
                if (MODE == 2) { float uq[8]; unpack8(aux[i], uq);
#pragma unroll
                    for (int j = 0; j < 8; ++j) y[j] = geluf_(y[j]) * uq[j]; }
                *(u32x4*)(dst + (size_t)(r0 + h * 8 + i) * ld_dst + c0) = pack8(y);
            }
            if (h == 1 && t0 + 16 == L) {
                float* ob = (seq < 16 ? out_p + (size_t)seq * (KW - 1) * NC : out_s + (size_t)(seq - 16) * (KW - 1) * NC) + c0;
#pragma unroll
                for (int j = 0; j < KW - 1; ++j) { float f[8]; unpack8(rows[8 - (KW - 1) + j], f);
                    *(f32x4*)(ob + (size_t)j * NC) = (f32x4){f[0], f[1], f[2], f[3]}; *(f32x4*)(ob + (size_t)j * NC + 4) = (f32x4){f[4], f[5], f[6], f[7]}; }
            }
        }
    }
}

constexpr int SC_CS = 0, SC_BS = 17408, SC_BTS = 34816, SC_XTS = 53248, SC_XDS = 62464, SC_HS = 71680, SC_MS = 89088, SC_AS = 98304, SC_SQ = 98560;
__device__ __forceinline__ void ssd_task(const Ctx cx, const Params& p, LAS unsigned char* lds, int seq, int hd) {
    const int tid = cx.tid, wid = tid >> 6, lane = tid & 63, fr = lane & 15, fq = lane >> 4;
    unsigned char* ws = P_WS(p);
    const bf16_t* XBCA = (const bf16_t*)(ws + WS_XBCA); bf16_t* A2 = (bf16_t*)(ws + WS_A2); const float* DT = (const float*)(ws + WS_DT); float* SSQ = (float*)(ws + WS_SSQ);
    const int g = hd >> 3, nchunks = seq < 16 ? 64 : 1;
    const size_t row_base = seq < 16 ? (size_t)seq * 4096 : (size_t)TP + (size_t)(seq - 16) * 64;
    const float Aneg = -__expf(IN(p, I_A_LOG)[hd]), Dh = IN(p, I_SSD_D)[hd];
    LAS float* As = (LAS float*)(lds + SC_AS); LAS float* Sq = (LAS float*)(lds + SC_SQ);
    f32x4 hst[4];
#pragma unroll
    for (int pt = 0; pt < 4; ++pt) {
        if (seq >= 16) hst[pt] = *(const f32x4*)(IN(p, I_ST_SSD) + ((size_t)((seq - 16) * 16 + hd) * 64 + 16 * pt + fr) * 128 + 16 * wid + 4 * fq);
        else hst[pt] = (f32x4){0.f, 0.f, 0.f, 0.f};
    }
    const int lt = wid >> 1, ph = wid & 1;
    for (int c = 0; c < nchunks; ++c) {
        const size_t r0 = row_base + (size_t)c * 64;
        const float dt_l = DT[(r0 + lane) * 16 + hd];
        float a = dt_l * Aneg;
#pragma unroll
        for (int o = 1; o < 64; o <<= 1) { const float t = __shfl_up(a, o); if (lane >= o) a += t; }
        const float a63 = __shfl(a, 63);
        const float wl = dt_l * __expf(a63 - a);
        if (wid == 0) As[lane] = a;
#pragma unroll
        for (int i = 0; i < 2; ++i) { const int q = tid + i * 512, row = q >> 4, sg = q & 15;
            const bf16_t* gp = XBCA + (r0 + row) * XBC + 1024 + g * 128 + sg * 8;
            const u32x4 bv = *(const u32x4*)gp, cv = *(const u32x4*)(gp + 256);
            *(LAS u32x4*)(lds + SC_BS + row * 272 + sg * 16) = bv; *(LAS u32x4*)(lds + SC_CS + row * 272 + sg * 16) = cv; }
        { float f[8]; unpack8(*(const u32x4*)(XBCA + (r0 + lane) * XBC + hd * 64 + wid * 8), f);
          LAS bf16_t* xt = (LAS bf16_t*)(lds + SC_XTS), *xd = (LAS bf16_t*)(lds + SC_XDS);
#pragma unroll
          for (int j = 0; j < 8; ++j) { const unsigned w2 = cvt_pk_bf16(f[j] * dt_l, f[j] * wl); xt[(wid * 8 + j) * 72 + lane] = (bf16_t)(w2 & 0xffffu); xd[(wid * 8 + j) * 72 + lane] = (bf16_t)(w2 >> 16); } }
#pragma unroll
        for (int i = 0; i < 2; ++i) { const int sg = wid + 8 * i; const u32x4 bw = *(const u32x4*)(XBCA + (r0 + lane) * XBC + 1024 + g * 128 + sg * 8);
            LAS bf16_t* bt = (LAS bf16_t*)(lds + SC_BTS);
            bt[(sg * 8 + 0) * 72 + lane] = (bf16_t)(bw.x & 0xffffu); bt[(sg * 8 + 1) * 72 + lane] = (bf16_t)(bw.x >> 16);
            bt[(sg * 8 + 2) * 72 + lane] = (bf16_t)(bw.y & 0xffffu); bt[(sg * 8 + 3) * 72 + lane] = (bf16_t)(bw.y >> 16);
            bt[(sg * 8 + 4) * 72 + lane] = (bf16_t)(bw.z & 0xffffu); bt[(sg * 8 + 5) * 72 + lane] = (bf16_t)(bw.z >> 16);
            bt[(sg * 8 + 6) * 72 + lane] = (bf16_t)(bw.w & 0xffffu); bt[(sg * 8 + 7) * 72 + lane] = (bf16_t)(bw.w >> 16); }
#pragma unroll
        for (int pt = 0; pt < 4; ++pt) { u32x2 w2; w2.x = cvt_pk_bf16(hst[pt][0], hst[pt][1]); w2.y = cvt_pk_bf16(hst[pt][2], hst[pt][3]);
            *(LAS u32x2*)(lds + SC_HS + (16 * pt + fr) * 272 + (16 * wid + 4 * fq) * 2) = w2; }
        __syncthreads();
        f32x4 yacc[2];
        {
            bf16x8 cf[4];
#pragma unroll
            for (int kk = 0; kk < 4; ++kk) cf[kk] = *(const LAS bf16x8*)(lds + SC_CS + (16 * lt + fr) * 272 + kk * 64 + fq * 16);
            const float a_l = As[16 * lt + fr];
#pragma unroll
            for (int j = 0; j < 2; ++j) {
                const int st = 2 * ph + j;
                f32x4 cb = (f32x4){0.f, 0.f, 0.f, 0.f};
                if (st <= lt) {
#pragma unroll
                    for (int kk = 0; kk < 4; ++kk) { const bf16x8 bf = *(const LAS bf16x8*)(lds + SC_BS + (16 * st + fr) * 272 + kk * 64 + fq * 16);
                        cb = __builtin_amdgcn_mfma_f32_16x16x32_bf16(bf, cf[kk], cb, 0, 0, 0); }
                    const f32x4 as4 = *(const LAS f32x4*)(lds + SC_AS + (16 * st + 4 * fq) * 4);
#pragma unroll
                    for (int r = 0; r < 4; ++r) { const int s = 16 * st + 4 * fq + r, l = 16 * lt + fr; cb[r] = (s <= l) ? cb[r] * __expf(a_l - as4[r]) : 0.f; }
                }
                u32x2 w2; w2.x = cvt_pk_bf16(cb[0], cb[1]); w2.y = cvt_pk_bf16(cb[2], cb[3]);
                *(LAS u32x2*)(lds + SC_MS + (16 * lt + fr) * 144 + (16 * st + 4 * fq) * 2) = w2;
            }
            const float el = __expf(a_l);
#pragma unroll
            for (int j = 0; j < 2; ++j) { const int pt = 2 * ph + j; f32x4 y = (f32x4){0.f, 0.f, 0.f, 0.f};
#pragma unroll
                for (int kk = 0; kk < 4; ++kk) { const bf16x8 hf = *(const LAS bf16x8*)(lds + SC_HS + (16 * pt + fr) * 272 + kk * 64 + fq * 16);
                    y = __builtin_amdgcn_mfma_f32_16x16x32_bf16(hf, cf[kk], y, 0, 0, 0); }
                yacc[j] = y * el; }
        }
        {
            const float dec = __expf(a63);
            bf16x8 btf[2];
#pragma unroll
            for (int kk = 0; kk < 2; ++kk) btf[kk] = *(const LAS bf16x8*)(lds + SC_BTS + (16 * wid + fr) * 144 + kk * 64 + fq * 16);
#pragma unroll
            for (int pt = 0; pt < 4; ++pt) { f32x4 h = hst[pt] * dec;
#pragma unroll
                for (int kk = 0; kk < 2; ++kk) { const bf16x8 xf = *(const LAS bf16x8*)(lds + SC_XDS + (16 * pt + fr) * 144 + kk * 64 + fq * 16);
                    h = __builtin_amdgcn_mfma_f32_16x16x32_bf16(btf[kk], xf, h, 0, 0, 0); }
                hst[pt] = h; }
        }
        __syncthreads();
        {
            bf16x8 mf[2];
#pragma unroll
            for (int kk = 0; kk < 2; ++kk) mf[kk] = *(const LAS bf16x8*)(lds + SC_MS + (16 * lt + fr) * 144 + kk * 64 + fq * 16);
            float sq = 0.f;
            const size_t row = r0 + 16 * lt + fr;
#pragma unroll
            for (int j = 0; j < 2; ++j) { const int pt = 2 * ph + j; f32x4 y = yacc[j];
#pragma unroll
                for (int kk = 0; kk < 2; ++kk) { const bf16x8 xf = *(const LAS bf16x8*)(lds + SC_XTS + (16 * pt + fr) * 144 + kk * 64 + fq * 16);
                    y = __builtin_amdgcn_mfma_f32_16x16x32_bf16(xf, mf[kk], y, 0, 0, 0); }
                const int col = hd * 64 + 16 * pt + 4 * fq;
                const u32x2 zw = *(const u32x2*)(A2 + row * 2048 + col), xw = *(const u32x2*)(XBCA + row * XBC + col);
                const float z0 = bf_lo(zw.x), z1 = bf_hi(zw.x), z2 = bf_lo(zw.y), z3 = bf_hi(zw.y);
                const float x0 = bf_lo(xw.x), x1 = bf_hi(xw.x), x2 = bf_lo(xw.y), x3 = bf_hi(xw.y);
                const float g0 = (y[0] + Dh * x0) * siluf_(z0), g1 = (y[1] + Dh * x1) * siluf_(z1), g2 = (y[2] + Dh * x2) * siluf_(z2), g3 = (y[3] + Dh * x3) * siluf_(z3);
                sq += g0 * g0 + g1 * g1 + g2 * g2 + g3 * g3;
                u32x2 ow; ow.x = cvt_pk_bf16(g0, g1); ow.y = cvt_pk_bf16(g2, g3);
                *(u32x2*)(A2 + row * 2048 + col) = ow; }
            sq += __shfl_xor(sq, 16); sq += __shfl_xor(sq, 32);
            if (fq == 0) Sq[ph * 64 + 16 * lt + fr] = sq;
        }
        __syncthreads();
        if (tid < 64) atomicAdd(SSQ + r0 + tid, Sq[tid] + Sq[64 + tid]);
    }
    float* so = (seq < 16 ? P_OUT(p) + O_P_SSD + (size_t)(seq * 16 + hd) * 8192 : P_OUT(p) + O_S_SSD + (size_t)((seq - 16) * 16 + hd) * 8192);
#pragma unroll
    for (int pt = 0; pt < 4; ++pt) *(f32x4*)(so + (size_t)(16 * pt + fr) * 128 + 16 * wid + 4 * fq) = hst[pt];
    __syncthreads();
}
__device__ __forceinline__ void phase_ssd(const Ctx cx, const Params& p, LAS unsigned char* lds) {
    for (int task = cx.bid; task < 384; task += cx.nblk) {
        if (task < 256) ssd_task(cx, p, lds, task >> 4, task & 15);
        else ssd_task(cx, p, lds, 16 + ((task - 256) >> 4), (task - 256) & 15);
    }
}

__device__ __forceinline__ void phase_lru_a(const Ctx cx, const bf16_t* LA, const bf16_t* UU, float* SL, float* HH) {
    const int total = 1032 * 128;
    for (int item = cx.bid * NTHREADS + cx.tid; item < total; item += cx.nblk * NTHREADS) {
        const int cgi = item & 127, ch = item >> 7, c0 = cgi * 8; const size_t r0 = (size_t)ch * 64;
        float sl[8], h[8];
#pragma unroll
        for (int j = 0; j < 8; ++j) { sl[j] = 0.f; h[j] = 0.f; }
        for (int i0 = 0; i0 < 64; i0 += 8) {
            u32x4 la[8], uu[8];
#pragma unroll
            for (int i = 0; i < 8; ++i) { la[i] = *(const u32x4*)(LA + (r0 + i0 + i) * 1024 + c0); uu[i] = *(const u32x4*)(UU + (r0 + i0 + i) * 1024 + c0); }
#pragma unroll
            for (int i = 0; i < 8; ++i) { float l[8], u[8]; unpack8(la[i], l); unpack8(uu[i], u);
#pragma unroll
                for (int j = 0; j < 8; ++j) { sl[j] += l[j]; h[j] = __expf(l[j]) * h[j] + u[j]; } }
        }
        float* o1 = SL + (size_t)ch * 1024 + c0; float* o2 = HH + (size_t)ch * 1024 + c0;
        *(f32x4*)o1 = (f32x4){sl[0], sl[1], sl[2], sl[3]}; *(f32x4*)(o1 + 4) = (f32x4){sl[4], sl[5], sl[6], sl[7]};
        *(f32x4*)o2 = (f32x4){h[0], h[1], h[2], h[3]}; *(f32x4*)(o2 + 4) = (f32x4){h[4], h[5], h[6], h[7]};
    }
}
__device__ __forceinline__ void phase_lru_b(const Ctx cx, const Params& p, const float* SL, const float* HH, float* CIN) {
    for (int item = cx.bid * NTHREADS + cx.tid; item < 24 * 1024; item += cx.nblk * NTHREADS) {
        const int chn = item & 1023, seq = item >> 10;
        const int nch = seq < 16 ? 64 : 1, ch0 = seq < 16 ? seq * 64 : 1024 + (seq - 16);
        float c = seq < 16 ? 0.f : IN(p, I_ST_LRU)[(seq - 16) * 1024 + chn];
        for (int i0 = 0; i0 < nch; i0 += 16) {
            float sl[16], hh[16];
#pragma unroll
            for (int i = 0; i < 16; ++i) if (i0 + i < nch) { sl[i] = SL[(size_t)(ch0 + i0 + i) * 1024 + chn]; hh[i] = HH[(size_t)(ch0 + i0 + i) * 1024 + chn]; }
#pragma unroll
            for (int i = 0; i < 16; ++i) if (i0 + i < nch) { CIN[(size_t)(ch0 + i0 + i) * 1024 + chn] = c; c = __expf(sl[i]) * c + hh[i]; }
        }
        (seq < 16 ? P_OUT(p) + O_P_LRU + seq * 1024 : P_OUT(p) + O_S_LRU + (seq - 16) * 1024)[chn] = c;
    }
}
__device__ __forceinline__ void phase_lru_c(const Ctx cx, const bf16_t* LA, const bf16_t* UU, const float* CIN, bf16_t* GATE) {
    const int total = 1032 * 128;
    for (int item = cx.bid * NTHREADS + cx.tid; item < total; item += cx.nblk * NTHREADS) {
        const int cgi = item & 127, ch = item >> 7, c0 = cgi * 8; const size_t r0 = (size_t)ch * 64;
        float h[8];
        { const float* ci = CIN + (size_t)ch * 1024 + c0; const f32x4 a = *(const f32x4*)ci, b = *(const f32x4*)(ci + 4);
#pragma unroll
          for (int j = 0; j < 4; ++j) { h[j] = a[j]; h[4 + j] = b[j]; } }
        for (int i0 = 0; i0 < 64; i0 += 8) {
            u32x4 la[8], uu[8], gt[8];
#pragma unroll
            for (int i = 0; i < 8; ++i) { la[i] = *(const u32x4*)(LA + (r0 + i0 + i) * 1024 + c0); uu[i] = *(const u32x4*)(UU + (r0 + i0 + i) * 1024 + c0); gt[i] = *(const u32x4*)(GATE + (r0 + i0 + i) * 1024 + c0); }
#pragma unroll
            for (int i = 0; i < 8; ++i) { float l[8], u[8], gq[8], o[8]; unpack8(la[i], l); unpack8(uu[i], u); unpack8(gt[i], gq);
#pragma unroll
                for (int j = 0; j < 8; ++j) { h[j] = __expf(l[j]) * h[j] + u[j]; o[j] = gq[j] * h[j]; }
                *(u32x4*)(GATE + (r0 + i0 + i) * 1024 + c0) = pack8(o); }
        }
    }
}

constexpr int NPHASE = 22;
__device__ __forceinline__ void run_phase(const Params& p, int ph, LAS unsigned char* lds) {
    Ctx cx; { int b = blockIdx.x, n = gridDim.x, t = threadIdx.x; asm volatile("" : "+s"(b), "+s"(n), "+v"(t)); cx.bid = b; cx.nblk = n; cx.tid = t; }
    unsigned char* ws = P_WS(p);
    bf16_t* XN = (bf16_t*)(ws + WS_XN);
    float* Y = P_OUT(p) + O_Y;
    switch (ph) {
    case 0: phase_prep(cx, p, lds); phase_norm(cx, IN(p, I_XP), IN(p, I_XS), XN); break;
    case 1: { Gemm g{XN, (const bf16_t*)(ws + WS_W1), T, N1, 1024, 1024, 0, 0};
        EpiG1 e{(bf16_t*)(ws + WS_A2), (bf16_t*)(ws + WS_XBCP), (bf16_t*)(ws + WS_V), (float*)(ws + WS_DT), IN(p, I_DT_BIAS)};
        gemm_phase<EpiG1, false>(cx, lds, g, e, nullptr); } break;
    case 2:
        phase_conv<4, 0>(cx, (const bf16_t*)(ws + WS_XBCP), XBC, XBC, IN(p, I_SSD_CONVW), IN(p, I_SSD_CONVB), (bf16_t*)(ws + WS_XBCA), XBC, IN(p, I_ST_SSDCONV), P_OUT(p) + O_P_SSDCONV, P_OUT(p) + O_S_SSDCONV);
        phase_conv<3, 1>(cx, (const bf16_t*)(ws + WS_V), 1024, 1024, IN(p, I_SC_CONVW), IN(p, I_SC_CONVB), (bf16_t*)(ws + WS_A2) + 1024, 2048, IN(p, I_ST_SCONV), P_OUT(p) + O_P_SCONV, P_OUT(p) + O_S_SCONV);
        break;
    case 3: phase_ssd(cx, p, lds); break;
    case 4: { Gemm g{(const bf16_t*)(ws + WS_A2), (const bf16_t*)(ws + WS_W2), T, 1024, 2048, 2048, 0, 0};
        EpiRes e{IN(p, I_XP), IN(p, I_XS), Y};
        gemm_phase<EpiRes, true>(cx, lds, g, e, (const float*)(ws + WS_SSQ)); } break;
    case 5: phase_norm(cx, Y, Y + (size_t)TP * DM, XN); break;
    case 6: { Gemm g{XN, (const bf16_t*)(ws + WS_W3), T, 5632, 1024, 1024, 0, 0};
        EpiFfnIn e{(bf16_t*)(ws + WS_GP), (bf16_t*)(ws + WS_U)};
        gemm_phase<EpiFfnIn, false>(cx, lds, g, e, nullptr); } break;
    case 7: phase_conv<3, 2>(cx, (const bf16_t*)(ws + WS_GP), DFF, DFF, IN(p, I_FFN_CONVW), IN(p, I_FFN_CONVB), (bf16_t*)(ws + WS_U), DFF, IN(p, I_ST_FFNCONV), P_OUT(p) + O_P_FFNCONV, P_OUT(p) + O_S_FFNCONV); break;
    case 8: { Gemm g{(const bf16_t*)(ws + WS_U), (const bf16_t*)(ws + WS_W4), T, 1024, DFF, DFF, 0, 0};
        EpiRes e{Y, Y + (size_t)TP * DM, Y};
        gemm_phase<EpiRes, false>(cx, lds, g, e, nullptr); } break;
    case 9: phase_norm(cx, Y, Y + (size_t)TP * DM, XN); break;
    case 10: { Gemm g{XN, (const bf16_t*)(ws + WS_W5), T, 2048, 1024, 1024, 0, 0};
        EpiLruIn e{(bf16_t*)(ws + WS_GATE), (bf16_t*)(ws + WS_XBP)};
        gemm_phase<EpiLruIn, false>(cx, lds, g, e, nullptr); } break;
    case 11: phase_conv<4, 3>(cx, (const bf16_t*)(ws + WS_XBP), 1024, 1024, IN(p, I_LRU_CONVW), IN(p, I_LRU_CONVB), (bf16_t*)(ws + WS_XBC2), 1024, IN(p, I_ST_LRUCONV), P_OUT(p) + O_P_LRUCONV, P_OUT(p) + O_S_LRUCONV); break;
    case 12: { Gemm g{(const bf16_t*)(ws + WS_XBC2), (const bf16_t*)(ws + WS_W6), T, 2048, 256, 1024, 1, 256};
        EpiLruGate e{(const bf16_t*)(ws + WS_XBC2), (bf16_t*)(ws + WS_LA), (bf16_t*)(ws + WS_UU), IN(p, I_LRU_BA), IN(p, I_LRU_BX), (const float*)(ws + WS_SP)};
        gemm_phase<EpiLruGate, false>(cx, lds, g, e, nullptr); } break;
    case 13: phase_lru_a(cx, (const bf16_t*)(ws + WS_LA), (const bf16_t*)(ws + WS_UU), (float*)(ws + WS_SL), (float*)(ws + WS_HH)); break;
    case 14: phase_lru_b(cx, p, (const float*)(ws + WS_SL), (const float*)(ws + WS_HH), (float*)(ws + WS_CIN)); break;
    case 15: phase_lru_c(cx, (const bf16_t*)(ws + WS_LA), (const bf16_t*)(ws + WS_UU), (const float*)(ws + WS_CIN), (bf16_t*)(ws + WS_GATE)); break;
    case 16: { Gemm g{(const bf16_t*)(ws + WS_GATE), (const bf16_t*)(ws + WS_W7), T, 1024, 1024, 1024, 0, 0};
        EpiRes e{Y, Y + (size_t)TP * DM, Y};
        gemm_phase<EpiRes, false>(cx, lds, g, e, nullptr); } break;
    case 17: phase_norm(cx, Y, Y + (size_t)TP * DM, XN); break;
    case 18: { Gemm g{XN, (const bf16_t*)(ws + WS_W3) + (size_t)5632 * 1024, T, 5632, 1024, 1024, 0, 0};
        EpiFfnIn e{(bf16_t*)(ws + WS_GP), (bf16_t*)(ws + WS_U)};
        gemm_phase<EpiFfnIn, false>(cx, lds, g, e, nullptr); } break;
    case 19: phase_conv<3, 2>(cx, (const bf16_t*)(ws + WS_GP), DFF, DFF, IN(p, I_FFN_CONVW) + 3 * DFF, IN(p, I_FFN_CONVB) + DFF, (bf16_t*)(ws + WS_U), DFF, IN(p, I_ST_FFNCONV) + 8 * 2 * DFF, P_OUT(p) + O_P_FFNCONV + 16 * 2 * DFF, P_OUT(p) + O_S_FFNCONV + 8 * 2 * DFF); break;
    case 20: { Gemm g{(const bf16_t*)(ws + WS_U), (const bf16_t*)(ws + WS_W4) + (size_t)1024 * DFF, T, 1024, DFF, DFF, 0, 0};
        EpiRes e{Y, Y + (size_t)TP * DM, Y};
        gemm_phase<EpiRes, false>(cx, lds, g, e, nullptr); } break;
    case 21: phase_final_norm(cx, Y, IN(p, I_NORM_FINAL)); break;
    default: break;
    }
}

__global__ void __launch_bounds__(NTHREADS, 2) fwd_mega(Params p, int ph_lo, int ph_hi) {
    extern __shared__ __attribute__((aligned(16))) unsigned char smem[];
    LAS unsigned char* lds = (LAS unsigned char*)smem;
    cg::grid_group grid = cg::this_grid();
    for (int ph = ph_lo; ph < ph_hi; ++ph) {
        run_phase(p, ph, lds);
        if (ph + 1 < ph_hi) grid.sync();
    }
}

#ifndef MK_MULTI
#define MK_MULTI 0
#endif

extern "C" void kernel_launch(void* const* d_in, const int* in_sizes, int n_in, void* d_out, int out_size, void* d_ws, size_t ws_size, hipStream_t stream) {
    static int grid = 0;
    if (grid == 0) {
        if (n_in != 34 || (size_t)out_size != O_END || ws_size < WS_NEED) { fprintf(stderr, "kernel_launch: unexpected shapes (n_in %d out %d ws %zu need %zu)\n", n_in, out_size, ws_size, (size_t)WS_NEED); grid = -1; return; }
        int dev = 0, cus = 0, per_cu = 0;
        hipGetDevice(&dev); hipDeviceGetAttribute(&cus, hipDeviceAttributeMultiprocessorCount, dev);
        if (hipFuncSetAttribute((const void*)fwd_mega, hipFuncAttributeMaxDynamicSharedMemorySize, LDS_BYTES) != hipSuccess) { fprintf(stderr, "kernel_launch: hipFuncSetAttribute failed\n"); grid = -1; return; }
        if (hipOccupancyMaxActiveBlocksPerMultiprocessor(&per_cu, (const void*)fwd_mega, NTHREADS, LDS_BYTES) != hipSuccess || per_cu < 1) { fprintf(stderr, "kernel_launch: occupancy query says %d\n", per_cu); per_cu = 1; }
        (void)hipGetLastError();
        grid = cus;
    }
    if (grid < 0) return;
    Params p{};
    for (int i = 0; i < 34; ++i) p.ptr[i] = (const float*)d_in[i];
    p.ptr[34] = (const float*)d_out; p.ptr[35] = (const float*)d_ws;
#if MK_MULTI
    for (int ph = 0; ph < NPHASE; ++ph) { int lo = ph, hi = ph + 1; void* args[] = {&p, &lo, &hi};
        hipError_t e = hipLaunchCooperativeKernel((const void*)fwd_mega, dim3(grid), dim3(NTHREADS), args, LDS_BYTES, stream);
        if (e != hipSuccess) { fprintf(stderr, "launch failed: %s\n", hipGetErrorString(e)); break; } }
#else
    int lo = 0, hi = NPHASE; void* args[] = {&p, &lo, &hi};
    hipError_t e = hipLaunchCooperativeKernel((const void*)fwd_mega, dim3(grid), dim3(NTHREADS), args, LDS_BYTES, stream);
    if (e != hipSuccess) fprintf(stderr, "cooperative launch failed: %s (grid %d)\n", hipGetErrorString(e), grid);
#endif
}
```

```cpp
#include <hip/hip_runtime.h>
#include <hip/hip_cooperative_groups.h>
#include <cstdio>
namespace cg = cooperative_groups;

#define LAS __attribute__((address_space(3)))
typedef unsigned short bf16_t;
typedef short bf16x8 __attribute__((ext_vector_type(8)));
typedef float f32x4 __attribute__((ext_vector_type(4)));
typedef unsigned u32x4 __attribute__((ext_vector_type(4)));
typedef unsigned u32x2 __attribute__((ext_vector_type(2)));

constexpr int TP = 65536;
constexpr int TS = 512;
constexpr int T = TP + TS;
constexpr int DM = 1024;
constexpr int DFF = 2816;
constexpr int XBC = 1536;
constexpr int N1 = 5888;
constexpr float EPS = 1e-6f;
constexpr int NTHREADS = 512;
constexpr int LDS_BYTES = 131072 + 4096;

constexpr size_t O_Y = 0;
constexpr size_t O_P_SSDCONV = (size_t)T * DM;
constexpr size_t O_P_SSD = O_P_SSDCONV + 16 * 3 * XBC;
constexpr size_t O_P_SCONV = O_P_SSD + (size_t)16 * 16 * 64 * 128;
constexpr size_t O_P_LRUCONV = O_P_SCONV + 16 * 2 * 1024;
constexpr size_t O_P_LRU = O_P_LRUCONV + 16 * 3 * 1024;
constexpr size_t O_P_FFNCONV = O_P_LRU + 16 * 1024;
constexpr size_t O_S_SSDCONV = O_P_FFNCONV + 2 * 16 * 2 * DFF;
constexpr size_t O_S_SSD = O_S_SSDCONV + 8 * 3 * XBC;
constexpr size_t O_S_SCONV = O_S_SSD + (size_t)8 * 16 * 64 * 128;
constexpr size_t O_S_LRUCONV = O_S_SCONV + 8 * 2 * 1024;
constexpr size_t O_S_LRU = O_S_LRUCONV + 8 * 3 * 1024;
constexpr size_t O_S_FFNCONV = O_S_LRU + 8 * 1024;
constexpr size_t O_END = O_S_FFNCONV + 2 * 8 * 2 * DFF;

constexpr size_t al256(size_t x) { return (x + 255) & ~(size_t)255; }
constexpr size_t WS_W1 = 0;
constexpr size_t WS_W2 = WS_W1 + (size_t)N1 * 1024 * 2;
constexpr size_t WS_W3 = WS_W2 + (size_t)1024 * 2048 * 2;
constexpr size_t WS_W4 = WS_W3 + (size_t)2 * 5632 * 1024 * 2;
constexpr size_t WS_W5 = WS_W4 + (size_t)2 * 1024 * 2816 * 2;
constexpr size_t WS_W6 = WS_W5 + (size_t)2048 * 1024 * 2;
constexpr size_t WS_W7 = WS_W6 + (size_t)2048 * 256 * 2;
constexpr size_t WS_SP = WS_W7 + (size_t)1024 * 1024 * 2;
constexpr size_t WS_BAR = WS_SP + 4096;
constexpr size_t WS_SSQ = WS_BAR + 16384;
constexpr size_t WS_SL = al256(WS_SSQ + (size_t)5 * T * 4);
constexpr size_t WS_HH = WS_SL + (size_t)1032 * 1024 * 4;
constexpr size_t WS_CIN = WS_HH + (size_t)1032 * 1024 * 4;
constexpr size_t WS_XN = al256(WS_CIN + (size_t)1032 * 1024 * 4);
constexpr size_t WS_ARENA = al256(WS_XN + (size_t)T * 1024 * 2);
constexpr size_t WS_A2 = WS_ARENA;
constexpr size_t WS_XBCP = WS_A2 + (size_t)T * 2048 * 2;
constexpr size_t WS_XBCA = WS_XBCP + (size_t)T * XBC * 2;
constexpr size_t WS_V = WS_XBCA + (size_t)T * XBC * 2;
constexpr size_t WS_DT = WS_V + (size_t)T * 1024 * 2;
constexpr size_t WS_END0 = WS_DT + (size_t)T * 16 * 4;
constexpr size_t WS_H = WS_ARENA;
constexpr size_t WS_GH = WS_H + (size_t)T * DFF * 2;
constexpr size_t WS_GT = WS_GH + (size_t)1032 * 2 * DFF * 2;
constexpr size_t WS_UH = WS_GT + (size_t)1032 * 2 * DFF * 2;
constexpr size_t WS_END1 = WS_UH + (size_t)1032 * 2 * DFF * 2;
constexpr size_t WS_GATE = WS_ARENA;
constexpr size_t WS_XBP = WS_GATE + (size_t)T * 1024 * 2;
constexpr size_t WS_XBC2 = WS_XBP + (size_t)T * 1024 * 2;
constexpr size_t WS_LA = WS_XBC2 + (size_t)T * 1024 * 2;
constexpr size_t WS_UU = WS_LA + (size_t)T * 1024 * 2;
constexpr size_t WS_END2 = WS_UU + (size_t)T * 1024 * 2;
constexpr size_t WS_NEED = WS_END0 > WS_END1 ? (WS_END0 > WS_END2 ? WS_END0 : WS_END2) : (WS_END1 > WS_END2 ? WS_END1 : WS_END2);

struct Params {
    const float* ptr[36];
};
__device__ __forceinline__ const float* IN(const Params& p, int i) { asm volatile("" : "+s"(i)); return p.ptr[i]; }
#define P_OUT(p) ((float*)IN(p, 34))
#define P_WS(p) ((unsigned char*)IN(p, 35))
enum { I_XP = 0, I_XS, I_ST_SSDCONV, I_ST_SSD, I_ST_SCONV, I_ST_LRUCONV, I_ST_LRU, I_ST_FFNCONV, I_NORM_MIX, I_NORM_FFN, I_NORM_FINAL,
       I_AB_WIN, I_SSD_CONVW, I_SSD_CONVB, I_DT_BIAS, I_A_LOG, I_SSD_D, I_SSD_NORM, I_SC_CONVW, I_SC_CONVB, I_AB_WOUT, I_LRU_WIN,
       I_LRU_CONVW, I_LRU_CONVB, I_LRU_WA, I_LRU_BA, I_LRU_WX, I_LRU_BX, I_LRU_LAMBDA, I_LRU_WOUT, I_FFN_WIN, I_FFN_CONVW, I_FFN_CONVB, I_FFN_WOUT };

struct Ctx { int bid, nblk, tid; };
__device__ __forceinline__ unsigned cvt_pk_bf16(float lo, float hi) { unsigned r; asm("v_cvt_pk_bf16_f32 %0, %1, %2" : "=v"(r) : "v"(lo), "v"(hi)); return r; }
__device__ __forceinline__ float bf_lo(unsigned w) { return __uint_as_float(w << 16); }
__device__ __forceinline__ float bf_hi(unsigned w) { return __uint_as_float(w & 0xffff0000u); }
__device__ __forceinline__ float sigmoidf_(float x) { return 1.0f / (1.0f + __expf(-x)); }
__device__ __forceinline__ float siluf_(float x) { return x / (1.0f + __expf(-x)); }
__device__ __forceinline__ float geluf_(float x) { const float u = 1.5957691216f * (x + 0.044715f * x * x * x); return x / (1.0f + __expf(-u)); }
__device__ __forceinline__ float softplusf_(float x) { return fmaxf(x, 0.0f) + log1pf(__expf(-fabsf(x))); }
__device__ __forceinline__ void unpack8(const u32x4 w, float (&f)[8]) {
    f[0] = bf_lo(w.x); f[1] = bf_hi(w.x); f[2] = bf_lo(w.y); f[3] = bf_hi(w.y); f[4] = bf_lo(w.z); f[5] = bf_hi(w.z); f[6] = bf_lo(w.w); f[7] = bf_hi(w.w);
}
__device__ __forceinline__ u32x4 pack8(const float (&f)[8]) {
    u32x4 w; w.x = cvt_pk_bf16(f[0], f[1]); w.y = cvt_pk_bf16(f[2], f[3]); w.z = cvt_pk_bf16(f[4], f[5]); w.w = cvt_pk_bf16(f[6], f[7]); return w;
}
__device__ __forceinline__ u32x4 pack44(const f32x4 a, const f32x4 b) {
    u32x4 w; w.x = cvt_pk_bf16(a[0], a[1]); w.y = cvt_pk_bf16(a[2], a[3]); w.z = cvt_pk_bf16(b[0], b[1]); w.w = cvt_pk_bf16(b[2], b[3]); return w;
}

constexpr int BM = 256, BK = 64, HALF = 128, HTB = HALF * BK * 2, NXCD = 8, WGM = 8;
__device__ __forceinline__ int lds_byte(int r, int c) { const int st = (r >> 4) * 2 + (c >> 5), rr = r & 15, cc = c & 31, ob = rr * 64 + cc * 2; return st * 1024 + (ob ^ (((ob >> 9) & 1) << 5)); }
__device__ __forceinline__ void stage_rc(int b, int& R, int& C) { const int st = b / 1024, sb = b % 1024, swz = sb ^ (((sb >> 9) & 1) << 5); R = (st >> 1) * 16 + swz / 64; C = (st & 1) * 32 + (swz % 64) / 2; }
__device__ __forceinline__ int perm32(int rho) { const int n = rho >> 4, i = rho & 15; return 8 * (i >> 2) + 4 * n + (i & 3); }

struct Unit { int pm, pn; };
struct Gemm { const bf16_t* A; const bf16_t* Bt; int M, N, K, lda, a_shift, a_koff; };

struct StaticOrder {
    int nM, nN, nwg, G, c;
    __device__ void init(int M, int N, int G_, int c_) { nM = M / BM; nN = N / BM; nwg = nM * nN; G = G_; c = c_; }
    __device__ bool next(int i, Unit& u) const {
        const long L = (long)i * G + c; if (L >= nwg) return false;
        int wgid = (int)L; { const int q = nwg / NXCD, r = nwg % NXCD, xcd = wgid % NXCD, off = wgid / NXCD; wgid = (xcd < r ? xcd * (q + 1) : r * (q + 1) + (xcd - r) * q) + off; }
        const int nig = WGM * nN, gid = wgid / nig, fm = gid * WGM, gsz = (nM - fm) < WGM ? (nM - fm) : WGM;
        u.pm = fm + ((wgid % nig) % gsz); u.pn = (wgid % nig) / gsz; return true;
    }
};

template <class Epi, bool MIDSCALE>
__device__ __forceinline__ void gemm_phase(const Ctx cx, LAS unsigned char* lds, const Gemm g, const Epi& E, const float* ssq) {
    const int tid = cx.tid, wid = __builtin_amdgcn_readfirstlane(tid >> 6), lane = tid & 63, wr = wid >> 2, wc = wid & 3, fr = lane & 15, fq = lane >> 4;
    int K_ = g.K; asm volatile("" : "+s"(K_));
    const int K = K_, nt = K / BK;
    StaticOrder S; S.init(g.M, g.N, cx.nblk, cx.bid);
    unsigned voffA[2], voffB[2];
#pragma unroll
    for (int i = 0; i < 2; ++i) { int R, C; stage_rc(tid * 16 + i * 8192, R, C); const int Rb = Epi::PERM ? ((R & ~31) + perm32(R & 31)) : R;
        voffA[i] = (unsigned)(R * g.lda + C) * 2u; voffB[i] = (unsigned)(Rb * K + C) * 2u; }
    const size_t kstep = (size_t)(BK * 2);
    const size_t hsA = (size_t)HALF * g.lda * 2, hsB = (size_t)HALF * K * 2;
    const size_t tsA = 2 * hsA, tsB = 2 * hsB;
    const unsigned ldsw = (unsigned)wid * 1024u;
    const int aoff = lds_byte(wr * 64 + fr, fq * 8), boff = lds_byte(wc * 32 + fr, fq * 8);
#define SA_(b, h) (((b) * 2 + (h)) * HTB)
#define SB_(b, h) ((4 + (b) * 2 + (h)) * HTB)
#define STAGE_(bufoff, gbase, voff) do { _Pragma("unroll") for (int _i = 0; _i < 2; ++_i) \
        __builtin_amdgcn_global_load_lds((const unsigned*)((const char*)(gbase) + (voff)[_i]), (LAS unsigned*)(lds + (bufoff) + ldsw + _i * 8192), 16, 0, 0); } while (0)
#define LDA_(dst, b, h) do { _Pragma("unroll") for (int m = 0; m < 4; ++m) _Pragma("unroll") for (int k = 0; k < 2; ++k) dst[m][k] = *(const LAS bf16x8*)(lds + SA_(b, h) + aoff + m * 2048 + k * 1024); } while (0)
#define LDB_(dst, b, h) do { _Pragma("unroll") for (int n = 0; n < 2; ++n) _Pragma("unroll") for (int k = 0; k < 2; ++k) dst[n][k] = *(const LAS bf16x8*)(lds + SB_(b, h) + boff + n * 2048 + k * 1024); } while (0)
#define MMA_(ai, bj, At, Bt) do { __builtin_amdgcn_s_setprio(1); _Pragma("unroll") for (int m = 0; m < 4; ++m) _Pragma("unroll") for (int n = 0; n < 2; ++n) _Pragma("unroll") for (int k = 0; k < 2; ++k) \
        acc[ai][bj][m][n] = __builtin_amdgcn_mfma_f32_16x16x32_bf16(Bt[n][k], At[m][k], acc[ai][bj][m][n], 0, 0, 0); __builtin_amdgcn_s_setprio(0); } while (0)
#define WAIT_V_(n) asm volatile("s_waitcnt vmcnt(" #n ")" ::: "memory")
#define WAIT_L_(n) asm volatile("s_waitcnt lgkmcnt(" #n ")" ::: "memory")
#define BAR_ __builtin_amdgcn_s_barrier()
#define SCHED_ __builtin_amdgcn_sched_barrier(0)
    Unit cur, nxt; int ui = 0;
    if (!S.next(0, cur)) return;
    f32x4 acc[2][2][4][2];
#pragma unroll
    for (int a = 0; a < 2; ++a)
#pragma unroll
        for (int b = 0; b < 2; ++b)
#pragma unroll
            for (int m = 0; m < 4; ++m)
#pragma unroll
                for (int n = 0; n < 2; ++n) acc[a][b][m][n] = (f32x4){0.f, 0.f, 0.f, 0.f};
    bf16x8 At[4][2], B0[2][2], B1[2][2];
    const char* cA = (const char*)g.A + (size_t)cur.pm * tsA + (size_t)((cur.pn >> g.a_shift) * g.a_koff) * 2;
    const char* cB = (const char*)g.Bt + (size_t)cur.pn * tsB;
    STAGE_(SB_(0, 0), cB, voffB); STAGE_(SA_(0, 0), cA, voffA); STAGE_(SB_(0, 1), cB + hsB, voffB); STAGE_(SA_(0, 1), cA + hsA, voffA);
    if (wr == 1) BAR_;
    WAIT_V_(4); BAR_;
    STAGE_(SB_(1, 0), cB + kstep, voffB); STAGE_(SA_(1, 0), cA + kstep, voffA); STAGE_(SB_(1, 1), cB + hsB + kstep, voffB);
    WAIT_V_(6); BAR_;
    for (;;) {
        const bool has_next = S.next(ui + 1, nxt);
        const char* nA = has_next ? (const char*)g.A + (size_t)nxt.pm * tsA + (size_t)((nxt.pn >> g.a_shift) * g.a_koff) * 2 : cA;
        const char* nB = has_next ? (const char*)g.Bt + (size_t)nxt.pn * tsB : cB;
        for (int t = 0; t < nt; t += 2) {
            const bool last = (t == nt - 2);
            const char* a1 = cA + (size_t)(t + 1) * kstep;
            const char* a2 = last ? nA : cA + (size_t)(t + 2) * kstep; const char* b2 = last ? nB : cB + (size_t)(t + 2) * kstep;
            const char* a3 = a2 + kstep; const char* b3 = b2 + kstep;
            if (MIDSCALE && t == 16) {
                int rb = cur.pm * BM + wr * 64 + fr; asm volatile("" : "+v"(rb));
#pragma unroll
                for (int ai = 0; ai < 2; ++ai)
#pragma unroll
                    for (int m = 0; m < 4; ++m) {
                        const float sc = rsqrtf(ssq[rb + ai * HALF + m * 16] * (1.0f / 1024.0f) + EPS);
#pragma unroll
                        for (int bj = 0; bj < 2; ++bj)
#pragma unroll
                            for (int n = 0; n < 2; ++n) acc[ai][bj][m][n] *= sc;
                    }
            }
            LDB_(B0, 0, 0); SCHED_; LDA_(At, 0, 0); STAGE_(SA_(1, 1), a1 + hsA, voffA);
            WAIT_L_(8); BAR_; WAIT_L_(0); MMA_(0, 0, At, B0); BAR_; SCHED_;
            LDB_(B1, 0, 1); STAGE_(SB_(0, 0), b2, voffB);
            BAR_; WAIT_L_(0); MMA_(0, 1, At, B1); BAR_;
            LDA_(At, 0, 1); STAGE_(SA_(0, 0), a2, voffA);
            BAR_; WAIT_L_(0); MMA_(1, 0, At, B0); BAR_; SCHED_;
            STAGE_(SB_(0, 1), b2 + hsB, voffB);
            WAIT_V_(6); BAR_; MMA_(1, 1, At, B1); BAR_;
            LDB_(B0, 1, 0); SCHED_; LDA_(At, 1, 0); STAGE_(SA_(0, 1), a2 + hsA, voffA);
            WAIT_L_(8); BAR_; WAIT_L_(0); MMA_(0, 0, At, B0); BAR_; SCHED_;
            LDB_(B1, 1, 1); STAGE_(SB_(1, 0), b3, voffB);
            BAR_; WAIT_L_(0); MMA_(0, 1, At, B1); BAR_;
            LDA_(At, 1, 1); STAGE_(SA_(1, 0), a3, voffA);
            BAR_; WAIT_L_(0); MMA_(1, 0, At, B0); BAR_; SCHED_;
            STAGE_(SB_(1, 1), b3 + hsB, voffB);
            WAIT_V_(6); BAR_; MMA_(1, 1, At, B1); BAR_;
        }
        E(acc, cur, wr, wc, fr, fq);
        if (!has_next) break;
#pragma unroll
        for (int a = 0; a < 2; ++a)
#pragma unroll
            for (int b = 0; b < 2; ++b)
#pragma unroll
                for (int m = 0; m < 4; ++m)
#pragma unroll
                    for (int n = 0; n < 2; ++n) acc[a][b][m][n] = (f32x4){0.f, 0.f, 0.f, 0.f};
        cur = nxt; cA = nA; cB = nB; ++ui;
    }
    WAIT_V_(0);
    if (wr == 0) BAR_;
    BAR_;
#undef SA_
#undef SB_
#undef STAGE_
#undef LDA_
#undef LDB_
#undef MMA_
}

struct EpiG1 {
    static constexpr bool PERM = true;
    bf16_t* A2; bf16_t* XBCP; bf16_t* V; float* DT; const float* dt_bias;
    __device__ __forceinline__ void operator()(const f32x4 (&acc)[2][2][4][2], const Unit& u, int wr, int wc, int fr, int fq) const {
        const int row0 = u.pm * BM + wr * 64 + fr, lc = wc * 32 + 8 * fq;
        if (u.pn < 14) {
            bf16_t* base; int ld, colt;
            if (u.pn < 4) { base = A2; ld = 2048; colt = u.pn * 256; }
            else if (u.pn < 10) { base = XBCP; ld = XBC; colt = (u.pn - 4) * 256; }
            else { base = A2; ld = 2048; colt = 1024 + (u.pn - 10) * 256; }
#pragma unroll
            for (int ai = 0; ai < 2; ++ai)
#pragma unroll
                for (int m = 0; m < 4; ++m) { bf16_t* rowp = base + (size_t)(row0 + ai * HALF + m * 16) * ld + colt + lc;
#pragma unroll
                    for (int bj = 0; bj < 2; ++bj) *(u32x4*)(rowp + bj * HALF) = pack44(acc[ai][bj][m][0], acc[ai][bj][m][1]); }
        } else if (u.pn < 22) {
            const int ch0 = (u.pn - 14) * 128 + lc;
#pragma unroll
            for (int ai = 0; ai < 2; ++ai)
#pragma unroll
                for (int m = 0; m < 4; ++m) { bf16_t* rowp = V + (size_t)(row0 + ai * HALF + m * 16) * 1024 + ch0;
                    *(u32x4*)rowp = pack44(acc[ai][0][m][0] * acc[ai][1][m][0], acc[ai][0][m][1] * acc[ai][1][m][1]); }
        } else {
            if (wc == 0 && fq < 2) {
                const f32x4 b0 = *(const f32x4*)(dt_bias + 8 * fq), b1 = *(const f32x4*)(dt_bias + 8 * fq + 4);
#pragma unroll
                for (int ai = 0; ai < 2; ++ai)
#pragma unroll
                    for (int m = 0; m < 4; ++m) { float* rowp = DT + (size_t)(row0 + ai * HALF + m * 16) * 16 + 8 * fq;
                        f32x4 v0 = acc[ai][0][m][0] + b0, v1 = acc[ai][0][m][1] + b1;
#pragma unroll
                        for (int j = 0; j < 4; ++j) { v0[j] = softplusf_(v0[j]); v1[j] = softplusf_(v1[j]); }
                        *(f32x4*)rowp = v0; *(f32x4*)(rowp + 4) = v1; }
            }
        }
    }
};
template <bool SRC_F32> struct EpiRes {
    static constexpr bool PERM = true;
    const float* xp; const float* xs; bf16_t* XN; float* ssq;
    __device__ __forceinline__ void operator()(const f32x4 (&acc)[2][2][4][2], const Unit& u, int wr, int wc, int fr, int fq) const {
        const int row0 = u.pm * BM + wr * 64 + fr, col0 = u.pn * BM + wc * 32 + 8 * fq;
#pragma unroll
        for (int ai = 0; ai < 2; ++ai)
#pragma unroll
            for (int m = 0; m < 4; ++m) { const int row = row0 + ai * HALF + m * 16;
                bf16_t* xnp = XN + (size_t)row * DM + col0;
                float sq = 0.f;
#pragma unroll
                for (int bj = 0; bj < 2; ++bj) {
                    f32x4 v0, v1;
                    if (SRC_F32) { const float* src = (row < TP ? xp + (size_t)row * DM : xs + (size_t)(row - TP) * DM) + col0 + bj * HALF; v0 = *(const f32x4*)src; v1 = *(const f32x4*)(src + 4); }
                    else { const u32x4 w = *(const u32x4*)(xnp + bj * HALF); v0 = (f32x4){bf_lo(w.x), bf_hi(w.x), bf_lo(w.y), bf_hi(w.y)}; v1 = (f32x4){bf_lo(w.z), bf_hi(w.z), bf_lo(w.w), bf_hi(w.w)}; }
                    v0 += acc[ai][bj][m][0]; v1 += acc[ai][bj][m][1];
                    *(u32x4*)(xnp + bj * HALF) = pack44(v0, v1);
                    sq += v0[0] * v0[0] + v0[1] * v0[1] + v0[2] * v0[2] + v0[3] * v0[3] + v1[0] * v1[0] + v1[1] * v1[1] + v1[2] * v1[2] + v1[3] * v1[3]; }
                sq += __shfl_xor(sq, 16); sq += __shfl_xor(sq, 32);
                if (fq == 0) atomicAdd(ssq + row, sq); }
    }
};
__device__ __forceinline__ float dpp_ror1(float v) { return __int_as_float(__builtin_amdgcn_update_dpp(0, __float_as_int(v), 0x121, 0xf, 0xf, false)); }
__device__ __forceinline__ float dpp_ror2(float v) { return __int_as_float(__builtin_amdgcn_update_dpp(0, __float_as_int(v), 0x122, 0xf, 0xf, false)); }
struct EpiFfnFused {
    static constexpr bool PERM = true;
    bf16_t* H; bf16_t* GH; bf16_t* GT; bf16_t* UH; const float* ssq; const float* cw; const float* cb;
    __device__ __forceinline__ void operator()(const f32x4 (&acc)[2][2][4][2], const Unit& u, int wr, int wc, int fr, int fq) const {
        const int ch0 = u.pn * 128 + wc * 32 + 8 * fq;
        float w0[8], w1[8], w2[8], bb[8];
#pragma unroll
        for (int h = 0; h < 2; ++h) { const f32x4 a = *(const f32x4*)(cw + ch0 + 4 * h), b = *(const f32x4*)(cw + DFF + ch0 + 4 * h), c = *(const f32x4*)(cw + 2 * DFF + ch0 + 4 * h), d = *(const f32x4*)(cb + ch0 + 4 * h);
#pragma unroll
            for (int j = 0; j < 4; ++j) { w0[4 * h + j] = a[j]; w1[4 * h + j] = b[j]; w2[4 * h + j] = c[j]; bb[4 * h + j] = d[j]; } }
#pragma unroll
        for (int ai = 0; ai < 2; ++ai) {
            const int grp = 4 * u.pm + 2 * ai + wr;
            float p1[8], p2[8];
#pragma unroll
            for (int q = 0; q < 8; ++q) { p1[q] = 0.f; p2[q] = 0.f; }
#pragma unroll
            for (int m = 0; m < 4; ++m) {
                const int row = u.pm * BM + ai * HALF + wr * 64 + m * 16 + fr;
                const float sc = rsqrtf(ssq[row] * (1.0f / 1024.0f) + EPS);
                float g[8], uu[8], c1[8], c2[8], hh[8];
#pragma unroll
                for (int n = 0; n < 2; ++n)
#pragma unroll
                    for (int j = 0; j < 4; ++j) { g[4 * n + j] = acc[ai][0][m][n][j] * sc; uu[4 * n + j] = acc[ai][1][m][n][j] * sc; }
#pragma unroll
                for (int q = 0; q < 8; ++q) { c1[q] = dpp_ror1(g[q]); c2[q] = dpp_ror2(g[q]); }
                if (m == 0 && fr < 2) { const size_t o = ((size_t)grp * 2 + fr) * DFF + ch0; *(u32x4*)(GH + o) = pack8(g); *(u32x4*)(UH + o) = pack8(uu); }
                if (m == 3 && fr >= 14) { const size_t o = ((size_t)grp * 2 + (fr - 14)) * DFF + ch0; *(u32x4*)(GT + o) = pack8(g); }
#pragma unroll
                for (int q = 0; q < 8; ++q) { const float gm1 = (fr == 0) ? p1[q] : c1[q], gm2 = (fr < 2) ? p2[q] : c2[q];
                    hh[q] = geluf_(bb[q] + w0[q] * gm2 + w1[q] * gm1 + w2[q] * g[q]) * uu[q]; p1[q] = c1[q]; p2[q] = c2[q]; }
                *(u32x4*)(H + (size_t)row * DFF + ch0) = pack8(hh);
            }
        }
    }
};
struct EpiLruIn {
    static constexpr bool PERM = true;
    bf16_t* GATE; bf16_t* XBP; const float* ssq;
    __device__ __forceinline__ void operator()(const f32x4 (&acc)[2][2][4][2], const Unit& u, int wr, int wc, int fr, int fq) const {
        const int row0 = u.pm * BM + wr * 64 + fr, lc = wc * 32 + 8 * fq;
        const bool isgate = u.pn < 4;
        bf16_t* base = isgate ? GATE : XBP; const int colt = (isgate ? u.pn : u.pn - 4) * 256 + lc;
#pragma unroll
        for (int ai = 0; ai < 2; ++ai)
#pragma unroll
            for (int m = 0; m < 4; ++m) { bf16_t* rowp = base + (size_t)(row0 + ai * HALF + m * 16) * 1024 + colt;
                const float sc = rsqrtf(ssq[row0 + ai * HALF + m * 16] * (1.0f / 1024.0f) + EPS);
#pragma unroll
                for (int bj = 0; bj < 2; ++bj) { f32x4 v0 = acc[ai][bj][m][0] * sc, v1 = acc[ai][bj][m][1] * sc;
                    if (isgate) {
#pragma unroll
                        for (int j = 0; j < 4; ++j) { v0[j] = geluf_(v0[j]); v1[j] = geluf_(v1[j]); } }
                    *(u32x4*)(rowp + bj * HALF) = pack44(v0, v1); } }
    }
};
struct EpiLruGate {
    static constexpr bool PERM = true;
    const bf16_t* XBC2; bf16_t* LA; bf16_t* UU; const float* ba; const float* bx; const float* sp;
    __device__ __forceinline__ void operator()(const f32x4 (&acc)[2][2][4][2], const Unit& u, int wr, int wc, int fr, int fq) const {
        const int row0 = u.pm * BM + wr * 64 + fr, ch0 = (u.pn >> 1) * 256 + (u.pn & 1) * 128 + wc * 32 + 8 * fq;
#pragma unroll
        for (int ai = 0; ai < 2; ++ai)
#pragma unroll
            for (int m = 0; m < 4; ++m) {
#pragma unroll
                for (int n = 0; n < 2; ++n) { const size_t o = (size_t)(row0 + ai * HALF + m * 16) * 1024 + ch0 + 4 * n;
                    const u32x2 xw = *(const u32x2*)(XBC2 + o);
                    const f32x4 vba = *(const f32x4*)(ba + ch0 + 4 * n), vbx = *(const f32x4*)(bx + ch0 + 4 * n), vsp = *(const f32x4*)(sp + ch0 + 4 * n);
                    const float xb[4] = {bf_lo(xw.x), bf_hi(xw.x), bf_lo(xw.y), bf_hi(xw.y)};
                    float la[4], uu[4];
#pragma unroll
                    for (int j = 0; j < 4; ++j) {
                        const float r = sigmoidf_(acc[ai][0][m][n][j] + vba[j]), ig = sigmoidf_(acc[ai][1][m][n][j] + vbx[j]);
                        const float l = -8.0f * r * vsp[j]; la[j] = l;
                        const float mult = sqrtf(fmaxf(0.0f, 1.0f - __expf(2.0f * l)));
                        uu[j] = mult * ig * xb[j]; }
                    u32x2 w1, w2; w1.x = cvt_pk_bf16(la[0], la[1]); w1.y = cvt_pk_bf16(la[2], la[3]); w2.x = cvt_pk_bf16(uu[0], uu[1]); w2.y = cvt_pk_bf16(uu[2], uu[3]);
                    *(u32x2*)(LA + o) = w1; *(u32x2*)(UU + o) = w2; }
                asm volatile("" ::: "memory"); }
    }
};

__device__ __forceinline__ void wconv_tile(const Ctx cx, const float* src, int ld_src, int nvalid, const float* gain, int k0, bf16_t* dst, int K, LAS unsigned char* lds) {
    const int tid = cx.tid; LAS bf16_t* L = (LAS bf16_t*)lds;
    { const int j = tid & 63, kk = tid >> 6;
#pragma unroll
      for (int i = 0; i < 8; ++i) { const int k = kk + 8 * i; float v = 0.f; if (j < nvalid) { v = src[(size_t)k * ld_src + j]; if (gain) v *= gain[k0 + k]; }
          L[j * 66 + k] = (bf16_t)(cvt_pk_bf16(v, 0.f) & 0xffffu); } }
    __syncthreads();
    { const int n = tid >> 3, kq = tid & 7; const LAS unsigned* q = (const LAS unsigned*)(L + n * 66 + kq * 8);
      u32x4 w; w.x = q[0]; w.y = q[1]; w.z = q[2]; w.w = q[3];
      *(u32x4*)(dst + (size_t)n * K + kq * 8) = w; }
    __syncthreads();
}
__device__ __forceinline__ void phase_prep(const Ctx cx, const Params& p, LAS unsigned char* lds) {
    unsigned char* ws = P_WS(p);
    constexpr int NT1 = 92 * 16, NT2 = 16 * 32, NT3 = 88 * 16, NT4 = 16 * 44, NT5 = 32 * 16, NT6 = 32 * 4, NT7 = 16 * 16;
    constexpr int NTASK = NT1 + NT2 + 2 * NT3 + 2 * NT4 + NT5 + NT6 + NT7;
    for (int task = cx.bid; task < NTASK; task += cx.nblk) {
        int id = task;
        if (id < NT1) { const int ntile = id / 16, kt = id % 16, n0 = ntile * 64, k0 = kt * 64, pn = n0 >> 8, lc0 = n0 & 255;
            int col, nv = 64;
            if (pn < 10) col = n0; else if (pn < 14) col = 2576 + (n0 - 2560);
            else if (pn < 22) col = (lc0 < 128 ? 3600 : 4624) + (pn - 14) * 128 + (lc0 & 127);
            else { col = 2560; nv = (lc0 == 0) ? 16 : 0; }
            wconv_tile(cx, IN(p, I_AB_WIN) + (size_t)k0 * 5648 + col, 5648, nv, IN(p, I_NORM_MIX), k0, (bf16_t*)(ws + WS_W1) + (size_t)n0 * 1024 + k0, 1024, lds); continue; }
        id -= NT1;
        if (id < NT2) { const int ntile = id / 32, kt = id % 32, n0 = ntile * 64, k0 = kt * 64;
            wconv_tile(cx, IN(p, I_AB_WOUT) + (size_t)k0 * 1024 + n0, 1024, 64, k0 < 1024 ? IN(p, I_SSD_NORM) : nullptr, k0, (bf16_t*)(ws + WS_W2) + (size_t)n0 * 2048 + k0, 2048, lds); continue; }
        id -= NT2;
        if (id < 2 * NT3) { const int l = id / NT3; id -= l * NT3; const int ntile = id / 16, kt = id % 16, n0 = ntile * 64, k0 = kt * 64, pn = n0 >> 8, lc0 = n0 & 255;
            const int col = (lc0 < 128 ? 0 : DFF) + pn * 128 + (lc0 & 127);
            wconv_tile(cx, IN(p, I_FFN_WIN) + (size_t)l * 1024 * 5632 + (size_t)k0 * 5632 + col, 5632, 64, IN(p, I_NORM_FFN) + l * 1024, k0, (bf16_t*)(ws + WS_W3) + (size_t)l * 5632 * 1024 + (size_t)n0 * 1024 + k0, 1024, lds); continue; }
        id -= 2 * NT3;
        if (id < 2 * NT4) { const int l = id / NT4; id -= l * NT4; const int ntile = id / 44, kt = id % 44, n0 = ntile * 64, k0 = kt * 64;
            wconv_tile(cx, IN(p, I_FFN_WOUT) + (size_t)l * DFF * 1024 + (size_t)k0 * 1024 + n0, 1024, 64, nullptr, k0, (bf16_t*)(ws + WS_W4) + (size_t)l * 1024 * DFF + (size_t)n0 * DFF + k0, DFF, lds); continue; }
        id -= 2 * NT4;
        if (id < NT5) { const int ntile = id / 16, kt = id % 16, n0 = ntile * 64, k0 = kt * 64;
            wconv_tile(cx, IN(p, I_LRU_WIN) + (size_t)k0 * 2048 + n0, 2048, 64, IN(p, I_NORM_MIX) + 1024, k0, (bf16_t*)(ws + WS_W5) + (size_t)n0 * 1024 + k0, 1024, lds); continue; }
        id -= NT5;
        if (id < NT6) { const int ntile = id / 4, kt = id % 4, n0 = ntile * 64, k0 = kt * 64, head = n0 >> 9, within = n0 & 511, pnl = within >> 8, lc0 = within & 255;
            const int ch = pnl * 128 + (lc0 & 127);
            const float* srcm = (lc0 < 128 ? IN(p, I_LRU_WA) : IN(p, I_LRU_WX)) + (size_t)head * 65536;
            wconv_tile(cx, srcm + (size_t)k0 * 256 + ch, 256, 64, nullptr, k0, (bf16_t*)(ws + WS_W6) + (size_t)n0 * 256 + k0, 256, lds); continue; }
        id -= NT6;
        { const int ntile = id / 16, kt = id % 16, n0 = ntile * 64, k0 = kt * 64;
            wconv_tile(cx, IN(p, I_LRU_WOUT) + (size_t)k0 * 1024 + n0, 1024, 64, nullptr, k0, (bf16_t*)(ws + WS_W7) + (size_t)n0 * 1024 + k0, 1024, lds); }
    }
    const int gt = cx.bid * NTHREADS + cx.tid, gs = cx.nblk * NTHREADS;
    for (int i = gt; i < 1024; i += gs) ((float*)(ws + WS_SP))[i] = softplusf_(-IN(p, I_LRU_LAMBDA)[i]);
    for (int i = gt; i < 5 * T; i += gs) ((float*)(ws + WS_SSQ))[i] = 0.f;
}

__device__ __forceinline__ void phase_norm(const Ctx cx, const float* xp, const float* xs, bf16_t* XN) {
    const int wid = cx.tid >> 6, lane = cx.tid & 63;
    for (int row = cx.bid * 8 + wid; row < T; row += cx.nblk * 8) {
        const float* src = row < TP ? xp + (size_t)row * DM : xs + (size_t)(row - TP) * DM;
        f32x4 v[4]; float s = 0.f;
#pragma unroll
        for (int j = 0; j < 4; ++j) { v[j] = *(const f32x4*)(src + lane * 4 + j * 256); s += v[j][0] * v[j][0] + v[j][1] * v[j][1] + v[j][2] * v[j][2] + v[j][3] * v[j][3]; }
#pragma unroll
        for (int o = 32; o >= 1; o >>= 1) s += __shfl_xor(s, o);
        const float rs = rsqrtf(s * (1.0f / 1024.0f) + EPS);
#pragma unroll
        for (int j = 0; j < 4; ++j) { u32x2 w; w.x = cvt_pk_bf16(v[j][0] * rs, v[j][1] * rs); w.y = cvt_pk_bf16(v[j][2] * rs, v[j][3] * rs);
            *(u32x2*)(XN + (size_t)row * DM + lane * 4 + j * 256) = w; }
    }
}
__device__ __forceinline__ void phase_final_norm(const Ctx cx, const bf16_t* XN, const float* ssq, const float* gain, float* y) {
    const int wid = cx.tid >> 6, lane = cx.tid & 63;
    f32x4 gv[4];
#pragma unroll
    for (int j = 0; j < 4; ++j) gv[j] = *(const f32x4*)(gain + lane * 16 + j * 4);
    for (int row0 = cx.bid * 8 + wid; row0 < T; row0 += cx.nblk * 32) {
        u32x4 w[4][2]; float rs[4];
#pragma unroll
        for (int i = 0; i < 4; ++i) { const int row = row0 + i * cx.nblk * 8;
            if (row < T) { w[i][0] = *(const u32x4*)(XN + (size_t)row * DM + lane * 16); w[i][1] = *(const u32x4*)(XN + (size_t)row * DM + lane * 16 + 8); rs[i] = rsqrtf(ssq[row] * (1.0f / 1024.0f) + EPS); } }
#pragma unroll
        for (int i = 0; i < 4; ++i) { const int row = row0 + i * cx.nblk * 8;
            if (row < T) { float f[16]; { float a[8], b[8]; unpack8(w[i][0], a); unpack8(w[i][1], b);
#pragma unroll
                    for (int q = 0; q < 8; ++q) { f[q] = a[q]; f[8 + q] = b[q]; } }
                float* dst = y + (size_t)row * DM + lane * 16;
#pragma unroll
                for (int j = 0; j < 4; ++j) *(f32x4*)(dst + j * 4) = (f32x4){f[4 * j], f[4 * j + 1], f[4 * j + 2], f[4 * j + 3]} * rs[i] * gv[j]; } }
    }
}

template <int KW, int MODE>
__device__ __forceinline__ void phase_conv(const Ctx cx, const bf16_t* src, int ld_src, int NC, const float* w, const float* bias, bf16_t* dst, int ld_dst,
                           const float* st_in, float* out_p, float* out_s) {
    const int ncg = NC >> 3, total = (T / 16) * ncg;
    for (int item = cx.bid * NTHREADS + cx.tid; item < total; item += cx.nblk * NTHREADS) {
        const int cgi = item % ncg, seg = item / ncg, c0 = cgi * 8, r0 = seg * 16;
        int seq, t0, L; if (r0 < TP) { seq = r0 >> 12; t0 = r0 & 4095; L = 4096; } else { seq = 16 + ((r0 - TP) >> 6); t0 = (r0 - TP) & 63; L = 64; }
        float wv[KW][8], bv[8];
#pragma unroll
        for (int k = 0; k < KW; ++k) { const f32x4 a = *(const f32x4*)(w + (size_t)k * NC + c0), b = *(const f32x4*)(w + (size_t)k * NC + c0 + 4);
#pragma unroll
            for (int j = 0; j < 4; ++j) { wv[k][j] = a[j]; wv[k][4 + j] = b[j]; } }
        { const f32x4 a = *(const f32x4*)(bias + c0), b = *(const f32x4*)(bias + c0 + 4);
#pragma unroll
          for (int j = 0; j < 4; ++j) { bv[j] = a[j]; bv[4 + j] = b[j]; } }
        float win[KW - 1][8];
#pragma unroll
        for (int k = 0; k < KW - 1; ++k) {
            if (t0 > 0) unpack8(*(const u32x4*)(src + (size_t)(r0 - (KW - 1) + k) * ld_src + c0), win[k]);
            else if (seq >= 16) { const float* sp_ = st_in + ((size_t)(seq - 16) * (KW - 1) + k) * NC + c0; const f32x4 a = *(const f32x4*)sp_, b = *(const f32x4*)(sp_ + 4);
#pragma unroll
                for (int j = 0; j < 4; ++j) { win[k][j] = a[j]; win[k][4 + j] = b[j]; } }
            else {
#pragma unroll
                for (int j = 0; j < 8; ++j) win[k][j] = 0.f; }
        }
#pragma unroll
        for (int h = 0; h < 2; ++h) {
            u32x4 rows[8], aux[8];
#pragma unroll
            for (int i = 0; i < 8; ++i) { rows[i] = *(const u32x4*)(src + (size_t)(r0 + h * 8 + i) * ld_src + c0);
                if (MODE == 1 || MODE == 2) aux[i] = *(const u32x4*)(dst + (size_t)(r0 + h * 8 + i) * ld_dst + c0); }
#pragma unroll
            for (int i = 0; i < 8; ++i) {
                float cur[8], y[8]; unpack8(rows[i], cur);
#pragma unroll
                for (int j = 0; j < 8; ++j) { float a = bv[j] + wv[KW - 1][j] * cur[j];
#pragma unroll
                    for (int k = 0; k < KW - 1; ++k) a += wv[k][j] * win[k][j];
                    y[j] = a; }
#pragma unroll
                for (int j = 0; j < 8; ++j) {
#pragma unroll
                    for (int k = 0; k < KW - 2; ++k) win[k][j] = win[k + 1][j];
                    win[KW - 2][j] = cur[j]; }
                if (MODE == 0) {
#pragma unroll
                    for (int j = 0; j < 8; ++j) y[j] = siluf_(y[j]); }
                if (MODE == 1) { float gq[8]; unpack8(aux[i], gq);
#pragma unroll
                    for (int j = 0; j < 8; ++j) y[j] = y[j] * gq[j]; }
                if (MODE == 2) { float uq[8]; unpack8(aux[i], uq);
#pragma unroll
                    for (int j = 0; j < 8; ++j) y[j] = geluf_(y[j]) * uq[j]; }
                *(u32x4*)(dst + (size_t)(r0 + h * 8 + i) * ld_dst + c0) = pack8(y);
            }
            if (h == 1 && t0 + 16 == L) {
                float* ob = (seq < 16 ? out_p + (size_t)seq * (KW - 1) * NC : out_s + (size_t)(seq - 16) * (KW - 1) * NC) + c0;
#pragma unroll
                for (int j = 0; j < KW - 1; ++j) { float f[8]; unpack8(rows[8 - (KW - 1) + j], f);
                    *(f32x4*)(ob + (size_t)j * NC) = (f32x4){f[0], f[1], f[2], f[3]}; *(f32x4*)(ob + (size_t)j * NC + 4) = (f32x4){f[4], f[5], f[6], f[7]}; }
            }
        }
    }
}

__device__ __forceinline__ void phase_ffn_fix(const Ctx cx, const bf16_t* GH, const bf16_t* GT, const bf16_t* UH, bf16_t* H, const float* cw, const float* cb,
                                              const float* st_in, float* out_p, float* out_s) {
    const int ncg = DFF / 8, total = 1032 * ncg;
    for (int item = cx.bid * NTHREADS + cx.tid; item < total; item += cx.nblk * NTHREADS) {
        const int cgi = item % ncg, G = item / ncg, c0 = cgi * 8;
        int seq; bool first, lastg;
        if (G < 1024) { seq = G >> 6; first = (G & 63) == 0; lastg = (G & 63) == 63; } else { seq = 16 + (G - 1024); first = true; lastg = true; }
        float w0[8], w1[8], w2[8], bb[8], gm2[8], gm1[8], g0[8], g1[8], u0[8], u1[8];
#pragma unroll
        for (int h = 0; h < 2; ++h) { const f32x4 a = *(const f32x4*)(cw + c0 + 4 * h), b = *(const f32x4*)(cw + DFF + c0 + 4 * h), c = *(const f32x4*)(cw + 2 * DFF + c0 + 4 * h), d = *(const f32x4*)(cb + c0 + 4 * h);
#pragma unroll
            for (int j = 0; j < 4; ++j) { w0[4 * h + j] = a[j]; w1[4 * h + j] = b[j]; w2[4 * h + j] = c[j]; bb[4 * h + j] = d[j]; } }
        if (!first) { unpack8(*(const u32x4*)(GT + ((size_t)(G - 1) * 2 + 0) * DFF + c0), gm2); unpack8(*(const u32x4*)(GT + ((size_t)(G - 1) * 2 + 1) * DFF + c0), gm1); }
        else if (seq >= 16) { const float* s0 = st_in + ((size_t)(seq - 16) * 2) * DFF + c0;
#pragma unroll
            for (int h = 0; h < 2; ++h) { const f32x4 a = *(const f32x4*)(s0 + 4 * h), b = *(const f32x4*)(s0 + DFF + 4 * h);
#pragma unroll
                for (int j = 0; j < 4; ++j) { gm2[4 * h + j] = a[j]; gm1[4 * h + j] = b[j]; } } }
        else {
#pragma unroll
            for (int q = 0; q < 8; ++q) { gm2[q] = 0.f; gm1[q] = 0.f; } }
        unpack8(*(const u32x4*)(GH + ((size_t)G * 2 + 0) * DFF + c0), g0); unpack8(*(const u32x4*)(GH + ((size_t)G * 2 + 1) * DFF + c0), g1);
        unpack8(*(const u32x4*)(UH + ((size_t)G * 2 + 0) * DFF + c0), u0); unpack8(*(const u32x4*)(UH + ((size_t)G * 2 + 1) * DFF + c0), u1);
        float h0[8], h1[8];
#pragma unroll
        for (int q = 0; q < 8; ++q) { h0[q] = geluf_(bb[q] + w0[q] * gm2[q] + w1[q] * gm1[q] + w2[q] * g0[q]) * u0[q];
            h1[q] = geluf_(bb[q] + w0[q] * gm1[q] + w1[q] * g0[q] + w2[q] * g1[q]) * u1[q]; }
        *(u32x4*)(H + (size_t)(G * 64) * DFF + c0) = pack8(h0); *(u32x4*)(H + (size_t)(G * 64 + 1) * DFF + c0) = pack8(h1);
        if (lastg) {
            float* ob = (seq < 16 ? out_p + (size_t)seq * 2 * DFF : out_s + (size_t)(seq - 16) * 2 * DFF) + c0;
#pragma unroll
            for (int j = 0; j < 2; ++j) { float f[8]; unpack8(*(const u32x4*)(GT + ((size_t)G * 2 + j) * DFF + c0), f);
                *(f32x4*)(ob + (size_t)j * DFF) = (f32x4){f[0], f[1], f[2], f[3]}; *(f32x4*)(ob + (size_t)j * DFF + 4) = (f32x4){f[4], f[5], f[6], f[7]}; }
        }
    }
}

constexpr int SC_CS = 0, SC_BS = 17408, SC_BTS = 34816, SC_XTS = 53248, SC_XDS = 62464, SC_HS = 71680, SC_MS = 89088, SC_AS = 98304, SC_SQ = 98560;
__device__ __forceinline__ void ssd_task(const Ctx cx, const Params& p, LAS unsigned char* lds, int seq, int hd) {
    const int tid = cx.tid, wid = tid >> 6, lane = tid & 63, fr = lane & 15, fq = lane >> 4;
    unsigned char* ws = P_WS(p);
    const bf16_t* XBCA = (const bf16_t*)(ws + WS_XBCA); bf16_t* A2 = (bf16_t*)(ws + WS_A2); const float* DT = (const float*)(ws + WS_DT); float* SSQ = (float*)(ws + WS_SSQ);
    const int g = hd >> 3, nchunks = seq < 16 ? 64 : 1;
    const size_t row_base = seq < 16 ? (size_t)seq * 4096 : (size_t)TP + (size_t)(seq - 16) * 64;
    const float Aneg = -__expf(IN(p, I_A_LOG)[hd]), Dh = IN(p, I_SSD_D)[hd];
    LAS float* As = (LAS float*)(lds + SC_AS); LAS float* Sq = (LAS float*)(lds + SC_SQ);
    f32x4 hst[4];
#pragma unroll
    for (int pt = 0; pt < 4; ++pt) {
        if (seq >= 16) hst[pt] = *(const f32x4*)(IN(p, I_ST_SSD) + ((size_t)((seq - 16) * 16 + hd) * 64 + 16 * pt + fr) * 128 + 16 * wid + 4 * fq);
        else hst[pt] = (f32x4){0.f, 0.f, 0.f, 0.f};
    }
    const int lt = wid >> 1, ph = wid & 1;
    float pf_dt; u32x4 pf_b[2], pf_c[2], pf_x, pf_bt[2];
#define SSD_PREFETCH(cc) do { const size_t r0p = row_base + (size_t)(cc) * 64; \
        pf_dt = DT[(r0p + lane) * 16 + hd]; \
        _Pragma("unroll") for (int i = 0; i < 2; ++i) { const int q = tid + i * 512, row = q >> 4, sg = q & 15; \
            const bf16_t* gp = XBCA + (r0p + row) * XBC + 1024 + g * 128 + sg * 8; pf_b[i] = *(const u32x4*)gp; pf_c[i] = *(const u32x4*)(gp + 256); } \
        pf_x = *(const u32x4*)(XBCA + (r0p + lane) * XBC + hd * 64 + wid * 8); \
        _Pragma("unroll") for (int i = 0; i < 2; ++i) pf_bt[i] = *(const u32x4*)(XBCA + (r0p + lane) * XBC + 1024 + g * 128 + (wid + 8 * i) * 8); } while (0)
    SSD_PREFETCH(0);
    for (int c = 0; c < nchunks; ++c) {
        const size_t r0 = row_base + (size_t)c * 64;
        const float dt_l = pf_dt;
        float a = dt_l * Aneg;
#pragma unroll
        for (int o = 1; o < 64; o <<= 1) { const float t = __shfl_up(a, o); if (lane >= o) a += t; }
        const float a63 = __shfl(a, 63);
        const float wl = dt_l * __expf(a63 - a);
        if (wid == 0) As[lane] = a;
#pragma unroll
        for (int i = 0; i < 2; ++i) { const int q = tid + i * 512, row = q >> 4, sg = q & 15;
            *(LAS u32x4*)(lds + SC_BS + row * 272 + sg * 16) = pf_b[i]; *(LAS u32x4*)(lds + SC_CS + row * 272 + sg * 16) = pf_c[i]; }
        { float f[8]; unpack8(pf_x, f);
          LAS bf16_t* xt = (LAS bf16_t*)(lds + SC_XTS), *xd = (LAS bf16_t*)(lds + SC_XDS);
#pragma unroll
          for (int j = 0; j < 8; ++j) { const unsigned w2 = cvt_pk_bf16(f[j] * dt_l, f[j] * wl); xt[(wid * 8 + j) * 72 + lane] = (bf16_t)(w2 & 0xffffu); xd[(wid * 8 + j) * 72 + lane] = (bf16_t)(w2 >> 16); } }
#pragma unroll
        for (int i = 0; i < 2; ++i) { const int sg = wid + 8 * i; const u32x4 bw = pf_bt[i];
            LAS bf16_t* bt = (LAS bf16_t*)(lds + SC_BTS);
            bt[(sg * 8 + 0) * 72 + lane] = (bf16_t)(bw.x & 0xffffu); bt[(sg * 8 + 1) * 72 + lane] = (bf16_t)(bw.x >> 16);
            bt[(sg * 8 + 2) * 72 + lane] = (bf16_t)(bw.y & 0xffffu); bt[(sg * 8 + 3) * 72 + lane] = (bf16_t)(bw.y >> 16);
            bt[(sg * 8 + 4) * 72 + lane] = (bf16_t)(bw.z & 0xffffu); bt[(sg * 8 + 5) * 72 + lane] = (bf16_t)(bw.z >> 16);
            bt[(sg * 8 + 6) * 72 + lane] = (bf16_t)(bw.w & 0xffffu); bt[(sg * 8 + 7) * 72 + lane] = (bf16_t)(bw.w >> 16); }
#pragma unroll
        for (int pt = 0; pt < 4; ++pt) { u32x2 w2; w2.x = cvt_pk_bf16(hst[pt][0], hst[pt][1]); w2.y = cvt_pk_bf16(hst[pt][2], hst[pt][3]);
            *(LAS u32x2*)(lds + SC_HS + (16 * pt + fr) * 272 + (16 * wid + 4 * fq) * 2) = w2; }
        u32x2 ep_z[2], ep_x[2];
#pragma unroll
        for (int j = 0; j < 2; ++j) { const size_t rowe = r0 + 16 * lt + fr; const int col = hd * 64 + 16 * (2 * ph + j) + 4 * fq;
            ep_z[j] = *(const u32x2*)(A2 + rowe * 2048 + col); ep_x[j] = *(const u32x2*)(XBCA + rowe * XBC + col); }
        if (c + 1 < nchunks) SSD_PREFETCH(c + 1);
        __syncthreads();
        f32x4 yacc[2];
        {
            bf16x8 cf[4];
#pragma unroll
            for (int kk = 0; kk < 4; ++kk) cf[kk] = *(const LAS bf16x8*)(lds + SC_CS + (16 * lt + fr) * 272 + kk * 64 + fq * 16);
            const float a_l = As[16 * lt + fr];
#pragma unroll
            for (int j = 0; j < 2; ++j) {
                const int st = 2 * ph + j;
                f32x4 cb = (f32x4){0.f, 0.f, 0.f, 0.f};
                if (st <= lt) {
#pragma unroll
                    for (int kk = 0; kk < 4; ++kk) { const bf16x8 bf = *(const LAS bf16x8*)(lds + SC_BS + (16 * st + fr) * 272 + kk * 64 + fq * 16);
                        cb = __builtin_amdgcn_mfma_f32_16x16x32_bf16(bf, cf[kk], cb, 0, 0, 0); }
                    const f32x4 as4 = *(const LAS f32x4*)(lds + SC_AS + (16 * st + 4 * fq) * 4);
#pragma unroll
                    for (int r = 0; r < 4; ++r) { const int s = 16 * st + 4 * fq + r, l = 16 * lt + fr; cb[r] = (s <= l) ? cb[r] * __expf(a_l - as4[r]) : 0.f; }
                }
                u32x2 w2; w2.x = cvt_pk_bf16(cb[0], cb[1]); w2.y = cvt_pk_bf16(cb[2], cb[3]);
                *(LAS u32x2*)(lds + SC_MS + (16 * lt + fr) * 144 + (16 * st + 4 * fq) * 2) = w2;
            }
            const float el = __expf(a_l);
#pragma unroll
            for (int j = 0; j < 2; ++j) { const int pt = 2 * ph + j; f32x4 y = (f32x4){0.f, 0.f, 0.f, 0.f};
#pragma unroll
                for (int kk = 0; kk < 4; ++kk) { const bf16x8 hf = *(const LAS bf16x8*)(lds + SC_HS + (16 * pt + fr) * 272 + kk * 64 + fq * 16);
                    y = __builtin_amdgcn_mfma_f32_16x16x32_bf16(hf, cf[kk], y, 0, 0, 0); }
                yacc[j] = y * el; }
        }
        {
            const float dec = __expf(a63);
            bf16x8 btf[2];
#pragma unroll
            for (int kk = 0; kk < 2; ++kk) btf[kk] = *(const LAS bf16x8*)(lds + SC_BTS + (16 * wid + fr) * 144 + kk * 64 + fq * 16);
#pragma unroll
            for (int pt = 0; pt < 4; ++pt) { f32x4 h = hst[pt] * dec;
#pragma unroll
                for (int kk = 0; kk < 2; ++kk) { const bf16x8 xf = *(const LAS bf16x8*)(lds + SC_XDS + (16 * pt + fr) * 144 + kk * 64 + fq * 16);
                    h = __builtin_amdgcn_mfma_f32_16x16x32_bf16(btf[kk], xf, h, 0, 0, 0); }
                hst[pt] = h; }
        }
        __syncthreads();
        {
            bf16x8 mf[2];
#pragma unroll
            for (int kk = 0; kk < 2; ++kk) mf[kk] = *(const LAS bf16x8*)(lds + SC_MS + (16 * lt + fr) * 144 + kk * 64 + fq * 16);
            float sq = 0.f;
            const size_t row = r0 + 16 * lt + fr;
#pragma unroll
            for (int j = 0; j < 2; ++j) { const int pt = 2 * ph + j; f32x4 y = yacc[j];
#pragma unroll
                for (int kk = 0; kk < 2; ++kk) { const bf16x8 xf = *(const LAS bf16x8*)(lds + SC_XTS + (16 * pt + fr) * 144 + kk * 64 + fq * 16);
                    y = __builtin_amdgcn_mfma_f32_16x16x32_bf16(xf, mf[kk], y, 0, 0, 0); }
                const int col = hd * 64 + 16 * pt + 4 * fq;
                const u32x2 zw = ep_z[j], xw = ep_x[j];
                const float z0 = bf_lo(zw.x), z1 = bf_hi(zw.x), z2 = bf_lo(zw.y), z3 = bf_hi(zw.y);
                const float x0 = bf_lo(xw.x), x1 = bf_hi(xw.x), x2 = bf_lo(xw.y), x3 = bf_hi(xw.y);
                const float g0 = (y[0] + Dh * x0) * siluf_(z0), g1 = (y[1] + Dh * x1) * siluf_(z1), g2 = (y[2] + Dh * x2) * siluf_(z2), g3 = (y[3] + Dh * x3) * siluf_(z3);
                sq += g0 * g0 + g1 * g1 + g2 * g2 + g3 * g3;
                u32x2 ow; ow.x = cvt_pk_bf16(g0, g1); ow.y = cvt_pk_bf16(g2, g3);
                *(u32x2*)(A2 + row * 2048 + col) = ow; }
            sq += __shfl_xor(sq, 16); sq += __shfl_xor(sq, 32);
            if (fq == 0) Sq[ph * 64 + 16 * lt + fr] = sq;
        }
        __syncthreads();
        if (tid < 64) atomicAdd(SSQ + r0 + tid, Sq[tid] + Sq[64 + tid]);
    }
    float* so = (seq < 16 ? P_OUT(p) + O_P_SSD + (size_t)(seq * 16 + hd) * 8192 : P_OUT(p) + O_S_SSD + (size_t)((seq - 16) * 16 + hd) * 8192);
#pragma unroll
    for (int pt = 0; pt < 4; ++pt) *(f32x4*)(so + (size_t)(16 * pt + fr) * 128 + 16 * wid + 4 * fq) = hst[pt];
    __syncthreads();
}
__device__ __forceinline__ void phase_ssd(const Ctx cx, const Params& p, LAS unsigned char* lds) {
    for (int task = cx.bid; task < 384; task += cx.nblk) {
        if (task < 256) ssd_task(cx, p, lds, task >> 4, task & 15);
        else ssd_task(cx, p, lds, 16 + ((task - 256) >> 4), (task - 256) & 15);
    }
}

__device__ __forceinline__ void phase_lru_a(const Ctx cx, const bf16_t* LA, const bf16_t* UU, float* SL, float* HH) {
    const int total = 1032 * 128;
    for (int item = cx.bid * NTHREADS + cx.tid; item < total; item += cx.nblk * NTHREADS) {
        const int cgi = item & 127, ch = item >> 7, c0 = cgi * 8; const size_t r0 = (size_t)ch * 64;
        float sl[8], h[8];
#pragma unroll
        for (int j = 0; j < 8; ++j) { sl[j] = 0.f; h[j] = 0.f; }
        for (int i0 = 0; i0 < 64; i0 += 8) {
            u32x4 la[8], uu[8];
#pragma unroll
            for (int i = 0; i < 8; ++i) { la[i] = *(const u32x4*)(LA + (r0 + i0 + i) * 1024 + c0); uu[i] = *(const u32x4*)(UU + (r0 + i0 + i) * 1024 + c0); }
#pragma unroll
            for (int i = 0; i < 8; ++i) { float l[8], u[8]; unpack8(la[i], l); unpack8(uu[i], u);
#pragma unroll
                for (int j = 0; j < 8; ++j) { sl[j] += l[j]; h[j] = __expf(l[j]) * h[j] + u[j]; } }
        }
        float* o1 = SL + (size_t)ch * 1024 + c0; float* o2 = HH + (size_t)ch * 1024 + c0;
        *(f32x4*)o1 = (f32x4){sl[0], sl[1], sl[2], sl[3]}; *(f32x4*)(o1 + 4) = (f32x4){sl[4], sl[5], sl[6], sl[7]};
        *(f32x4*)o2 = (f32x4){h[0], h[1], h[2], h[3]}; *(f32x4*)(o2 + 4) = (f32x4){h[4], h[5], h[6], h[7]};
    }
}
__device__ __forceinline__ void phase_lru_b(const Ctx cx, const Params& p, const float* SL, const float* HH, float* CIN) {
    for (int item = cx.bid * NTHREADS + cx.tid; item < 24 * 1024; item += cx.nblk * NTHREADS) {
        const int chn = item & 1023, seq = item >> 10;
        const int nch = seq < 16 ? 64 : 1, ch0 = seq < 16 ? seq * 64 : 1024 + (seq - 16);
        float c = seq < 16 ? 0.f : IN(p, I_ST_LRU)[(seq - 16) * 1024 + chn];
        for (int i0 = 0; i0 < nch; i0 += 16) {
            float sl[16], hh[16];
#pragma unroll
            for (int i = 0; i < 16; ++i) if (i0 + i < nch) { sl[i] = SL[(size_t)(ch0 + i0 + i) * 1024 + chn]; hh[i] = HH[(size_t)(ch0 + i0 + i) * 1024 + chn]; }
#pragma unroll
            for (int i = 0; i < 16; ++i) if (i0 + i < nch) { CIN[(size_t)(ch0 + i0 + i) * 1024 + chn] = c; c = __expf(sl[i]) * c + hh[i]; }
        }
        (seq < 16 ? P_OUT(p) + O_P_LRU + seq * 1024 : P_OUT(p) + O_S_LRU + (seq - 16) * 1024)[chn] = c;
    }
}
__device__ __forceinline__ void phase_lru_c(const Ctx cx, const bf16_t* LA, const bf16_t* UU, const float* CIN, bf16_t* GATE) {
    const int total = 1032 * 128;
    for (int item = cx.bid * NTHREADS + cx.tid; item < total; item += cx.nblk * NTHREADS) {
        const int cgi = item & 127, ch = item >> 7, c0 = cgi * 8; const size_t r0 = (size_t)ch * 64;
        float h[8];
        { const float* ci = CIN + (size_t)ch * 1024 + c0; const f32x4 a = *(const f32x4*)ci, b = *(const f32x4*)(ci + 4);
#pragma unroll
          for (int j = 0; j < 4; ++j) { h[j] = a[j]; h[4 + j] = b[j]; } }
        for (int i0 = 0; i0 < 64; i0 += 8) {
            u32x4 la[8], uu[8], gt[8];
#pragma unroll
            for (int i = 0; i < 8; ++i) { la[i] = *(const u32x4*)(LA + (r0 + i0 + i) * 1024 + c0); uu[i] = *(const u32x4*)(UU + (r0 + i0 + i) * 1024 + c0); gt[i] = *(const u32x4*)(GATE + (r0 + i0 + i) * 1024 + c0); }
#pragma unroll
            for (int i = 0; i < 8; ++i) { float l[8], u[8], gq[8], o[8]; unpack8(la[i], l); unpack8(uu[i], u); unpack8(gt[i], gq);
#pragma unroll
                for (int j = 0; j < 8; ++j) { h[j] = __expf(l[j]) * h[j] + u[j]; o[j] = gq[j] * h[j]; }
                *(u32x4*)(GATE + (r0 + i0 + i) * 1024 + c0) = pack8(o); }
        }
    }
}

#define XB_TMO      128
#define XB_XCNT(j)  (256  + 64 * (j))
#define XB_XSUB(j)  (1280 + 64 * (j))
#define XB_XGEN(j)  (2304 + 64 * (j))
#define XB_TOP      3328
#define XB_TOPGEN   3392
#define XCD_BAR_WORDS 3456
#define XB_SPIN_CAP (1u << 18)
__device__ __forceinline__ unsigned xb_ld(unsigned* p)              { return __hip_atomic_load(p, __ATOMIC_RELAXED, __HIP_MEMORY_SCOPE_AGENT); }
__device__ __forceinline__ unsigned xb_add(unsigned* p, unsigned v) { return __hip_atomic_fetch_add(p, v, __ATOMIC_RELAXED, __HIP_MEMORY_SCOPE_AGENT); }
__device__ __forceinline__ unsigned xb_xcc_id() { return (unsigned)__builtin_amdgcn_s_getreg((3 << 11) | 20) & 0xFu; }
#define XB_SPIN(cond, bar) do { unsigned _sp = 0; while (cond) { __builtin_amdgcn_s_sleep(1); \
    if ((++_sp & 255u) == 0u) { if (xb_ld(&(bar)[XB_TMO])) break; if (_sp > XB_SPIN_CAP) { atomicAdd(&(bar)[XB_TMO], 1u); break; } } } } while (0)
struct XcdBarrier { unsigned* bar; unsigned x; volatile LAS unsigned* st; };
__device__ __forceinline__ XcdBarrier xcd_barrier_post(unsigned* bar, volatile LAS unsigned* st) {
    XcdBarrier b; b.bar = bar; b.x = xb_xcc_id(); b.st = st;
    if (threadIdx.x == 0) (void)xb_add(&bar[XB_XCNT(b.x)], 1u);
    return b;
}
__device__ __forceinline__ void xcd_barrier_complete(unsigned* bar, unsigned x, unsigned& nloc, unsigned& nx) {
    const unsigned G = gridDim.x * gridDim.y * gridDim.z;
    unsigned sum, cnt, mine, sp = 0u;
    for (;;) {
        sum = 0u; cnt = 0u; mine = 0u;
#pragma unroll
        for (unsigned j = 0; j < 16; ++j) { const unsigned c = xb_ld(&bar[XB_XCNT(j)]); sum += c; cnt += (c > 0u) ? 1u : 0u; mine = (j == x) ? c : mine; }
        if (sum == G) break;
        __builtin_amdgcn_s_sleep(1);
        if ((++sp & 255u) == 0u) { if (xb_ld(&bar[XB_TMO])) break; if (sp > XB_SPIN_CAP) { atomicAdd(&bar[XB_TMO], 1u); break; } }
    }
    nloc = mine > 0u ? mine : 1u; nx = cnt > 0u ? cnt : 1u;
}
__device__ __forceinline__ void xcd_barrier(const XcdBarrier& b) {
    asm volatile("s_waitcnt vmcnt(0)" ::: "memory");
    __syncthreads();
    if (threadIdx.x == 0) {
        unsigned* bar = b.bar;
        __builtin_amdgcn_s_waitcnt(0);
        unsigned nloc = b.st[0], nx = b.st[1];
        if (nloc == 0u) { xcd_barrier_complete(bar, b.x, nloc, nx); b.st[0] = nloc; b.st[1] = nx; }
        const unsigned old = xb_add(&bar[XB_XSUB(b.x)], 1u);
        const unsigned gen = old / nloc;
        if (old + 1u == (gen + 1u) * nloc) {
            __builtin_amdgcn_fence(__ATOMIC_RELEASE, "agent");
            asm volatile("s_waitcnt vmcnt(0)" ::: "memory");
            const unsigned og = xb_add(&bar[XB_TOP], 1u);
            const unsigned tg = og / nx;
            if (og + 1u == (tg + 1u) * nx) xb_add(&bar[XB_TOPGEN], 1u);
            else XB_SPIN(xb_ld(&bar[XB_TOPGEN]) == tg, bar);
            __builtin_amdgcn_fence(__ATOMIC_ACQUIRE, "agent");
            xb_add(&bar[XB_XGEN(b.x)], 1u);
            asm volatile("s_waitcnt vmcnt(0)" ::: "memory");
        } else {
            XB_SPIN(xb_ld(&bar[XB_XGEN(b.x)]) == gen, bar);
            __builtin_amdgcn_fence(__ATOMIC_ACQUIRE, "agent");
            asm volatile("s_waitcnt vmcnt(0)" ::: "memory");
        }
    }
    __syncthreads();
}

constexpr int NPHASE = 19;
__device__ __forceinline__ void run_phase(const Params& p, int ph, LAS unsigned char* lds) {
    Ctx cx; { int b = blockIdx.x, n = gridDim.x, t = threadIdx.x; asm volatile("" : "+s"(b), "+s"(n), "+v"(t)); cx.bid = b; cx.nblk = n; cx.tid = t; }
    unsigned char* ws = P_WS(p);
    bf16_t* XN = (bf16_t*)(ws + WS_XN);
    float* Y = P_OUT(p) + O_Y;
    float* SSQ = (float*)(ws + WS_SSQ);
    switch (ph) {
    case 0: phase_prep(cx, p, lds); phase_norm(cx, IN(p, I_XP), IN(p, I_XS), XN); break;
    case 1: { Gemm g{XN, (const bf16_t*)(ws + WS_W1), T, N1, 1024, 1024, 0, 0};
        EpiG1 e{(bf16_t*)(ws + WS_A2), (bf16_t*)(ws + WS_XBCP), (bf16_t*)(ws + WS_V), (float*)(ws + WS_DT), IN(p, I_DT_BIAS)};
        gemm_phase<EpiG1, false>(cx, lds, g, e, nullptr); } break;
    case 2:
        phase_conv<4, 0>(cx, (const bf16_t*)(ws + WS_XBCP), XBC, XBC, IN(p, I_SSD_CONVW), IN(p, I_SSD_CONVB), (bf16_t*)(ws + WS_XBCA), XBC, IN(p, I_ST_SSDCONV), P_OUT(p) + O_P_SSDCONV, P_OUT(p) + O_S_SSDCONV);
        phase_conv<3, 1>(cx, (const bf16_t*)(ws + WS_V), 1024, 1024, IN(p, I_SC_CONVW), IN(p, I_SC_CONVB), (bf16_t*)(ws + WS_A2) + 1024, 2048, IN(p, I_ST_SCONV), P_OUT(p) + O_P_SCONV, P_OUT(p) + O_S_SCONV);
        break;
    case 3: phase_ssd(cx, p, lds); break;
    case 4: { Gemm g{(const bf16_t*)(ws + WS_A2), (const bf16_t*)(ws + WS_W2), T, 1024, 2048, 2048, 0, 0};
        EpiRes<true> e{IN(p, I_XP), IN(p, I_XS), XN, SSQ + T};
        gemm_phase<EpiRes<true>, true>(cx, lds, g, e, SSQ); } break;
    case 5: case 15: { const int l = ph == 5 ? 0 : 1;
        Gemm g{XN, (const bf16_t*)(ws + WS_W3) + (size_t)l * 5632 * 1024, T, 5632, 1024, 1024, 0, 0};
        EpiFfnFused e{(bf16_t*)(ws + WS_H), (bf16_t*)(ws + WS_GH), (bf16_t*)(ws + WS_GT), (bf16_t*)(ws + WS_UH), SSQ + (l == 0 ? T : 3 * T), IN(p, I_FFN_CONVW) + l * 3 * DFF, IN(p, I_FFN_CONVB) + l * DFF};
        gemm_phase<EpiFfnFused, false>(cx, lds, g, e, nullptr); } break;
    case 6: case 16: { const int l = ph == 6 ? 0 : 1;
        phase_ffn_fix(cx, (const bf16_t*)(ws + WS_GH), (const bf16_t*)(ws + WS_GT), (const bf16_t*)(ws + WS_UH), (bf16_t*)(ws + WS_H), IN(p, I_FFN_CONVW) + l * 3 * DFF, IN(p, I_FFN_CONVB) + l * DFF,
                      IN(p, I_ST_FFNCONV) + l * 8 * 2 * DFF, P_OUT(p) + O_P_FFNCONV + l * 16 * 2 * DFF, P_OUT(p) + O_S_FFNCONV + l * 8 * 2 * DFF); } break;
    case 7: case 17: { const int l = ph == 7 ? 0 : 1;
        Gemm g{(const bf16_t*)(ws + WS_H), (const bf16_t*)(ws + WS_W4) + (size_t)l * 1024 * DFF, T, 1024, DFF, DFF, 0, 0};
        EpiRes<false> e{nullptr, nullptr, XN, SSQ + (l == 0 ? 2 * T : 4 * T)};
        gemm_phase<EpiRes<false>, false>(cx, lds, g, e, nullptr); } break;
    case 8: { Gemm g{XN, (const bf16_t*)(ws + WS_W5), T, 2048, 1024, 1024, 0, 0};
        EpiLruIn e{(bf16_t*)(ws + WS_GATE), (bf16_t*)(ws + WS_XBP), SSQ + 2 * T};
        gemm_phase<EpiLruIn, false>(cx, lds, g, e, nullptr); } break;
    case 9: phase_conv<4, 3>(cx, (const bf16_t*)(ws + WS_XBP), 1024, 1024, IN(p, I_LRU_CONVW), IN(p, I_LRU_CONVB), (bf16_t*)(ws + WS_XBC2), 1024, IN(p, I_ST_LRUCONV), P_OUT(p) + O_P_LRUCONV, P_OUT(p) + O_S_LRUCONV); break;
    case 10: { Gemm g{(const bf16_t*)(ws + WS_XBC2), (const bf16_t*)(ws + WS_W6), T, 2048, 256, 1024, 1, 256};
        EpiLruGate e{(const bf16_t*)(ws + WS_XBC2), (bf16_t*)(ws + WS_LA), (bf16_t*)(ws + WS_UU), IN(p, I_LRU_BA), IN(p, I_LRU_BX), (const float*)(ws + WS_SP)};
        gemm_phase<EpiLruGate, false>(cx, lds, g, e, nullptr); } break;
    case 11: phase_lru_a(cx, (const bf16_t*)(ws + WS_LA), (const bf16_t*)(ws + WS_UU), (float*)(ws + WS_SL), (float*)(ws + WS_HH)); break;
    case 12: phase_lru_b(cx, p, (const float*)(ws + WS_SL), (const float*)(ws + WS_HH), (float*)(ws + WS_CIN)); break;
    case 13: phase_lru_c(cx, (const bf16_t*)(ws + WS_LA), (const bf16_t*)(ws + WS_UU), (const float*)(ws + WS_CIN), (bf16_t*)(ws + WS_GATE)); break;
    case 14: { Gemm g{(const bf16_t*)(ws + WS_GATE), (const bf16_t*)(ws + WS_W7), T, 1024, 1024, 1024, 0, 0};
        EpiRes<false> e{nullptr, nullptr, XN, SSQ + 3 * T};
        gemm_phase<EpiRes<false>, false>(cx, lds, g, e, nullptr); } break;
    case 18: phase_final_norm(cx, XN, SSQ + 4 * T, IN(p, I_NORM_FINAL), Y); break;
    default: break;
    }
}

__global__ void __launch_bounds__(NTHREADS, 2) fwd_mega(Params p, int ph_lo, int ph_hi) {
    extern __shared__ __attribute__((aligned(16))) unsigned char smem[];
    LAS unsigned char* lds = (LAS unsigned char*)smem;
    cg::grid_group grid = cg::this_grid();
    volatile LAS unsigned* bst = (volatile LAS unsigned*)(lds + 131072 + 1024);
    if (threadIdx.x == 0) { bst[0] = 0u; bst[1] = 0u; }
    __syncthreads();
    const XcdBarrier xb = xcd_barrier_post((unsigned*)(IN(p, 35)) + WS_BAR / 4, bst);
#ifndef PROBE_K
#define PROBE_K -1
#endif
    bool first = true;
    if (PROBE_K >= 0) {
        for (int ph = 0; ph <= PROBE_K; ++ph) { run_phase(p, ph, lds); if (first) { grid.sync(); first = false; } else xcd_barrier(xb); }
    }
    for (int ph = ph_lo; ph < ph_hi; ++ph) {
        run_phase(p, ph, lds);
        if (ph + 1 < ph_hi) { if (first) { grid.sync(); first = false; } else xcd_barrier(xb); }
    }
}

extern "C" void kernel_launch(void* const* d_in, const int* in_sizes, int n_in, void* d_out, int out_size, void* d_ws, size_t ws_size, hipStream_t stream) {
    static int grid = 0;
    if (grid == 0) {
        if (n_in != 34 || (size_t)out_size != O_END || ws_size < WS_NEED) { fprintf(stderr, "kernel_launch: unexpected shapes (n_in %d out %d ws %zu need %zu)\n", n_in, out_size, ws_size, (size_t)WS_NEED); grid = -1; return; }
        int dev = 0, cus = 0, per_cu = 0;
        (void)hipGetDevice(&dev); (void)hipDeviceGetAttribute(&cus, hipDeviceAttributeMultiprocessorCount, dev);
        if (hipFuncSetAttribute((const void*)fwd_mega, hipFuncAttributeMaxDynamicSharedMemorySize, LDS_BYTES) != hipSuccess) { fprintf(stderr, "kernel_launch: hipFuncSetAttribute failed\n"); grid = -1; return; }
        if (hipOccupancyMaxActiveBlocksPerMultiprocessor(&per_cu, (const void*)fwd_mega, NTHREADS, LDS_BYTES) != hipSuccess || per_cu < 1) { fprintf(stderr, "kernel_launch: occupancy query says %d\n", per_cu); per_cu = 1; }
        (void)hipGetLastError();
        grid = cus;
    }
    if (grid < 0) return;
    (void)hipMemsetAsync((unsigned char*)d_ws + WS_BAR, 0, 16384, stream);
    Params p{};
    for (int i = 0; i < 34; ++i) p.ptr[i] = (const float*)d_in[i];
    p.ptr[34] = (const float*)d_out; p.ptr[35] = (const float*)d_ws;
    int lo = 0, hi = NPHASE; void* args[] = {&p, &lo, &hi};
    hipError_t e = hipLaunchCooperativeKernel((const void*)fwd_mega, dim3(grid), dim3(NTHREADS), args, LDS_BYTES, stream);
    if (e != hipSuccess) fprintf(stderr, "cooperative launch failed: %s (grid %d)\n", hipGetErrorString(e), grid);
}
```

```cpp
#include <hip/hip_runtime.h>
#include <hip/hip_cooperative_groups.h>
#include <cstdio>
namespace cg = cooperative_groups;

#define LAS __attribute__((address_space(3)))
typedef unsigned short bf16_t;
typedef short bf16x8 __attribute__((ext_vector_type(8)));
typedef float f32x4 __attribute__((ext_vector_type(4)));
typedef unsigned u32x4 __attribute__((ext_vector_type(4)));
typedef unsigned u32x2 __attribute__((ext_vector_type(2)));

constexpr int TP = 65536;
constexpr int TS = 512;
constexpr int T = TP + TS;
constexpr int DM = 1024;
constexpr int DFF = 2816;
constexpr int XBC = 1536;
constexpr int N1 = 5888;
constexpr float EPS = 1e-6f;
constexpr int NTHREADS = 512;
constexpr int LDS_BYTES = 131072 + 4096;

constexpr size_t O_Y = 0;
constexpr size_t O_P_SSDCONV = (size_t)T * DM;
constexpr size_t O_P_SSD = O_P_SSDCONV + 16 * 3 * XBC;
constexpr size_t O_P_SCONV = O_P_SSD + (size_t)16 * 16 * 64 * 128;
constexpr size_t O_P_LRUCONV = O_P_SCONV + 16 * 2 * 1024;
constexpr size_t O_P_LRU = O_P_LRUCONV + 16 * 3 * 1024;
constexpr size_t O_P_FFNCONV = O_P_LRU + 16 * 1024;
constexpr size_t O_S_SSDCONV = O_P_FFNCONV + 2 * 16 * 2 * DFF;
constexpr size_t O_S_SSD = O_S_SSDCONV + 8 * 3 * XBC;
constexpr size_t O_S_SCONV = O_S_SSD + (size_t)8 * 16 * 64 * 128;
constexpr size_t O_S_LRUCONV = O_S_SCONV + 8 * 2 * 1024;
constexpr size_t O_S_LRU = O_S_LRUCONV + 8 * 3 * 1024;
constexpr size_t O_S_FFNCONV = O_S_LRU + 8 * 1024;
constexpr size_t O_END = O_S_FFNCONV + 2 * 8 * 2 * DFF;

constexpr size_t al256(size_t x) { return (x + 255) & ~(size_t)255; }
constexpr size_t WS_W1 = 0;
constexpr size_t WS_W2 = WS_W1 + (size_t)N1 * 1024 * 2;
constexpr size_t WS_W3 = WS_W2 + (size_t)1024 * 2048 * 2;
constexpr size_t WS_W4 = WS_W3 + (size_t)2 * 5632 * 1024 * 2;
constexpr size_t WS_W5 = WS_W4 + (size_t)2 * 1024 * 2816 * 2;
constexpr size_t WS_W6 = WS_W5 + (size_t)2048 * 1024 * 2;
constexpr size_t WS_W7 = WS_W6 + (size_t)2048 * 256 * 2;
constexpr size_t WS_SP = WS_W7 + (size_t)1024 * 1024 * 2;
constexpr size_t WS_BAR = WS_SP + 4096;
constexpr size_t WS_SSQ = WS_BAR + 16384;
constexpr size_t WS_SL = al256(WS_SSQ + (size_t)5 * T * 4);
constexpr size_t WS_HH = WS_SL + (size_t)1032 * 1024 * 4;
constexpr size_t WS_CIN = WS_HH + (size_t)1032 * 1024 * 4;
constexpr size_t WS_SLAB = al256(WS_CIN + (size_t)1032 * 1024 * 4);
constexpr size_t WS_XN = al256(WS_SLAB + (size_t)88 * 65536 * 4);
constexpr size_t WS_ARENA = al256(WS_XN + (size_t)T * 1024 * 2);
constexpr size_t WS_A2 = WS_ARENA;
constexpr size_t WS_XBCP = WS_A2 + (size_t)T * 2048 * 2;
constexpr size_t WS_XBCA = WS_XBCP + (size_t)T * XBC * 2;
constexpr size_t WS_V = WS_XBCA + (size_t)T * XBC * 2;
constexpr size_t WS_DT = WS_V + (size_t)T * 1024 * 2;
constexpr size_t WS_END0 = WS_DT + (size_t)T * 16 * 4;
constexpr size_t WS_H = WS_ARENA;
constexpr size_t WS_GH = WS_H + (size_t)T * DFF * 2;
constexpr size_t WS_GT = WS_GH + (size_t)1032 * 2 * DFF * 2;
constexpr size_t WS_UH = WS_GT + (size_t)1032 * 2 * DFF * 2;
constexpr size_t WS_END1 = WS_UH + (size_t)1032 * 2 * DFF * 2;
constexpr size_t WS_GATE = WS_ARENA;
constexpr size_t WS_XBP = WS_GATE + (size_t)T * 1024 * 2;
constexpr size_t WS_XBC2 = WS_XBP + (size_t)T * 1024 * 2;
constexpr size_t WS_LA = WS_XBC2 + (size_t)T * 1024 * 2;
constexpr size_t WS_UU = WS_LA + (size_t)T * 1024 * 2;
constexpr size_t WS_END2 = WS_UU + (size_t)T * 1024 * 2;
constexpr size_t WS_NEED = WS_END0 > WS_END1 ? (WS_END0 > WS_END2 ? WS_END0 : WS_END2) : (WS_END1 > WS_END2 ? WS_END1 : WS_END2);

struct Params {
    const float* ptr[36];
};
__device__ __forceinline__ const float* IN(const Params& p, int i) { asm volatile("" : "+s"(i)); return p.ptr[i]; }
#define P_OUT(p) ((float*)IN(p, 34))
#define P_WS(p) ((unsigned char*)IN(p, 35))
enum { I_XP = 0, I_XS, I_ST_SSDCONV, I_ST_SSD, I_ST_SCONV, I_ST_LRUCONV, I_ST_LRU, I_ST_FFNCONV, I_NORM_MIX, I_NORM_FFN, I_NORM_FINAL,
       I_AB_WIN, I_SSD_CONVW, I_SSD_CONVB, I_DT_BIAS, I_A_LOG, I_SSD_D, I_SSD_NORM, I_SC_CONVW, I_SC_CONVB, I_AB_WOUT, I_LRU_WIN,
       I_LRU_CONVW, I_LRU_CONVB, I_LRU_WA, I_LRU_BA, I_LRU_WX, I_LRU_BX, I_LRU_LAMBDA, I_LRU_WOUT, I_FFN_WIN, I_FFN_CONVW, I_FFN_CONVB, I_FFN_WOUT };

struct Ctx { int bid, nblk, tid; };
__device__ __forceinline__ unsigned cvt_pk_bf16(float lo, float hi) { unsigned r; asm("v_cvt_pk_bf16_f32 %0, %1, %2" : "=v"(r) : "v"(lo), "v"(hi)); return r; }
__device__ __forceinline__ float bf_lo(unsigned w) { return __uint_as_float(w << 16); }
__device__ __forceinline__ float bf_hi(unsigned w) { return __uint_as_float(w & 0xffff0000u); }
__device__ __forceinline__ float sigmoidf_(float x) { return __builtin_amdgcn_rcpf(1.0f + __expf(-x)); }
__device__ __forceinline__ float siluf_(float x) { return x * __builtin_amdgcn_rcpf(1.0f + __expf(-x)); }
__device__ __forceinline__ float geluf_(float x) { const float u = x * (1.5957691216f + 0.0713548163f * x * x); return x * __builtin_amdgcn_rcpf(1.0f + __builtin_amdgcn_exp2f(-1.4426950409f * u)); }
__device__ __forceinline__ float softplusf_(float x) { return fmaxf(x, 0.0f) + log1pf(__expf(-fabsf(x))); }
__device__ __forceinline__ void unpack8(const u32x4 w, float (&f)[8]) {
    f[0] = bf_lo(w.x); f[1] = bf_hi(w.x); f[2] = bf_lo(w.y); f[3] = bf_hi(w.y); f[4] = bf_lo(w.z); f[5] = bf_hi(w.z); f[6] = bf_lo(w.w); f[7] = bf_hi(w.w);
}
__device__ __forceinline__ u32x4 pack8(const float (&f)[8]) {
    u32x4 w; w.x = cvt_pk_bf16(f[0], f[1]); w.y = cvt_pk_bf16(f[2], f[3]); w.z = cvt_pk_bf16(f[4], f[5]); w.w = cvt_pk_bf16(f[6], f[7]); return w;
}
__device__ __forceinline__ u32x4 pack44(const f32x4 a, const f32x4 b) {
    u32x4 w; w.x = cvt_pk_bf16(a[0], a[1]); w.y = cvt_pk_bf16(a[2], a[3]); w.z = cvt_pk_bf16(b[0], b[1]); w.w = cvt_pk_bf16(b[2], b[3]); return w;
}

constexpr int BM = 256, BK = 64, HALF = 128, HTB = HALF * BK * 2, NXCD = 8, WGM = 8;
__device__ __forceinline__ int lds_byte(int r, int c) { const int st = (r >> 4) * 2 + (c >> 5), rr = r & 15, cc = c & 31, ob = rr * 64 + cc * 2; return st * 1024 + (ob ^ (((ob >> 9) & 1) << 5)); }
__device__ __forceinline__ void stage_rc(int b, int& R, int& C) { const int st = b / 1024, sb = b % 1024, swz = sb ^ (((sb >> 9) & 1) << 5); R = (st >> 1) * 16 + swz / 64; C = (st & 1) * 32 + (swz % 64) / 2; }
__device__ __forceinline__ int perm32(int rho) { const int n = rho >> 4, i = rho & 15; return 8 * (i >> 2) + 4 * n + (i & 3); }

struct Unit { int pm, pn, kt0, nkt, slab; };
struct Gemm { const bf16_t* A; const bf16_t* Bt; int M, N, K, lda, a_shift, a_koff; };

struct StaticOrder {
    int nM, nN, nwg, G, c, nt, nsplit, ntail;
    __device__ void init(int M, int N, int G_, int c_, int nt_, bool split) { nM = M / BM; nN = N / BM; G = G_; c = c_; nt = nt_; nsplit = 0; ntail = 0;
        if (split) { nM = TP / BM; nsplit = nt / 4; ntail = 2 * nN * nsplit; } nwg = nM * nN; }
    __device__ bool next(int i, Unit& u) const {
        const long L = (long)i * G + c;
        if (L >= nwg) { const int t = (int)(L - nwg); if (t >= ntail) return false;
            const int tile = t / nsplit, piece = t - tile * nsplit; u.pm = TP / BM + tile / nN; u.pn = tile % nN; u.kt0 = piece * 4; u.nkt = 4; u.slab = t; return true; }
        int wgid = (int)L; { const int q = nwg / NXCD, r = nwg % NXCD, xcd = wgid % NXCD, off = wgid / NXCD; wgid = (xcd < r ? xcd * (q + 1) : r * (q + 1) + (xcd - r) * q) + off; }
        const int nig = WGM * nN, gid = wgid / nig, fm = gid * WGM, gsz = (nM - fm) < WGM ? (nM - fm) : WGM;
        u.pm = fm + ((wgid % nig) % gsz); u.pn = (wgid % nig) / gsz; u.kt0 = 0; u.nkt = nt; u.slab = -1; return true;
    }
};

template <class Epi, bool MIDSCALE, bool SPLIT = false>
__device__ __forceinline__ void gemm_phase(const Ctx cx, LAS unsigned char* lds, const Gemm g, const Epi& E, const float* ssq, float* slabs = nullptr) {
    const int tid = cx.tid, wid = __builtin_amdgcn_readfirstlane(tid >> 6), lane = tid & 63, wr = wid >> 2, wc = wid & 3, fr = lane & 15, fq = lane >> 4;
    int K_ = g.K; asm volatile("" : "+s"(K_));
    const int K = K_, nt = K / BK;
    StaticOrder S; S.init(g.M, g.N, cx.nblk, cx.bid, nt, SPLIT);
    unsigned voffA[2], voffB[2];
#pragma unroll
    for (int i = 0; i < 2; ++i) { int R, C; stage_rc(tid * 16 + i * 8192, R, C); const int Rb = Epi::PERM ? ((R & ~31) + perm32(R & 31)) : R;
        voffA[i] = (unsigned)(R * g.lda + C) * 2u; voffB[i] = (unsigned)(Rb * K + C) * 2u; }
    const size_t kstep = (size_t)(BK * 2);
    const size_t hsA = (size_t)HALF * g.lda * 2, hsB = (size_t)HALF * K * 2;
    const size_t tsA = 2 * hsA, tsB = 2 * hsB;
    const unsigned ldsw = (unsigned)wid * 1024u;
    const int aoff = lds_byte(wr * 64 + fr, fq * 8), boff = lds_byte(wc * 32 + fr, fq * 8);
#define SA_(b, h) (((b) * 2 + (h)) * HTB)
#define SB_(b, h) ((4 + (b) * 2 + (h)) * HTB)
#define STAGE_(bufoff, gbase, voff) do { _Pragma("unroll") for (int _i = 0; _i < 2; ++_i) \
        __builtin_amdgcn_global_load_lds((const unsigned*)((const char*)(gbase) + (voff)[_i]), (LAS unsigned*)(lds + (bufoff) + ldsw + _i * 8192), 16, 0, 0); } while (0)
#define LDA_(dst, b, h) do { _Pragma("unroll") for (int m = 0; m < 4; ++m) _Pragma("unroll") for (int k = 0; k < 2; ++k) dst[m][k] = *(const LAS bf16x8*)(lds + SA_(b, h) + aoff + m * 2048 + k * 1024); } while (0)
#define LDB_(dst, b, h) do { _Pragma("unroll") for (int n = 0; n < 2; ++n) _Pragma("unroll") for (int k = 0; k < 2; ++k) dst[n][k] = *(const LAS bf16x8*)(lds + SB_(b, h) + boff + n * 2048 + k * 1024); } while (0)
#define MMA_(ai, bj, At, Bt) do { __builtin_amdgcn_s_setprio(1); _Pragma("unroll") for (int m = 0; m < 4; ++m) _Pragma("unroll") for (int n = 0; n < 2; ++n) _Pragma("unroll") for (int k = 0; k < 2; ++k) \
        acc[ai][bj][m][n] = __builtin_amdgcn_mfma_f32_16x16x32_bf16(Bt[n][k], At[m][k], acc[ai][bj][m][n], 0, 0, 0); __builtin_amdgcn_s_setprio(0); } while (0)
#define WAIT_V_(n) asm volatile("s_waitcnt vmcnt(" #n ")" ::: "memory")
#define WAIT_L_(n) asm volatile("s_waitcnt lgkmcnt(" #n ")" ::: "memory")
#define BAR_ __builtin_amdgcn_s_barrier()
#define SCHED_ __builtin_amdgcn_sched_barrier(0)
#ifndef STAGGER
#define STAGGER 0
#endif
    if (STAGGER && (cx.bid & 8)) {
        const unsigned long long t0 = __builtin_amdgcn_s_memrealtime(); const unsigned long long dl = 800ull;
        while (__builtin_amdgcn_s_memrealtime() - t0 < dl) __builtin_amdgcn_s_sleep(8);
    }
    Unit cur, nxt; int ui = 0;
    if (!S.next(0, cur)) return;
    f32x4 acc[2][2][4][2];
#pragma unroll
    for (int a = 0; a < 2; ++a)
#pragma unroll
        for (int b = 0; b < 2; ++b)
#pragma unroll
            for (int m = 0; m < 4; ++m)
#pragma unroll
                for (int n = 0; n < 2; ++n) acc[a][b][m][n] = (f32x4){0.f, 0.f, 0.f, 0.f};
    bf16x8 At[4][2], B0[2][2], B1[2][2];
    const char* cA = (const char*)g.A + (size_t)cur.pm * tsA + (size_t)((cur.pn >> g.a_shift) * g.a_koff) * 2 + (size_t)cur.kt0 * kstep;
    const char* cB = (const char*)g.Bt + (size_t)cur.pn * tsB + (size_t)cur.kt0 * kstep;
    STAGE_(SB_(0, 0), cB, voffB); STAGE_(SA_(0, 0), cA, voffA); STAGE_(SB_(0, 1), cB + hsB, voffB); STAGE_(SA_(0, 1), cA + hsA, voffA);
    if (wr == 1) BAR_;
    WAIT_V_(4); BAR_;
    STAGE_(SB_(1, 0), cB + kstep, voffB); STAGE_(SA_(1, 0), cA + kstep, voffA); STAGE_(SB_(1, 1), cB + hsB + kstep, voffB);
    WAIT_V_(6); BAR_;
    for (;;) {
        const bool has_next = S.next(ui + 1, nxt);
        const char* nA = has_next ? (const char*)g.A + (size_t)nxt.pm * tsA + (size_t)((nxt.pn >> g.a_shift) * g.a_koff) * 2 + (size_t)nxt.kt0 * kstep : cA;
        const char* nB = has_next ? (const char*)g.Bt + (size_t)nxt.pn * tsB + (size_t)nxt.kt0 * kstep : cB;
        const int cnt = cur.nkt;
        for (int t = 0; t < cnt; t += 2) {
            const bool last = (t == cnt - 2);
            const char* a1 = cA + (size_t)(t + 1) * kstep;
            const char* a2 = last ? nA : cA + (size_t)(t + 2) * kstep; const char* b2 = last ? nB : cB + (size_t)(t + 2) * kstep;
            const char* a3 = a2 + kstep; const char* b3 = b2 + kstep;
            if (MIDSCALE && t == 16 && cur.slab < 0) {
                int rb = cur.pm * BM + wr * 64 + fr; asm volatile("" : "+v"(rb));
#pragma unroll
                for (int ai = 0; ai < 2; ++ai)
#pragma unroll
                    for (int m = 0; m < 4; ++m) {
                        const float sc = rsqrtf(ssq[rb + ai * HALF + m * 16] * (1.0f / 1024.0f) + EPS);
#pragma unroll
                        for (int bj = 0; bj < 2; ++bj)
#pragma unroll
                            for (int n = 0; n < 2; ++n) acc[ai][bj][m][n] *= sc;
                    }
            }
            LDB_(B0, 0, 0); SCHED_; LDA_(At, 0, 0); STAGE_(SA_(1, 1), a1 + hsA, voffA);
            WAIT_L_(8); BAR_; WAIT_L_(0); MMA_(0, 0, At, B0); BAR_; SCHED_;
            LDB_(B1, 0, 1); STAGE_(SB_(0, 0), b2, voffB);
            BAR_; WAIT_L_(0); MMA_(0, 1, At, B1); BAR_;
            LDA_(At, 0, 1); STAGE_(SA_(0, 0), a2, voffA);
            BAR_; WAIT_L_(0); MMA_(1, 0, At, B0); BAR_; SCHED_;
            STAGE_(SB_(0, 1), b2 + hsB, voffB);
            WAIT_V_(6); BAR_; MMA_(1, 1, At, B1); BAR_;
            LDB_(B0, 1, 0); SCHED_; LDA_(At, 1, 0); STAGE_(SA_(0, 1), a2 + hsA, voffA);
            WAIT_L_(8); BAR_; WAIT_L_(0); MMA_(0, 0, At, B0); BAR_; SCHED_;
            LDB_(B1, 1, 1); STAGE_(SB_(1, 0), b3, voffB);
            BAR_; WAIT_L_(0); MMA_(0, 1, At, B1); BAR_;
            LDA_(At, 1, 1); STAGE_(SA_(1, 0), a3, voffA);
            BAR_; WAIT_L_(0); MMA_(1, 0, At, B0); BAR_; SCHED_;
            STAGE_(SB_(1, 1), b3 + hsB, voffB);
            WAIT_V_(6); BAR_; MMA_(1, 1, At, B1); BAR_;
        }
        if (SPLIT && cur.slab >= 0) {
            float* sb = slabs + (size_t)cur.slab * 65536 + (size_t)(wr * 64 + fr) * 256 + wc * 32 + 8 * fq;
#pragma unroll
            for (int ai = 0; ai < 2; ++ai)
#pragma unroll
                for (int m = 0; m < 4; ++m)
#pragma unroll
                    for (int bj = 0; bj < 2; ++bj) { float* q = sb + (size_t)(ai * HALF + m * 16) * 256 + bj * HALF; *(f32x4*)q = acc[ai][bj][m][0]; *(f32x4*)(q + 4) = acc[ai][bj][m][1]; }
        } else E(acc, cur, wr, wc, fr, fq);
        if (!has_next) break;
#pragma unroll
        for (int a = 0; a < 2; ++a)
#pragma unroll
            for (int b = 0; b < 2; ++b)
#pragma unroll
                for (int m = 0; m < 4; ++m)
#pragma unroll
                    for (int n = 0; n < 2; ++n) acc[a][b][m][n] = (f32x4){0.f, 0.f, 0.f, 0.f};
        cur = nxt; cA = nA; cB = nB; ++ui;
    }
    WAIT_V_(0);
    if (wr == 0) BAR_;
    BAR_;
#undef SA_
#undef SB_
#undef STAGE_
#undef LDA_
#undef LDB_
#undef MMA_
}

struct EpiG1 {
    static constexpr bool PERM = true;
    bf16_t* A2; bf16_t* XBCP; bf16_t* V; float* DT; const float* dt_bias;
    __device__ __forceinline__ void operator()(const f32x4 (&acc)[2][2][4][2], const Unit& u, int wr, int wc, int fr, int fq) const {
        const int row0 = u.pm * BM + wr * 64 + fr, lc = wc * 32 + 8 * fq;
        if (u.pn < 14) {
            bf16_t* base; int ld, colt;
            if (u.pn < 4) { base = A2; ld = 2048; colt = u.pn * 256; }
            else if (u.pn < 10) { base = XBCP; ld = XBC; colt = (u.pn - 4) * 256; }
            else { base = A2; ld = 2048; colt = 1024 + (u.pn - 10) * 256; }
#pragma unroll
            for (int ai = 0; ai < 2; ++ai)
#pragma unroll
                for (int m = 0; m < 4; ++m) { bf16_t* rowp = base + (size_t)(row0 + ai * HALF + m * 16) * ld + colt + lc;
#pragma unroll
                    for (int bj = 0; bj < 2; ++bj) *(u32x4*)(rowp + bj * HALF) = pack44(acc[ai][bj][m][0], acc[ai][bj][m][1]); }
        } else if (u.pn < 22) {
            const int ch0 = (u.pn - 14) * 128 + lc;
#pragma unroll
            for (int ai = 0; ai < 2; ++ai)
#pragma unroll
                for (int m = 0; m < 4; ++m) { bf16_t* rowp = V + (size_t)(row0 + ai * HALF + m * 16) * 1024 + ch0;
                    *(u32x4*)rowp = pack44(acc[ai][0][m][0] * acc[ai][1][m][0], acc[ai][0][m][1] * acc[ai][1][m][1]); }
        } else {
            if (wc == 0 && fq < 2) {
                const f32x4 b0 = *(const f32x4*)(dt_bias + 8 * fq), b1 = *(const f32x4*)(dt_bias + 8 * fq + 4);
#pragma unroll
                for (int ai = 0; ai < 2; ++ai)
#pragma unroll
                    for (int m = 0; m < 4; ++m) { float* rowp = DT + (size_t)(row0 + ai * HALF + m * 16) * 16 + 8 * fq;
                        f32x4 v0 = acc[ai][0][m][0] + b0, v1 = acc[ai][0][m][1] + b1;
#pragma unroll
                        for (int j = 0; j < 4; ++j) { v0[j] = softplusf_(v0[j]); v1[j] = softplusf_(v1[j]); }
                        *(f32x4*)rowp = v0; *(f32x4*)(rowp + 4) = v1; }
            }
        }
    }
};
template <bool SRC_F32> struct EpiRes {
    static constexpr bool PERM = true;
    const float* xp; const float* xs; bf16_t* XN; float* ssq;
    __device__ __forceinline__ void operator()(const f32x4 (&acc)[2][2][4][2], const Unit& u, int wr, int wc, int fr, int fq) const {
        const int row0 = u.pm * BM + wr * 64 + fr, col0 = u.pn * BM + wc * 32 + 8 * fq;
#pragma unroll
        for (int ai = 0; ai < 2; ++ai)
#pragma unroll
            for (int m = 0; m < 4; ++m) { const int row = row0 + ai * HALF + m * 16;
                bf16_t* xnp = XN + (size_t)row * DM + col0;
                float sq = 0.f;
#pragma unroll
                for (int bj = 0; bj < 2; ++bj) {
                    f32x4 v0, v1;
                    if (SRC_F32) { const float* src = (row < TP ? xp + (size_t)row * DM : xs + (size_t)(row - TP) * DM) + col0 + bj * HALF; v0 = *(const f32x4*)src; v1 = *(const f32x4*)(src + 4); }
                    else { const u32x4 w = *(const u32x4*)(xnp + bj * HALF); v0 = (f32x4){bf_lo(w.x), bf_hi(w.x), bf_lo(w.y), bf_hi(w.y)}; v1 = (f32x4){bf_lo(w.z), bf_hi(w.z), bf_lo(w.w), bf_hi(w.w)}; }
                    v0 += acc[ai][bj][m][0]; v1 += acc[ai][bj][m][1];
                    *(u32x4*)(xnp + bj * HALF) = pack44(v0, v1);
                    sq += v0[0] * v0[0] + v0[1] * v0[1] + v0[2] * v0[2] + v0[3] * v0[3] + v1[0] * v1[0] + v1[1] * v1[1] + v1[2] * v1[2] + v1[3] * v1[3]; }
                sq += __shfl_xor(sq, 16); sq += __shfl_xor(sq, 32);
                if (fq == 0) atomicAdd(ssq + row, sq); }
    }
};
__device__ __forceinline__ float dpp_ror1(float v) { return __int_as_float(__builtin_amdgcn_update_dpp(0, __float_as_int(v), 0x121, 0xf, 0xf, false)); }
__device__ __forceinline__ float dpp_ror2(float v) { return __int_as_float(__builtin_amdgcn_update_dpp(0, __float_as_int(v), 0x122, 0xf, 0xf, false)); }
struct EpiFfnFused {
    static constexpr bool PERM = true;
    bf16_t* H; bf16_t* GH; bf16_t* GT; bf16_t* UH; const float* ssq; const float* cw; const float* cb;
    __device__ __forceinline__ void operator()(const f32x4 (&acc)[2][2][4][2], const Unit& u, int wr, int wc, int fr, int fq) const {
        const int ch0 = u.pn * 128 + wc * 32 + 8 * fq;
        float w0[8], w1[8], w2[8], bb[8];
#pragma unroll
        for (int h = 0; h < 2; ++h) { const f32x4 a = *(const f32x4*)(cw + ch0 + 4 * h), b = *(const f32x4*)(cw + DFF + ch0 + 4 * h), c = *(const f32x4*)(cw + 2 * DFF + ch0 + 4 * h), d = *(const f32x4*)(cb + ch0 + 4 * h);
#pragma unroll
            for (int j = 0; j < 4; ++j) { w0[4 * h + j] = a[j]; w1[4 * h + j] = b[j]; w2[4 * h + j] = c[j]; bb[4 * h + j] = d[j]; } }
#pragma unroll
        for (int ai = 0; ai < 2; ++ai) {
            const int grp = 4 * u.pm + 2 * ai + wr;
            float p1[8], p2[8];
#pragma unroll
            for (int q = 0; q < 8; ++q) { p1[q] = 0.f; p2[q] = 0.f; }
#pragma unroll
            for (int m = 0; m < 4; ++m) {
                const int row = u.pm * BM + ai * HALF + wr * 64 + m * 16 + fr;
                const float sc = rsqrtf(ssq[row] * (1.0f / 1024.0f) + EPS);
                float g[8], uu[8], c1[8], c2[8], hh[8];
#pragma unroll
                for (int n = 0; n < 2; ++n)
#pragma unroll
                    for (int j = 0; j < 4; ++j) { g[4 * n + j] = acc[ai][0][m][n][j] * sc; uu[4 * n + j] = acc[ai][1][m][n][j] * sc; }
#pragma unroll
                for (int q = 0; q < 8; ++q) { c1[q] = dpp_ror1(g[q]); c2[q] = dpp_ror2(g[q]); }
                if (m == 0 && fr < 2) { const size_t o = ((size_t)grp * 2 + fr) * DFF + ch0; *(u32x4*)(GH + o) = pack8(g); *(u32x4*)(UH + o) = pack8(uu); }
                if (m == 3 && fr >= 14) { const size_t o = ((size_t)grp * 2 + (fr - 14)) * DFF + ch0; *(u32x4*)(GT + o) = pack8(g); }
#pragma unroll
                for (int q = 0; q < 8; ++q) { const float gm1 = (fr == 0) ? p1[q] : c1[q], gm2 = (fr < 2) ? p2[q] : c2[q];
                    hh[q] = geluf_(bb[q] + w0[q] * gm2 + w1[q] * gm1 + w2[q] * g[q]) * uu[q]; p1[q] = c1[q]; p2[q] = c2[q]; }
                *(u32x4*)(H + (size_t)row * DFF + ch0) = pack8(hh);
            }
        }
    }
};
struct EpiLruIn {
    static constexpr bool PERM = true;
    bf16_t* GATE; bf16_t* XBP; const float* ssq;
    __device__ __forceinline__ void operator()(const f32x4 (&acc)[2][2][4][2], const Unit& u, int wr, int wc, int fr, int fq) const {
        const int row0 = u.pm * BM + wr * 64 + fr, lc = wc * 32 + 8 * fq;
        const bool isgate = u.pn < 4;
        bf16_t* base = isgate ? GATE : XBP; const int colt = (isgate ? u.pn : u.pn - 4) * 256 + lc;
#pragma unroll
        for (int ai = 0; ai < 2; ++ai)
#pragma unroll
            for (int m = 0; m < 4; ++m) { bf16_t* rowp = base + (size_t)(row0 + ai * HALF + m * 16) * 1024 + colt;
                const float sc = rsqrtf(ssq[row0 + ai * HALF + m * 16] * (1.0f / 1024.0f) + EPS);
#pragma unroll
                for (int bj = 0; bj < 2; ++bj) { f32x4 v0 = acc[ai][bj][m][0] * sc, v1 = acc[ai][bj][m][1] * sc;
                    if (isgate) {
#pragma unroll
                        for (int j = 0; j < 4; ++j) { v0[j] = geluf_(v0[j]); v1[j] = geluf_(v1[j]); } }
                    *(u32x4*)(rowp + bj * HALF) = pack44(v0, v1); } }
    }
};
struct EpiLruGate {
    static constexpr bool PERM = true;
    const bf16_t* XBC2; bf16_t* LA; bf16_t* UU; const float* ba; const float* bx; const float* sp;
    __device__ __forceinline__ void operator()(const f32x4 (&acc)[2][2][4][2], const Unit& u, int wr, int wc, int fr, int fq) const {
        const int row0 = u.pm * BM + wr * 64 + fr, ch0 = (u.pn >> 1) * 256 + (u.pn & 1) * 128 + wc * 32 + 8 * fq;
#pragma unroll
        for (int ai = 0; ai < 2; ++ai)
#pragma unroll
            for (int m = 0; m < 4; ++m) {
#pragma unroll
                for (int n = 0; n < 2; ++n) { const size_t o = (size_t)(row0 + ai * HALF + m * 16) * 1024 + ch0 + 4 * n;
                    const u32x2 xw = *(const u32x2*)(XBC2 + o);
                    const f32x4 vba = *(const f32x4*)(ba + ch0 + 4 * n), vbx = *(const f32x4*)(bx + ch0 + 4 * n), vsp = *(const f32x4*)(sp + ch0 + 4 * n);
                    const float xb[4] = {bf_lo(xw.x), bf_hi(xw.x), bf_lo(xw.y), bf_hi(xw.y)};
                    float la[4], uu[4];
#pragma unroll
                    for (int j = 0; j < 4; ++j) {
                        const float r = sigmoidf_(acc[ai][0][m][n][j] + vba[j]), ig = sigmoidf_(acc[ai][1][m][n][j] + vbx[j]);
                        const float l = -8.0f * r * vsp[j]; la[j] = l;
                        const float mult = __builtin_amdgcn_sqrtf(fmaxf(0.0f, 1.0f - __expf(2.0f * l)));
                        uu[j] = mult * ig * xb[j]; }
                    u32x2 w1, w2; w1.x = cvt_pk_bf16(la[0], la[1]); w1.y = cvt_pk_bf16(la[2], la[3]); w2.x = cvt_pk_bf16(uu[0], uu[1]); w2.y = cvt_pk_bf16(uu[2], uu[3]);
                    *(u32x2*)(LA + o) = w1; *(u32x2*)(UU + o) = w2; }
                asm volatile("" ::: "memory"); }
    }
};

__device__ __forceinline__ void wconv_tile(const Ctx cx, const float* src, int ld_src, int nvalid, const float* gain, int k0, bf16_t* dst, int K, LAS unsigned char* lds) {
    const int lane = cx.tid & 63; LAS bf16_t* L = (LAS bf16_t*)(lds + (cx.tid >> 6) * 8448);
    float v[64];
#pragma unroll
    for (int k = 0; k < 64; ++k) v[k] = (lane < nvalid) ? src[(size_t)k * ld_src + lane] : 0.f;
    if (gain) {
#pragma unroll
        for (int k = 0; k < 64; ++k) v[k] *= gain[k0 + k]; }
#pragma unroll
    for (int k = 0; k < 64; k += 2) *(LAS unsigned*)(L + lane * 66 + k) = cvt_pk_bf16(v[k], v[k + 1]);
    asm volatile("s_waitcnt lgkmcnt(0)" ::: "memory");
#pragma unroll
    for (int i = 0; i < 8; ++i) { const int n = (lane >> 3) + 8 * i, kq = lane & 7; const LAS unsigned* q = (const LAS unsigned*)(L + n * 66 + kq * 8);
        u32x4 w; w.x = q[0]; w.y = q[1]; w.z = q[2]; w.w = q[3];
        *(u32x4*)(dst + (size_t)n * K + kq * 8) = w; }
    asm volatile("s_waitcnt lgkmcnt(0)" ::: "memory");
}
__device__ __forceinline__ void phase_prep(const Ctx cx, const Params& p, LAS unsigned char* lds) {
    unsigned char* ws = P_WS(p);
    constexpr int NT1 = 92 * 16, NT2 = 16 * 32, NT3 = 88 * 16, NT4 = 16 * 44, NT5 = 32 * 16, NT6 = 32 * 4, NT7 = 16 * 16;
    constexpr int NTASK = NT1 + NT2 + 2 * NT3 + 2 * NT4 + NT5 + NT6 + NT7;
    for (int task = cx.bid * 8 + __builtin_amdgcn_readfirstlane(cx.tid >> 6); task < NTASK; task += cx.nblk * 8) {
        int id = task;
        if (id < NT1) { const int ntile = id / 16, kt = id % 16, n0 = ntile * 64, k0 = kt * 64, pn = n0 >> 8, lc0 = n0 & 255;
            int col, nv = 64;
            if (pn < 10) col = n0; else if (pn < 14) col = 2576 + (n0 - 2560);
            else if (pn < 22) col = (lc0 < 128 ? 3600 : 4624) + (pn - 14) * 128 + (lc0 & 127);
            else { col = 2560; nv = (lc0 == 0) ? 16 : 0; }
            wconv_tile(cx, IN(p, I_AB_WIN) + (size_t)k0 * 5648 + col, 5648, nv, IN(p, I_NORM_MIX), k0, (bf16_t*)(ws + WS_W1) + (size_t)n0 * 1024 + k0, 1024, lds); continue; }
        id -= NT1;
        if (id < NT2) { const int ntile = id / 32, kt = id % 32, n0 = ntile * 64, k0 = kt * 64;
            wconv_tile(cx, IN(p, I_AB_WOUT) + (size_t)k0 * 1024 + n0, 1024, 64, k0 < 1024 ? IN(p, I_SSD_NORM) : nullptr, k0, (bf16_t*)(ws + WS_W2) + (size_t)n0 * 2048 + k0, 2048, lds); continue; }
        id -= NT2;
        if (id < 2 * NT3) { const int l = id / NT3; id -= l * NT3; const int ntile = id / 16, kt = id % 16, n0 = ntile * 64, k0 = kt * 64, pn = n0 >> 8, lc0 = n0 & 255;
            const int col = (lc0 < 128 ? 0 : DFF) + pn * 128 + (lc0 & 127);
            wconv_tile(cx, IN(p, I_FFN_WIN) + (size_t)l * 1024 * 5632 + (size_t)k0 * 5632 + col, 5632, 64, IN(p, I_NORM_FFN) + l * 1024, k0, (bf16_t*)(ws + WS_W3) + (size_t)l * 5632 * 1024 + (size_t)n0 * 1024 + k0, 1024, lds); continue; }
        id -= 2 * NT3;
        if (id < 2 * NT4) { const int l = id / NT4; id -= l * NT4; const int ntile = id / 44, kt = id % 44, n0 = ntile * 64, k0 = kt * 64;
            wconv_tile(cx, IN(p, I_FFN_WOUT) + (size_t)l * DFF * 1024 + (size_t)k0 * 1024 + n0, 1024, 64, nullptr, k0, (bf16_t*)(ws + WS_W4) + (size_t)l * 1024 * DFF + (size_t)n0 * DFF + k0, DFF, lds); continue; }
        id -= 2 * NT4;
        if (id < NT5) { const int ntile = id / 16, kt = id % 16, n0 = ntile * 64, k0 = kt * 64;
            wconv_tile(cx, IN(p, I_LRU_WIN) + (size_t)k0 * 2048 + n0, 2048, 64, IN(p, I_NORM_MIX) + 1024, k0, (bf16_t*)(ws + WS_W5) + (size_t)n0 * 1024 + k0, 1024, lds); continue; }
        id -= NT5;
        if (id < NT6) { const int ntile = id / 4, kt = id % 4, n0 = ntile * 64, k0 = kt * 64, head = n0 >> 9, within = n0 & 511, pnl = within >> 8, lc0 = within & 255;
            const int ch = pnl * 128 + (lc0 & 127);
            const float* srcm = (lc0 < 128 ? IN(p, I_LRU_WA) : IN(p, I_LRU_WX)) + (size_t)head * 65536;
            wconv_tile(cx, srcm + (size_t)k0 * 256 + ch, 256, 64, nullptr, k0, (bf16_t*)(ws + WS_W6) + (size_t)n0 * 256 + k0, 256, lds); continue; }
        id -= NT6;
        { const int ntile = id / 16, kt = id % 16, n0 = ntile * 64, k0 = kt * 64;
            wconv_tile(cx, IN(p, I_LRU_WOUT) + (size_t)k0 * 1024 + n0, 1024, 64, nullptr, k0, (bf16_t*)(ws + WS_W7) + (size_t)n0 * 1024 + k0, 1024, lds); }
    }
    const int gt = cx.bid * NTHREADS + cx.tid, gs = cx.nblk * NTHREADS;
    for (int i = gt; i < 1024; i += gs) ((float*)(ws + WS_SP))[i] = softplusf_(-IN(p, I_LRU_LAMBDA)[i]);
    for (int i = gt; i < 5 * T; i += gs) ((float*)(ws + WS_SSQ))[i] = 0.f;
}

__device__ __forceinline__ void phase_norm(const Ctx cx, const float* xp, const float* xs, bf16_t* XN) {
    const int wid = cx.tid >> 6, lane = cx.tid & 63;
    for (int row = cx.bid * 8 + wid; row < T; row += cx.nblk * 8) {
        const float* src = row < TP ? xp + (size_t)row * DM : xs + (size_t)(row - TP) * DM;
        f32x4 v[4]; float s = 0.f;
#pragma unroll
        for (int j = 0; j < 4; ++j) { v[j] = *(const f32x4*)(src + lane * 4 + j * 256); s += v[j][0] * v[j][0] + v[j][1] * v[j][1] + v[j][2] * v[j][2] + v[j][3] * v[j][3]; }
#pragma unroll
        for (int o = 32; o >= 1; o >>= 1) s += __shfl_xor(s, o);
        const float rs = rsqrtf(s * (1.0f / 1024.0f) + EPS);
#pragma unroll
        for (int j = 0; j < 4; ++j) { u32x2 w; w.x = cvt_pk_bf16(v[j][0] * rs, v[j][1] * rs); w.y = cvt_pk_bf16(v[j][2] * rs, v[j][3] * rs);
            *(u32x2*)(XN + (size_t)row * DM + lane * 4 + j * 256) = w; }
    }
}
__device__ __forceinline__ void phase_final_norm(const Ctx cx, const bf16_t* XN, const float* ssq, const float* gain, float* y) {
    const int wid = cx.tid >> 6, lane = cx.tid & 63;
    f32x4 gv[4];
#pragma unroll
    for (int j = 0; j < 4; ++j) gv[j] = *(const f32x4*)(gain + lane * 16 + j * 4);
    for (int row0 = cx.bid * 8 + wid; row0 < T; row0 += cx.nblk * 32) {
        u32x4 w[4][2]; float rs[4];
#pragma unroll
        for (int i = 0; i < 4; ++i) { const int row = row0 + i * cx.nblk * 8;
            if (row < T) { w[i][0] = *(const u32x4*)(XN + (size_t)row * DM + lane * 16); w[i][1] = *(const u32x4*)(XN + (size_t)row * DM + lane * 16 + 8); rs[i] = rsqrtf(ssq[row] * (1.0f / 1024.0f) + EPS); } }
#pragma unroll
        for (int i = 0; i < 4; ++i) { const int row = row0 + i * cx.nblk * 8;
            if (row < T) { float f[16]; { float a[8], b[8]; unpack8(w[i][0], a); unpack8(w[i][1], b);
#pragma unroll
                    for (int q = 0; q < 8; ++q) { f[q] = a[q]; f[8 + q] = b[q]; } }
                float* dst = y + (size_t)row * DM + lane * 16;
#pragma unroll
                for (int j = 0; j < 4; ++j) *(f32x4*)(dst + j * 4) = (f32x4){f[4 * j], f[4 * j + 1], f[4 * j + 2], f[4 * j + 3]} * rs[i] * gv[j]; } }
    }
}

template <int KW, int MODE>
__device__ __forceinline__ void phase_conv(const Ctx cx, const bf16_t* src, int ld_src, int NC, const float* w, const float* bias, bf16_t* dst, int ld_dst,
                           const float* st_in, float* out_p, float* out_s) {
    const int ncg = NC >> 3, total = (T / 16) * ncg;
    for (int item = cx.bid * NTHREADS + cx.tid; item < total; item += cx.nblk * NTHREADS) {
        const int cgi = item % ncg, seg = item / ncg, c0 = cgi * 8, r0 = seg * 16;
        int seq, t0, L; if (r0 < TP) { seq = r0 >> 12; t0 = r0 & 4095; L = 4096; } else { seq = 16 + ((r0 - TP) >> 6); t0 = (r0 - TP) & 63; L = 64; }
        float wv[KW][8], bv[8];
#pragma unroll
        for (int k = 0; k < KW; ++k) { const f32x4 a = *(const f32x4*)(w + (size_t)k * NC + c0), b = *(const f32x4*)(w + (size_t)k * NC + c0 + 4);
#pragma unroll
            for (int j = 0; j < 4; ++j) { wv[k][j] = a[j]; wv[k][4 + j] = b[j]; } }
        { const f32x4 a = *(const f32x4*)(bias + c0), b = *(const f32x4*)(bias + c0 + 4);
#pragma unroll
          for (int j = 0; j < 4; ++j) { bv[j] = a[j]; bv[4 + j] = b[j]; } }
        float win[KW - 1][8];
#pragma unroll
        for (int k = 0; k < KW - 1; ++k) {
            if (t0 > 0) unpack8(*(const u32x4*)(src + (size_t)(r0 - (KW - 1) + k) * ld_src + c0), win[k]);
            else if (seq >= 16) { const float* sp_ = st_in + ((size_t)(seq - 16) * (KW - 1) + k) * NC + c0; const f32x4 a = *(const f32x4*)sp_, b = *(const f32x4*)(sp_ + 4);
#pragma unroll
                for (int j = 0; j < 4; ++j) { win[k][j] = a[j]; win[k][4 + j] = b[j]; } }
            else {
#pragma unroll
                for (int j = 0; j < 8; ++j) win[k][j] = 0.f; }
        }
#pragma unroll
        for (int h = 0; h < 2; ++h) {
            u32x4 rows[8], aux[8];
#pragma unroll
            for (int i = 0; i < 8; ++i) { rows[i] = *(const u32x4*)(src + (size_t)(r0 + h * 8 + i) * ld_src + c0);
                if (MODE == 1 || MODE == 2) aux[i] = *(const u32x4*)(dst + (size_t)(r0 + h * 8 + i) * ld_dst + c0); }
#pragma unroll
            for (int i = 0; i < 8; ++i) {
                float cur[8], y[8]; unpack8(rows[i], cur);
#pragma unroll
                for (int j = 0; j < 8; ++j) { float a = bv[j] + wv[KW - 1][j] * cur[j];
#pragma unroll
                    for (int k = 0; k < KW - 1; ++k) a += wv[k][j] * win[k][j];
                    y[j] = a; }
#pragma unroll
                for (int j = 0; j < 8; ++j) {
#pragma unroll
                    for (int k = 0; k < KW - 2; ++k) win[k][j] = win[k + 1][j];
                    win[KW - 2][j] = cur[j]; }
                if (MODE == 0) {
#pragma unroll
                    for (int j = 0; j < 8; ++j) y[j] = siluf_(y[j]); }
                if (MODE == 1) { float gq[8]; unpack8(aux[i], gq);
#pragma unroll
                    for (int j = 0; j < 8; ++j) y[j] = y[j] * gq[j]; }
                if (MODE == 2) { float uq[8]; unpack8(aux[i], uq);
#pragma unroll
                    for (int j = 0; j < 8; ++j) y[j] = geluf_(y[j]) * uq[j]; }
                *(u32x4*)(dst + (size_t)(r0 + h * 8 + i) * ld_dst + c0) = pack8(y);
            }
            if (h == 1 && t0 + 16 == L) {
                float* ob = (seq < 16 ? out_p + (size_t)seq * (KW - 1) * NC : out_s + (size_t)(seq - 16) * (KW - 1) * NC) + c0;
#pragma unroll
                for (int j = 0; j < KW - 1; ++j) { float f[8]; unpack8(rows[8 - (KW - 1) + j], f);
                    *(f32x4*)(ob + (size_t)j * NC) = (f32x4){f[0], f[1], f[2], f[3]}; *(f32x4*)(ob + (size_t)j * NC + 4) = (f32x4){f[4], f[5], f[6], f[7]}; }
            }
        }
    }
}

template <bool SRC_F32, bool GSCALE>
__device__ __forceinline__ void phase_split_finish(const Ctx cx, const float* slabs, int nsplit, const float* xs, bf16_t* XN, float* ssq, const float* gssq) {
    const int wid = cx.tid >> 6, lane = cx.tid & 63;
    for (int r = cx.bid * 8 + wid; r < TS; r += cx.nblk * 8) {
        const int panel = r >> 8, rl = r & 255, pn = lane >> 4, lc = (lane & 15) * 16;
        const float* sb = slabs + (size_t)((panel * 4 + pn) * nsplit) * 65536 + (size_t)rl * 256 + lc;
        f32x4 v[4];
#pragma unroll
        for (int q = 0; q < 4; ++q) v[q] = (f32x4){0.f, 0.f, 0.f, 0.f};
        for (int pc = 0; pc < nsplit; ++pc) {
#pragma unroll
            for (int q = 0; q < 4; ++q) v[q] += *(const f32x4*)(sb + (size_t)pc * 65536 + 4 * q);
            if (GSCALE && pc == 3) { const float sc = rsqrtf(gssq[TP + r] * (1.0f / 1024.0f) + EPS);
#pragma unroll
                for (int q = 0; q < 4; ++q) v[q] *= sc; }
        }
        bf16_t* xnp = XN + (size_t)(TP + r) * DM + lane * 16;
        if (SRC_F32) { const float* src = xs + (size_t)r * DM + lane * 16;
#pragma unroll
            for (int q = 0; q < 4; ++q) v[q] += *(const f32x4*)(src + 4 * q); }
        else { float a[8], b[8]; unpack8(*(const u32x4*)xnp, a); unpack8(*(const u32x4*)(xnp + 8), b);
            v[0] += (f32x4){a[0], a[1], a[2], a[3]}; v[1] += (f32x4){a[4], a[5], a[6], a[7]}; v[2] += (f32x4){b[0], b[1], b[2], b[3]}; v[3] += (f32x4){b[4], b[5], b[6], b[7]}; }
        *(u32x4*)xnp = pack44(v[0], v[1]); *(u32x4*)(xnp + 8) = pack44(v[2], v[3]);
        float sq = 0.f;
#pragma unroll
        for (int q = 0; q < 4; ++q) sq += v[q][0] * v[q][0] + v[q][1] * v[q][1] + v[q][2] * v[q][2] + v[q][3] * v[q][3];
#pragma unroll
        for (int o = 32; o >= 1; o >>= 1) sq += __shfl_xor(sq, o);
        if (lane == 0) ssq[TP + r] = sq;
    }
}

__device__ __forceinline__ void phase_ffn_fix(const Ctx cx, const bf16_t* GH, const bf16_t* GT, const bf16_t* UH, bf16_t* H, const float* cw, const float* cb,
                                              const float* st_in, float* out_p, float* out_s) {
    const int ncg = DFF / 8, total = 1032 * ncg;
    for (int item = cx.bid * NTHREADS + cx.tid; item < total; item += cx.nblk * NTHREADS) {
        const int cgi = item % ncg, G = item / ncg, c0 = cgi * 8;
        int seq; bool first, lastg;
        if (G < 1024) { seq = G >> 6; first = (G & 63) == 0; lastg = (G & 63) == 63; } else { seq = 16 + (G - 1024); first = true; lastg = true; }
        float w0[8], w1[8], w2[8], bb[8], gm2[8], gm1[8], g0[8], g1[8], u0[8], u1[8];
#pragma unroll
        for (int h = 0; h < 2; ++h) { const f32x4 a = *(const f32x4*)(cw + c0 + 4 * h), b = *(const f32x4*)(cw + DFF + c0 + 4 * h), c = *(const f32x4*)(cw + 2 * DFF + c0 + 4 * h), d = *(const f32x4*)(cb + c0 + 4 * h);
#pragma unroll
            for (int j = 0; j < 4; ++j) { w0[4 * h + j] = a[j]; w1[4 * h + j] = b[j]; w2[4 * h + j] = c[j]; bb[4 * h + j] = d[j]; } }
        if (!first) { unpack8(*(const u32x4*)(GT + ((size_t)(G - 1) * 2 + 0) * DFF + c0), gm2); unpack8(*(const u32x4*)(GT + ((size_t)(G - 1) * 2 + 1) * DFF + c0), gm1); }
        else if (seq >= 16) { const float* s0 = st_in + ((size_t)(seq - 16) * 2) * DFF + c0;
#pragma unroll
            for (int h = 0; h < 2; ++h) { const f32x4 a = *(const f32x4*)(s0 + 4 * h), b = *(const f32x4*)(s0 + DFF + 4 * h);
#pragma unroll
                for (int j = 0; j < 4; ++j) { gm2[4 * h + j] = a[j]; gm1[4 * h + j] = b[j]; } } }
        else {
#pragma unroll
            for (int q = 0; q < 8; ++q) { gm2[q] = 0.f; gm1[q] = 0.f; } }
        unpack8(*(const u32x4*)(GH + ((size_t)G * 2 + 0) * DFF + c0), g0); unpack8(*(const u32x4*)(GH + ((size_t)G * 2 + 1) * DFF + c0), g1);
        unpack8(*(const u32x4*)(UH + ((size_t)G * 2 + 0) * DFF + c0), u0); unpack8(*(const u32x4*)(UH + ((size_t)G * 2 + 1) * DFF + c0), u1);
        float h0[8], h1[8];
#pragma unroll
        for (int q = 0; q < 8; ++q) { h0[q] = geluf_(bb[q] + w0[q] * gm2[q] + w1[q] * gm1[q] + w2[q] * g0[q]) * u0[q];
            h1[q] = geluf_(bb[q] + w0[q] * gm1[q] + w1[q] * g0[q] + w2[q] * g1[q]) * u1[q]; }
        *(u32x4*)(H + (size_t)(G * 64) * DFF + c0) = pack8(h0); *(u32x4*)(H + (size_t)(G * 64 + 1) * DFF + c0) = pack8(h1);
        if (lastg) {
            float* ob = (seq < 16 ? out_p + (size_t)seq * 2 * DFF : out_s + (size_t)(seq - 16) * 2 * DFF) + c0;
#pragma unroll
            for (int j = 0; j < 2; ++j) { float f[8]; unpack8(*(const u32x4*)(GT + ((size_t)G * 2 + j) * DFF + c0), f);
                *(f32x4*)(ob + (size_t)j * DFF) = (f32x4){f[0], f[1], f[2], f[3]}; *(f32x4*)(ob + (size_t)j * DFF + 4) = (f32x4){f[4], f[5], f[6], f[7]}; }
        }
    }
}

constexpr int SC_CS = 0, SC_BS = 17408, SC_BTS = 34816, SC_XTS = 53248, SC_XDS = 62464, SC_HS = 71680, SC_MS = 89088, SC_AS = 98304, SC_SQ = 98560;
#define LDS_BARRIER() do { asm volatile("s_waitcnt lgkmcnt(0)" ::: "memory"); __builtin_amdgcn_s_barrier(); asm volatile("" ::: "memory"); } while (0)
template <int N> __device__ __forceinline__ float dpp_shr(float v) { return __int_as_float(__builtin_amdgcn_update_dpp(0, __float_as_int(v), 0x110 + N, 0xf, 0xf, true)); }
__device__ __forceinline__ void ssd_task(const Ctx cx, const Params& p, LAS unsigned char* lds, int seq, int hd) {
    const int tid = cx.tid, wid = tid >> 6, lane = tid & 63, fr = lane & 15, fq = lane >> 4;
    unsigned char* ws = P_WS(p);
    const bf16_t* XBCA = (const bf16_t*)(ws + WS_XBCA); bf16_t* A2 = (bf16_t*)(ws + WS_A2); const float* DT = (const float*)(ws + WS_DT); float* SSQ = (float*)(ws + WS_SSQ);
    const int g = hd >> 3, nchunks = seq < 16 ? 64 : 1;
    const size_t row_base = seq < 16 ? (size_t)seq * 4096 : (size_t)TP + (size_t)(seq - 16) * 64;
    const float Aneg = -__expf(IN(p, I_A_LOG)[hd]), Dh = IN(p, I_SSD_D)[hd];
    LAS float* As = (LAS float*)(lds + SC_AS); LAS float* Sq = (LAS float*)(lds + SC_SQ);
    f32x4 hst[4];
#pragma unroll
    for (int pt = 0; pt < 4; ++pt) {
        if (seq >= 16) hst[pt] = *(const f32x4*)(IN(p, I_ST_SSD) + ((size_t)((seq - 16) * 16 + hd) * 64 + 16 * pt + fr) * 128 + 16 * wid + 4 * fq);
        else hst[pt] = (f32x4){0.f, 0.f, 0.f, 0.f};
    }
    const int lt = wid >> 1, ph = wid & 1;
    float pf_dt; u32x4 pf_b[2], pf_c[2], pf_x, pf_bt[2];
#define SSD_PREFETCH(cc) do { const size_t r0p = row_base + (size_t)(cc) * 64; \
        pf_dt = DT[(r0p + lane) * 16 + hd]; \
        _Pragma("unroll") for (int i = 0; i < 2; ++i) { const int q = tid + i * 512, row = q >> 4, sg = q & 15; \
            const bf16_t* gp = XBCA + (r0p + row) * XBC + 1024 + g * 128 + sg * 8; pf_b[i] = *(const u32x4*)gp; pf_c[i] = *(const u32x4*)(gp + 256); } \
        pf_x = *(const u32x4*)(XBCA + (r0p + lane) * XBC + hd * 64 + wid * 8); \
        _Pragma("unroll") for (int i = 0; i < 2; ++i) pf_bt[i] = *(const u32x4*)(XBCA + (r0p + lane) * XBC + 1024 + g * 128 + (wid + 8 * i) * 8); } while (0)
    SSD_PREFETCH(0);
    for (int c = 0; c < nchunks; ++c) {
        const size_t r0 = row_base + (size_t)c * 64;
        const float dt_l = pf_dt;
        float a = dt_l * Aneg;
        a += dpp_shr<1>(a); a += dpp_shr<2>(a); a += dpp_shr<4>(a); a += dpp_shr<8>(a);
        { const float t0 = __int_as_float(__builtin_amdgcn_readlane(__float_as_int(a), 15)), t1 = __int_as_float(__builtin_amdgcn_readlane(__float_as_int(a), 31)), t2 = __int_as_float(__builtin_amdgcn_readlane(__float_as_int(a), 47));
          a += (fq == 1) ? t0 : (fq == 2) ? (t0 + t1) : (fq == 3) ? (t0 + t1 + t2) : 0.0f; }
        const float a63 = __int_as_float(__builtin_amdgcn_readlane(__float_as_int(a), 63));
        const float wl = dt_l * __expf(a63 - a);
        if (wid == 0) As[lane] = a;
#pragma unroll
        for (int i = 0; i < 2; ++i) { const int q = tid + i * 512, row = q >> 4, sg = q & 15;
            *(LAS u32x4*)(lds + SC_BS + row * 272 + sg * 16) = pf_b[i]; *(LAS u32x4*)(lds + SC_CS + row * 272 + sg * 16) = pf_c[i]; }
        { float f[8]; unpack8(pf_x, f);
          LAS bf16_t* xt = (LAS bf16_t*)(lds + SC_XTS), *xd = (LAS bf16_t*)(lds + SC_XDS);
#pragma unroll
          for (int j = 0; j < 8; ++j) { const unsigned w2 = cvt_pk_bf16(f[j] * dt_l, f[j] * wl); xt[(wid * 8 + j) * 72 + lane] = (bf16_t)(w2 & 0xffffu); xd[(wid * 8 + j) * 72 + lane] = (bf16_t)(w2 >> 16); } }
#pragma unroll
        for (int i = 0; i < 2; ++i) { const int sg = wid + 8 * i; const u32x4 bw = pf_bt[i];
            LAS bf16_t* bt = (LAS bf16_t*)(lds + SC_BTS);
            bt[(sg * 8 + 0) * 72 + lane] = (bf16_t)(bw.x & 0xffffu); bt[(sg * 8 + 1) * 72 + lane] = (bf16_t)(bw.x >> 16);
            bt[(sg * 8 + 2) * 72 + lane] = (bf16_t)(bw.y & 0xffffu); bt[(sg * 8 + 3) * 72 + lane] = (bf16_t)(bw.y >> 16);
            bt[(sg * 8 + 4) * 72 + lane] = (bf16_t)(bw.z & 0xffffu); bt[(sg * 8 + 5) * 72 + lane] = (bf16_t)(bw.z >> 16);
            bt[(sg * 8 + 6) * 72 + lane] = (bf16_t)(bw.w & 0xffffu); bt[(sg * 8 + 7) * 72 + lane] = (bf16_t)(bw.w >> 16); }
#pragma unroll
        for (int pt = 0; pt < 4; ++pt) { u32x2 w2; w2.x = cvt_pk_bf16(hst[pt][0], hst[pt][1]); w2.y = cvt_pk_bf16(hst[pt][2], hst[pt][3]);
            *(LAS u32x2*)(lds + SC_HS + (16 * pt + fr) * 272 + (16 * wid + 4 * fq) * 2) = w2; }
        u32x2 ep_z[2], ep_x[2];
#pragma unroll
        for (int j = 0; j < 2; ++j) { const size_t rowe = r0 + 16 * lt + fr; const int col = hd * 64 + 16 * (2 * ph + j) + 4 * fq;
            ep_z[j] = *(const u32x2*)(A2 + rowe * 2048 + col); ep_x[j] = *(const u32x2*)(XBCA + rowe * XBC + col); }
        if (c + 1 < nchunks) SSD_PREFETCH(c + 1);
        LDS_BARRIER();
        f32x4 yacc[2];
        {
            bf16x8 cf[4];
#pragma unroll
            for (int kk = 0; kk < 4; ++kk) cf[kk] = *(const LAS bf16x8*)(lds + SC_CS + (16 * lt + fr) * 272 + kk * 64 + fq * 16);
            const float a_l = As[16 * lt + fr];
#pragma unroll
            for (int j = 0; j < 2; ++j) {
                const int st = 2 * ph + j;
                f32x4 cb = (f32x4){0.f, 0.f, 0.f, 0.f};
                if (st <= lt) {
#pragma unroll
                    for (int kk = 0; kk < 4; ++kk) { const bf16x8 bf = *(const LAS bf16x8*)(lds + SC_BS + (16 * st + fr) * 272 + kk * 64 + fq * 16);
                        cb = __builtin_amdgcn_mfma_f32_16x16x32_bf16(bf, cf[kk], cb, 0, 0, 0); }
                    const f32x4 as4 = *(const LAS f32x4*)(lds + SC_AS + (16 * st + 4 * fq) * 4);
#pragma unroll
                    for (int r = 0; r < 4; ++r) { const int s = 16 * st + 4 * fq + r, l = 16 * lt + fr; cb[r] = (s <= l) ? cb[r] * __expf(a_l - as4[r]) : 0.f; }
                }
                u32x2 w2; w2.x = cvt_pk_bf16(cb[0], cb[1]); w2.y = cvt_pk_bf16(cb[2], cb[3]);
                *(LAS u32x2*)(lds + SC_MS + (16 * lt + fr) * 144 + (16 * st + 4 * fq) * 2) = w2;
            }
            const float el = __expf(a_l);
#pragma unroll
            for (int j = 0; j < 2; ++j) { const int pt = 2 * ph + j; f32x4 y = (f32x4){0.f, 0.f, 0.f, 0.f};
#pragma unroll
                for (int kk = 0; kk < 4; ++kk) { const bf16x8 hf = *(const LAS bf16x8*)(lds + SC_HS + (16 * pt + fr) * 272 + kk * 64 + fq * 16);
                    y = __builtin_amdgcn_mfma_f32_16x16x32_bf16(hf, cf[kk], y, 0, 0, 0); }
                yacc[j] = y * el; }
        }
        {
            const float dec = __expf(a63);
            bf16x8 btf[2];
#pragma unroll
            for (int kk = 0; kk < 2; ++kk) btf[kk] = *(const LAS bf16x8*)(lds + SC_BTS + (16 * wid + fr) * 144 + kk * 64 + fq * 16);
#pragma unroll
            for (int pt = 0; pt < 4; ++pt) { f32x4 h = hst[pt] * dec;
#pragma unroll
                for (int kk = 0; kk < 2; ++kk) { const bf16x8 xf = *(const LAS bf16x8*)(lds + SC_XDS + (16 * pt + fr) * 144 + kk * 64 + fq * 16);
                    h = __builtin_amdgcn_mfma_f32_16x16x32_bf16(btf[kk], xf, h, 0, 0, 0); }
                hst[pt] = h; }
        }
        LDS_BARRIER();
        {
            bf16x8 mf[2];
#pragma unroll
            for (int kk = 0; kk < 2; ++kk) mf[kk] = *(const LAS bf16x8*)(lds + SC_MS + (16 * lt + fr) * 144 + kk * 64 + fq * 16);
            float sq = 0.f;
            const size_t row = r0 + 16 * lt + fr;
#pragma unroll
            for (int j = 0; j < 2; ++j) { const int pt = 2 * ph + j; f32x4 y = yacc[j];
#pragma unroll
                for (int kk = 0; kk < 2; ++kk) { const bf16x8 xf = *(const LAS bf16x8*)(lds + SC_XTS + (16 * pt + fr) * 144 + kk * 64 + fq * 16);
                    y = __builtin_amdgcn_mfma_f32_16x16x32_bf16(xf, mf[kk], y, 0, 0, 0); }
                const int col = hd * 64 + 16 * pt + 4 * fq;
                const u32x2 zw = ep_z[j], xw = ep_x[j];
                const float z0 = bf_lo(zw.x), z1 = bf_hi(zw.x), z2 = bf_lo(zw.y), z3 = bf_hi(zw.y);
                const float x0 = bf_lo(xw.x), x1 = bf_hi(xw.x), x2 = bf_lo(xw.y), x3 = bf_hi(xw.y);
                const float g0 = (y[0] + Dh * x0) * siluf_(z0), g1 = (y[1] + Dh * x1) * siluf_(z1), g2 = (y[2] + Dh * x2) * siluf_(z2), g3 = (y[3] + Dh * x3) * siluf_(z3);
                sq += g0 * g0 + g1 * g1 + g2 * g2 + g3 * g3;
                u32x2 ow; ow.x = cvt_pk_bf16(g0, g1); ow.y = cvt_pk_bf16(g2, g3);
                *(u32x2*)(A2 + row * 2048 + col) = ow; }
            sq += __shfl_xor(sq, 16); sq += __shfl_xor(sq, 32);
            if (fq == 0) Sq[ph * 64 + 16 * lt + fr] = sq;
        }
        LDS_BARRIER();
        if (tid < 64) atomicAdd(SSQ + r0 + tid, Sq[tid] + Sq[64 + tid]);
    }
    float* so = (seq < 16 ? P_OUT(p) + O_P_SSD + (size_t)(seq * 16 + hd) * 8192 : P_OUT(p) + O_S_SSD + (size_t)((seq - 16) * 16 + hd) * 8192);
#pragma unroll
    for (int pt = 0; pt < 4; ++pt) *(f32x4*)(so + (size_t)(16 * pt + fr) * 128 + 16 * wid + 4 * fq) = hst[pt];
    LDS_BARRIER();
}
__device__ __forceinline__ void phase_ssd(const Ctx cx, const Params& p, LAS unsigned char* lds) {
    for (int task = cx.bid; task < 384; task += cx.nblk) {
        if (task < 256) ssd_task(cx, p, lds, task >> 4, task & 15);
        else ssd_task(cx, p, lds, 16 + ((task - 256) >> 4), (task - 256) & 15);
    }
}

__device__ __forceinline__ void phase_lru_a(const Ctx cx, const bf16_t* LA, const bf16_t* UU, float* SL, float* HH) {
    const int total = 1032 * 128;
    for (int item = cx.bid * NTHREADS + cx.tid; item < total; item += cx.nblk * NTHREADS) {
        const int cgi = item & 127, ch = item >> 7, c0 = cgi * 8; const size_t r0 = (size_t)ch * 64;
        float sl[8], h[8];
#pragma unroll
        for (int j = 0; j < 8; ++j) { sl[j] = 0.f; h[j] = 0.f; }
        for (int i0 = 0; i0 < 64; i0 += 8) {
            u32x4 la[8], uu[8];
#pragma unroll
            for (int i = 0; i < 8; ++i) { la[i] = *(const u32x4*)(LA + (r0 + i0 + i) * 1024 + c0); uu[i] = *(const u32x4*)(UU + (r0 + i0 + i) * 1024 + c0); }
#pragma unroll
            for (int i = 0; i < 8; ++i) { float l[8], u[8]; unpack8(la[i], l); unpack8(uu[i], u);
#pragma unroll
                for (int j = 0; j < 8; ++j) { sl[j] += l[j]; h[j] = __expf(l[j]) * h[j] + u[j]; } }
        }
        float* o1 = SL + (size_t)ch * 1024 + c0; float* o2 = HH + (size_t)ch * 1024 + c0;
        *(f32x4*)o1 = (f32x4){sl[0], sl[1], sl[2], sl[3]}; *(f32x4*)(o1 + 4) = (f32x4){sl[4], sl[5], sl[6], sl[7]};
        *(f32x4*)o2 = (f32x4){h[0], h[1], h[2], h[3]}; *(f32x4*)(o2 + 4) = (f32x4){h[4], h[5], h[6], h[7]};
    }
}
__device__ __forceinline__ void phase_lru_b(const Ctx cx, const Params& p, const float* SL, const float* HH, float* CIN) {
    for (int item = cx.bid * NTHREADS + cx.tid; item < 24 * 1024; item += cx.nblk * NTHREADS) {
        const int chn = item & 1023, seq = item >> 10;
        const int nch = seq < 16 ? 64 : 1, ch0 = seq < 16 ? seq * 64 : 1024 + (seq - 16);
        float c = seq < 16 ? 0.f : IN(p, I_ST_LRU)[(seq - 16) * 1024 + chn];
        for (int i0 = 0; i0 < nch; i0 += 16) {
            float sl[16], hh[16];
#pragma unroll
            for (int i = 0; i < 16; ++i) if (i0 + i < nch) { sl[i] = SL[(size_t)(ch0 + i0 + i) * 1024 + chn]; hh[i] = HH[(size_t)(ch0 + i0 + i) * 1024 + chn]; }
#pragma unroll
            for (int i = 0; i < 16; ++i) if (i0 + i < nch) { CIN[(size_t)(ch0 + i0 + i) * 1024 + chn] = c; c = __expf(sl[i]) * c + hh[i]; }
        }
        (seq < 16 ? P_OUT(p) + O_P_LRU + seq * 1024 : P_OUT(p) + O_S_LRU + (seq - 16) * 1024)[chn] = c;
    }
}
__device__ __forceinline__ void phase_lru_c(const Ctx cx, const bf16_t* LA, const bf16_t* UU, const float* CIN, bf16_t* GATE) {
    const int total = 1032 * 128;
    for (int item = cx.bid * NTHREADS + cx.tid; item < total; item += cx.nblk * NTHREADS) {
        const int cgi = item & 127, ch = item >> 7, c0 = cgi * 8; const size_t r0 = (size_t)ch * 64;
        float h[8];
        { const float* ci = CIN + (size_t)ch * 1024 + c0; const f32x4 a = *(const f32x4*)ci, b = *(const f32x4*)(ci + 4);
#pragma unroll
          for (int j = 0; j < 4; ++j) { h[j] = a[j]; h[4 + j] = b[j]; } }
        for (int i0 = 0; i0 < 64; i0 += 8) {
            u32x4 la[8], uu[8], gt[8];
#pragma unroll
            for (int i = 0; i < 8; ++i) { la[i] = *(const u32x4*)(LA + (r0 + i0 + i) * 1024 + c0); uu[i] = *(const u32x4*)(UU + (r0 + i0 + i) * 1024 + c0); gt[i] = *(const u32x4*)(GATE + (r0 + i0 + i) * 1024 + c0); }
#pragma unroll
            for (int i = 0; i < 8; ++i) { float l[8], u[8], gq[8], o[8]; unpack8(la[i], l); unpack8(uu[i], u); unpack8(gt[i], gq);
#pragma unroll
                for (int j = 0; j < 8; ++j) { h[j] = __expf(l[j]) * h[j] + u[j]; o[j] = gq[j] * h[j]; }
                *(u32x4*)(GATE + (r0 + i0 + i) * 1024 + c0) = pack8(o); }
        }
    }
}

#define XB_TMO      128
#define XB_XCNT(j)  (256  + 64 * (j))
#define XB_XSUB(j)  (1280 + 64 * (j))
#define XB_XGEN(j)  (2304 + 64 * (j))
#define XB_TOP      3328
#define XB_TOPGEN   3392
#define XCD_BAR_WORDS 3456
#define XB_SPIN_CAP (1u << 18)
__device__ __forceinline__ unsigned xb_ld(unsigned* p)              { return __hip_atomic_load(p, __ATOMIC_RELAXED, __HIP_MEMORY_SCOPE_AGENT); }
__device__ __forceinline__ unsigned xb_add(unsigned* p, unsigned v) { return __hip_atomic_fetch_add(p, v, __ATOMIC_RELAXED, __HIP_MEMORY_SCOPE_AGENT); }
__device__ __forceinline__ unsigned xb_xcc_id() { return (unsigned)__builtin_amdgcn_s_getreg((3 << 11) | 20) & 0xFu; }
#define XB_SPIN(cond, bar) do { unsigned _sp = 0; while (cond) { __builtin_amdgcn_s_sleep(1); \
    if ((++_sp & 255u) == 0u) { if (xb_ld(&(bar)[XB_TMO])) break; if (_sp > XB_SPIN_CAP) { atomicAdd(&(bar)[XB_TMO], 1u); break; } } } } while (0)
struct XcdBarrier { unsigned* bar; unsigned x; volatile LAS unsigned* st; };
__device__ __forceinline__ XcdBarrier xcd_barrier_post(unsigned* bar, volatile LAS unsigned* st) {
    XcdBarrier b; b.bar = bar; b.x = xb_xcc_id(); b.st = st;
    if (threadIdx.x == 0) (void)xb_add(&bar[XB_XCNT(b.x)], 1u);
    return b;
}
__device__ __forceinline__ void xcd_barrier_complete(unsigned* bar, unsigned x, unsigned& nloc, unsigned& nx) {
    const unsigned G = gridDim.x * gridDim.y * gridDim.z;
    unsigned sum, cnt, mine, sp = 0u;
    for (;;) {
        sum = 0u; cnt = 0u; mine = 0u;
#pragma unroll
        for (unsigned j = 0; j < 16; ++j) { const unsigned c = xb_ld(&bar[XB_XCNT(j)]); sum += c; cnt += (c > 0u) ? 1u : 0u; mine = (j == x) ? c : mine; }
        if (sum == G) break;
        __builtin_amdgcn_s_sleep(1);
        if ((++sp & 255u) == 0u) { if (xb_ld(&bar[XB_TMO])) break; if (sp > XB_SPIN_CAP) { atomicAdd(&bar[XB_TMO], 1u); break; } }
    }
    nloc = mine > 0u ? mine : 1u; nx = cnt > 0u ? cnt : 1u;
}
__device__ __forceinline__ void xcd_barrier(const XcdBarrier& b) {
    asm volatile("s_waitcnt vmcnt(0)" ::: "memory");
    __syncthreads();
    if (threadIdx.x == 0) {
        unsigned* bar = b.bar;
        __builtin_amdgcn_s_waitcnt(0);
        unsigned nloc = b.st[0], nx = b.st[1];
        if (nloc == 0u) { xcd_barrier_complete(bar, b.x, nloc, nx); b.st[0] = nloc; b.st[1] = nx; }
        const unsigned old = xb_add(&bar[XB_XSUB(b.x)], 1u);
        const unsigned gen = old / nloc;
        if (old + 1u == (gen + 1u) * nloc) {
            __builtin_amdgcn_fence(__ATOMIC_RELEASE, "agent");
            asm volatile("s_waitcnt vmcnt(0)" ::: "memory");
            const unsigned og = xb_add(&bar[XB_TOP], 1u);
            const unsigned tg = og / nx;
            if (og + 1u == (tg + 1u) * nx) xb_add(&bar[XB_TOPGEN], 1u);
            else XB_SPIN(xb_ld(&bar[XB_TOPGEN]) == tg, bar);
            __builtin_amdgcn_fence(__ATOMIC_ACQUIRE, "agent");
            xb_add(&bar[XB_XGEN(b.x)], 1u);
            asm volatile("s_waitcnt vmcnt(0)" ::: "memory");
        } else {
            XB_SPIN(xb_ld(&bar[XB_XGEN(b.x)]) == gen, bar);
            __builtin_amdgcn_fence(__ATOMIC_ACQUIRE, "agent");
            asm volatile("s_waitcnt vmcnt(0)" ::: "memory");
        }
    }
    __syncthreads();
}

constexpr int NPHASE = 23;
__device__ __forceinline__ void run_phase(const Params& p, int ph, LAS unsigned char* lds) {
    Ctx cx; { int b = blockIdx.x, n = gridDim.x, t = threadIdx.x; asm volatile("" : "+s"(b), "+s"(n), "+v"(t)); cx.bid = b; cx.nblk = n; cx.tid = t; }
    unsigned char* ws = P_WS(p);
    bf16_t* XN = (bf16_t*)(ws + WS_XN);
    float* Y = P_OUT(p) + O_Y;
    float* SSQ = (float*)(ws + WS_SSQ);
    switch (ph) {
    case 0: phase_prep(cx, p, lds); phase_norm(cx, IN(p, I_XP), IN(p, I_XS), XN); break;
    case 1: { Gemm g{XN, (const bf16_t*)(ws + WS_W1), T, N1, 1024, 1024, 0, 0};
        EpiG1 e{(bf16_t*)(ws + WS_A2), (bf16_t*)(ws + WS_XBCP), (bf16_t*)(ws + WS_V), (float*)(ws + WS_DT), IN(p, I_DT_BIAS)};
        gemm_phase<EpiG1, false>(cx, lds, g, e, nullptr); } break;
    case 2:
        phase_conv<4, 0>(cx, (const bf16_t*)(ws + WS_XBCP), XBC, XBC, IN(p, I_SSD_CONVW), IN(p, I_SSD_CONVB), (bf16_t*)(ws + WS_XBCA), XBC, IN(p, I_ST_SSDCONV), P_OUT(p) + O_P_SSDCONV, P_OUT(p) + O_S_SSDCONV);
        phase_conv<3, 1>(cx, (const bf16_t*)(ws + WS_V), 1024, 1024, IN(p, I_SC_CONVW), IN(p, I_SC_CONVB), (bf16_t*)(ws + WS_A2) + 1024, 2048, IN(p, I_ST_SCONV), P_OUT(p) + O_P_SCONV, P_OUT(p) + O_S_SCONV);
        break;
    case 3: phase_ssd(cx, p, lds); break;
    case 4: { Gemm g{(const bf16_t*)(ws + WS_A2), (const bf16_t*)(ws + WS_W2), T, 1024, 2048, 2048, 0, 0};
        EpiRes<true> e{IN(p, I_XP), IN(p, I_XS), XN, SSQ + T};
        gemm_phase<EpiRes<true>, true, true>(cx, lds, g, e, SSQ, (float*)(ws + WS_SLAB)); } break;
    case 30: phase_split_finish<true, true>(cx, (const float*)(ws + WS_SLAB), 8, IN(p, I_XS), XN, SSQ + T, SSQ); break;
    case 5: case 15: { const int l = ph == 5 ? 0 : 1;
        Gemm g{XN, (const bf16_t*)(ws + WS_W3) + (size_t)l * 5632 * 1024, T, 5632, 1024, 1024, 0, 0};
        EpiFfnFused e{(bf16_t*)(ws + WS_H), (bf16_t*)(ws + WS_GH), (bf16_t*)(ws + WS_GT), (bf16_t*)(ws + WS_UH), SSQ + (l == 0 ? T : 3 * T), IN(p, I_FFN_CONVW) + l * 3 * DFF, IN(p, I_FFN_CONVB) + l * DFF};
        gemm_phase<EpiFfnFused, false>(cx, lds, g, e, nullptr); } break;
    case 6: case 16: { const int l = ph == 6 ? 0 : 1;
        phase_ffn_fix(cx, (const bf16_t*)(ws + WS_GH), (const bf16_t*)(ws + WS_GT), (const bf16_t*)(ws + WS_UH), (bf16_t*)(ws + WS_H), IN(p, I_FFN_CONVW) + l * 3 * DFF, IN(p, I_FFN_CONVB) + l * DFF,
                      IN(p, I_ST_FFNCONV) + l * 8 * 2 * DFF, P_OUT(p) + O_P_FFNCONV + l * 16 * 2 * DFF, P_OUT(p) + O_S_FFNCONV + l * 8 * 2 * DFF); } break;
    case 7: case 17: { const int l = ph == 7 ? 0 : 1;
        Gemm g{(const bf16_t*)(ws + WS_H), (const bf16_t*)(ws + WS_W4) + (size_t)l * 1024 * DFF, T, 1024, DFF, DFF, 0, 0};
        EpiRes<false> e{nullptr, nullptr, XN, SSQ + (l == 0 ? 2 * T : 4 * T)};
        gemm_phase<EpiRes<false>, false, true>(cx, lds, g, e, nullptr, (float*)(ws + WS_SLAB)); } break;
    case 31: phase_split_finish<false, false>(cx, (const float*)(ws + WS_SLAB), 11, nullptr, XN, SSQ + 2 * T, nullptr); break;
    case 33: phase_split_finish<false, false>(cx, (const float*)(ws + WS_SLAB), 11, nullptr, XN, SSQ + 4 * T, nullptr); break;
    case 8: { Gemm g{XN, (const bf16_t*)(ws + WS_W5), T, 2048, 1024, 1024, 0, 0};
        EpiLruIn e{(bf16_t*)(ws + WS_GATE), (bf16_t*)(ws + WS_XBP), SSQ + 2 * T};
        gemm_phase<EpiLruIn, false>(cx, lds, g, e, nullptr); } break;
    case 9: phase_conv<4, 3>(cx, (const bf16_t*)(ws + WS_XBP), 1024, 1024, IN(p, I_LRU_CONVW), IN(p, I_LRU_CONVB), (bf16_t*)(ws + WS_XBC2), 1024, IN(p, I_ST_LRUCONV), P_OUT(p) + O_P_LRUCONV, P_OUT(p) + O_S_LRUCONV); break;
    case 10: { Gemm g{(const bf16_t*)(ws + WS_XBC2), (const bf16_t*)(ws + WS_W6), T, 2048, 256, 1024, 1, 256};
        EpiLruGate e{(const bf16_t*)(ws + WS_XBC2), (bf16_t*)(ws + WS_LA), (bf16_t*)(ws + WS_UU), IN(p, I_LRU_BA), IN(p, I_LRU_BX), (const float*)(ws + WS_SP)};
        gemm_phase<EpiLruGate, false>(cx, lds, g, e, nullptr); } break;
    case 11: phase_lru_a(cx, (const bf16_t*)(ws + WS_LA), (const bf16_t*)(ws + WS_UU), (float*)(ws + WS_SL), (float*)(ws + WS_HH)); break;
    case 12: phase_lru_b(cx, p, (const float*)(ws + WS_SL), (const float*)(ws + WS_HH), (float*)(ws + WS_CIN)); break;
    case 13: phase_lru_c(cx, (const bf16_t*)(ws + WS_LA), (const bf16_t*)(ws + WS_UU), (const float*)(ws + WS_CIN), (bf16_t*)(ws + WS_GATE)); break;
    case 14: { Gemm g{(const bf16_t*)(ws + WS_GATE), (const bf16_t*)(ws + WS_W7), T, 1024, 1024, 1024, 0, 0};
        EpiRes<false> e{nullptr, nullptr, XN, SSQ + 3 * T};
        gemm_phase<EpiRes<false>, false, true>(cx, lds, g, e, nullptr, (float*)(ws + WS_SLAB)); } break;
    case 32: phase_split_finish<false, false>(cx, (const float*)(ws + WS_SLAB), 4, nullptr, XN, SSQ + 3 * T, nullptr); break;
    case 18: phase_final_norm(cx, XN, SSQ + 4 * T, IN(p, I_NORM_FINAL), Y); break;
    default: break;
    }
}

__global__ void __launch_bounds__(NTHREADS, 2) fwd_mega(Params p, int ph_lo, int ph_hi) {
    extern __shared__ __attribute__((aligned(16))) unsigned char smem[];
    LAS unsigned char* lds = (LAS unsigned char*)smem;
    cg::grid_group grid = cg::this_grid();
    volatile LAS unsigned* bst = (volatile LAS unsigned*)(lds + 131072 + 1024);
    if (threadIdx.x == 0) { bst[0] = 0u; bst[1] = 0u; }
    __syncthreads();
    const XcdBarrier xb = xcd_barrier_post((unsigned*)(IN(p, 35)) + WS_BAR / 4, bst);
#ifndef PROBE_K
#define PROBE_K -1
#endif
    bool first = true;
    for (int i = ph_lo; i < ph_hi; ++i) {
        int ph = i;
        if (i >= 5) ph = (i == 5) ? 30 : (i <= 8) ? i - 1 : (i == 9) ? 31 : (i <= 16) ? i - 2 : (i == 17) ? 32 : (i <= 20) ? i - 3 : (i == 21) ? 33 : 18;
        run_phase(p, ph, lds);
        if (i + 1 < ph_hi) { if (first) { grid.sync(); first = false; } else xcd_barrier(xb); }
    }
}

extern "C" void kernel_launch(void* const* d_in, const int* in_sizes, int n_in, void* d_out, int out_size, void* d_ws, size_t ws_size, hipStream_t stream) {
    static int grid = 0;
    if (grid == 0) {
        if (n_in != 34 || (size_t)out_size != O_END || ws_size < WS_NEED) { fprintf(stderr, "kernel_launch: unexpected shapes (n_in %d out %d ws %zu need %zu)\n", n_in, out_size, ws_size, (size_t)WS_NEED); grid = -1; return; }
        int dev = 0, cus = 0, per_cu = 0;
        (void)hipGetDevice(&dev); (void)hipDeviceGetAttribute(&cus, hipDeviceAttributeMultiprocessorCount, dev);
        if (hipFuncSetAttribute((const void*)fwd_mega, hipFuncAttributeMaxDynamicSharedMemorySize, LDS_BYTES) != hipSuccess) { fprintf(stderr, "kernel_launch: hipFuncSetAttribute failed\n"); grid = -1; return; }
        if (hipOccupancyMaxActiveBlocksPerMultiprocessor(&per_cu, (const void*)fwd_mega, NTHREADS, LDS_BYTES) != hipSuccess || per_cu < 1) { fprintf(stderr, "kernel_launch: occupancy query says %d\n", per_cu); per_cu = 1; }
        (void)hipGetLastError();
        grid = cus;
    }
    if (grid < 0) return;
    (void)hipMemsetAsync((unsigned char*)d_ws + WS_BAR, 0, 16384, stream);
    Params p{};
    for (int i = 0; i < 34; ++i) p.ptr[i] = (const float*)d_in[i];
    p.ptr[34] = (const float*)d_out; p.ptr[35] = (const float*)d_ws;
    int lo = 0, hi = NPHASE; void* args[] = {&p, &lo, &hi};
    hipError_t e = hipLaunchCooperativeKernel((const void*)fwd_mega, dim3(grid), dim3(NTHREADS), args, LDS_BYTES, stream);
    if (e != hipSuccess) fprintf(stderr, "cooperative launch failed: %s (grid %d)\n", hipGetErrorString(e), grid);
}
```

```cpp
#include <hip/hip_runtime.h>
#include <hip/hip_cooperative_groups.h>
#include <cstdio>
namespace cg = cooperative_groups;

#define LAS __attribute__((address_space(3)))
typedef unsigned short bf16_t;
typedef short bf16x8 __attribute__((ext_vector_type(8)));
typedef float f32x4 __attribute__((ext_vector_type(4)));
typedef unsigned u32x4 __attribute__((ext_vector_type(4)));
typedef unsigned u32x2 __attribute__((ext_vector_type(2)));

constexpr int TP = 65536;
constexpr int TS = 512;
constexpr int T = TP + TS;
constexpr int DM = 1024;
constexpr int DFF = 2816;
constexpr int XBC = 1536;
constexpr int N1 = 5888;
constexpr float EPS = 1e-6f;
constexpr int NTHREADS = 512;
constexpr int LDS_BYTES = 131072 + 4096;

constexpr size_t O_Y = 0;
constexpr size_t O_P_SSDCONV = (size_t)T * DM;
constexpr size_t O_P_SSD = O_P_SSDCONV + 16 * 3 * XBC;
constexpr size_t O_P_SCONV = O_P_SSD + (size_t)16 * 16 * 64 * 128;
constexpr size_t O_P_LRUCONV = O_P_SCONV + 16 * 2 * 1024;
constexpr size_t O_P_LRU = O_P_LRUCONV + 16 * 3 * 1024;
constexpr size_t O_P_FFNCONV = O_P_LRU + 16 * 1024;
constexpr size_t O_S_SSDCONV = O_P_FFNCONV + 2 * 16 * 2 * DFF;
constexpr size_t O_S_SSD = O_S_SSDCONV + 8 * 3 * XBC;
constexpr size_t O_S_SCONV = O_S_SSD + (size_t)8 * 16 * 64 * 128;
constexpr size_t O_S_LRUCONV = O_S_SCONV + 8 * 2 * 1024;
constexpr size_t O_S_LRU = O_S_LRUCONV + 8 * 3 * 1024;
constexpr size_t O_S_FFNCONV = O_S_LRU + 8 * 1024;
constexpr size_t O_END = O_S_FFNCONV + 2 * 8 * 2 * DFF;

constexpr size_t al256(size_t x) { return (x + 255) & ~(size_t)255; }
constexpr size_t WS_W1 = 0;
constexpr size_t WS_W2 = WS_W1 + (size_t)N1 * 1024 * 2;
constexpr size_t WS_W3 = WS_W2 + (size_t)1024 * 2048 * 2;
constexpr size_t WS_W4 = WS_W3 + (size_t)2 * 5632 * 1024 * 2;
constexpr size_t WS_W5 = WS_W4 + (size_t)2 * 1024 * 2816 * 2;
constexpr size_t WS_W6 = WS_W5 + (size_t)2048 * 1024 * 2;
constexpr size_t WS_W7 = WS_W6 + (size_t)2048 * 256 * 2;
constexpr size_t WS_SP = WS_W7 + (size_t)1024 * 1024 * 2;
constexpr size_t WS_BAR = WS_SP + 4096;
constexpr size_t WS_SSQ = WS_BAR + 16384;
constexpr size_t WS_SL = al256(WS_SSQ + (size_t)5 * T * 4);
constexpr size_t WS_HH = WS_SL + (size_t)1032 * 1024 * 4;
constexpr size_t WS_CIN = WS_HH + (size_t)1032 * 1024 * 4;
constexpr size_t WS_SLAB = al256(WS_CIN + (size_t)1032 * 1024 * 4);
constexpr size_t WS_XN = al256(WS_SLAB + (size_t)88 * 65536 * 4);
constexpr size_t WS_ARENA = al256(WS_XN + (size_t)T * 1024 * 2);
constexpr size_t WS_A2 = WS_ARENA;
constexpr size_t WS_XBCP = WS_A2 + (size_t)T * 2048 * 2;
constexpr size_t WS_XBCA = WS_XBCP + (size_t)T * XBC * 2;
constexpr size_t WS_V = WS_XBCA + (size_t)T * XBC * 2;
constexpr size_t WS_DT = WS_V + (size_t)T * 1024 * 2;
constexpr size_t WS_END0 = WS_DT + (size_t)T * 16 * 4;
constexpr size_t WS_H = WS_ARENA;
constexpr size_t WS_GH = WS_H + (size_t)T * DFF * 2;
constexpr size_t WS_GT = WS_GH + (size_t)1032 * 2 * DFF * 2;
constexpr size_t WS_UH = WS_GT + (size_t)1032 * 2 * DFF * 2;
constexpr size_t WS_END1 = WS_UH + (size_t)1032 * 2 * DFF * 2;
constexpr size_t WS_GATE = WS_ARENA;
constexpr size_t WS_XBP = WS_GATE + (size_t)T * 1024 * 2;
constexpr size_t WS_XBC2 = WS_XBP + (size_t)T * 1024 * 2;
constexpr size_t WS_LA = WS_XBC2 + (size_t)T * 1024 * 2;
constexpr size_t WS_UU = WS_LA + (size_t)T * 1024 * 2;
constexpr size_t WS_END2 = WS_UU + (size_t)T * 1024 * 2;
constexpr size_t WS_NEED = WS_END0 > WS_END1 ? (WS_END0 > WS_END2 ? WS_END0 : WS_END2) : (WS_END1 > WS_END2 ? WS_END1 : WS_END2);

struct Params {
    const float* ptr[36];
};
__device__ __forceinline__ const float* IN(const Params& p, int i) { asm volatile("" : "+s"(i)); return p.ptr[i]; }
#define P_OUT(p) ((float*)IN(p, 34))
#define P_WS(p) ((unsigned char*)IN(p, 35))
enum { I_XP = 0, I_XS, I_ST_SSDCONV, I_ST_SSD, I_ST_SCONV, I_ST_LRUCONV, I_ST_LRU, I_ST_FFNCONV, I_NORM_MIX, I_NORM_FFN, I_NORM_FINAL,
       I_AB_WIN, I_SSD_CONVW, I_SSD_CONVB, I_DT_BIAS, I_A_LOG, I_SSD_D, I_SSD_NORM, I_SC_CONVW, I_SC_CONVB, I_AB_WOUT, I_LRU_WIN,
       I_LRU_CONVW, I_LRU_CONVB, I_LRU_WA, I_LRU_BA, I_LRU_WX, I_LRU_BX, I_LRU_LAMBDA, I_LRU_WOUT, I_FFN_WIN, I_FFN_CONVW, I_FFN_CONVB, I_FFN_WOUT };

struct Ctx { int bid, nblk, tid; };
__device__ __forceinline__ unsigned cvt_pk_bf16(float lo, float hi) { unsigned r; asm("v_cvt_pk_bf16_f32 %0, %1, %2" : "=v"(r) : "v"(lo), "v"(hi)); return r; }
__device__ __forceinline__ float bf_lo(unsigned w) { return __uint_as_float(w << 16); }
__device__ __forceinline__ float bf_hi(unsigned w) { return __uint_as_float(w & 0xffff0000u); }
__device__ __forceinline__ float sigmoidf_(float x) { return __builtin_amdgcn_rcpf(1.0f + __expf(-x)); }
__device__ __forceinline__ float siluf_(float x) { return x * __builtin_amdgcn_rcpf(1.0f + __expf(-x)); }
__device__ __forceinline__ float geluf_(float x) { const float u = x * (1.5957691216f + 0.0713548163f * x * x); return x * __builtin_amdgcn_rcpf(1.0f + __builtin_amdgcn_exp2f(-1.4426950409f * u)); }
__device__ __forceinline__ float softplusf_(float x) { return fmaxf(x, 0.0f) + log1pf(__expf(-fabsf(x))); }
__device__ __forceinline__ void unpack8(const u32x4 w, float (&f)[8]) {
    f[0] = bf_lo(w.x); f[1] = bf_hi(w.x); f[2] = bf_lo(w.y); f[3] = bf_hi(w.y); f[4] = bf_lo(w.z); f[5] = bf_hi(w.z); f[6] = bf_lo(w.w); f[7] = bf_hi(w.w);
}
__device__ __forceinline__ u32x4 pack8(const float (&f)[8]) {
    u32x4 w; w.x = cvt_pk_bf16(f[0], f[1]); w.y = cvt_pk_bf16(f[2], f[3]); w.z = cvt_pk_bf16(f[4], f[5]); w.w = cvt_pk_bf16(f[6], f[7]); return w;
}
__device__ __forceinline__ u32x4 pack44(const f32x4 a, const f32x4 b) {
    u32x4 w; w.x = cvt_pk_bf16(a[0], a[1]); w.y = cvt_pk_bf16(a[2], a[3]); w.z = cvt_pk_bf16(b[0], b[1]); w.w = cvt_pk_bf16(b[2], b[3]); return w;
}

constexpr int BM = 256, BK = 64, HALF = 128, HTB = HALF * BK * 2, NXCD = 8, WGM = 8;
__device__ __forceinline__ int lds_byte(int r, int c) { const int st = (r >> 4) * 2 + (c >> 5), rr = r & 15, cc = c & 31, ob = rr * 64 + cc * 2; return st * 1024 + (ob ^ (((ob >> 9) & 1) << 5)); }
__device__ __forceinline__ void stage_rc(int b, int& R, int& C) { const int st = b / 1024, sb = b % 1024, swz = sb ^ (((sb >> 9) & 1) << 5); R = (st >> 1) * 16 + swz / 64; C = (st & 1) * 32 + (swz % 64) / 2; }
__device__ __forceinline__ int perm32(int rho) { const int n = rho >> 4, i = rho & 15; return 8 * (i >> 2) + 4 * n + (i & 3); }

struct Unit { int pm, pn, kt0, nkt, slab; };
struct Gemm { const bf16_t* A; const bf16_t* Bt; int M, N, K, lda, a_shift, a_koff; };

struct StaticOrder {
    int nM, nN, nwg, G, c, nt, nsplit, ntail;
    __device__ void init(int M, int N, int G_, int c_, int nt_, bool split) { nM = M / BM; nN = N / BM; G = G_; c = c_; nt = nt_; nsplit = 0; ntail = 0;
        if (split) { nM = TP / BM; nsplit = nt / 4; ntail = 2 * nN * nsplit; } nwg = nM * nN; }
    __device__ bool next(int i, Unit& u) const {
        const long L = (long)i * G + c;
        if (L >= nwg) { const int t = (int)(L - nwg); if (t >= ntail) return false;
            const int tile = t / nsplit, piece = t - tile * nsplit; u.pm = TP / BM + tile / nN; u.pn = tile % nN; u.kt0 = piece * 4; u.nkt = 4; u.slab = t; return true; }
        int wgid = (int)L; { const int q = nwg / NXCD, r = nwg % NXCD, xcd = wgid % NXCD, off = wgid / NXCD; wgid = (xcd < r ? xcd * (q + 1) : r * (q + 1) + (xcd - r) * q) + off; }
        const int nig = WGM * nN, gid = wgid / nig, fm = gid * WGM, gsz = (nM - fm) < WGM ? (nM - fm) : WGM;
        u.pm = fm + ((wgid % nig) % gsz); u.pn = (wgid % nig) / gsz; u.kt0 = 0; u.nkt = nt; u.slab = -1; return true;
    }
};

template <class Epi, bool MIDSCALE, bool SPLIT = false>
__device__ __forceinline__ void gemm_phase(const Ctx cx, LAS unsigned char* lds, const Gemm g, const Epi& E, const float* ssq, float* slabs = nullptr) {
    const int tid = cx.tid, wid = __builtin_amdgcn_readfirstlane(tid >> 6), lane = tid & 63, wr = wid >> 2, wc = wid & 3, fr = lane & 15, fq = lane >> 4;
    int K_ = g.K; asm volatile("" : "+s"(K_));
    const int K = K_, nt = K / BK;
    StaticOrder S; S.init(g.M, g.N, cx.nblk, cx.bid, nt, SPLIT);
    unsigned voffA[2], voffB[2];
#pragma unroll
    for (int i = 0; i < 2; ++i) { int R, C; stage_rc(tid * 16 + i * 8192, R, C); const int Rb = Epi::PERM ? ((R & ~31) + perm32(R & 31)) : R;
        voffA[i] = (unsigned)(R * g.lda + C) * 2u; voffB[i] = (unsigned)(Rb * K + C) * 2u; }
    const size_t kstep = (size_t)(BK * 2);
    const size_t hsA = (size_t)HALF * g.lda * 2, hsB = (size_t)HALF * K * 2;
    const size_t tsA = 2 * hsA, tsB = 2 * hsB;
    const unsigned ldsw = (unsigned)wid * 1024u;
    const int aoff = lds_byte(wr * 64 + fr, fq * 8), boff = lds_byte(wc * 32 + fr, fq * 8);
#define SA_(b, h) (((b) * 2 + (h)) * HTB)
#define SB_(b, h) ((4 + (b) * 2 + (h)) * HTB)
#define STAGE_(bufoff, gbase, voff) do { _Pragma("unroll") for (int _i = 0; _i < 2; ++_i) \
        __builtin_amdgcn_global_load_lds((const unsigned*)((const char*)(gbase) + (voff)[_i]), (LAS unsigned*)(lds + (bufoff) + ldsw + _i * 8192), 16, 0, 0); } while (0)
#define LDA_(dst, b, h) do { _Pragma("unroll") for (int m = 0; m < 4; ++m) _Pragma("unroll") for (int k = 0; k < 2; ++k) dst[m][k] = *(const LAS bf16x8*)(lds + SA_(b, h) + aoff + m * 2048 + k * 1024); } while (0)
#define LDB_(dst, b, h) do { _Pragma("unroll") for (int n = 0; n < 2; ++n) _Pragma("unroll") for (int k = 0; k < 2; ++k) dst[n][k] = *(const LAS bf16x8*)(lds + SB_(b, h) + boff + n * 2048 + k * 1024); } while (0)
#define MMA_(ai, bj, At, Bt) do { __builtin_amdgcn_s_setprio(1); _Pragma("unroll") for (int m = 0; m < 4; ++m) _Pragma("unroll") for (int n = 0; n < 2; ++n) _Pragma("unroll") for (int k = 0; k < 2; ++k) \
        acc[ai][bj][m][n] = __builtin_amdgcn_mfma_f32_16x16x32_bf16(Bt[n][k], At[m][k], acc[ai][bj][m][n], 0, 0, 0); __builtin_amdgcn_s_setprio(0); } while (0)
#define WAIT_V_(n) asm volatile("s_waitcnt vmcnt(" #n ")" ::: "memory")
#define WAIT_L_(n) asm volatile("s_waitcnt lgkmcnt(" #n ")" ::: "memory")
#define BAR_ __builtin_amdgcn_s_barrier()
#define SCHED_ __builtin_amdgcn_sched_barrier(0)
#ifndef STAGGER
#define STAGGER 0
#endif
    if (STAGGER && (cx.bid & 8)) {
        const unsigned long long t0 = __builtin_amdgcn_s_memrealtime(); const unsigned long long dl = 800ull;
        while (__builtin_amdgcn_s_memrealtime() - t0 < dl) __builtin_amdgcn_s_sleep(8);
    }
    Unit cur, nxt; int ui = 0;
    if (!S.next(0, cur)) return;
    f32x4 acc[2][2][4][2];
#pragma unroll
    for (int a = 0; a < 2; ++a)
#pragma unroll
        for (int b = 0; b < 2; ++b)
#pragma unroll
            for (int m = 0; m < 4; ++m)
#pragma unroll
                for (int n = 0; n < 2; ++n) acc[a][b][m][n] = (f32x4){0.f, 0.f, 0.f, 0.f};
    bf16x8 At[4][2], B0[2][2], B1[2][2];
    const char* cA = (const char*)g.A + (size_t)cur.pm * tsA + (size_t)((cur.pn >> g.a_shift) * g.a_koff) * 2 + (size_t)cur.kt0 * kstep;
    const char* cB = (const char*)g.Bt + (size_t)cur.pn * tsB + (size_t)cur.kt0 * kstep;
    STAGE_(SB_(0, 0), cB, voffB); STAGE_(SA_(0, 0), cA, voffA); STAGE_(SB_(0, 1), cB + hsB, voffB); STAGE_(SA_(0, 1), cA + hsA, voffA);
    if (wr == 1) BAR_;
    WAIT_V_(4); BAR_;
    STAGE_(SB_(1, 0), cB + kstep, voffB); STAGE_(SA_(1, 0), cA + kstep, voffA); STAGE_(SB_(1, 1), cB + hsB + kstep, voffB);
    WAIT_V_(6); BAR_;
    for (;;) {
        const bool has_next = S.next(ui + 1, nxt);
        const char* nA = has_next ? (const char*)g.A + (size_t)nxt.pm * tsA + (size_t)((nxt.pn >> g.a_shift) * g.a_koff) * 2 + (size_t)nxt.kt0 * kstep : cA;
        const char* nB = has_next ? (const char*)g.Bt + (size_t)nxt.pn * tsB + (size_t)nxt.kt0 * kstep : cB;
        const int cnt = cur.nkt;
        for (int t = 0; t < cnt; t += 2) {
            const bool last = (t == cnt - 2);
            const char* a1 = cA + (size_t)(t + 1) * kstep;
            const char* a2 = last ? nA : cA + (size_t)(t + 2) * kstep; const char* b2 = last ? nB : cB + (size_t)(t + 2) * kstep;
            const char* a3 = a2 + kstep; const char* b3 = b2 + kstep;
            if (MIDSCALE && t == 16 && cur.slab < 0) {
                int rb = cur.pm * BM + wr * 64 + fr; asm volatile("" : "+v"(rb));
#pragma unroll
                for (int ai = 0; ai < 2; ++ai)
#pragma unroll
                    for (int m = 0; m < 4; ++m) {
                        const float sc = rsqrtf(ssq[rb + ai * HALF + m * 16] * (1.0f / 1024.0f) + EPS);
#pragma unroll
                        for (int bj = 0; bj < 2; ++bj)
#pragma unroll
                            for (int n = 0; n < 2; ++n) acc[ai][bj][m][n] *= sc;
                    }
            }
            LDB_(B0, 0, 0); SCHED_; LDA_(At, 0, 0); STAGE_(SA_(1, 1), a1 + hsA, voffA);
            WAIT_L_(8); BAR_; WAIT_L_(0); MMA_(0, 0, At, B0); BAR_; SCHED_;
            LDB_(B1, 0, 1); STAGE_(SB_(0, 0), b2, voffB);
            BAR_; WAIT_L_(0); MMA_(0, 1, At, B1); BAR_;
            LDA_(At, 0, 1); STAGE_(SA_(0, 0), a2, voffA);
            BAR_; WAIT_L_(0); MMA_(1, 0, At, B0); BAR_; SCHED_;
            STAGE_(SB_(0, 1), b2 + hsB, voffB);
            WAIT_V_(6); BAR_; MMA_(1, 1, At, B1); BAR_;
            LDB_(B0, 1, 0); SCHED_; LDA_(At, 1, 0); STAGE_(SA_(0, 1), a2 + hsA, voffA);
            WAIT_L_(8); BAR_; WAIT_L_(0); MMA_(0, 0, At, B0); BAR_; SCHED_;
            LDB_(B1, 1, 1); STAGE_(SB_(1, 0), b3, voffB);
            BAR_; WAIT_L_(0); MMA_(0, 1, At, B1); BAR_;
            LDA_(At, 1, 1); STAGE_(SA_(1, 0), a3, voffA);
            BAR_; WAIT_L_(0); MMA_(1, 0, At, B0); BAR_; SCHED_;
            STAGE_(SB_(1, 1), b3 + hsB, voffB);
            WAIT_V_(6); BAR_; MMA_(1, 1, At, B1); BAR_;
        }
        if (SPLIT && cur.slab >= 0) {
            float* sb = slabs + (size_t)cur.slab * 65536 + (size_t)(wr * 64 + fr) * 256 + wc * 32 + 8 * fq;
#pragma unroll
            for (int ai = 0; ai < 2; ++ai)
#pragma unroll
                for (int m = 0; m < 4; ++m)
#pragma unroll
                    for (int bj = 0; bj < 2; ++bj) { float* q = sb + (size_t)(ai * HALF + m * 16) * 256 + bj * HALF; *(f32x4*)q = acc[ai][bj][m][0]; *(f32x4*)(q + 4) = acc[ai][bj][m][1]; }
        } else E(acc, cur, wr, wc, fr, fq);
        if (!has_next) break;
#pragma unroll
        for (int a = 0; a < 2; ++a)
#pragma unroll
            for (int b = 0; b < 2; ++b)
#pragma unroll
                for (int m = 0; m < 4; ++m)
#pragma unroll
                    for (int n = 0; n < 2; ++n) acc[a][b][m][n] = (f32x4){0.f, 0.f, 0.f, 0.f};
        cur = nxt; cA = nA; cB = nB; ++ui;
    }
    WAIT_V_(0);
    if (wr == 0) BAR_;
    BAR_;
#undef SA_
#undef SB_
#undef STAGE_
#undef LDA_
#undef LDB_
#undef MMA_
}

struct EpiG1 {
    static constexpr bool PERM = true;
    bf16_t* A2; bf16_t* XBCP; bf16_t* V; float* DT; const float* dt_bias;
    __device__ __forceinline__ void operator()(const f32x4 (&acc)[2][2][4][2], const Unit& u, int wr, int wc, int fr, int fq) const {
        const int row0 = u.pm * BM + wr * 64 + fr, lc = wc * 32 + 8 * fq;
        if (u.pn < 14) {
            bf16_t* base; int ld, colt;
            if (u.pn < 4) { base = A2; ld = 2048; colt = u.pn * 256; }
            else if (u.pn < 10) { base = XBCP; ld = XBC; colt = (u.pn - 4) * 256; }
            else { base = A2; ld = 2048; colt = 1024 + (u.pn - 10) * 256; }
#pragma unroll
            for (int ai = 0; ai < 2; ++ai)
#pragma unroll
                for (int m = 0; m < 4; ++m) { bf16_t* rowp = base + (size_t)(row0 + ai * HALF + m * 16) * ld + colt + lc;
#pragma unroll
                    for (int bj = 0; bj < 2; ++bj) *(u32x4*)(rowp + bj * HALF) = pack44(acc[ai][bj][m][0], acc[ai][bj][m][1]); }
        } else if (u.pn < 22) {
            const int ch0 = (u.pn - 14) * 128 + lc;
#pragma unroll
            for (int ai = 0; ai < 2; ++ai)
#pragma unroll
                for (int m = 0; m < 4; ++m) { bf16_t* rowp = V + (size_t)(row0 + ai * HALF + m * 16) * 1024 + ch0;
                    *(u32x4*)rowp = pack44(acc[ai][0][m][0] * acc[ai][1][m][0], acc[ai][0][m][1] * acc[ai][1][m][1]); }
        } else {
            if (wc == 0 && fq < 2) {
                const f32x4 b0 = *(const f32x4*)(dt_bias + 8 * fq), b1 = *(const f32x4*)(dt_bias + 8 * fq + 4);
#pragma unroll
                for (int ai = 0; ai < 2; ++ai)
#pragma unroll
                    for (int m = 0; m < 4; ++m) { float* rowp = DT + (size_t)(row0 + ai * HALF + m * 16) * 16 + 8 * fq;
                        f32x4 v0 = acc[ai][0][m][0] + b0, v1 = acc[ai][0][m][1] + b1;
#pragma unroll
                        for (int j = 0; j < 4; ++j) { v0[j] = softplusf_(v0[j]); v1[j] = softplusf_(v1[j]); }
                        *(f32x4*)rowp = v0; *(f32x4*)(rowp + 4) = v1; }
            }
        }
    }
};
template <bool SRC_F32> struct EpiRes {
    static constexpr bool PERM = true;
    const float* xp; const float* xs; bf16_t* XN; float* ssq;
    __device__ __forceinline__ void operator()(const f32x4 (&acc)[2][2][4][2], const Unit& u, int wr, int wc, int fr, int fq) const {
        const int row0 = u.pm * BM + wr * 64 + fr, col0 = u.pn * BM + wc * 32 + 8 * fq;
        if (SRC_F32) {
#pragma unroll
            for (int ai = 0; ai < 2; ++ai) {
                f32x4 old[4][2][2];
#pragma unroll
                for (int m = 0; m < 4; ++m) { const int row = row0 + ai * HALF + m * 16;
                    const float* src = (row < TP ? xp + (size_t)row * DM : xs + (size_t)(row - TP) * DM) + col0;
#pragma unroll
                    for (int bj = 0; bj < 2; ++bj) { old[m][bj][0] = *(const f32x4*)(src + bj * HALF); old[m][bj][1] = *(const f32x4*)(src + bj * HALF + 4); } }
#pragma unroll
                for (int m = 0; m < 4; ++m) { const int row = row0 + ai * HALF + m * 16; bf16_t* xnp = XN + (size_t)row * DM + col0; float sq = 0.f;
#pragma unroll
                    for (int bj = 0; bj < 2; ++bj) { const f32x4 v0 = old[m][bj][0] + acc[ai][bj][m][0], v1 = old[m][bj][1] + acc[ai][bj][m][1];
                        *(u32x4*)(xnp + bj * HALF) = pack44(v0, v1);
                        sq += v0[0] * v0[0] + v0[1] * v0[1] + v0[2] * v0[2] + v0[3] * v0[3] + v1[0] * v1[0] + v1[1] * v1[1] + v1[2] * v1[2] + v1[3] * v1[3]; }
                    sq += __shfl_xor(sq, 16); sq += __shfl_xor(sq, 32);
                    if (fq == 0) atomicAdd(ssq + row, sq); }
            }
        } else {
#pragma unroll
            for (int ai = 0; ai < 2; ++ai) {
                u32x4 old[4][2];
#pragma unroll
                for (int m = 0; m < 4; ++m)
#pragma unroll
                    for (int bj = 0; bj < 2; ++bj) old[m][bj] = *(const u32x4*)(XN + (size_t)(row0 + ai * HALF + m * 16) * DM + col0 + bj * HALF);
#pragma unroll
                for (int m = 0; m < 4; ++m) { const int row = row0 + ai * HALF + m * 16; bf16_t* xnp = XN + (size_t)row * DM + col0; float sq = 0.f;
#pragma unroll
                    for (int bj = 0; bj < 2; ++bj) { const u32x4 w = old[m][bj];
                        const f32x4 v0 = (f32x4){bf_lo(w.x), bf_hi(w.x), bf_lo(w.y), bf_hi(w.y)} + acc[ai][bj][m][0], v1 = (f32x4){bf_lo(w.z), bf_hi(w.z), bf_lo(w.w), bf_hi(w.w)} + acc[ai][bj][m][1];
                        *(u32x4*)(xnp + bj * HALF) = pack44(v0, v1);
                        sq += v0[0] * v0[0] + v0[1] * v0[1] + v0[2] * v0[2] + v0[3] * v0[3] + v1[0] * v1[0] + v1[1] * v1[1] + v1[2] * v1[2] + v1[3] * v1[3]; }
                    sq += __shfl_xor(sq, 16); sq += __shfl_xor(sq, 32);
                    if (fq == 0) atomicAdd(ssq + row, sq); }
            }
        }
    }
};
__device__ __forceinline__ float dpp_ror1(float v) { return __int_as_float(__builtin_amdgcn_update_dpp(0, __float_as_int(v), 0x121, 0xf, 0xf, false)); }
__device__ __forceinline__ float dpp_ror2(float v) { return __int_as_float(__builtin_amdgcn_update_dpp(0, __float_as_int(v), 0x122, 0xf, 0xf, false)); }
struct EpiFfnFused {
    static constexpr bool PERM = true;
    bf16_t* H; bf16_t* GH; bf16_t* GT; bf16_t* UH; const float* ssq; const float* cw; const float* cb;
    __device__ __forceinline__ void operator()(const f32x4 (&acc)[2][2][4][2], const Unit& u, int wr, int wc, int fr, int fq) const {
        const int ch0 = u.pn * 128 + wc * 32 + 8 * fq;
        float w0[8], w1[8], w2[8], bb[8];
#pragma unroll
        for (int h = 0; h < 2; ++h) { const f32x4 a = *(const f32x4*)(cw + ch0 + 4 * h), b = *(const f32x4*)(cw + DFF + ch0 + 4 * h), c = *(const f32x4*)(cw + 2 * DFF + ch0 + 4 * h), d = *(const f32x4*)(cb + ch0 + 4 * h);
#pragma unroll
            for (int j = 0; j < 4; ++j) { w0[4 * h + j] = a[j]; w1[4 * h + j] = b[j]; w2[4 * h + j] = c[j]; bb[4 * h + j] = d[j]; } }
        float ssv[2][4];
#pragma unroll
        for (int ai = 0; ai < 2; ++ai)
#pragma unroll
            for (int m = 0; m < 4; ++m) ssv[ai][m] = ssq[u.pm * BM + ai * HALF + wr * 64 + m * 16 + fr];
#pragma unroll
        for (int ai = 0; ai < 2; ++ai) {
            const int grp = 4 * u.pm + 2 * ai + wr;
            float p1[8], p2[8];
#pragma unroll
            for (int q = 0; q < 8; ++q) { p1[q] = 0.f; p2[q] = 0.f; }
#pragma unroll
            for (int m = 0; m < 4; ++m) {
                const int row = u.pm * BM + ai * HALF + wr * 64 + m * 16 + fr;
                const float sc = rsqrtf(ssv[ai][m] * (1.0f / 1024.0f) + EPS);
                float g[8], uu[8], c1[8], c2[8], hh[8];
#pragma unroll
                for (int n = 0; n < 2; ++n)
#pragma unroll
                    for (int j = 0; j < 4; ++j) { g[4 * n + j] = acc[ai][0][m][n][j] * sc; uu[4 * n + j] = acc[ai][1][m][n][j] * sc; }
#pragma unroll
                for (int q = 0; q < 8; ++q) { c1[q] = dpp_ror1(g[q]); c2[q] = dpp_ror2(g[q]); }
                if (m == 0 && fr < 2) { const size_t o = ((size_t)grp * 2 + fr) * DFF + ch0; *(u32x4*)(GH + o) = pack8(g); *(u32x4*)(UH + o) = pack8(uu); }
                if (m == 3 && fr >= 14) { const size_t o = ((size_t)grp * 2 + (fr - 14)) * DFF + ch0; *(u32x4*)(GT + o) = pack8(g); }
#pragma unroll
                for (int q = 0; q < 8; ++q) { const float gm1 = (fr == 0) ? p1[q] : c1[q], gm2 = (fr < 2) ? p2[q] : c2[q];
                    hh[q] = geluf_(bb[q] + w0[q] * gm2 + w1[q] * gm1 + w2[q] * g[q]) * uu[q]; p1[q] = c1[q]; p2[q] = c2[q]; }
                *(u32x4*)(H + (size_t)row * DFF + ch0) = pack8(hh);
            }
        }
    }
};
struct EpiLruIn {
    static constexpr bool PERM = true;
    bf16_t* GATE; bf16_t* XBP; const float* ssq;
    __device__ __forceinline__ void operator()(const f32x4 (&acc)[2][2][4][2], const Unit& u, int wr, int wc, int fr, int fq) const {
        const int row0 = u.pm * BM + wr * 64 + fr, lc = wc * 32 + 8 * fq;
        const bool isgate = u.pn < 4;
        bf16_t* base = isgate ? GATE : XBP; const int colt = (isgate ? u.pn : u.pn - 4) * 256 + lc;
        float ssv[2][4];
#pragma unroll
        for (int ai = 0; ai < 2; ++ai)
#pragma unroll
            for (int m = 0; m < 4; ++m) ssv[ai][m] = ssq[row0 + ai * HALF + m * 16];
#pragma unroll
        for (int ai = 0; ai < 2; ++ai)
#pragma unroll
            for (int m = 0; m < 4; ++m) { bf16_t* rowp = base + (size_t)(row0 + ai * HALF + m * 16) * 1024 + colt;
                const float sc = rsqrtf(ssv[ai][m] * (1.0f / 1024.0f) + EPS);
#pragma unroll
                for (int bj = 0; bj < 2; ++bj) { f32x4 v0 = acc[ai][bj][m][0] * sc, v1 = acc[ai][bj][m][1] * sc;
                    if (isgate) {
#pragma unroll
                        for (int j = 0; j < 4; ++j) { v0[j] = geluf_(v0[j]); v1[j] = geluf_(v1[j]); } }
                    *(u32x4*)(rowp + bj * HALF) = pack44(v0, v1); } }
    }
};
struct EpiLruGate {
    static constexpr bool PERM = true;
    const bf16_t* XBC2; bf16_t* LA; bf16_t* UU; const float* ba; const float* bx; const float* sp;
    __device__ __forceinline__ void operator()(const f32x4 (&acc)[2][2][4][2], const Unit& u, int wr, int wc, int fr, int fq) const {
        const int row0 = u.pm * BM + wr * 64 + fr, ch0 = (u.pn >> 1) * 256 + (u.pn & 1) * 128 + wc * 32 + 8 * fq;
        u32x4 xw[2][4];
#pragma unroll
        for (int ai = 0; ai < 2; ++ai)
#pragma unroll
            for (int m = 0; m < 4; ++m) xw[ai][m] = *(const u32x4*)(XBC2 + (size_t)(row0 + ai * HALF + m * 16) * 1024 + ch0);
        f32x4 vba[2], vbx[2], vsp[2];
#pragma unroll
        for (int n = 0; n < 2; ++n) { vba[n] = *(const f32x4*)(ba + ch0 + 4 * n); vbx[n] = *(const f32x4*)(bx + ch0 + 4 * n); vsp[n] = *(const f32x4*)(sp + ch0 + 4 * n); }
#pragma unroll
        for (int ai = 0; ai < 2; ++ai)
#pragma unroll
            for (int m = 0; m < 4; ++m) { const size_t o = (size_t)(row0 + ai * HALF + m * 16) * 1024 + ch0;
                float xb[8]; unpack8(xw[ai][m], xb);
                float la[8], uu[8];
#pragma unroll
                for (int n = 0; n < 2; ++n)
#pragma unroll
                    for (int j = 0; j < 4; ++j) { const int q = 4 * n + j;
                        const float r = sigmoidf_(acc[ai][0][m][n][j] + vba[n][j]), ig = sigmoidf_(acc[ai][1][m][n][j] + vbx[n][j]);
                        const float l = -8.0f * r * vsp[n][j]; la[q] = l;
                        const float mult = __builtin_amdgcn_sqrtf(fmaxf(0.0f, 1.0f - __expf(2.0f * l)));
                        uu[q] = mult * ig * xb[q]; }
                *(u32x4*)(LA + o) = pack8(la); *(u32x4*)(UU + o) = pack8(uu); }
    }
};

__device__ __forceinline__ void wconv_tile(const Ctx cx, const float* src, int ld_src, int nvalid, const float* gain, int k0, bf16_t* dst, int K, LAS unsigned char* lds) {
    const int lane = cx.tid & 63; LAS bf16_t* L = (LAS bf16_t*)(lds + (cx.tid >> 6) * 8448);
    float v[64];
#pragma unroll
    for (int k = 0; k < 64; ++k) v[k] = (lane < nvalid) ? src[(size_t)k * ld_src + lane] : 0.f;
    if (gain) {
#pragma unroll
        for (int k = 0; k < 64; ++k) v[k] *= gain[k0 + k]; }
#pragma unroll
    for (int k = 0; k < 64; k += 2) *(LAS unsigned*)(L + lane * 66 + k) = cvt_pk_bf16(v[k], v[k + 1]);
    asm volatile("s_waitcnt lgkmcnt(0)" ::: "memory");
#pragma unroll
    for (int i = 0; i < 8; ++i) { const int n = (lane >> 3) + 8 * i, kq = lane & 7; const LAS unsigned* q = (const LAS unsigned*)(L + n * 66 + kq * 8);
        u32x4 w; w.x = q[0]; w.y = q[1]; w.z = q[2]; w.w = q[3];
        *(u32x4*)(dst + (size_t)n * K + kq * 8) = w; }
    asm volatile("s_waitcnt lgkmcnt(0)" ::: "memory");
}
__device__ __forceinline__ void phase_prep(const Ctx cx, const Params& p, LAS unsigned char* lds) {
    unsigned char* ws = P_WS(p);
    constexpr int NT1 = 92 * 16, NT2 = 16 * 32, NT3 = 88 * 16, NT4 = 16 * 44, NT5 = 32 * 16, NT6 = 32 * 4, NT7 = 16 * 16;
    constexpr int NTASK = NT1 + NT2 + 2 * NT3 + 2 * NT4 + NT5 + NT6 + NT7;
    for (int task = cx.bid * 8 + __builtin_amdgcn_readfirstlane(cx.tid >> 6); task < NTASK; task += cx.nblk * 8) {
        int id = task;
        if (id < NT1) { const int ntile = id / 16, kt = id % 16, n0 = ntile * 64, k0 = kt * 64, pn = n0 >> 8, lc0 = n0 & 255;
            int col, nv = 64;
            if (pn < 10) col = n0; else if (pn < 14) col = 2576 + (n0 - 2560);
            else if (pn < 22) col = (lc0 < 128 ? 3600 : 4624) + (pn - 14) * 128 + (lc0 & 127);
            else { col = 2560; nv = (lc0 == 0) ? 16 : 0; }
            wconv_tile(cx, IN(p, I_AB_WIN) + (size_t)k0 * 5648 + col, 5648, nv, IN(p, I_NORM_MIX), k0, (bf16_t*)(ws + WS_W1) + (size_t)n0 * 1024 + k0, 1024, lds); continue; }
        id -= NT1;
        if (id < NT2) { const int ntile = id / 32, kt = id % 32, n0 = ntile * 64, k0 = kt * 64;
            wconv_tile(cx, IN(p, I_AB_WOUT) + (size_t)k0 * 1024 + n0, 1024, 64, k0 < 1024 ? IN(p, I_SSD_NORM) : nullptr, k0, (bf16_t*)(ws + WS_W2) + (size_t)n0 * 2048 + k0, 2048, lds); continue; }
        id -= NT2;
        if (id < 2 * NT3) { const int l = id / NT3; id -= l * NT3; const int ntile = id / 16, kt = id % 16, n0 = ntile * 64, k0 = kt * 64, pn = n0 >> 8, lc0 = n0 & 255;
            const int col = (lc0 < 128 ? 0 : DFF) + pn * 128 + (lc0 & 127);
            wconv_tile(cx, IN(p, I_FFN_WIN) + (size_t)l * 1024 * 5632 + (size_t)k0 * 5632 + col, 5632, 64, IN(p, I_NORM_FFN) + l * 1024, k0, (bf16_t*)(ws + WS_W3) + (size_t)l * 5632 * 1024 + (size_t)n0 * 1024 + k0, 1024, lds); continue; }
        id -= 2 * NT3;
        if (id < 2 * NT4) { const int l = id / NT4; id -= l * NT4; const int ntile = id / 44, kt = id % 44, n0 = ntile * 64, k0 = kt * 64;
            wconv_tile(cx, IN(p, I_FFN_WOUT) + (size_t)l * DFF * 1024 + (size_t)k0 * 1024 + n0, 1024, 64, nullptr, k0, (bf16_t*)(ws + WS_W4) + (size_t)l * 1024 * DFF + (size_t)n0 * DFF + k0, DFF, lds); continue; }
        id -= 2 * NT4;
        if (id < NT5) { const int ntile = id / 16, kt = id % 16, n0 = ntile * 64, k0 = kt * 64;
            wconv_tile(cx, IN(p, I_LRU_WIN) + (size_t)k0 * 2048 + n0, 2048, 64, IN(p, I_NORM_MIX) + 1024, k0, (bf16_t*)(ws + WS_W5) + (size_t)n0 * 1024 + k0, 1024, lds); continue; }
        id -= NT5;
        if (id < NT6) { const int ntile = id / 4, kt = id % 4, n0 = ntile * 64, k0 = kt * 64, head = n0 >> 9, within = n0 & 511, pnl = within >> 8, lc0 = within & 255;
            const int ch = pnl * 128 + (lc0 & 127);
            const float* srcm = (lc0 < 128 ? IN(p, I_LRU_WA) : IN(p, I_LRU_WX)) + (size_t)head * 65536;
            wconv_tile(cx, srcm + (size_t)k0 * 256 + ch, 256, 64, nullptr, k0, (bf16_t*)(ws + WS_W6) + (size_t)n0 * 256 + k0, 256, lds); continue; }
        id -= NT6;
        { const int ntile = id / 16, kt = id % 16, n0 = ntile * 64, k0 = kt * 64;
            wconv_tile(cx, IN(p, I_LRU_WOUT) + (size_t)k0 * 1024 + n0, 1024, 64, nullptr, k0, (bf16_t*)(ws + WS_W7) + (size_t)n0 * 1024 + k0, 1024, lds); }
    }
    const int gt = cx.bid * NTHREADS + cx.tid, gs = cx.nblk * NTHREADS;
    for (int i = gt; i < 1024; i += gs) ((float*)(ws + WS_SP))[i] = softplusf_(-IN(p, I_LRU_LAMBDA)[i]);
    for (int i = gt; i < 5 * T; i += gs) ((float*)(ws + WS_SSQ))[i] = 0.f;
}

__device__ __forceinline__ void phase_norm(const Ctx cx, const float* xp, const float* xs, bf16_t* XN) {
    const int wid = cx.tid >> 6, lane = cx.tid & 63;
    for (int row0 = cx.bid * 8 + wid; row0 < T; row0 += cx.nblk * 32) {
        f32x4 v[4][4];
#pragma unroll
        for (int i = 0; i < 4; ++i) { const int row = row0 + i * cx.nblk * 8;
            if (row < T) { const float* src = row < TP ? xp + (size_t)row * DM : xs + (size_t)(row - TP) * DM;
#pragma unroll
                for (int j = 0; j < 4; ++j) v[i][j] = *(const f32x4*)(src + lane * 4 + j * 256); } }
#pragma unroll
        for (int i = 0; i < 4; ++i) { const int row = row0 + i * cx.nblk * 8;
            if (row < T) { float s = 0.f;
#pragma unroll
                for (int j = 0; j < 4; ++j) s += v[i][j][0] * v[i][j][0] + v[i][j][1] * v[i][j][1] + v[i][j][2] * v[i][j][2] + v[i][j][3] * v[i][j][3];
#pragma unroll
                for (int o = 32; o >= 1; o >>= 1) s += __shfl_xor(s, o);
                const float rs = rsqrtf(s * (1.0f / 1024.0f) + EPS);
#pragma unroll
                for (int j = 0; j < 4; ++j) { u32x2 w; w.x = cvt_pk_bf16(v[i][j][0] * rs, v[i][j][1] * rs); w.y = cvt_pk_bf16(v[i][j][2] * rs, v[i][j][3] * rs);
                    *(u32x2*)(XN + (size_t)row * DM + lane * 4 + j * 256) = w; } } }
    }
}
__device__ __forceinline__ void phase_final_norm(const Ctx cx, const bf16_t* XN, const float* ssq, const float* gain, float* y) {
    const int wid = cx.tid >> 6, lane = cx.tid & 63;
    f32x4 gv[4];
#pragma unroll
    for (int j = 0; j < 4; ++j) gv[j] = *(const f32x4*)(gain + lane * 16 + j * 4);
    for (int row0 = cx.bid * 8 + wid; row0 < T; row0 += cx.nblk * 64) {
        u32x4 w[8][2]; float rs[8];
#pragma unroll
        for (int i = 0; i < 8; ++i) { const int row = row0 + i * cx.nblk * 8;
            if (row < T) { w[i][0] = *(const u32x4*)(XN + (size_t)row * DM + lane * 16); w[i][1] = *(const u32x4*)(XN + (size_t)row * DM + lane * 16 + 8); rs[i] = rsqrtf(ssq[row] * (1.0f / 1024.0f) + EPS); } }
#pragma unroll
        for (int i = 0; i < 8; ++i) { const int row = row0 + i * cx.nblk * 8;
            if (row < T) { float f[16]; { float a[8], b[8]; unpack8(w[i][0], a); unpack8(w[i][1], b);
#pragma unroll
                    for (int q = 0; q < 8; ++q) { f[q] = a[q]; f[8 + q] = b[q]; } }
                float* dst = y + (size_t)row * DM + lane * 16;
#pragma unroll
                for (int j = 0; j < 4; ++j) *(f32x4*)(dst + j * 4) = (f32x4){f[4 * j], f[4 * j + 1], f[4 * j + 2], f[4 * j + 3]} * rs[i] * gv[j]; } }
    }
}

template <int KW, int MODE>
__device__ __forceinline__ void phase_conv(const Ctx cx, const bf16_t* src, int ld_src, int NC, const float* w, const float* bias, bf16_t* dst, int ld_dst,
                           const float* st_in, float* out_p, float* out_s) {
    const int ncg = NC >> 3, total = (T / 16) * ncg;
    for (int item = cx.bid * NTHREADS + cx.tid; item < total; item += cx.nblk * NTHREADS) {
        const int cgi = item % ncg, seg = item / ncg, c0 = cgi * 8, r0 = seg * 16;
        int seq, t0, L; if (r0 < TP) { seq = r0 >> 12; t0 = r0 & 4095; L = 4096; } else { seq = 16 + ((r0 - TP) >> 6); t0 = (r0 - TP) & 63; L = 64; }
        float wv[KW][8], bv[8];
#pragma unroll
        for (int k = 0; k < KW; ++k) { const f32x4 a = *(const f32x4*)(w + (size_t)k * NC + c0), b = *(const f32x4*)(w + (size_t)k * NC + c0 + 4);
#pragma unroll
            for (int j = 0; j < 4; ++j) { wv[k][j] = a[j]; wv[k][4 + j] = b[j]; } }
        { const f32x4 a = *(const f32x4*)(bias + c0), b = *(const f32x4*)(bias + c0 + 4);
#pragma unroll
          for (int j = 0; j < 4; ++j) { bv[j] = a[j]; bv[4 + j] = b[j]; } }
        float win[KW - 1][8];
#pragma unroll
        for (int k = 0; k < KW - 1; ++k) {
            if (t0 > 0) unpack8(*(const u32x4*)(src + (size_t)(r0 - (KW - 1) + k) * ld_src + c0), win[k]);
            else if (seq >= 16) { const float* sp_ = st_in + ((size_t)(seq - 16) * (KW - 1) + k) * NC + c0; const f32x4 a = *(const f32x4*)sp_, b = *(const f32x4*)(sp_ + 4);
#pragma unroll
                for (int j = 0; j < 4; ++j) { win[k][j] = a[j]; win[k][4 + j] = b[j]; } }
            else {
#pragma unroll
                for (int j = 0; j < 8; ++j) win[k][j] = 0.f; }
        }
#pragma unroll
        for (int h = 0; h < 2; ++h) {
            u32x4 rows[8], aux[8];
#pragma unroll
            for (int i = 0; i < 8; ++i) { rows[i] = *(const u32x4*)(src + (size_t)(r0 + h * 8 + i) * ld_src + c0);
                if (MODE == 1 || MODE == 2) aux[i] = *(const u32x4*)(dst + (size_t)(r0 + h * 8 + i) * ld_dst + c0); }
#pragma unroll
            for (int i = 0; i < 8; ++i) {
                float cur[8], y[8]; unpack8(rows[i], cur);
#pragma unroll
                for (int j = 0; j < 8; ++j) { float a = bv[j] + wv[KW - 1][j] * cur[j];
#pragma unroll
                    for (int k = 0; k < KW - 1; ++k) a += wv[k][j] * win[k][j];
                    y[j] = a; }
#pragma unroll
                for (int j = 0; j < 8; ++j) {
#pragma unroll
                    for (int k = 0; k < KW - 2; ++k) win[k][j] = win[k + 1][j];
                    win[KW - 2][j] = cur[j]; }
                if (MODE == 0) {
#pragma unroll
                    for (int j = 0; j < 8; ++j) y[j] = siluf_(y[j]); }
                if (MODE == 1) { float gq[8]; unpack8(aux[i], gq);
#pragma unroll
                    for (int j = 0; j < 8; ++j) y[j] = y[j] * gq[j]; }
                if (MODE == 2) { float uq[8]; unpack8(aux[i], uq);
#pragma unroll
                    for (int j = 0; j < 8; ++j) y[j] = geluf_(y[j]) * uq[j]; }
                *(u32x4*)(dst + (size_t)(r0 + h * 8 + i) * ld_dst + c0) = pack8(y);
            }
            if (h == 1 && t0 + 16 == L) {
                float* ob = (seq < 16 ? out_p + (size_t)seq * (KW - 1) * NC : out_s + (size_t)(seq - 16) * (KW - 1) * NC) + c0;
#pragma unroll
                for (int j = 0; j < KW - 1; ++j) { float f[8]; unpack8(rows[8 - (KW - 1) + j], f);
                    *(f32x4*)(ob + (size_t)j * NC) = (f32x4){f[0], f[1], f[2], f[3]}; *(f32x4*)(ob + (size_t)j * NC + 4) = (f32x4){f[4], f[5], f[6], f[7]}; }
            }
        }
    }
}

template <bool SRC_F32, bool GSCALE>
__device__ __forceinline__ void phase_split_finish(const Ctx cx, const float* slabs, int nsplit, const float* xs, bf16_t* XN, float* ssq, const float* gssq) {
    const int wid = cx.tid >> 6, lane = cx.tid & 63;
    for (int r = cx.bid * 8 + wid; r < TS; r += cx.nblk * 8) {
        const int panel = r >> 8, rl = r & 255, pn = lane >> 4, lc = (lane & 15) * 16;
        const float* sb = slabs + (size_t)((panel * 4 + pn) * nsplit) * 65536 + (size_t)rl * 256 + lc;
        f32x4 v[4];
#pragma unroll
        for (int q = 0; q < 4; ++q) v[q] = (f32x4){0.f, 0.f, 0.f, 0.f};
        for (int pc = 0; pc < nsplit; ++pc) {
#pragma unroll
            for (int q = 0; q < 4; ++q) v[q] += *(const f32x4*)(sb + (size_t)pc * 65536 + 4 * q);
            if (GSCALE && pc == 3) { const float sc = rsqrtf(gssq[TP + r] * (1.0f / 1024.0f) + EPS);
#pragma unroll
                for (int q = 0; q < 4; ++q) v[q] *= sc; }
        }
        bf16_t* xnp = XN + (size_t)(TP + r) * DM + lane * 16;
        if (SRC_F32) { const float* src = xs + (size_t)r * DM + lane * 16;
#pragma unroll
            for (int q = 0; q < 4; ++q) v[q] += *(const f32x4*)(src + 4 * q); }
        else { float a[8], b[8]; unpack8(*(const u32x4*)xnp, a); unpack8(*(const u32x4*)(xnp + 8), b);
            v[0] += (f32x4){a[0], a[1], a[2], a[3]}; v[1] += (f32x4){a[4], a[5], a[6], a[7]}; v[2] += (f32x4){b[0], b[1], b[2], b[3]}; v[3] += (f32x4){b[4], b[5], b[6], b[7]}; }
        *(u32x4*)xnp = pack44(v[0], v[1]); *(u32x4*)(xnp + 8) = pack44(v[2], v[3]);
        float sq = 0.f;
#pragma unroll
        for (int q = 0; q < 4; ++q) sq += v[q][0] * v[q][0] + v[q][1] * v[q][1] + v[q][2] * v[q][2] + v[q][3] * v[q][3];
#pragma unroll
        for (int o = 32; o >= 1; o >>= 1) sq += __shfl_xor(sq, o);
        if (lane == 0) ssq[TP + r] = sq;
    }
}

__device__ __forceinline__ void phase_ffn_fix(const Ctx cx, const bf16_t* GH, const bf16_t* GT, const bf16_t* UH, bf16_t* H, const float* cw, const float* cb,
                                              const float* st_in, float* out_p, float* out_s) {
    const int ncg = DFF / 8, total = 1032 * ncg;
    for (int item = cx.bid * NTHREADS + cx.tid; item < total; item += cx.nblk * NTHREADS) {
        const int cgi = item % ncg, G = item / ncg, c0 = cgi * 8;
        int seq; bool first, lastg;
        if (G < 1024) { seq = G >> 6; first = (G & 63) == 0; lastg = (G & 63) == 63; } else { seq = 16 + (G - 1024); first = true; lastg = true; }
        float w0[8], w1[8], w2[8], bb[8], gm2[8], gm1[8], g0[8], g1[8], u0[8], u1[8];
#pragma unroll
        for (int h = 0; h < 2; ++h) { const f32x4 a = *(const f32x4*)(cw + c0 + 4 * h), b = *(const f32x4*)(cw + DFF + c0 + 4 * h), c = *(const f32x4*)(cw + 2 * DFF + c0 + 4 * h), d = *(const f32x4*)(cb + c0 + 4 * h);
#pragma unroll
            for (int j = 0; j < 4; ++j) { w0[4 * h + j] = a[j]; w1[4 * h + j] = b[j]; w2[4 * h + j] = c[j]; bb[4 * h + j] = d[j]; } }
        if (!first) { unpack8(*(const u32x4*)(GT + ((size_t)(G - 1) * 2 + 0) * DFF + c0), gm2); unpack8(*(const u32x4*)(GT + ((size_t)(G - 1) * 2 + 1) * DFF + c0), gm1); }
        else if (seq >= 16) { const float* s0 = st_in + ((size_t)(seq - 16) * 2) * DFF + c0;
#pragma unroll
            for (int h = 0; h < 2; ++h) { const f32x4 a = *(const f32x4*)(s0 + 4 * h), b = *(const f32x4*)(s0 + DFF + 4 * h);
#pragma unroll
                for (int j = 0; j < 4; ++j) { gm2[4 * h + j] = a[j]; gm1[4 * h + j] = b[j]; } } }
        else {
#pragma unroll
            for (int q = 0; q < 8; ++q) { gm2[q] = 0.f; gm1[q] = 0.f; } }
        unpack8(*(const u32x4*)(GH + ((size_t)G * 2 + 0) * DFF + c0), g0); unpack8(*(const u32x4*)(GH + ((size_t)G * 2 + 1) * DFF + c0), g1);
        unpack8(*(const u32x4*)(UH + ((size_t)G * 2 + 0) * DFF + c0), u0); unpack8(*(const u32x4*)(UH + ((size_t)G * 2 + 1) * DFF + c0), u1);
        float h0[8], h1[8];
#pragma unroll
        for (int q = 0; q < 8; ++q) { h0[q] = geluf_(bb[q] + w0[q] * gm2[q] + w1[q] * gm1[q] + w2[q] * g0[q]) * u0[q];
            h1[q] = geluf_(bb[q] + w0[q] * gm1[q] + w1[q] * g0[q] + w2[q] * g1[q]) * u1[q]; }
        *(u32x4*)(H + (size_t)(G * 64) * DFF + c0) = pack8(h0); *(u32x4*)(H + (size_t)(G * 64 + 1) * DFF + c0) = pack8(h1);
        if (lastg) {
            float* ob = (seq < 16 ? out_p + (size_t)seq * 2 * DFF : out_s + (size_t)(seq - 16) * 2 * DFF) + c0;
#pragma unroll
            for (int j = 0; j < 2; ++j) { float f[8]; unpack8(*(const u32x4*)(GT + ((size_t)G * 2 + j) * DFF + c0), f);
                *(f32x4*)(ob + (size_t)j * DFF) = (f32x4){f[0], f[1], f[2], f[3]}; *(f32x4*)(ob + (size_t)j * DFF + 4) = (f32x4){f[4], f[5], f[6], f[7]}; }
        }
    }
}

constexpr int SC_CS = 0, SC_BS = 17408, SC_BTS = 34816, SC_XTS = 53248, SC_XDS = 62464, SC_HS = 71680, SC_MS = 89088, SC_AS = 98304, SC_SQ = 98560;
#define LDS_BARRIER() do { asm volatile("s_waitcnt lgkmcnt(0)" ::: "memory"); __builtin_amdgcn_s_barrier(); asm volatile("" ::: "memory"); } while (0)
template <int N> __device__ __forceinline__ float dpp_shr(float v) { return __int_as_float(__builtin_amdgcn_update_dpp(0, __float_as_int(v), 0x110 + N, 0xf, 0xf, true)); }
__device__ __forceinline__ void ssd_task(const Ctx cx, const Params& p, LAS unsigned char* lds, int seq, int hd) {
    const int tid = cx.tid, wid = tid >> 6, lane = tid & 63, fr = lane & 15, fq = lane >> 4;
    unsigned char* ws = P_WS(p);
    const bf16_t* XBCA = (const bf16_t*)(ws + WS_XBCA); bf16_t* A2 = (bf16_t*)(ws + WS_A2); const float* DT = (const float*)(ws + WS_DT); float* SSQ = (float*)(ws + WS_SSQ);
    const int g = hd >> 3, nchunks = seq < 16 ? 64 : 1;
    const size_t row_base = seq < 16 ? (size_t)seq * 4096 : (size_t)TP + (size_t)(seq - 16) * 64;
    const float Aneg = -__expf(IN(p, I_A_LOG)[hd]), Dh = IN(p, I_SSD_D)[hd];
    LAS float* As = (LAS float*)(lds + SC_AS); LAS float* Sq = (LAS float*)(lds + SC_SQ);
    f32x4 hst[4];
#pragma unroll
    for (int pt = 0; pt < 4; ++pt) {
        if (seq >= 16) hst[pt] = *(const f32x4*)(IN(p, I_ST_SSD) + ((size_t)((seq - 16) * 16 + hd) * 64 + 16 * pt + fr) * 128 + 16 * wid + 4 * fq);
        else hst[pt] = (f32x4){0.f, 0.f, 0.f, 0.f};
    }
    const int lt = wid >> 1, ph = wid & 1;
    float pf_dt; u32x4 pf_b[2], pf_c[2], pf_x, pf_bt[2];
#define SSD_PREFETCH(cc) do { const size_t r0p = row_base + (size_t)(cc) * 64; \
        pf_dt = DT[(r0p + lane) * 16 + hd]; \
        _Pragma("unroll") for (int i = 0; i < 2; ++i) { const int q = tid + i * 512, row = q >> 4, sg = q & 15; \
            const bf16_t* gp = XBCA + (r0p + row) * XBC + 1024 + g * 128 + sg * 8; pf_b[i] = *(const u32x4*)gp; pf_c[i] = *(const u32x4*)(gp + 256); } \
        pf_x = *(const u32x4*)(XBCA + (r0p + lane) * XBC + hd * 64 + wid * 8); \
        _Pragma("unroll") for (int i = 0; i < 2; ++i) pf_bt[i] = *(const u32x4*)(XBCA + (r0p + lane) * XBC + 1024 + g * 128 + (wid + 8 * i) * 8); } while (0)
    SSD_PREFETCH(0);
    for (int c = 0; c < nchunks; ++c) {
        const size_t r0 = row_base + (size_t)c * 64;
        const float dt_l = pf_dt;
        float a = dt_l * Aneg;
        a += dpp_shr<1>(a); a += dpp_shr<2>(a); a += dpp_shr<4>(a); a += dpp_shr<8>(a);
        { const float t0 = __int_as_float(__builtin_amdgcn_readlane(__float_as_int(a), 15)), t1 = __int_as_float(__builtin_amdgcn_readlane(__float_as_int(a), 31)), t2 = __int_as_float(__builtin_amdgcn_readlane(__float_as_int(a), 47));
          a += (fq == 1) ? t0 : (fq == 2) ? (t0 + t1) : (fq == 3) ? (t0 + t1 + t2) : 0.0f; }
        const float a63 = __int_as_float(__builtin_amdgcn_readlane(__float_as_int(a), 63));
        const float wl = dt_l * __expf(a63 - a);
        if (wid == 0) As[lane] = a;
#pragma unroll
        for (int i = 0; i < 2; ++i) { const int q = tid + i * 512, row = q >> 4, sg = q & 15;
            *(LAS u32x4*)(lds + SC_BS + row * 272 + sg * 16) = pf_b[i]; *(LAS u32x4*)(lds + SC_CS + row * 272 + sg * 16) = pf_c[i]; }
        { float f[8]; unpack8(pf_x, f);
          LAS bf16_t* xt = (LAS bf16_t*)(lds + SC_XTS), *xd = (LAS bf16_t*)(lds + SC_XDS);
#pragma unroll
          for (int j = 0; j < 8; ++j) { const unsigned w2 = cvt_pk_bf16(f[j] * dt_l, f[j] * wl); xt[(wid * 8 + j) * 72 + lane] = (bf16_t)(w2 & 0xffffu); xd[(wid * 8 + j) * 72 + lane] = (bf16_t)(w2 >> 16); } }
#pragma unroll
        for (int i = 0; i < 2; ++i) { const int sg = wid + 8 * i; const u32x4 bw = pf_bt[i];
            LAS bf16_t* bt = (LAS bf16_t*)(lds + SC_BTS);
            bt[(sg * 8 + 0) * 72 + lane] = (bf16_t)(bw.x & 0xffffu); bt[(sg * 8 + 1) * 72 + lane] = (bf16_t)(bw.x >> 16);
            bt[(sg * 8 + 2) * 72 + lane] = (bf16_t)(bw.y & 0xffffu); bt[(sg * 8 + 3) * 72 + lane] = (bf16_t)(bw.y >> 16);
            bt[(sg * 8 + 4) * 72 + lane] = (bf16_t)(bw.z & 0xffffu); bt[(sg * 8 + 5) * 72 + lane] = (bf16_t)(bw.z >> 16);
            bt[(sg * 8 + 6) * 72 + lane] = (bf16_t)(bw.w & 0xffffu); bt[(sg * 8 + 7) * 72 + lane] = (bf16_t)(bw.w >> 16); }
#pragma unroll
        for (int pt = 0; pt < 4; ++pt) { u32x2 w2; w2.x = cvt_pk_bf16(hst[pt][0], hst[pt][1]); w2.y = cvt_pk_bf16(hst[pt][2], hst[pt][3]);
            *(LAS u32x2*)(lds + SC_HS + (16 * pt + fr) * 272 + (16 * wid + 4 * fq) * 2) = w2; }
        u32x2 ep_z[2], ep_x[2];
#pragma unroll
        for (int j = 0; j < 2; ++j) { const size_t rowe = r0 + 16 * lt + fr; const int col = hd * 64 + 16 * (2 * ph + j) + 4 * fq;
            ep_z[j] = *(const u32x2*)(A2 + rowe * 2048 + col); ep_x[j] = *(const u32x2*)(XBCA + rowe * XBC + col); }
        if (c + 1 < nchunks) SSD_PREFETCH(c + 1);
        LDS_BARRIER();
        f32x4 yacc[2];
        {
            bf16x8 cf[4];
#pragma unroll
            for (int kk = 0; kk < 4; ++kk) cf[kk] = *(const LAS bf16x8*)(lds + SC_CS + (16 * lt + fr) * 272 + kk * 64 + fq * 16);
            const float a_l = As[16 * lt + fr];
#pragma unroll
            for (int j = 0; j < 2; ++j) {
                const int st = 2 * ph + j;
                f32x4 cb = (f32x4){0.f, 0.f, 0.f, 0.f};
                if (st <= lt) {
#pragma unroll
                    for (int kk = 0; kk < 4; ++kk) { const bf16x8 bf = *(const LAS bf16x8*)(lds + SC_BS + (16 * st + fr) * 272 + kk * 64 + fq * 16);
                        cb = __builtin_amdgcn_mfma_f32_16x16x32_bf16(bf, cf[kk], cb, 0, 0, 0); }
                    const f32x4 as4 = *(const LAS f32x4*)(lds + SC_AS + (16 * st + 4 * fq) * 4);
#pragma unroll
                    for (int r = 0; r < 4; ++r) { const int s = 16 * st + 4 * fq + r, l = 16 * lt + fr; cb[r] = (s <= l) ? cb[r] * __expf(a_l - as4[r]) : 0.f; }
                }
                u32x2 w2; w2.x = cvt_pk_bf16(cb[0], cb[1]); w2.y = cvt_pk_bf16(cb[2], cb[3]);
                *(LAS u32x2*)(lds + SC_MS + (16 * lt + fr) * 144 + (16 * st + 4 * fq) * 2) = w2;
            }
            const float el = __expf(a_l);
#pragma unroll
            for (int j = 0; j < 2; ++j) { const int pt = 2 * ph + j; f32x4 y = (f32x4){0.f, 0.f, 0.f, 0.f};
#pragma unroll
                for (int kk = 0; kk < 4; ++kk) { const bf16x8 hf = *(const LAS bf16x8*)(lds + SC_HS + (16 * pt + fr) * 272 + kk * 64 + fq * 16);
                    y = __builtin_amdgcn_mfma_f32_16x16x32_bf16(hf, cf[kk], y, 0, 0, 0); }
                yacc[j] = y * el; }
        }
        {
            const float dec = __expf(a63);
            bf16x8 btf[2];
#pragma unroll
            for (int kk = 0; kk < 2; ++kk) btf[kk] = *(const LAS bf16x8*)(lds + SC_BTS + (16 * wid + fr) * 144 + kk * 64 + fq * 16);
#pragma unroll
            for (int pt = 0; pt < 4; ++pt) { f32x4 h = hst[pt] * dec;
#pragma unroll
                for (int kk = 0; kk < 2; ++kk) { const bf16x8 xf = *(const LAS bf16x8*)(lds + SC_XDS + (16 * pt + fr) * 144 + kk * 64 + fq * 16);
                    h = __builtin_amdgcn_mfma_f32_16x16x32_bf16(btf[kk], xf, h, 0, 0, 0); }
                hst[pt] = h; }
        }
        LDS_BARRIER();
        {
            bf16x8 mf[2];
#pragma unroll
            for (int kk = 0; kk < 2; ++kk) mf[kk] = *(const LAS bf16x8*)(lds + SC_MS + (16 * lt + fr) * 144 + kk * 64 + fq * 16);
            float sq = 0.f;
            const size_t row = r0 + 16 * lt + fr;
#pragma unroll
            for (int j = 0; j < 2; ++j) { const int pt = 2 * ph + j; f32x4 y = yacc[j];
#pragma unroll
                for (int kk = 0; kk < 2; ++kk) { const bf16x8 xf = *(const LAS bf16x8*)(lds + SC_XTS + (16 * pt + fr) * 144 + kk * 64 + fq * 16);
                    y = __builtin_amdgcn_mfma_f32_16x16x32_bf16(xf, mf[kk], y, 0, 0, 0); }
                const int col = hd * 64 + 16 * pt + 4 * fq;
                const u32x2 zw = ep_z[j], xw = ep_x[j];
                const float z0 = bf_lo(zw.x), z1 = bf_hi(zw.x), z2 = bf_lo(zw.y), z3 = bf_hi(zw.y);
                const float x0 = bf_lo(xw.x), x1 = bf_hi(xw.x), x2 = bf_lo(xw.y), x3 = bf_hi(xw.y);
                const float g0 = (y[0] + Dh * x0) * siluf_(z0), g1 = (y[1] + Dh * x1) * siluf_(z1), g2 = (y[2] + Dh * x2) * siluf_(z2), g3 = (y[3] + Dh * x3) * siluf_(z3);
                sq += g0 * g0 + g1 * g1 + g2 * g2 + g3 * g3;
                u32x2 ow; ow.x = cvt_pk_bf16(g0, g1); ow.y = cvt_pk_bf16(g2, g3);
                *(u32x2*)(A2 + row * 2048 + col) = ow; }
            sq += __shfl_xor(sq, 16); sq += __shfl_xor(sq, 32);
            if (fq == 0) Sq[ph * 64 + 16 * lt + fr] = sq;
        }
        LDS_BARRIER();
        if (tid < 64) atomicAdd(SSQ + r0 + tid, Sq[tid] + Sq[64 + tid]);
    }
    float* so = (seq < 16 ? P_OUT(p) + O_P_SSD + (size_t)(seq * 16 + hd) * 8192 : P_OUT(p) + O_S_SSD + (size_t)((seq - 16) * 16 + hd) * 8192);
#pragma unroll
    for (int pt = 0; pt < 4; ++pt) *(f32x4*)(so + (size_t)(16 * pt + fr) * 128 + 16 * wid + 4 * fq) = hst[pt];
    LDS_BARRIER();
}
__device__ __forceinline__ void phase_ssd(const Ctx cx, const Params& p, LAS unsigned char* lds) {
    for (int task = cx.bid; task < 384; task += cx.nblk) {
        if (task < 256) ssd_task(cx, p, lds, task >> 4, task & 15);
        else ssd_task(cx, p, lds, 16 + ((task - 256) >> 4), (task - 256) & 15);
    }
}

__device__ __forceinline__ void phase_lru_a(const Ctx cx, const bf16_t* LA, const bf16_t* UU, float* SL, float* HH) {
    const int total = 1032 * 128;
    for (int item = cx.bid * NTHREADS + cx.tid; item < total; item += cx.nblk * NTHREADS) {
        const int cgi = item & 127, ch = item >> 7, c0 = cgi * 8; const size_t r0 = (size_t)ch * 64;
        float sl[8], h[8];
#pragma unroll
        for (int j = 0; j < 8; ++j) { sl[j] = 0.f; h[j] = 0.f; }
        for (int i0 = 0; i0 < 64; i0 += 8) {
            u32x4 la[8], uu[8];
#pragma unroll
            for (int i = 0; i < 8; ++i) { la[i] = *(const u32x4*)(LA + (r0 + i0 + i) * 1024 + c0); uu[i] = *(const u32x4*)(UU + (r0 + i0 + i) * 1024 + c0); }
#pragma unroll
            for (int i = 0; i < 8; ++i) { float l[8], u[8]; unpack8(la[i], l); unpack8(uu[i], u);
#pragma unroll
                for (int j = 0; j < 8; ++j) { sl[j] += l[j]; h[j] = __expf(l[j]) * h[j] + u[j]; } }
        }
        float* o1 = SL + (size_t)ch * 1024 + c0; float* o2 = HH + (size_t)ch * 1024 + c0;
        *(f32x4*)o1 = (f32x4){sl[0], sl[1], sl[2], sl[3]}; *(f32x4*)(o1 + 4) = (f32x4){sl[4], sl[5], sl[6], sl[7]};
        *(f32x4*)o2 = (f32x4){h[0], h[1], h[2], h[3]}; *(f32x4*)(o2 + 4) = (f32x4){h[4], h[5], h[6], h[7]};
    }
}
__device__ __forceinline__ void phase_lru_b(const Ctx cx, const Params& p, const float* SL, const float* HH, float* CIN) {
    for (int item = cx.bid * NTHREADS + cx.tid; item < 24 * 1024; item += cx.nblk * NTHREADS) {
        const int chn = item & 1023, seq = item >> 10;
        const int nch = seq < 16 ? 64 : 1, ch0 = seq < 16 ? seq * 64 : 1024 + (seq - 16);
        float c = seq < 16 ? 0.f : IN(p, I_ST_LRU)[(seq - 16) * 1024 + chn];
        for (int i0 = 0; i0 < nch; i0 += 16) {
            float sl[16], hh[16];
#pragma unroll
            for (int i = 0; i < 16; ++i) if (i0 + i < nch) { sl[i] = SL[(size_t)(ch0 + i0 + i) * 1024 + chn]; hh[i] = HH[(size_t)(ch0 + i0 + i) * 1024 + chn]; }
#pragma unroll
            for (int i = 0; i < 16; ++i) if (i0 + i < nch) { CIN[(size_t)(ch0 + i0 + i) * 1024 + chn] = c; c = __expf(sl[i]) * c + hh[i]; }
        }
        (seq < 16 ? P_OUT(p) + O_P_LRU + seq * 1024 : P_OUT(p) + O_S_LRU + (seq - 16) * 1024)[chn] = c;
    }
}
__device__ __forceinline__ void phase_lru_c(const Ctx cx, const bf16_t* LA, const bf16_t* UU, const float* CIN, bf16_t* GATE) {
    const int total = 1032 * 128;
    for (int item = cx.bid * NTHREADS + cx.tid; item < total; item += cx.nblk * NTHREADS) {
        const int cgi = item & 127, ch = item >> 7, c0 = cgi * 8; const size_t r0 = (size_t)ch * 64;
        float h[8];
        { const float* ci = CIN + (size_t)ch * 1024 + c0; const f32x4 a = *(const f32x4*)ci, b = *(const f32x4*)(ci + 4);
#pragma unroll
          for (int j = 0; j < 4; ++j) { h[j] = a[j]; h[4 + j] = b[j]; } }
        for (int i0 = 0; i0 < 64; i0 += 8) {
            u32x4 la[8], uu[8], gt[8];
#pragma unroll
            for (int i = 0; i < 8; ++i) { la[i] = *(const u32x4*)(LA + (r0 + i0 + i) * 1024 + c0); uu[i] = *(const u32x4*)(UU + (r0 + i0 + i) * 1024 + c0); gt[i] = *(const u32x4*)(GATE + (r0 + i0 + i) * 1024 + c0); }
#pragma unroll
            for (int i = 0; i < 8; ++i) { float l[8], u[8], gq[8], o[8]; unpack8(la[i], l); unpack8(uu[i], u); unpack8(gt[i], gq);
#pragma unroll
                for (int j = 0; j < 8; ++j) { h[j] = __expf(l[j]) * h[j] + u[j]; o[j] = gq[j] * h[j]; }
                *(u32x4*)(GATE + (r0 + i0 + i) * 1024 + c0) = pack8(o); }
        }
    }
}

#define XB_TMO      128
#define XB_XCNT(j)  (256  + 64 * (j))
#define XB_XSUB(j)  (1280 + 64 * (j))
#define XB_XGEN(j)  (2304 + 64 * (j))
#define XB_TOP      3328
#define XB_TOPGEN   3392
#define XCD_BAR_WORDS 3456
#define XB_SPIN_CAP (1u << 18)
__device__ __forceinline__ unsigned xb_ld(unsigned* p)              { return __hip_atomic_load(p, __ATOMIC_RELAXED, __HIP_MEMORY_SCOPE_AGENT); }
__device__ __forceinline__ unsigned xb_add(unsigned* p, unsigned v) { return __hip_atomic_fetch_add(p, v, __ATOMIC_RELAXED, __HIP_MEMORY_SCOPE_AGENT); }
__device__ __forceinline__ unsigned xb_xcc_id() { return (unsigned)__builtin_amdgcn_s_getreg((3 << 11) | 20) & 0xFu; }
#define XB_SPIN(cond, bar) do { unsigned _sp = 0; while (cond) { __builtin_amdgcn_s_sleep(1); \
    if ((++_sp & 255u) == 0u) { if (xb_ld(&(bar)[XB_TMO])) break; if (_sp > XB_SPIN_CAP) { atomicAdd(&(bar)[XB_TMO], 1u); break; } } } } while (0)
struct XcdBarrier { unsigned* bar; unsigned x; volatile LAS unsigned* st; };
__device__ __forceinline__ XcdBarrier xcd_barrier_post(unsigned* bar, volatile LAS unsigned* st) {
    XcdBarrier b; b.bar = bar; b.x = xb_xcc_id(); b.st = st;
    if (threadIdx.x == 0) (void)xb_add(&bar[XB_XCNT(b.x)], 1u);
    return b;
}
__device__ __forceinline__ void xcd_barrier_complete(unsigned* bar, unsigned x, unsigned& nloc, unsigned& nx) {
    const unsigned G = gridDim.x * gridDim.y * gridDim.z;
    unsigned sum, cnt, mine, sp = 0u;
    for (;;) {
        sum = 0u; cnt = 0u; mine = 0u;
#pragma unroll
        for (unsigned j = 0; j < 16; ++j) { const unsigned c = xb_ld(&bar[XB_XCNT(j)]); sum += c; cnt += (c > 0u) ? 1u : 0u; mine = (j == x) ? c : mine; }
        if (sum == G) break;
        __builtin_amdgcn_s_sleep(1);
        if ((++sp & 255u) == 0u) { if (xb_ld(&bar[XB_TMO])) break; if (sp > XB_SPIN_CAP) { atomicAdd(&bar[XB_TMO], 1u); break; } }
    }
    nloc = mine > 0u ? mine : 1u; nx = cnt > 0u ? cnt : 1u;
}
__device__ __forceinline__ void xcd_barrier(const XcdBarrier& b) {
    asm volatile("s_waitcnt vmcnt(0)" ::: "memory");
    __syncthreads();
    if (threadIdx.x == 0) {
        unsigned* bar = b.bar;
        __builtin_amdgcn_s_waitcnt(0);
        unsigned nloc = b.st[0], nx = b.st[1];
        if (nloc == 0u) { xcd_barrier_complete(bar, b.x, nloc, nx); b.st[0] = nloc; b.st[1] = nx; }
        const unsigned old = xb_add(&bar[XB_XSUB(b.x)], 1u);
        const unsigned gen = old / nloc;
        if (old + 1u == (gen + 1u) * nloc) {
            __builtin_amdgcn_fence(__ATOMIC_RELEASE, "agent");
            asm volatile("s_waitcnt vmcnt(0)" ::: "memory");
            const unsigned og = xb_add(&bar[XB_TOP], 1u);
            const unsigned tg = og / nx;
            if (og + 1u == (tg + 1u) * nx) xb_add(&bar[XB_TOPGEN], 1u);
            else XB_SPIN(xb_ld(&bar[XB_TOPGEN]) == tg, bar);
            __builtin_amdgcn_fence(__ATOMIC_ACQUIRE, "agent");
            xb_add(&bar[XB_XGEN(b.x)], 1u);
            asm volatile("s_waitcnt vmcnt(0)" ::: "memory");
        } else {
            XB_SPIN(xb_ld(&bar[XB_XGEN(b.x)]) == gen, bar);
            __builtin_amdgcn_fence(__ATOMIC_ACQUIRE, "agent");
            asm volatile("s_waitcnt vmcnt(0)" ::: "memory");
        }
    }
    __syncthreads();
}

constexpr int NPHASE = 23;
__device__ __forceinline__ void run_phase(const Params& p, int ph, LAS unsigned char* lds) {
    Ctx cx; { int b = blockIdx.x, n = gridDim.x, t = threadIdx.x; asm volatile("" : "+s"(b), "+s"(n), "+v"(t)); cx.bid = b; cx.nblk = n; cx.tid = t; }
    unsigned char* ws = P_WS(p);
    bf16_t* XN = (bf16_t*)(ws + WS_XN);
    float* Y = P_OUT(p) + O_Y;
    float* SSQ = (float*)(ws + WS_SSQ);
    switch (ph) {
    case 0: phase_prep(cx, p, lds); phase_norm(cx, IN(p, I_XP), IN(p, I_XS), XN); break;
    case 1: { Gemm g{XN, (const bf16_t*)(ws + WS_W1), T, N1, 1024, 1024, 0, 0};
        EpiG1 e{(bf16_t*)(ws + WS_A2), (bf16_t*)(ws + WS_XBCP), (bf16_t*)(ws + WS_V), (float*)(ws + WS_DT), IN(p, I_DT_BIAS)};
        gemm_phase<EpiG1, false>(cx, lds, g, e, nullptr); } break;
    case 2:
        phase_conv<4, 0>(cx, (const bf16_t*)(ws + WS_XBCP), XBC, XBC, IN(p, I_SSD_CONVW), IN(p, I_SSD_CONVB), (bf16_t*)(ws + WS_XBCA), XBC, IN(p, I_ST_SSDCONV), P_OUT(p) + O_P_SSDCONV, P_OUT(p) + O_S_SSDCONV);
        phase_conv<3, 1>(cx, (const bf16_t*)(ws + WS_V), 1024, 1024, IN(p, I_SC_CONVW), IN(p, I_SC_CONVB), (bf16_t*)(ws + WS_A2) + 1024, 2048, IN(p, I_ST_SCONV), P_OUT(p) + O_P_SCONV, P_OUT(p) + O_S_SCONV);
        break;
    case 3: phase_ssd(cx, p, lds); break;
    case 4: { Gemm g{(const bf16_t*)(ws + WS_A2), (const bf16_t*)(ws + WS_W2), T, 1024, 2048, 2048, 0, 0};
        EpiRes<true> e{IN(p, I_XP), IN(p, I_XS), XN, SSQ + T};
        gemm_phase<EpiRes<true>, true, true>(cx, lds, g, e, SSQ, (float*)(ws + WS_SLAB)); } break;
    case 30: phase_split_finish<true, true>(cx, (const float*)(ws + WS_SLAB), 8, IN(p, I_XS), XN, SSQ + T, SSQ); break;
    case 5: case 15: { const int l = ph == 5 ? 0 : 1;
        Gemm g{XN, (const bf16_t*)(ws + WS_W3) + (size_t)l * 5632 * 1024, T, 5632, 1024, 1024, 0, 0};
        EpiFfnFused e{(bf16_t*)(ws + WS_H), (bf16_t*)(ws + WS_GH), (bf16_t*)(ws + WS_GT), (bf16_t*)(ws + WS_UH), SSQ + (l == 0 ? T : 3 * T), IN(p, I_FFN_CONVW) + l * 3 * DFF, IN(p, I_FFN_CONVB) + l * DFF};
        gemm_phase<EpiFfnFused, false>(cx, lds, g, e, nullptr); } break;
    case 6: case 16: { const int l = ph == 6 ? 0 : 1;
        phase_ffn_fix(cx, (const bf16_t*)(ws + WS_GH), (const bf16_t*)(ws + WS_GT), (const bf16_t*)(ws + WS_UH), (bf16_t*)(ws + WS_H), IN(p, I_FFN_CONVW) + l * 3 * DFF, IN(p, I_FFN_CONVB) + l * DFF,
                      IN(p, I_ST_FFNCONV) + l * 8 * 2 * DFF, P_OUT(p) + O_P_FFNCONV + l * 16 * 2 * DFF, P_OUT(p) + O_S_FFNCONV + l * 8 * 2 * DFF); } break;
    case 7: case 17: { const int l = ph == 7 ? 0 : 1;
        Gemm g{(const bf16_t*)(ws + WS_H), (const bf16_t*)(ws + WS_W4) + (size_t)l * 1024 * DFF, T, 1024, DFF, DFF, 0, 0};
        EpiRes<false> e{nullptr, nullptr, XN, SSQ + (l == 0 ? 2 * T : 4 * T)};
        gemm_phase<EpiRes<false>, false, true>(cx, lds, g, e, nullptr, (float*)(ws + WS_SLAB)); } break;
    case 31: phase_split_finish<false, false>(cx, (const float*)(ws + WS_SLAB), 11, nullptr, XN, SSQ + 2 * T, nullptr); break;
    case 33: phase_split_finish<false, false>(cx, (const float*)(ws + WS_SLAB), 11, nullptr, XN, SSQ + 4 * T, nullptr); break;
    case 8: { Gemm g{XN, (const bf16_t*)(ws + WS_W5), T, 2048, 1024, 1024, 0, 0};
        EpiLruIn e{(bf16_t*)(ws + WS_GATE), (bf16_t*)(ws + WS_XBP), SSQ + 2 * T};
        gemm_phase<EpiLruIn, false>(cx, lds, g, e, nullptr); } break;
    case 9: phase_conv<4, 3>(cx, (const bf16_t*)(ws + WS_XBP), 1024, 1024, IN(p, I_LRU_CONVW), IN(p, I_LRU_CONVB), (bf16_t*)(ws + WS_XBC2), 1024, IN(p, I_ST_LRUCONV), P_OUT(p) + O_P_LRUCONV, P_OUT(p) + O_S_LRUCONV); break;
    case 10: { Gemm g{(const bf16_t*)(ws + WS_XBC2), (const bf16_t*)(ws + WS_W6), T, 2048, 256, 1024, 1, 256};
        EpiLruGate e{(const bf16_t*)(ws + WS_XBC2), (bf16_t*)(ws + WS_LA), (bf16_t*)(ws + WS_UU), IN(p, I_LRU_BA), IN(p, I_LRU_BX), (const float*)(ws + WS_SP)};
        gemm_phase<EpiLruGate, false>(cx, lds, g, e, nullptr); } break;
    case 11: phase_lru_a(cx, (const bf16_t*)(ws + WS_LA), (const bf16_t*)(ws + WS_UU), (float*)(ws + WS_SL), (float*)(ws + WS_HH)); break;
    case 12: phase_lru_b(cx, p, (const float*)(ws + WS_SL), (const float*)(ws + WS_HH), (float*)(ws + WS_CIN)); break;
    case 13: phase_lru_c(cx, (const bf16_t*)(ws + WS_LA), (const bf16_t*)(ws + WS_UU), (const float*)(ws + WS_CIN), (bf16_t*)(ws + WS_GATE)); break;
    case 14: { Gemm g{(const bf16_t*)(ws + WS_GATE), (const bf16_t*)(ws + WS_W7), T, 1024, 1024, 1024, 0, 0};
        EpiRes<false> e{nullptr, nullptr, XN, SSQ + 3 * T};
        gemm_phase<EpiRes<false>, false, true>(cx, lds, g, e, nullptr, (float*)(ws + WS_SLAB)); } break;
    case 32: phase_split_finish<false, false>(cx, (const float*)(ws + WS_SLAB), 4, nullptr, XN, SSQ + 3 * T, nullptr); break;
    case 18: phase_final_norm(cx, XN, SSQ + 4 * T, IN(p, I_NORM_FINAL), Y); break;
    default: break;
    }
}

__global__ void __launch_bounds__(NTHREADS, 2) fwd_mega(Params p, int ph_lo, int ph_hi) {
    extern __shared__ __attribute__((aligned(16))) unsigned char smem[];
    LAS unsigned char* lds = (LAS unsigned char*)smem;
    cg::grid_group grid = cg::this_grid();
    volatile LAS unsigned* bst = (volatile LAS unsigned*)(lds + 131072 + 1024);
    if (threadIdx.x == 0) { bst[0] = 0u; bst[1] = 0u; }
    __syncthreads();
    const XcdBarrier xb = xcd_barrier_post((unsigned*)(IN(p, 35)) + WS_BAR / 4, bst);
#ifndef PROBE_K
#define PROBE_K -1
#endif
    bool first = true;
    for (int i = ph_lo; i < ph_hi; ++i) {
        int ph = i;
        if (i >= 5) ph = (i == 5) ? 30 : (i <= 8) ? i - 1 : (i == 9) ? 31 : (i <= 16) ? i - 2 : (i == 17) ? 32 : (i <= 20) ? i - 3 : (i == 21) ? 33 : 18;
        run_phase(p, ph, lds);
        if (i + 1 < ph_hi) { if (first) { grid.sync(); first = false; } else xcd_barrier(xb); }
    }
}

extern "C" void kernel_launch(void* const* d_in, const int* in_sizes, int n_in, void* d_out, int out_size, void* d_ws, size_t ws_size, hipStream_t stream) {
    static int grid = 0;
    if (grid == 0) {
        if (n_in != 34 || (size_t)out_size != O_END || ws_size < WS_NEED) { fprintf(stderr, "kernel_launch: unexpected shapes (n_in %d out %d ws %zu need %zu)\n", n_in, out_size, ws_size, (size_t)WS_NEED); grid = -1; return; }
        int dev = 0, cus = 0, per_cu = 0;
        (void)hipGetDevice(&dev); (void)hipDeviceGetAttribute(&cus, hipDeviceAttributeMultiprocessorCount, dev);
        if (hipFuncSetAttribute((const void*)fwd_mega, hipFuncAttributeMaxDynamicSharedMemorySize, LDS_BYTES) != hipSuccess) { fprintf(stderr, "kernel_launch: hipFuncSetAttribute failed\n"); grid = -1; return; }
        if (hipOccupancyMaxActiveBlocksPerMultiprocessor(&per_cu, (const void*)fwd_mega, NTHREADS, LDS_BYTES) != hipSuccess || per_cu < 1) { fprintf(stderr, "kernel_launch: occupancy query says %d\n", per_cu); per_cu = 1; }
        (void)hipGetLastError();
        grid = cus;
    }
    if (grid < 0) return;
    (void)hipMemsetAsync((unsigned char*)d_ws + WS_BAR, 0, 16384, stream);
    Params p{};
    for (int i = 0; i < 34; ++i) p.ptr[i] = (const float*)d_in[i];
    p.ptr[34] = (const float*)d_out; p.ptr[35] = (const float*)d_ws;
    int lo = 0, hi = NPHASE; void* args[] = {&p, &lo, &hi};
    hipError_t e = hipLaunchCooperativeKernel((const void*)fwd_mega, dim3(grid), dim3(NTHREADS), args, LDS_BYTES, stream);
    if (e != hipSuccess) fprintf(stderr, "cooperative launch failed: %s (grid %d)\n", hipGetErrorString(e), grid);
}
```

```cpp
#include <hip/hip_runtime.h>
#include <hip/hip_cooperative_groups.h>
#include <cstdio>
namespace cg = cooperative_groups;

#define LAS __attribute__((address_space(3)))
typedef unsigned short bf16_t;
typedef short bf16x8 __attribute__((ext_vector_type(8)));
typedef float f32x4 __attribute__((ext_vector_type(4)));
typedef unsigned u32x4 __attribute__((ext_vector_type(4)));
typedef unsigned u32x2 __attribute__((ext_vector_type(2)));

constexpr int TP = 65536;
constexpr int TS = 512;
constexpr int T = TP + TS;
constexpr int DM = 1024;
constexpr int DFF = 2816;
constexpr int XBC = 1536;
constexpr int N1 = 5888;
constexpr float EPS = 1e-6f;
constexpr int NTHREADS = 512;
constexpr int LDS_BYTES = 131072 + 4096;

constexpr size_t O_Y = 0;
constexpr size_t O_P_SSDCONV = (size_t)T * DM;
constexpr size_t O_P_SSD = O_P_SSDCONV + 16 * 3 * XBC;
constexpr size_t O_P_SCONV = O_P_SSD + (size_t)16 * 16 * 64 * 128;
constexpr size_t O_P_LRUCONV = O_P_SCONV + 16 * 2 * 1024;
constexpr size_t O_P_LRU = O_P_LRUCONV + 16 * 3 * 1024;
constexpr size_t O_P_FFNCONV = O_P_LRU + 16 * 1024;
constexpr size_t O_S_SSDCONV = O_P_FFNCONV + 2 * 16 * 2 * DFF;
constexpr size_t O_S_SSD = O_S_SSDCONV + 8 * 3 * XBC;
constexpr size_t O_S_SCONV = O_S_SSD + (size_t)8 * 16 * 64 * 128;
constexpr size_t O_S_LRUCONV = O_S_SCONV + 8 * 2 * 1024;
constexpr size_t O_S_LRU = O_S_LRUCONV + 8 * 3 * 1024;
constexpr size_t O_S_FFNCONV = O_S_LRU + 8 * 1024;
constexpr size_t O_END = O_S_FFNCONV + 2 * 8 * 2 * DFF;

constexpr size_t al256(size_t x) { return (x + 255) & ~(size_t)255; }
constexpr size_t WS_W1 = 0;
constexpr size_t WS_W2 = WS_W1 + (size_t)N1 * 1024 * 2;
constexpr size_t WS_W3 = WS_W2 + (size_t)1024 * 2048 * 2;
constexpr size_t WS_W4 = WS_W3 + (size_t)2 * 5632 * 1024 * 2;
constexpr size_t WS_W5 = WS_W4 + (size_t)2 * 1024 * 2816 * 2;
constexpr size_t WS_W6 = WS_W5 + (size_t)2048 * 1024 * 2;
constexpr size_t WS_W7 = WS_W6 + (size_t)2048 * 256 * 2;
constexpr size_t WS_SP = WS_W7 + (size_t)1024 * 1024 * 2;
constexpr size_t WS_BAR = WS_SP + 4096;
constexpr size_t WS_SSQ = WS_BAR + 16384;
constexpr size_t WS_SL = al256(WS_SSQ + (size_t)5 * T * 4);
constexpr size_t WS_HH = WS_SL + (size_t)1088 * 1024 * 4;
constexpr size_t WS_CIN = WS_HH + (size_t)1088 * 1024 * 4;
constexpr size_t WS_SLAB = al256(WS_CIN + (size_t)1088 * 1024 * 4);
constexpr size_t WS_XN = al256(WS_SLAB + (size_t)88 * 65536 * 4);
constexpr size_t WS_ARENA = al256(WS_XN + (size_t)T * 1024 * 2);
constexpr size_t WS_A2 = WS_ARENA;
constexpr size_t WS_XBCP = WS_A2 + (size_t)T * 2048 * 2;
constexpr size_t WS_XBCA = WS_XBCP + (size_t)T * XBC * 2;
constexpr size_t WS_V = WS_XBCA + (size_t)T * XBC * 2;
constexpr size_t WS_DT = WS_V + (size_t)T * 1024 * 2;
constexpr size_t WS_END0 = WS_DT + (size_t)T * 16 * 4;
constexpr size_t WS_H = WS_ARENA;
constexpr size_t WS_GH = WS_H + (size_t)T * DFF * 2;
constexpr size_t WS_GT = WS_GH + (size_t)1032 * 2 * DFF * 2;
constexpr size_t WS_UH = WS_GT + (size_t)1032 * 2 * DFF * 2;
constexpr size_t WS_END1 = WS_UH + (size_t)1032 * 2 * DFF * 2;
constexpr size_t WS_GATE = WS_ARENA;
constexpr size_t WS_XBP = WS_GATE + (size_t)T * 1024 * 2;
constexpr size_t WS_XBC2 = WS_XBP + (size_t)T * 1024 * 2;
constexpr size_t WS_LA = WS_XBC2 + (size_t)T * 1024 * 2;
constexpr size_t WS_UU = WS_LA + (size_t)T * 1024 * 2;
constexpr size_t WS_END2 = WS_UU + (size_t)T * 1024 * 2;
constexpr size_t WS_NEED = WS_END0 > WS_END1 ? (WS_END0 > WS_END2 ? WS_END0 : WS_END2) : (WS_END1 > WS_END2 ? WS_END1 : WS_END2);

struct Params {
    const float* ptr[36];
};
__device__ __forceinline__ const float* IN(const Params& p, int i) { asm volatile("" : "+s"(i)); return p.ptr[i]; }
#define P_OUT(p) ((float*)IN(p, 34))
#define P_WS(p) ((unsigned char*)IN(p, 35))
enum { I_XP = 0, I_XS, I_ST_SSDCONV, I_ST_SSD, I_ST_SCONV, I_ST_LRUCONV, I_ST_LRU, I_ST_FFNCONV, I_NORM_MIX, I_NORM_FFN, I_NORM_FINAL,
       I_AB_WIN, I_SSD_CONVW, I_SSD_CONVB, I_DT_BIAS, I_A_LOG, I_SSD_D, I_SSD_NORM, I_SC_CONVW, I_SC_CONVB, I_AB_WOUT, I_LRU_WIN,
       I_LRU_CONVW, I_LRU_CONVB, I_LRU_WA, I_LRU_BA, I_LRU_WX, I_LRU_BX, I_LRU_LAMBDA, I_LRU_WOUT, I_FFN_WIN, I_FFN_CONVW, I_FFN_CONVB, I_FFN_WOUT };

struct Ctx { int bid, nblk, tid; };
__device__ __forceinline__ unsigned cvt_pk_bf16(float lo, float hi) { unsigned r; asm("v_cvt_pk_bf16_f32 %0, %1, %2" : "=v"(r) : "v"(lo), "v"(hi)); return r; }
__device__ __forceinline__ float bf_lo(unsigned w) { return __uint_as_float(w << 16); }
__device__ __forceinline__ float bf_hi(unsigned w) { return __uint_as_float(w & 0xffff0000u); }
__device__ __forceinline__ float sigmoidf_(float x) { return __builtin_amdgcn_rcpf(1.0f + __expf(-x)); }
__device__ __forceinline__ float siluf_(float x) { return x * __builtin_amdgcn_rcpf(1.0f + __expf(-x)); }
__device__ __forceinline__ float geluf_(float x) { const float u = x * (1.5957691216f + 0.0713548163f * x * x); return x * __builtin_amdgcn_rcpf(1.0f + __builtin_amdgcn_exp2f(-1.4426950409f * u)); }
__device__ __forceinline__ float softplusf_(float x) { return fmaxf(x, 0.0f) + log1pf(__expf(-fabsf(x))); }
__device__ __forceinline__ void unpack8(const u32x4 w, float (&f)[8]) {
    f[0] = bf_lo(w.x); f[1] = bf_hi(w.x); f[2] = bf_lo(w.y); f[3] = bf_hi(w.y); f[4] = bf_lo(w.z); f[5] = bf_hi(w.z); f[6] = bf_lo(w.w); f[7] = bf_hi(w.w);
}
__device__ __forceinline__ u32x4 pack8(const float (&f)[8]) {
    u32x4 w; w.x = cvt_pk_bf16(f[0], f[1]); w.y = cvt_pk_bf16(f[2], f[3]); w.z = cvt_pk_bf16(f[4], f[5]); w.w = cvt_pk_bf16(f[6], f[7]); return w;
}
__device__ __forceinline__ u32x4 pack44(const f32x4 a, const f32x4 b) {
    u32x4 w; w.x = cvt_pk_bf16(a[0], a[1]); w.y = cvt_pk_bf16(a[2], a[3]); w.z = cvt_pk_bf16(b[0], b[1]); w.w = cvt_pk_bf16(b[2], b[3]); return w;
}

constexpr int BM = 256, BK = 64, HALF = 128, HTB = HALF * BK * 2, NXCD = 8, WGM = 4;
__device__ __forceinline__ int lds_byte(int r, int c) { const int st = (r >> 4) * 2 + (c >> 5), rr = r & 15, cc = c & 31, ob = rr * 64 + cc * 2; return st * 1024 + (ob ^ (((ob >> 9) & 1) << 5)); }
__device__ __forceinline__ void stage_rc(int b, int& R, int& C) { const int st = b / 1024, sb = b % 1024, swz = sb ^ (((sb >> 9) & 1) << 5); R = (st >> 1) * 16 + swz / 64; C = (st & 1) * 32 + (swz % 64) / 2; }
__device__ __forceinline__ int perm32(int rho) { const int n = rho >> 4, i = rho & 15; return 8 * (i >> 2) + 4 * n + (i & 3); }

struct Unit { int pm, pn, kt0, nkt, slab; };
struct Gemm { const bf16_t* A; const bf16_t* Bt; int M, N, K, lda, a_shift, a_koff; };

struct StaticOrder {
    int nM, nN, nwg, G, c, nt, nsplit, ntail;
    __device__ void init(int M, int N, int G_, int c_, int nt_, bool split) { nM = M / BM; nN = N / BM; G = G_; c = c_; nt = nt_; nsplit = 0; ntail = 0;
        if (split) { nM = TP / BM; nsplit = nt / 4; ntail = 2 * nN * nsplit; } nwg = nM * nN; }
    __device__ bool next(int i, Unit& u) const {
        const long L = (long)i * G + c;
        if (L >= nwg) { const int t = (int)(L - nwg); if (t >= ntail) return false;
            const int tile = t / nsplit, piece = t - tile * nsplit; u.pm = TP / BM + tile / nN; u.pn = tile % nN; u.kt0 = piece * 4; u.nkt = 4; u.slab = t; return true; }
        int wgid = (int)L; { const int q = nwg / NXCD, r = nwg % NXCD, xcd = wgid % NXCD, off = wgid / NXCD; wgid = (xcd < r ? xcd * (q + 1) : r * (q + 1) + (xcd - r) * q) + off; }
        const int nig = WGM * nN, gid = wgid / nig, fm = gid * WGM, gsz = (nM - fm) < WGM ? (nM - fm) : WGM;
        u.pm = fm + ((wgid % nig) % gsz); u.pn = (wgid % nig) / gsz; u.kt0 = 0; u.nkt = nt; u.slab = -1; return true;
    }
};

template <class Epi, bool MIDSCALE, bool SPLIT = false>
__device__ __forceinline__ void gemm_phase(const Ctx cx, LAS unsigned char* lds, const Gemm g, const Epi& E, const float* ssq, float* slabs = nullptr) {
    const int tid = cx.tid, wid = __builtin_amdgcn_readfirstlane(tid >> 6), lane = tid & 63, wr = wid >> 2, wc = wid & 3, fr = lane & 15, fq = lane >> 4;
    int K_ = g.K; asm volatile("" : "+s"(K_));
    const int K = K_, nt = K / BK;
    StaticOrder S; S.init(g.M, g.N, cx.nblk, cx.bid, nt, SPLIT);
    unsigned voffA[2], voffB[2];
#pragma unroll
    for (int i = 0; i < 2; ++i) { int R, C; stage_rc(tid * 16 + i * 8192, R, C); const int Rb = Epi::PERM ? ((R & ~31) + perm32(R & 31)) : R;
        voffA[i] = (unsigned)(R * g.lda + C) * 2u; voffB[i] = (unsigned)(Rb * K + C) * 2u; }
    const size_t kstep = (size_t)(BK * 2);
    const size_t hsA = (size_t)HALF * g.lda * 2, hsB = (size_t)HALF * K * 2;
    const size_t tsA = 2 * hsA, tsB = 2 * hsB;
    const unsigned ldsw = (unsigned)wid * 1024u;
    const int aoff = lds_byte(wr * 64 + fr, fq * 8), boff = lds_byte(wc * 32 + fr, fq * 8);
#define SA_(b, h) (((b) * 2 + (h)) * HTB)
#define SB_(b, h) ((4 + (b) * 2 + (h)) * HTB)
#define STAGE_(bufoff, gbase, voff) do { _Pragma("unroll") for (int _i = 0; _i < 2; ++_i) \
        __builtin_amdgcn_global_load_lds((const unsigned*)((const char*)(gbase) + (voff)[_i]), (LAS unsigned*)(lds + (bufoff) + ldsw + _i * 8192), 16, 0, 0); } while (0)
#define LDA_(dst, b, h) do { _Pragma("unroll") for (int m = 0; m < 4; ++m) _Pragma("unroll") for (int k = 0; k < 2; ++k) dst[m][k] = *(const LAS bf16x8*)(lds + SA_(b, h) + aoff + m * 2048 + k * 1024); } while (0)
#define LDB_(dst, b, h) do { _Pragma("unroll") for (int n = 0; n < 2; ++n) _Pragma("unroll") for (int k = 0; k < 2; ++k) dst[n][k] = *(const LAS bf16x8*)(lds + SB_(b, h) + boff + n * 2048 + k * 1024); } while (0)
#define MMA_(ai, bj, At, Bt) do { __builtin_amdgcn_s_setprio(1); _Pragma("unroll") for (int m = 0; m < 4; ++m) _Pragma("unroll") for (int n = 0; n < 2; ++n) _Pragma("unroll") for (int k = 0; k < 2; ++k) \
        acc[ai][bj][m][n] = __builtin_amdgcn_mfma_f32_16x16x32_bf16(Bt[n][k], At[m][k], acc[ai][bj][m][n], 0, 0, 0); __builtin_amdgcn_s_setprio(0); } while (0)
#define WAIT_V_(n) asm volatile("s_waitcnt vmcnt(" #n ")" ::: "memory")
#define WAIT_L_(n) asm volatile("s_waitcnt lgkmcnt(" #n ")" ::: "memory")
#define BAR_ __builtin_amdgcn_s_barrier()
#define SCHED_ __builtin_amdgcn_sched_barrier(0)
#ifndef STAGGER
#define STAGGER 0
#endif
    if (STAGGER && (cx.bid & 8)) {
        const unsigned long long t0 = __builtin_amdgcn_s_memrealtime(); const unsigned long long dl = 800ull;
        while (__builtin_amdgcn_s_memrealtime() - t0 < dl) __builtin_amdgcn_s_sleep(8);
    }
    Unit cur, nxt; int ui = 0;
    if (!S.next(0, cur)) return;
    f32x4 acc[2][2][4][2];
#pragma unroll
    for (int a = 0; a < 2; ++a)
#pragma unroll
        for (int b = 0; b < 2; ++b)
#pragma unroll
            for (int m = 0; m < 4; ++m)
#pragma unroll
                for (int n = 0; n < 2; ++n) acc[a][b][m][n] = (f32x4){0.f, 0.f, 0.f, 0.f};
    bf16x8 At[4][2], B0[2][2], B1[2][2];
    const char* cA = (const char*)g.A + (size_t)cur.pm * tsA + (size_t)((cur.pn >> g.a_shift) * g.a_koff) * 2 + (size_t)cur.kt0 * kstep;
    const char* cB = (const char*)g.Bt + (size_t)cur.pn * tsB + (size_t)cur.kt0 * kstep;
    STAGE_(SB_(0, 0), cB, voffB); STAGE_(SA_(0, 0), cA, voffA); STAGE_(SB_(0, 1), cB + hsB, voffB); STAGE_(SA_(0, 1), cA + hsA, voffA);
    if (wr == 1) BAR_;
    WAIT_V_(4); BAR_;
    STAGE_(SB_(1, 0), cB + kstep, voffB); STAGE_(SA_(1, 0), cA + kstep, voffA); STAGE_(SB_(1, 1), cB + hsB + kstep, voffB);
    WAIT_V_(6); BAR_;
    for (;;) {
        const bool has_next = S.next(ui + 1, nxt);
        const char* nA = has_next ? (const char*)g.A + (size_t)nxt.pm * tsA + (size_t)((nxt.pn >> g.a_shift) * g.a_koff) * 2 + (size_t)nxt.kt0 * kstep : cA;
        const char* nB = has_next ? (const char*)g.Bt + (size_t)nxt.pn * tsB + (size_t)nxt.kt0 * kstep : cB;
        const int cnt = cur.nkt;
        for (int t = 0; t < cnt; t += 2) {
            const bool last = (t == cnt - 2);
            const char* a1 = cA + (size_t)(t + 1) * kstep;
            const char* a2 = last ? nA : cA + (size_t)(t + 2) * kstep; const char* b2 = last ? nB : cB + (size_t)(t + 2) * kstep;
            const char* a3 = a2 + kstep; const char* b3 = b2 + kstep;
            if (MIDSCALE && t == 16 && cur.slab < 0) {
                int rb = cur.pm * BM + wr * 64 + fr; asm volatile("" : "+v"(rb));
#pragma unroll
                for (int ai = 0; ai < 2; ++ai)
#pragma unroll
                    for (int m = 0; m < 4; ++m) {
                        const float sc = rsqrtf(ssq[rb + ai * HALF + m * 16] * (1.0f / 1024.0f) + EPS);
#pragma unroll
                        for (int bj = 0; bj < 2; ++bj)
#pragma unroll
                            for (int n = 0; n < 2; ++n) acc[ai][bj][m][n] *= sc;
                    }
            }
            LDB_(B0, 0, 0); SCHED_; LDA_(At, 0, 0); STAGE_(SA_(1, 1), a1 + hsA, voffA);
            WAIT_L_(8); BAR_; WAIT_L_(0); MMA_(0, 0, At, B0); BAR_; SCHED_;
            LDB_(B1, 0, 1); STAGE_(SB_(0, 0), b2, voffB);
            BAR_; WAIT_L_(0); MMA_(0, 1, At, B1); BAR_;
            LDA_(At, 0, 1); STAGE_(SA_(0, 0), a2, voffA);
            BAR_; WAIT_L_(0); MMA_(1, 0, At, B0); BAR_; SCHED_;
            STAGE_(SB_(0, 1), b2 + hsB, voffB);
            WAIT_V_(6); BAR_; MMA_(1, 1, At, B1); BAR_;
            LDB_(B0, 1, 0); SCHED_; LDA_(At, 1, 0); STAGE_(SA_(0, 1), a2 + hsA, voffA);
            WAIT_L_(8); BAR_; WAIT_L_(0); MMA_(0, 0, At, B0); BAR_; SCHED_;
            LDB_(B1, 1, 1); STAGE_(SB_(1, 0), b3, voffB);
            BAR_; WAIT_L_(0); MMA_(0, 1, At, B1); BAR_;
            LDA_(At, 1, 1); STAGE_(SA_(1, 0), a3, voffA);
            BAR_; WAIT_L_(0); MMA_(1, 0, At, B0); BAR_; SCHED_;
            STAGE_(SB_(1, 1), b3 + hsB, voffB);
            WAIT_V_(6); BAR_; MMA_(1, 1, At, B1); BAR_;
        }
        if (SPLIT && cur.slab >= 0) {
            float* sb = slabs + (size_t)cur.slab * 65536 + (size_t)(wr * 64 + fr) * 256 + wc * 32 + 8 * fq;
#pragma unroll
            for (int ai = 0; ai < 2; ++ai)
#pragma unroll
                for (int m = 0; m < 4; ++m)
#pragma unroll
                    for (int bj = 0; bj < 2; ++bj) { float* q = sb + (size_t)(ai * HALF + m * 16) * 256 + bj * HALF; *(f32x4*)q = acc[ai][bj][m][0]; *(f32x4*)(q + 4) = acc[ai][bj][m][1]; }
        } else E(acc, cur, wr, wc, fr, fq);
        if (!has_next) break;
#pragma unroll
        for (int a = 0; a < 2; ++a)
#pragma unroll
            for (int b = 0; b < 2; ++b)
#pragma unroll
                for (int m = 0; m < 4; ++m)
#pragma unroll
                    for (int n = 0; n < 2; ++n) acc[a][b][m][n] = (f32x4){0.f, 0.f, 0.f, 0.f};
        cur = nxt; cA = nA; cB = nB; ++ui;
    }
    WAIT_V_(0);
    if (wr == 0) BAR_;
    BAR_;
#undef SA_
#undef SB_
#undef STAGE_
#undef LDA_
#undef LDB_
#undef MMA_
}

struct EpiG1 {
    static constexpr bool PERM = true;
    bf16_t* A2; bf16_t* XBCP; bf16_t* V; float* DT; const float* dt_bias;
    __device__ __forceinline__ void operator()(const f32x4 (&acc)[2][2][4][2], const Unit& u, int wr, int wc, int fr, int fq) const {
        const int row0 = u.pm * BM + wr * 64 + fr, lc = wc * 32 + 8 * fq;
        if (u.pn < 14) {
            bf16_t* base; int ld, colt;
            if (u.pn < 4) { base = A2; ld = 2048; colt = u.pn * 256; }
            else if (u.pn < 10) { base = XBCP; ld = XBC; colt = (u.pn - 4) * 256; }
            else { base = A2; ld = 2048; colt = 1024 + (u.pn - 10) * 256; }
#pragma unroll
            for (int ai = 0; ai < 2; ++ai)
#pragma unroll
                for (int m = 0; m < 4; ++m) { bf16_t* rowp = base + (size_t)(row0 + ai * HALF + m * 16) * ld + colt + lc;
#pragma unroll
                    for (int bj = 0; bj < 2; ++bj) *(u32x4*)(rowp + bj * HALF) = pack44(acc[ai][bj][m][0], acc[ai][bj][m][1]); }
        } else if (u.pn < 22) {
            const int ch0 = (u.pn - 14) * 128 + lc;
#pragma unroll
            for (int ai = 0; ai < 2; ++ai)
#pragma unroll
                for (int m = 0; m < 4; ++m) { bf16_t* rowp = V + (size_t)(row0 + ai * HALF + m * 16) * 1024 + ch0;
                    *(u32x4*)rowp = pack44(acc[ai][0][m][0] * acc[ai][1][m][0], acc[ai][0][m][1] * acc[ai][1][m][1]); }
        } else {
            if (wc == 0 && fq < 2) {
                const f32x4 b0 = *(const f32x4*)(dt_bias + 8 * fq), b1 = *(const f32x4*)(dt_bias + 8 * fq + 4);
#pragma unroll
                for (int ai = 0; ai < 2; ++ai)
#pragma unroll
                    for (int m = 0; m < 4; ++m) { float* rowp = DT + (size_t)(row0 + ai * HALF + m * 16) * 16 + 8 * fq;
                        f32x4 v0 = acc[ai][0][m][0] + b0, v1 = acc[ai][0][m][1] + b1;
#pragma unroll
                        for (int j = 0; j < 4; ++j) { v0[j] = softplusf_(v0[j]); v1[j] = softplusf_(v1[j]); }
                        *(f32x4*)rowp = v0; *(f32x4*)(rowp + 4) = v1; }
            }
        }
    }
};
template <bool SRC_F32> struct EpiRes {
    static constexpr bool PERM = true;
    const float* xp; const float* xs; bf16_t* XN; float* ssq;
    __device__ __forceinline__ void operator()(const f32x4 (&acc)[2][2][4][2], const Unit& u, int wr, int wc, int fr, int fq) const {
        const int row0 = u.pm * BM + wr * 64 + fr, col0 = u.pn * BM + wc * 32 + 8 * fq;
        if (SRC_F32) {
#pragma unroll
            for (int ai = 0; ai < 2; ++ai) {
                f32x4 old[4][2][2];
#pragma unroll
                for (int m = 0; m < 4; ++m) { const int row = row0 + ai * HALF + m * 16;
                    const float* src = (row < TP ? xp + (size_t)row * DM : xs + (size_t)(row - TP) * DM) + col0;
#pragma unroll
                    for (int bj = 0; bj < 2; ++bj) { old[m][bj][0] = *(const f32x4*)(src + bj * HALF); old[m][bj][1] = *(const f32x4*)(src + bj * HALF + 4); } }
#pragma unroll
                for (int m = 0; m < 4; ++m) { const int row = row0 + ai * HALF + m * 16; bf16_t* xnp = XN + (size_t)row * DM + col0; float sq = 0.f;
#pragma unroll
                    for (int bj = 0; bj < 2; ++bj) { const f32x4 v0 = old[m][bj][0] + acc[ai][bj][m][0], v1 = old[m][bj][1] + acc[ai][bj][m][1];
                        *(u32x4*)(xnp + bj * HALF) = pack44(v0, v1);
                        sq += v0[0] * v0[0] + v0[1] * v0[1] + v0[2] * v0[2] + v0[3] * v0[3] + v1[0] * v1[0] + v1[1] * v1[1] + v1[2] * v1[2] + v1[3] * v1[3]; }
                    sq += __shfl_xor(sq, 16); sq += __shfl_xor(sq, 32);
                    if (fq == 0) atomicAdd(ssq + row, sq); }
            }
        } else {
#pragma unroll
            for (int ai = 0; ai < 2; ++ai) {
                u32x4 old[4][2];
#pragma unroll
                for (int m = 0; m < 4; ++m)
#pragma unroll
                    for (int bj = 0; bj < 2; ++bj) old[m][bj] = *(const u32x4*)(XN + (size_t)(row0 + ai * HALF + m * 16) * DM + col0 + bj * HALF);
#pragma unroll
                for (int m = 0; m < 4; ++m) { const int row = row0 + ai * HALF + m * 16; bf16_t* xnp = XN + (size_t)row * DM + col0; float sq = 0.f;
#pragma unroll
                    for (int bj = 0; bj < 2; ++bj) { const u32x4 w = old[m][bj];
                        const f32x4 v0 = (f32x4){bf_lo(w.x), bf_hi(w.x), bf_lo(w.y), bf_hi(w.y)} + acc[ai][bj][m][0], v1 = (f32x4){bf_lo(w.z), bf_hi(w.z), bf_lo(w.w), bf_hi(w.w)} + acc[ai][bj][m][1];
                        *(u32x4*)(xnp + bj * HALF) = pack44(v0, v1);
                        sq += v0[0] * v0[0] + v0[1] * v0[1] + v0[2] * v0[2] + v0[3] * v0[3] + v1[0] * v1[0] + v1[1] * v1[1] + v1[2] * v1[2] + v1[3] * v1[3]; }
                    sq += __shfl_xor(sq, 16); sq += __shfl_xor(sq, 32);
                    if (fq == 0) atomicAdd(ssq + row, sq); }
            }
        }
    }
};
__device__ __forceinline__ float dpp_ror1(float v) { return __int_as_float(__builtin_amdgcn_update_dpp(0, __float_as_int(v), 0x121, 0xf, 0xf, false)); }
__device__ __forceinline__ float dpp_ror2(float v) { return __int_as_float(__builtin_amdgcn_update_dpp(0, __float_as_int(v), 0x122, 0xf, 0xf, false)); }
struct EpiFfnFused {
    static constexpr bool PERM = true;
    bf16_t* H; bf16_t* GH; bf16_t* GT; bf16_t* UH; const float* ssq; const float* cw; const float* cb;
    __device__ __forceinline__ void operator()(const f32x4 (&acc)[2][2][4][2], const Unit& u, int wr, int wc, int fr, int fq) const {
        const int ch0 = u.pn * 128 + wc * 32 + 8 * fq;
        float w0[8], w1[8], w2[8], bb[8];
#pragma unroll
        for (int h = 0; h < 2; ++h) { const f32x4 a = *(const f32x4*)(cw + ch0 + 4 * h), b = *(const f32x4*)(cw + DFF + ch0 + 4 * h), c = *(const f32x4*)(cw + 2 * DFF + ch0 + 4 * h), d = *(const f32x4*)(cb + ch0 + 4 * h);
#pragma unroll
            for (int j = 0; j < 4; ++j) { w0[4 * h + j] = a[j]; w1[4 * h + j] = b[j]; w2[4 * h + j] = c[j]; bb[4 * h + j] = d[j]; } }
        float ssv[2][4];
#pragma unroll
        for (int ai = 0; ai < 2; ++ai)
#pragma unroll
            for (int m = 0; m < 4; ++m) ssv[ai][m] = ssq[u.pm * BM + ai * HALF + wr * 64 + m * 16 + fr];
#pragma unroll
        for (int ai = 0; ai < 2; ++ai) {
            const int grp = 4 * u.pm + 2 * ai + wr;
            float p1[8], p2[8];
#pragma unroll
            for (int q = 0; q < 8; ++q) { p1[q] = 0.f; p2[q] = 0.f; }
#pragma unroll
            for (int m = 0; m < 4; ++m) {
                const int row = u.pm * BM + ai * HALF + wr * 64 + m * 16 + fr;
                const float sc = rsqrtf(ssv[ai][m] * (1.0f / 1024.0f) + EPS);
                float g[8], uu[8], c1[8], c2[8], hh[8];
#pragma unroll
                for (int n = 0; n < 2; ++n)
#pragma unroll
                    for (int j = 0; j < 4; ++j) { g[4 * n + j] = acc[ai][0][m][n][j] * sc; uu[4 * n + j] = acc[ai][1][m][n][j] * sc; }
#pragma unroll
                for (int q = 0; q < 8; ++q) { c1[q] = dpp_ror1(g[q]); c2[q] = dpp_ror2(g[q]); }
                if (m == 0 && fr < 2) { const size_t o = ((size_t)grp * 2 + fr) * DFF + ch0; *(u32x4*)(GH + o) = pack8(g); *(u32x4*)(UH + o) = pack8(uu); }
                if (m == 3 && fr >= 14) { const size_t o = ((size_t)grp * 2 + (fr - 14)) * DFF + ch0; *(u32x4*)(GT + o) = pack8(g); }
#pragma unroll
                for (int q = 0; q < 8; ++q) { const float gm1 = (fr == 0) ? p1[q] : c1[q], gm2 = (fr < 2) ? p2[q] : c2[q];
                    hh[q] = geluf_(bb[q] + w0[q] * gm2 + w1[q] * gm1 + w2[q] * g[q]) * uu[q]; p1[q] = c1[q]; p2[q] = c2[q]; }
                *(u32x4*)(H + (size_t)row * DFF + ch0) = pack8(hh);
            }
        }
    }
};
struct EpiLruIn {
    static constexpr bool PERM = true;
    bf16_t* GATE; bf16_t* XBP; const float* ssq;
    __device__ __forceinline__ void operator()(const f32x4 (&acc)[2][2][4][2], const Unit& u, int wr, int wc, int fr, int fq) const {
        const int row0 = u.pm * BM + wr * 64 + fr, lc = wc * 32 + 8 * fq;
        const bool isgate = u.pn < 4;
        bf16_t* base = isgate ? GATE : XBP; const int colt = (isgate ? u.pn : u.pn - 4) * 256 + lc;
        float ssv[2][4];
#pragma unroll
        for (int ai = 0; ai < 2; ++ai)
#pragma unroll
            for (int m = 0; m < 4; ++m) ssv[ai][m] = ssq[row0 + ai * HALF + m * 16];
#pragma unroll
        for (int ai = 0; ai < 2; ++ai)
#pragma unroll
            for (int m = 0; m < 4; ++m) { bf16_t* rowp = base + (size_t)(row0 + ai * HALF + m * 16) * 1024 + colt;
                const float sc = rsqrtf(ssv[ai][m] * (1.0f / 1024.0f) + EPS);
#pragma unroll
                for (int bj = 0; bj < 2; ++bj) { f32x4 v0 = acc[ai][bj][m][0] * sc, v1 = acc[ai][bj][m][1] * sc;
                    if (isgate) {
#pragma unroll
                        for (int j = 0; j < 4; ++j) { v0[j] = geluf_(v0[j]); v1[j] = geluf_(v1[j]); } }
                    *(u32x4*)(rowp + bj * HALF) = pack44(v0, v1); } }
    }
};
struct EpiLruGate {
    static constexpr bool PERM = true;
    const bf16_t* XBC2; bf16_t* LA; bf16_t* UU; const float* ba; const float* bx; const float* sp;
    __device__ __forceinline__ void operator()(const f32x4 (&acc)[2][2][4][2], const Unit& u, int wr, int wc, int fr, int fq) const {
        const int row0 = u.pm * BM + wr * 64 + fr, ch0 = (u.pn >> 1) * 256 + (u.pn & 1) * 128 + wc * 32 + 8 * fq;
        u32x4 xw[2][4];
#pragma unroll
        for (int ai = 0; ai < 2; ++ai)
#pragma unroll
            for (int m = 0; m < 4; ++m) xw[ai][m] = *(const u32x4*)(XBC2 + (size_t)(row0 + ai * HALF + m * 16) * 1024 + ch0);
        f32x4 vba[2], vbx[2], vsp[2];
#pragma unroll
        for (int n = 0; n < 2; ++n) { vba[n] = *(const f32x4*)(ba + ch0 + 4 * n); vbx[n] = *(const f32x4*)(bx + ch0 + 4 * n); vsp[n] = *(const f32x4*)(sp + ch0 + 4 * n); }
#pragma unroll
        for (int ai = 0; ai < 2; ++ai)
#pragma unroll
            for (int m = 0; m < 4; ++m) { const size_t o = (size_t)(row0 + ai * HALF + m * 16) * 1024 + ch0;
                float xb[8]; unpack8(xw[ai][m], xb);
                float la[8], uu[8];
#pragma unroll
                for (int n = 0; n < 2; ++n)
#pragma unroll
                    for (int j = 0; j < 4; ++j) { const int q = 4 * n + j;
                        const float r = sigmoidf_(acc[ai][0][m][n][j] + vba[n][j]), ig = sigmoidf_(acc[ai][1][m][n][j] + vbx[n][j]);
                        const float l = -8.0f * r * vsp[n][j]; la[q] = l;
                        const float mult = __builtin_amdgcn_sqrtf(fmaxf(0.0f, 1.0f - __expf(2.0f * l)));
                        uu[q] = mult * ig * xb[q]; }
                *(u32x4*)(LA + o) = pack8(la); *(u32x4*)(UU + o) = pack8(uu); }
    }
};

__device__ __forceinline__ void wconv_tile(const Ctx cx, const float* src, int ld_src, int nvalid, const float* gain, int k0, bf16_t* dst, int K, LAS unsigned char* lds) {
    const int lane = cx.tid & 63; LAS bf16_t* L = (LAS bf16_t*)(lds + (cx.tid >> 6) * 8448);
    float v[64];
#pragma unroll
    for (int k = 0; k < 64; ++k) v[k] = (lane < nvalid) ? src[(size_t)k * ld_src + lane] : 0.f;
    if (gain) {
#pragma unroll
        for (int k = 0; k < 64; ++k) v[k] *= gain[k0 + k]; }
#pragma unroll
    for (int k = 0; k < 64; k += 2) *(LAS unsigned*)(L + lane * 66 + k) = cvt_pk_bf16(v[k], v[k + 1]);
    asm volatile("s_waitcnt lgkmcnt(0)" ::: "memory");
#pragma unroll
    for (int i = 0; i < 8; ++i) { const int n = (lane >> 3) + 8 * i, kq = lane & 7; const LAS unsigned* q = (const LAS unsigned*)(L + n * 66 + kq * 8);
        u32x4 w; w.x = q[0]; w.y = q[1]; w.z = q[2]; w.w = q[3];
        *(u32x4*)(dst + (size_t)n * K + kq * 8) = w; }
    asm volatile("s_waitcnt lgkmcnt(0)" ::: "memory");
}
__device__ __forceinline__ void phase_prep(const Ctx cx, const Params& p, LAS unsigned char* lds, const int task_lo, const int task_hi, const int vb, const int nvb, const bool tables) {
    unsigned char* ws = P_WS(p);
    constexpr int NT1 = 92 * 16, NT2 = 16 * 32, NT3 = 88 * 16, NT4 = 16 * 44, NT5 = 32 * 16, NT6 = 32 * 4, NT7 = 16 * 16;
    constexpr int NTASK = NT1 + NT2 + 2 * NT3 + 2 * NT4 + NT5 + NT6 + NT7;
    for (int task = task_lo + vb * 8 + __builtin_amdgcn_readfirstlane(cx.tid >> 6); task < (task_hi < NTASK ? task_hi : NTASK); task += nvb * 8) {
        int id = task;
        if (id < NT1) { const int ntile = id / 16, kt = id % 16, n0 = ntile * 64, k0 = kt * 64, pn = n0 >> 8, lc0 = n0 & 255;
            int col, nv = 64;
            if (pn < 10) col = n0; else if (pn < 14) col = 2576 + (n0 - 2560);
            else if (pn < 22) col = (lc0 < 128 ? 3600 : 4624) + (pn - 14) * 128 + (lc0 & 127);
            else { col = 2560; nv = (lc0 == 0) ? 16 : 0; }
            wconv_tile(cx, IN(p, I_AB_WIN) + (size_t)k0 * 5648 + col, 5648, nv, IN(p, I_NORM_MIX), k0, (bf16_t*)(ws + WS_W1) + (size_t)n0 * 1024 + k0, 1024, lds); continue; }
        id -= NT1;
        if (id < NT2) { const int ntile = id / 32, kt = id % 32, n0 = ntile * 64, k0 = kt * 64;
            wconv_tile(cx, IN(p, I_AB_WOUT) + (size_t)k0 * 1024 + n0, 1024, 64, k0 < 1024 ? IN(p, I_SSD_NORM) : nullptr, k0, (bf16_t*)(ws + WS_W2) + (size_t)n0 * 2048 + k0, 2048, lds); continue; }
        id -= NT2;
        if (id < 2 * NT3) { const int l = id / NT3; id -= l * NT3; const int ntile = id / 16, kt = id % 16, n0 = ntile * 64, k0 = kt * 64, pn = n0 >> 8, lc0 = n0 & 255;
            const int col = (lc0 < 128 ? 0 : DFF) + pn * 128 + (lc0 & 127);
            wconv_tile(cx, IN(p, I_FFN_WIN) + (size_t)l * 1024 * 5632 + (size_t)k0 * 5632 + col, 5632, 64, IN(p, I_NORM_FFN) + l * 1024, k0, (bf16_t*)(ws + WS_W3) + (size_t)l * 5632 * 1024 + (size_t)n0 * 1024 + k0, 1024, lds); continue; }
        id -= 2 * NT3;
        if (id < 2 * NT4) { const int l = id / NT4; id -= l * NT4; const int ntile = id / 44, kt = id % 44, n0 = ntile * 64, k0 = kt * 64;
            wconv_tile(cx, IN(p, I_FFN_WOUT) + (size_t)l * DFF * 1024 + (size_t)k0 * 1024 + n0, 1024, 64, nullptr, k0, (bf16_t*)(ws + WS_W4) + (size_t)l * 1024 * DFF + (size_t)n0 * DFF + k0, DFF, lds); continue; }
        id -= 2 * NT4;
        if (id < NT5) { const int ntile = id / 16, kt = id % 16, n0 = ntile * 64, k0 = kt * 64;
            wconv_tile(cx, IN(p, I_LRU_WIN) + (size_t)k0 * 2048 + n0, 2048, 64, IN(p, I_NORM_MIX) + 1024, k0, (bf16_t*)(ws + WS_W5) + (size_t)n0 * 1024 + k0, 1024, lds); continue; }
        id -= NT5;
        if (id < NT6) { const int ntile = id / 4, kt = id % 4, n0 = ntile * 64, k0 = kt * 64, head = n0 >> 9, within = n0 & 511, pnl = within >> 8, lc0 = within & 255;
            const int ch = pnl * 128 + (lc0 & 127);
            const float* srcm = (lc0 < 128 ? IN(p, I_LRU_WA) : IN(p, I_LRU_WX)) + (size_t)head * 65536;
            wconv_tile(cx, srcm + (size_t)k0 * 256 + ch, 256, 64, nullptr, k0, (bf16_t*)(ws + WS_W6) + (size_t)n0 * 256 + k0, 256, lds); continue; }
        id -= NT6;
        { const int ntile = id / 16, kt = id % 16, n0 = ntile * 64, k0 = kt * 64;
            wconv_tile(cx, IN(p, I_LRU_WOUT) + (size_t)k0 * 1024 + n0, 1024, 64, nullptr, k0, (bf16_t*)(ws + WS_W7) + (size_t)n0 * 1024 + k0, 1024, lds); }
    }
    if (!tables) return;
    const int gt = cx.bid * NTHREADS + cx.tid, gs = cx.nblk * NTHREADS;
    for (int i = gt; i < 1024; i += gs) ((float*)(ws + WS_SP))[i] = softplusf_(-IN(p, I_LRU_LAMBDA)[i]);
    for (int i = gt; i < 5 * T; i += gs) ((float*)(ws + WS_SSQ))[i] = 0.f;
}

__device__ __forceinline__ void phase_norm(const Ctx cx, const float* xp, const float* xs, bf16_t* XN) {
    const int wid = cx.tid >> 6, lane = cx.tid & 63;
    for (int row0 = cx.bid * 8 + wid; row0 < T; row0 += cx.nblk * 32) {
        f32x4 v[4][4];
#pragma unroll
        for (int i = 0; i < 4; ++i) { const int row = row0 + i * cx.nblk * 8;
            if (row < T) { const float* src = row < TP ? xp + (size_t)row * DM : xs + (size_t)(row - TP) * DM;
#pragma unroll
                for (int j = 0; j < 4; ++j) v[i][j] = *(const f32x4*)(src + lane * 4 + j * 256); } }
#pragma unroll
        for (int i = 0; i < 4; ++i) { const int row = row0 + i * cx.nblk * 8;
            if (row < T) { float s = 0.f;
#pragma unroll
                for (int j = 0; j < 4; ++j) s += v[i][j][0] * v[i][j][0] + v[i][j][1] * v[i][j][1] + v[i][j][2] * v[i][j][2] + v[i][j][3] * v[i][j][3];
#pragma unroll
                for (int o = 32; o >= 1; o >>= 1) s += __shfl_xor(s, o);
                const float rs = rsqrtf(s * (1.0f / 1024.0f) + EPS);
#pragma unroll
                for (int j = 0; j < 4; ++j) { u32x2 w; w.x = cvt_pk_bf16(v[i][j][0] * rs, v[i][j][1] * rs); w.y = cvt_pk_bf16(v[i][j][2] * rs, v[i][j][3] * rs);
                    *(u32x2*)(XN + (size_t)row * DM + lane * 4 + j * 256) = w; } } }
    }
}
__device__ __forceinline__ void phase_final_norm(const Ctx cx, const bf16_t* XN, const float* ssq, const float* gain, float* y) {
    const int wid = cx.tid >> 6, lane = cx.tid & 63;
    f32x4 gv[4];
#pragma unroll
    for (int j = 0; j < 4; ++j) gv[j] = *(const f32x4*)(gain + lane * 16 + j * 4);
    for (int row0 = cx.bid * 8 + wid; row0 < T; row0 += cx.nblk * 64) {
        u32x4 w[8][2]; float rs[8];
#pragma unroll
        for (int i = 0; i < 8; ++i) { const int row = row0 + i * cx.nblk * 8;
            if (row < T) { w[i][0] = *(const u32x4*)(XN + (size_t)row * DM + lane * 16); w[i][1] = *(const u32x4*)(XN + (size_t)row * DM + lane * 16 + 8); rs[i] = rsqrtf(ssq[row] * (1.0f / 1024.0f) + EPS); } }
#pragma unroll
        for (int i = 0; i < 8; ++i) { const int row = row0 + i * cx.nblk * 8;
            if (row < T) { float f[16]; { float a[8], b[8]; unpack8(w[i][0], a); unpack8(w[i][1], b);
#pragma unroll
                    for (int q = 0; q < 8; ++q) { f[q] = a[q]; f[8 + q] = b[q]; } }
                float* dst = y + (size_t)row * DM + lane * 16;
#pragma unroll
                for (int j = 0; j < 4; ++j) *(f32x4*)(dst + j * 4) = (f32x4){f[4 * j], f[4 * j + 1], f[4 * j + 2], f[4 * j + 3]} * rs[i] * gv[j]; } }
    }
}

template <int KW, int MODE>
__device__ __forceinline__ void phase_conv(const Ctx cx, const bf16_t* src, int ld_src, int NC, const float* w, const float* bias, bf16_t* dst, int ld_dst,
                           const float* st_in, float* out_p, float* out_s) {
    const int ncg = NC >> 3, total = (T / 16) * ncg;
    for (int item = cx.bid * NTHREADS + cx.tid; item < total; item += cx.nblk * NTHREADS) {
        const int cgi = item % ncg, seg = item / ncg, c0 = cgi * 8, r0 = seg * 16;
        int seq, t0, L; if (r0 < TP) { seq = r0 >> 12; t0 = r0 & 4095; L = 4096; } else { seq = 16 + ((r0 - TP) >> 6); t0 = (r0 - TP) & 63; L = 64; }
        float wv[KW][8], bv[8];
#pragma unroll
        for (int k = 0; k < KW; ++k) { const f32x4 a = *(const f32x4*)(w + (size_t)k * NC + c0), b = *(const f32x4*)(w + (size_t)k * NC + c0 + 4);
#pragma unroll
            for (int j = 0; j < 4; ++j) { wv[k][j] = a[j]; wv[k][4 + j] = b[j]; } }
        { const f32x4 a = *(const f32x4*)(bias + c0), b = *(const f32x4*)(bias + c0 + 4);
#pragma unroll
          for (int j = 0; j < 4; ++j) { bv[j] = a[j]; bv[4 + j] = b[j]; } }
        float win[KW - 1][8];
#pragma unroll
        for (int k = 0; k < KW - 1; ++k) {
            if (t0 > 0) unpack8(*(const u32x4*)(src + (size_t)(r0 - (KW - 1) + k) * ld_src + c0), win[k]);
            else if (seq >= 16) { const float* sp_ = st_in + ((size_t)(seq - 16) * (KW - 1) + k) * NC + c0; const f32x4 a = *(const f32x4*)sp_, b = *(const f32x4*)(sp_ + 4);
#pragma unroll
                for (int j = 0; j < 4; ++j) { win[k][j] = a[j]; win[k][4 + j] = b[j]; } }
            else {
#pragma unroll
                for (int j = 0; j < 8; ++j) win[k][j] = 0.f; }
        }
#pragma unroll
        for (int h = 0; h < 2; ++h) {
            u32x4 rows[8], aux[8];
#pragma unroll
            for (int i = 0; i < 8; ++i) { rows[i] = *(const u32x4*)(src + (size_t)(r0 + h * 8 + i) * ld_src + c0);
                if (MODE == 1 || MODE == 2) aux[i] = *(const u32x4*)(dst + (size_t)(r0 + h * 8 + i) * ld_dst + c0); }
#pragma unroll
            for (int i = 0; i < 8; ++i) {
                float cur[8], y[8]; unpack8(rows[i], cur);
#pragma unroll
                for (int j = 0; j < 8; ++j) { float a = bv[j] + wv[KW - 1][j] * cur[j];
#pragma unroll
                    for (int k = 0; k < KW - 1; ++k) a += wv[k][j] * win[k][j];
                    y[j] = a; }
#pragma unroll
                for (int j = 0; j < 8; ++j) {
#pragma unroll
                    for (int k = 0; k < KW - 2; ++k) win[k][j] = win[k + 1][j];
                    win[KW - 2][j] = cur[j]; }
                if (MODE == 0) {
#pragma unroll
                    for (int j = 0; j < 8; ++j) y[j] = siluf_(y[j]); }
                if (MODE == 1) { float gq[8]; unpack8(aux[i], gq);
#pragma unroll
                    for (int j = 0; j < 8; ++j) y[j] = y[j] * gq[j]; }
                if (MODE == 2) { float uq[8]; unpack8(aux[i], uq);
#pragma unroll
                    for (int j = 0; j < 8; ++j) y[j] = geluf_(y[j]) * uq[j]; }
                *(u32x4*)(dst + (size_t)(r0 + h * 8 + i) * ld_dst + c0) = pack8(y);
            }
            if (h == 1 && t0 + 16 == L) {
                float* ob = (seq < 16 ? out_p + (size_t)seq * (KW - 1) * NC : out_s + (size_t)(seq - 16) * (KW - 1) * NC) + c0;
#pragma unroll
                for (int j = 0; j < KW - 1; ++j) { float f[8]; unpack8(rows[8 - (KW - 1) + j], f);
                    *(f32x4*)(ob + (size_t)j * NC) = (f32x4){f[0], f[1], f[2], f[3]}; *(f32x4*)(ob + (size_t)j * NC + 4) = (f32x4){f[4], f[5], f[6], f[7]}; }
            }
        }
    }
}

template <bool SRC_F32, bool GSCALE>
__device__ __forceinline__ void phase_split_finish(const Ctx cx, const float* slabs, int nsplit, const float* xs, bf16_t* XN, float* ssq, const float* gssq) {
    const int wid = cx.tid >> 6, lane = cx.tid & 63;
    for (int r = cx.bid * 8 + wid; r < TS; r += cx.nblk * 8) {
        const int panel = r >> 8, rl = r & 255, pn = lane >> 4, lc = (lane & 15) * 16;
        const float* sb = slabs + (size_t)((panel * 4 + pn) * nsplit) * 65536 + (size_t)rl * 256 + lc;
        f32x4 v[4];
#pragma unroll
        for (int q = 0; q < 4; ++q) v[q] = (f32x4){0.f, 0.f, 0.f, 0.f};
        for (int pc = 0; pc < nsplit; ++pc) {
#pragma unroll
            for (int q = 0; q < 4; ++q) v[q] += *(const f32x4*)(sb + (size_t)pc * 65536 + 4 * q);
            if (GSCALE && pc == 3) { const float sc = rsqrtf(gssq[TP + r] * (1.0f / 1024.0f) + EPS);
#pragma unroll
                for (int q = 0; q < 4; ++q) v[q] *= sc; }
        }
        bf16_t* xnp = XN + (size_t)(TP + r) * DM + lane * 16;
        if (SRC_F32) { const float* src = xs + (size_t)r * DM + lane * 16;
#pragma unroll
            for (int q = 0; q < 4; ++q) v[q] += *(const f32x4*)(src + 4 * q); }
        else { float a[8], b[8]; unpack8(*(const u32x4*)xnp, a); unpack8(*(const u32x4*)(xnp + 8), b);
            v[0] += (f32x4){a[0], a[1], a[2], a[3]}; v[1] += (f32x4){a[4], a[5], a[6], a[7]}; v[2] += (f32x4){b[0], b[1], b[2], b[3]}; v[3] += (f32x4){b[4], b[5], b[6], b[7]}; }
        *(u32x4*)xnp = pack44(v[0], v[1]); *(u32x4*)(xnp + 8) = pack44(v[2], v[3]);
        float sq = 0.f;
#pragma unroll
        for (int q = 0; q < 4; ++q) sq += v[q][0] * v[q][0] + v[q][1] * v[q][1] + v[q][2] * v[q][2] + v[q][3] * v[q][3];
#pragma unroll
        for (int o = 32; o >= 1; o >>= 1) sq += __shfl_xor(sq, o);
        if (lane == 0) ssq[TP + r] = sq;
    }
}

__device__ __forceinline__ void phase_ffn_fix(const Ctx cx, const bf16_t* GH, const bf16_t* GT, const bf16_t* UH, bf16_t* H, const float* cw, const float* cb,
                                              const float* st_in, float* out_p, float* out_s) {
    const int ncg = DFF / 8, total = 1032 * ncg;
    for (int item = cx.bid * NTHREADS + cx.tid; item < total; item += cx.nblk * NTHREADS) {
        const int cgi = item % ncg, G = item / ncg, c0 = cgi * 8;
        int seq; bool first, lastg;
        if (G < 1024) { seq = G >> 6; first = (G & 63) == 0; lastg = (G & 63) == 63; } else { seq = 16 + (G - 1024); first = true; lastg = true; }
        float w0[8], w1[8], w2[8], bb[8], gm2[8], gm1[8], g0[8], g1[8], u0[8], u1[8];
#pragma unroll
        for (int h = 0; h < 2; ++h) { const f32x4 a = *(const f32x4*)(cw + c0 + 4 * h), b = *(const f32x4*)(cw + DFF + c0 + 4 * h), c = *(const f32x4*)(cw + 2 * DFF + c0 + 4 * h), d = *(const f32x4*)(cb + c0 + 4 * h);
#pragma unroll
            for (int j = 0; j < 4; ++j) { w0[4 * h + j] = a[j]; w1[4 * h + j] = b[j]; w2[4 * h + j] = c[j]; bb[4 * h + j] = d[j]; } }
        if (!first) { unpack8(*(const u32x4*)(GT + ((size_t)(G - 1) * 2 + 0) * DFF + c0), gm2); unpack8(*(const u32x4*)(GT + ((size_t)(G - 1) * 2 + 1) * DFF + c0), gm1); }
        else if (seq >= 16) { const float* s0 = st_in + ((size_t)(seq - 16) * 2) * DFF + c0;
#pragma unroll
            for (int h = 0; h < 2; ++h) { const f32x4 a = *(const f32x4*)(s0 + 4 * h), b = *(const f32x4*)(s0 + DFF + 4 * h);
#pragma unroll
                for (int j = 0; j < 4; ++j) { gm2[4 * h + j] = a[j]; gm1[4 * h + j] = b[j]; } } }
        else {
#pragma unroll
            for (int q = 0; q < 8; ++q) { gm2[q] = 0.f; gm1[q] = 0.f; } }
        unpack8(*(const u32x4*)(GH + ((size_t)G * 2 + 0) * DFF + c0), g0); unpack8(*(const u32x4*)(GH + ((size_t)G * 2 + 1) * DFF + c0), g1);
        unpack8(*(const u32x4*)(UH + ((size_t)G * 2 + 0) * DFF + c0), u0); unpack8(*(const u32x4*)(UH + ((size_t)G * 2 + 1) * DFF + c0), u1);
        float h0[8], h1[8];
#pragma unroll
        for (int q = 0; q < 8; ++q) { h0[q] = geluf_(bb[q] + w0[q] * gm2[q] + w1[q] * gm1[q] + w2[q] * g0[q]) * u0[q];
            h1[q] = geluf_(bb[q] + w0[q] * gm1[q] + w1[q] * g0[q] + w2[q] * g1[q]) * u1[q]; }
        *(u32x4*)(H + (size_t)(G * 64) * DFF + c0) = pack8(h0); *(u32x4*)(H + (size_t)(G * 64 + 1) * DFF + c0) = pack8(h1);
        if (lastg) {
            float* ob = (seq < 16 ? out_p + (size_t)seq * 2 * DFF : out_s + (size_t)(seq - 16) * 2 * DFF) + c0;
#pragma unroll
            for (int j = 0; j < 2; ++j) { float f[8]; unpack8(*(const u32x4*)(GT + ((size_t)G * 2 + j) * DFF + c0), f);
                *(f32x4*)(ob + (size_t)j * DFF) = (f32x4){f[0], f[1], f[2], f[3]}; *(f32x4*)(ob + (size_t)j * DFF + 4) = (f32x4){f[4], f[5], f[6], f[7]}; }
        }
    }
}

constexpr int SC_CS = 0, SC_BS = 17408, SC_BTS = 34816, SC_XTS = 53248, SC_XDS = 62464, SC_HS = 71680, SC_MS = 89088, SC_AS = 98304, SC_SQ = 98560;
#define LDS_BARRIER() do { asm volatile("s_waitcnt lgkmcnt(0)" ::: "memory"); __builtin_amdgcn_s_barrier(); asm volatile("" ::: "memory"); } while (0)
template <int N> __device__ __forceinline__ float dpp_shr(float v) { return __int_as_float(__builtin_amdgcn_update_dpp(0, __float_as_int(v), 0x110 + N, 0xf, 0xf, true)); }
__device__ __forceinline__ void ssd_task(const Ctx cx, const Params& p, LAS unsigned char* lds, int seq, int hd) {
    const int tid = cx.tid, wid = tid >> 6, lane = tid & 63, fr = lane & 15, fq = lane >> 4;
    unsigned char* ws = P_WS(p);
    const bf16_t* XBCA = (const bf16_t*)(ws + WS_XBCA); bf16_t* A2 = (bf16_t*)(ws + WS_A2); const float* DT = (const float*)(ws + WS_DT); float* SSQ = (float*)(ws + WS_SSQ);
    const int g = hd >> 3, nchunks = seq < 16 ? 64 : 1;
    const size_t row_base = seq < 16 ? (size_t)seq * 4096 : (size_t)TP + (size_t)(seq - 16) * 64;
    const float Aneg = -__expf(IN(p, I_A_LOG)[hd]), Dh = IN(p, I_SSD_D)[hd];
    LAS float* As = (LAS float*)(lds + SC_AS); LAS float* Sq = (LAS float*)(lds + SC_SQ);
    f32x4 hst[4];
#pragma unroll
    for (int pt = 0; pt < 4; ++pt) {
        if (seq >= 16) hst[pt] = *(const f32x4*)(IN(p, I_ST_SSD) + ((size_t)((seq - 16) * 16 + hd) * 64 + 16 * pt + fr) * 128 + 16 * wid + 4 * fq);
        else hst[pt] = (f32x4){0.f, 0.f, 0.f, 0.f};
    }
    const int lt = wid >> 1, ph = wid & 1;
    float pf_dt; u32x4 pf_b[2], pf_c[2], pf_x, pf_bt[2];
#define SSD_PREFETCH(cc) do { const size_t r0p = row_base + (size_t)(cc) * 64; \
        pf_dt = DT[(r0p + lane) * 16 + hd]; \
        _Pragma("unroll") for (int i = 0; i < 2; ++i) { const int q = tid + i * 512, row = q >> 4, sg = q & 15; \
            const bf16_t* gp = XBCA + (r0p + row) * XBC + 1024 + g * 128 + sg * 8; pf_b[i] = *(const u32x4*)gp; pf_c[i] = *(const u32x4*)(gp + 256); } \
        pf_x = *(const u32x4*)(XBCA + (r0p + lane) * XBC + hd * 64 + wid * 8); \
        _Pragma("unroll") for (int i = 0; i < 2; ++i) pf_bt[i] = *(const u32x4*)(XBCA + (r0p + lane) * XBC + 1024 + g * 128 + (wid + 8 * i) * 8); } while (0)
    SSD_PREFETCH(0);
    for (int c = 0; c < nchunks; ++c) {
        const size_t r0 = row_base + (size_t)c * 64;
        const float dt_l = pf_dt;
        float a = dt_l * Aneg;
        a += dpp_shr<1>(a); a += dpp_shr<2>(a); a += dpp_shr<4>(a); a += dpp_shr<8>(a);
        { const float t0 = __int_as_float(__builtin_amdgcn_readlane(__float_as_int(a), 15)), t1 = __int_as_float(__builtin_amdgcn_readlane(__float_as_int(a), 31)), t2 = __int_as_float(__builtin_amdgcn_readlane(__float_as_int(a), 47));
          a += (fq == 1) ? t0 : (fq == 2) ? (t0 + t1) : (fq == 3) ? (t0 + t1 + t2) : 0.0f; }
        const float a63 = __int_as_float(__builtin_amdgcn_readlane(__float_as_int(a), 63));
        const float wl = dt_l * __expf(a63 - a);
        if (wid == 0) As[lane] = a;
#pragma unroll
        for (int i = 0; i < 2; ++i) { const int q = tid + i * 512, row = q >> 4, sg = q & 15;
            *(LAS u32x4*)(lds + SC_BS + row * 272 + sg * 16) = pf_b[i]; *(LAS u32x4*)(lds + SC_CS + row * 272 + sg * 16) = pf_c[i]; }
        { float f[8]; unpack8(pf_x, f);
          LAS bf16_t* xt = (LAS bf16_t*)(lds + SC_XTS), *xd = (LAS bf16_t*)(lds + SC_XDS);
#pragma unroll
          for (int j = 0; j < 8; ++j) { const unsigned w2 = cvt_pk_bf16(f[j] * dt_l, f[j] * wl); xt[(wid * 8 + j) * 72 + lane] = (bf16_t)(w2 & 0xffffu); xd[(wid * 8 + j) * 72 + lane] = (bf16_t)(w2 >> 16); } }
#pragma unroll
        for (int i = 0; i < 2; ++i) { const int sg = wid + 8 * i; const u32x4 bw = pf_bt[i];
            LAS bf16_t* bt = (LAS bf16_t*)(lds + SC_BTS);
            bt[(sg * 8 + 0) * 72 + lane] = (bf16_t)(bw.x & 0xffffu); bt[(sg * 8 + 1) * 72 + lane] = (bf16_t)(bw.x >> 16);
            bt[(sg * 8 + 2) * 72 + lane] = (bf16_t)(bw.y & 0xffffu); bt[(sg * 8 + 3) * 72 + lane] = (bf16_t)(bw.y >> 16);
            bt[(sg * 8 + 4) * 72 + lane] = (bf16_t)(bw.z & 0xffffu); bt[(sg * 8 + 5) * 72 + lane] = (bf16_t)(bw.z >> 16);
            bt[(sg * 8 + 6) * 72 + lane] = (bf16_t)(bw.w & 0xffffu); bt[(sg * 8 + 7) * 72 + lane] = (bf16_t)(bw.w >> 16); }
#pragma unroll
        for (int pt = 0; pt < 4; ++pt) { u32x2 w2; w2.x = cvt_pk_bf16(hst[pt][0], hst[pt][1]); w2.y = cvt_pk_bf16(hst[pt][2], hst[pt][3]);
            *(LAS u32x2*)(lds + SC_HS + (16 * pt + fr) * 272 + (16 * wid + 4 * fq) * 2) = w2; }
        u32x2 ep_z[2], ep_x[2];
#pragma unroll
        for (int j = 0; j < 2; ++j) { const size_t rowe = r0 + 16 * lt + fr; const int col = hd * 64 + 16 * (2 * ph + j) + 4 * fq;
            ep_z[j] = *(const u32x2*)(A2 + rowe * 2048 + col); ep_x[j] = *(const u32x2*)(XBCA + rowe * XBC + col); }
        if (c + 1 < nchunks) SSD_PREFETCH(c + 1);
        LDS_BARRIER();
        f32x4 yacc[2];
        {
            bf16x8 cf[4];
#pragma unroll
            for (int kk = 0; kk < 4; ++kk) cf[kk] = *(const LAS bf16x8*)(lds + SC_CS + (16 * lt + fr) * 272 + kk * 64 + fq * 16);
            const float a_l = As[16 * lt + fr];
#pragma unroll
            for (int j = 0; j < 2; ++j) {
                const int st = 2 * ph + j;
                f32x4 cb = (f32x4){0.f, 0.f, 0.f, 0.f};
                if (st <= lt) {
#pragma unroll
                    for (int kk = 0; kk < 4; ++kk) { const bf16x8 bf = *(const LAS bf16x8*)(lds + SC_BS + (16 * st + fr) * 272 + kk * 64 + fq * 16);
                        cb = __builtin_amdgcn_mfma_f32_16x16x32_bf16(bf, cf[kk], cb, 0, 0, 0); }
                    const f32x4 as4 = *(const LAS f32x4*)(lds + SC_AS + (16 * st + 4 * fq) * 4);
#pragma unroll
                    for (int r = 0; r < 4; ++r) { const int s = 16 * st + 4 * fq + r, l = 16 * lt + fr; cb[r] = (s <= l) ? cb[r] * __expf(a_l - as4[r]) : 0.f; }
                }
                u32x2 w2; w2.x = cvt_pk_bf16(cb[0], cb[1]); w2.y = cvt_pk_bf16(cb[2], cb[3]);
                *(LAS u32x2*)(lds + SC_MS + (16 * lt + fr) * 144 + (16 * st + 4 * fq) * 2) = w2;
            }
            const float el = __expf(a_l);
#pragma unroll
            for (int j = 0; j < 2; ++j) { const int pt = 2 * ph + j; f32x4 y = (f32x4){0.f, 0.f, 0.f, 0.f};
#pragma unroll
                for (int kk = 0; kk < 4; ++kk) { const bf16x8 hf = *(const LAS bf16x8*)(lds + SC_HS + (16 * pt + fr) * 272 + kk * 64 + fq * 16);
                    y = __builtin_amdgcn_mfma_f32_16x16x32_bf16(hf, cf[kk], y, 0, 0, 0); }
                yacc[j] = y * el; }
        }
        {
            const float dec = __expf(a63);
            bf16x8 btf[2];
#pragma unroll
            for (int kk = 0; kk < 2; ++kk) btf[kk] = *(const LAS bf16x8*)(lds + SC_BTS + (16 * wid + fr) * 144 + kk * 64 + fq * 16);
#pragma unroll
            for (int pt = 0; pt < 4; ++pt) { f32x4 h = hst[pt] * dec;
#pragma unroll
                for (int kk = 0; kk < 2; ++kk) { const bf16x8 xf = *(const LAS bf16x8*)(lds + SC_XDS + (16 * pt + fr) * 144 + kk * 64 + fq * 16);
                    h = __builtin_amdgcn_mfma_f32_16x16x32_bf16(btf[kk], xf, h, 0, 0, 0); }
                hst[pt] = h; }
        }
        LDS_BARRIER();
        {
            bf16x8 mf[2];
#pragma unroll
            for (int kk = 0; kk < 2; ++kk) mf[kk] = *(const LAS bf16x8*)(lds + SC_MS + (16 * lt + fr) * 144 + kk * 64 + fq * 16);
            float sq = 0.f;
            const size_t row = r0 + 16 * lt + fr;
#pragma unroll
            for (int j = 0; j < 2; ++j) { const int pt = 2 * ph + j; f32x4 y = yacc[j];
#pragma unroll
                for (int kk = 0; kk < 2; ++kk) { const bf16x8 xf = *(const LAS bf16x8*)(lds + SC_XTS + (16 * pt + fr) * 144 + kk * 64 + fq * 16);
                    y = __builtin_amdgcn_mfma_f32_16x16x32_bf16(xf, mf[kk], y, 0, 0, 0); }
                const int col = hd * 64 + 16 * pt + 4 * fq;
                const u32x2 zw = ep_z[j], xw = ep_x[j];
                const float z0 = bf_lo(zw.x), z1 = bf_hi(zw.x), z2 = bf_lo(zw.y), z3 = bf_hi(zw.y);
                const float x0 = bf_lo(xw.x), x1 = bf_hi(xw.x), x2 = bf_lo(xw.y), x3 = bf_hi(xw.y);
                const float g0 = (y[0] + Dh * x0) * siluf_(z0), g1 = (y[1] + Dh * x1) * siluf_(z1), g2 = (y[2] + Dh * x2) * siluf_(z2), g3 = (y[3] + Dh * x3) * siluf_(z3);
                sq += g0 * g0 + g1 * g1 + g2 * g2 + g3 * g3;
                u32x2 ow; ow.x = cvt_pk_bf16(g0, g1); ow.y = cvt_pk_bf16(g2, g3);
                *(u32x2*)(A2 + row * 2048 + col) = ow; }
            sq += __shfl_xor(sq, 16); sq += __shfl_xor(sq, 32);
            if (fq == 0) Sq[ph * 64 + 16 * lt + fr] = sq;
        }
        LDS_BARRIER();
        if (tid < 64) atomicAdd(SSQ + r0 + tid, Sq[tid] + Sq[64 + tid]);
    }
    float* so = (seq < 16 ? P_OUT(p) + O_P_SSD + (size_t)(seq * 16 + hd) * 8192 : P_OUT(p) + O_S_SSD + (size_t)((seq - 16) * 16 + hd) * 8192);
#pragma unroll
    for (int pt = 0; pt < 4; ++pt) *(f32x4*)(so + (size_t)(16 * pt + fr) * 128 + 16 * wid + 4 * fq) = hst[pt];
    LDS_BARRIER();
}
__device__ __forceinline__ void phase_ssd(const Ctx cx, const Params& p, LAS unsigned char* lds) {
    for (int task = cx.bid; task < 384; task += cx.nblk) {
        if (task < 256) ssd_task(cx, p, lds, task >> 4, task & 15);
        else ssd_task(cx, p, lds, 16 + ((task - 256) >> 4), (task - 256) & 15);
    }
}

__device__ __forceinline__ void phase_lru_a(const Ctx cx, const bf16_t* LA, const bf16_t* UU, float* SL, float* HH) {
    const int total = 1088 * 128;
    for (int item = cx.bid * NTHREADS + cx.tid; item < total; item += cx.nblk * NTHREADS) {
        const int cgi = item & 127, ch = item >> 7, c0 = cgi * 8; const size_t r0 = ch < 1024 ? (size_t)ch * 64 : (size_t)TP + (size_t)(ch - 1024) * 8; const int nr = ch < 1024 ? 64 : 8;
        float sl[8], h[8];
#pragma unroll
        for (int j = 0; j < 8; ++j) { sl[j] = 0.f; h[j] = 0.f; }
        for (int i0 = 0; i0 < nr; i0 += 8) {
            u32x4 la[8], uu[8];
#pragma unroll
            for (int i = 0; i < 8; ++i) { la[i] = *(const u32x4*)(LA + (r0 + i0 + i) * 1024 + c0); uu[i] = *(const u32x4*)(UU + (r0 + i0 + i) * 1024 + c0); }
#pragma unroll
            for (int i = 0; i < 8; ++i) { float l[8], u[8]; unpack8(la[i], l); unpack8(uu[i], u);
#pragma unroll
                for (int j = 0; j < 8; ++j) { sl[j] += l[j]; h[j] = __expf(l[j]) * h[j] + u[j]; } }
        }
        float* o1 = SL + (size_t)ch * 1024 + c0; float* o2 = HH + (size_t)ch * 1024 + c0;
        *(f32x4*)o1 = (f32x4){sl[0], sl[1], sl[2], sl[3]}; *(f32x4*)(o1 + 4) = (f32x4){sl[4], sl[5], sl[6], sl[7]};
        *(f32x4*)o2 = (f32x4){h[0], h[1], h[2], h[3]}; *(f32x4*)(o2 + 4) = (f32x4){h[4], h[5], h[6], h[7]};
    }
}
__device__ __forceinline__ void phase_lru_b(const Ctx cx, const Params& p, const float* SL, const float* HH, float* CIN) {
    for (int item = cx.bid * NTHREADS + cx.tid; item < 24 * 1024; item += cx.nblk * NTHREADS) {
        const int chn = item & 1023, seq = item >> 10;
        const int nch = seq < 16 ? 64 : 8, ch0 = seq < 16 ? seq * 64 : 1024 + (seq - 16) * 8;
        float c = seq < 16 ? 0.f : IN(p, I_ST_LRU)[(seq - 16) * 1024 + chn];
        for (int i0 = 0; i0 < nch; i0 += 16) {
            float sl[16], hh[16];
#pragma unroll
            for (int i = 0; i < 16; ++i) if (i0 + i < nch) { sl[i] = SL[(size_t)(ch0 + i0 + i) * 1024 + chn]; hh[i] = HH[(size_t)(ch0 + i0 + i) * 1024 + chn]; }
#pragma unroll
            for (int i = 0; i < 16; ++i) if (i0 + i < nch) { CIN[(size_t)(ch0 + i0 + i) * 1024 + chn] = c; c = __expf(sl[i]) * c + hh[i]; }
        }
        (seq < 16 ? P_OUT(p) + O_P_LRU + seq * 1024 : P_OUT(p) + O_S_LRU + (seq - 16) * 1024)[chn] = c;
    }
}
__device__ __forceinline__ void phase_lru_c(const Ctx cx, const bf16_t* LA, const bf16_t* UU, const float* CIN, bf16_t* GATE) {
    const int total = 1088 * 128;
    for (int item = cx.bid * NTHREADS + cx.tid; item < total; item += cx.nblk * NTHREADS) {
        const int cgi = item & 127, ch = item >> 7, c0 = cgi * 8; const size_t r0 = ch < 1024 ? (size_t)ch * 64 : (size_t)TP + (size_t)(ch - 1024) * 8; const int nr = ch < 1024 ? 64 : 8;
        float h[8];
        { const float* ci = CIN + (size_t)ch * 1024 + c0; const f32x4 a = *(const f32x4*)ci, b = *(const f32x4*)(ci + 4);
#pragma unroll
          for (int j = 0; j < 4; ++j) { h[j] = a[j]; h[4 + j] = b[j]; } }
        for (int i0 = 0; i0 < nr; i0 += 8) {
            u32x4 la[8], uu[8], gt[8];
#pragma unroll
            for (int i = 0; i < 8; ++i) { la[i] = *(const u32x4*)(LA + (r0 + i0 + i) * 1024 + c0); uu[i] = *(const u32x4*)(UU + (r0 + i0 + i) * 1024 + c0); gt[i] = *(const u32x4*)(GATE + (r0 + i0 + i) * 1024 + c0); }
#pragma unroll
            for (int i = 0; i < 8; ++i) { float l[8], u[8], gq[8], o[8]; unpack8(la[i], l); unpack8(uu[i], u); unpack8(gt[i], gq);
#pragma unroll
                for (int j = 0; j < 8; ++j) { h[j] = __expf(l[j]) * h[j] + u[j]; o[j] = gq[j] * h[j]; }
                *(u32x4*)(GATE + (r0 + i0 + i) * 1024 + c0) = pack8(o); }
        }
    }
}

#define XB_TMO      128
#define XB_XCNT(j)  (256  + 64 * (j))
#define XB_XSUB(j)  (1280 + 64 * (j))
#define XB_XGEN(j)  (2304 + 64 * (j))
#define XB_TOP      3328
#define XB_TOPGEN   3392
#define XCD_BAR_WORDS 3456
#define XB_SPIN_CAP (1u << 18)
__device__ __forceinline__ unsigned xb_ld(unsigned* p)              { return __hip_atomic_load(p, __ATOMIC_RELAXED, __HIP_MEMORY_SCOPE_AGENT); }
__device__ __forceinline__ unsigned xb_add(unsigned* p, unsigned v) { return __hip_atomic_fetch_add(p, v, __ATOMIC_RELAXED, __HIP_MEMORY_SCOPE_AGENT); }
__device__ __forceinline__ unsigned xb_xcc_id() { return (unsigned)__builtin_amdgcn_s_getreg((3 << 11) | 20) & 0xFu; }
#define XB_SPIN(cond, bar) do { unsigned _sp = 0; while (cond) { __builtin_amdgcn_s_sleep(1); \
    if ((++_sp & 255u) == 0u) { if (xb_ld(&(bar)[XB_TMO])) break; if (_sp > XB_SPIN_CAP) { atomicAdd(&(bar)[XB_TMO], 1u); break; } } } } while (0)
struct XcdBarrier { unsigned* bar; unsigned x; volatile LAS unsigned* st; };
__device__ __forceinline__ XcdBarrier xcd_barrier_post(unsigned* bar, volatile LAS unsigned* st) {
    XcdBarrier b; b.bar = bar; b.x = xb_xcc_id(); b.st = st;
    if (threadIdx.x == 0) (void)xb_add(&bar[XB_XCNT(b.x)], 1u);
    return b;
}
__device__ __forceinline__ void xcd_barrier_complete(unsigned* bar, unsigned x, unsigned& nloc, unsigned& nx) {
    const unsigned G = gridDim.x * gridDim.y * gridDim.z;
    unsigned sum, cnt, mine, sp = 0u;
    for (;;) {
        sum = 0u; cnt = 0u; mine = 0u;
#pragma unroll
        for (unsigned j = 0; j < 16; ++j) { const unsigned c = xb_ld(&bar[XB_XCNT(j)]); sum += c; cnt += (c > 0u) ? 1u : 0u; mine = (j == x) ? c : mine; }
        if (sum == G) break;
        __builtin_amdgcn_s_sleep(1);
        if ((++sp & 255u) == 0u) { if (xb_ld(&bar[XB_TMO])) break; if (sp > XB_SPIN_CAP) { atomicAdd(&bar[XB_TMO], 1u); break; } }
    }
    nloc = mine > 0u ? mine : 1u; nx = cnt > 0u ? cnt : 1u;
}
__device__ __forceinline__ void xcd_barrier(const XcdBarrier& b) {
    asm volatile("s_waitcnt vmcnt(0)" ::: "memory");
    __syncthreads();
    if (threadIdx.x == 0) {
        unsigned* bar = b.bar;
        __builtin_amdgcn_s_waitcnt(0);
        unsigned nloc = b.st[0], nx = b.st[1];
        if (nloc == 0u) { xcd_barrier_complete(bar, b.x, nloc, nx); b.st[0] = nloc; b.st[1] = nx; }
        const unsigned old = xb_add(&bar[XB_XSUB(b.x)], 1u);
        const unsigned gen = old / nloc;
        if (old + 1u == (gen + 1u) * nloc) {
            __builtin_amdgcn_fence(__ATOMIC_RELEASE, "agent");
            asm volatile("s_waitcnt vmcnt(0)" ::: "memory");
            const unsigned og = xb_add(&bar[XB_TOP], 1u);
            const unsigned tg = og / nx;
            if (og + 1u == (tg + 1u) * nx) xb_add(&bar[XB_TOPGEN], 1u);
            else XB_SPIN(xb_ld(&bar[XB_TOPGEN]) == tg, bar);
            __builtin_amdgcn_fence(__ATOMIC_ACQUIRE, "agent");
            xb_add(&bar[XB_XGEN(b.x)], 1u);
            asm volatile("s_waitcnt vmcnt(0)" ::: "memory");
        } else {
            XB_SPIN(xb_ld(&bar[XB_XGEN(b.x)]) == gen, bar);
            __builtin_amdgcn_fence(__ATOMIC_ACQUIRE, "agent");
            asm volatile("s_waitcnt vmcnt(0)" ::: "memory");
        }
    }
    __syncthreads();
}

constexpr int NPHASE = 23;
__device__ __forceinline__ void run_phase(const Params& p, int ph, LAS unsigned char* lds) {
    Ctx cx; { int b = blockIdx.x, n = gridDim.x, t = threadIdx.x; asm volatile("" : "+s"(b), "+s"(n), "+v"(t)); cx.bid = b; cx.nblk = n; cx.tid = t; }
    unsigned char* ws = P_WS(p);
    bf16_t* XN = (bf16_t*)(ws + WS_XN);
    float* Y = P_OUT(p) + O_Y;
    float* SSQ = (float*)(ws + WS_SSQ);
    switch (ph) {
    case 0: phase_prep(cx, p, lds, 0, 92 * 16, cx.bid, cx.nblk, true); phase_norm(cx, IN(p, I_XP), IN(p, I_XS), XN); break;
    case 1: { Gemm g{XN, (const bf16_t*)(ws + WS_W1), T, N1, 1024, 1024, 0, 0};
        EpiG1 e{(bf16_t*)(ws + WS_A2), (bf16_t*)(ws + WS_XBCP), (bf16_t*)(ws + WS_V), (float*)(ws + WS_DT), IN(p, I_DT_BIAS)};
        gemm_phase<EpiG1, false>(cx, lds, g, e, nullptr);
        const int nt1 = (T / BM) * (N1 / BM), nlate = nt1 % cx.nblk;
        if (cx.bid >= nlate) phase_prep(cx, p, lds, 92 * 16, 1 << 30, cx.bid - nlate, cx.nblk - nlate, false); } break;
    case 2:
        phase_conv<4, 0>(cx, (const bf16_t*)(ws + WS_XBCP), XBC, XBC, IN(p, I_SSD_CONVW), IN(p, I_SSD_CONVB), (bf16_t*)(ws + WS_XBCA), XBC, IN(p, I_ST_SSDCONV), P_OUT(p) + O_P_SSDCONV, P_OUT(p) + O_S_SSDCONV);
        phase_conv<3, 1>(cx, (const bf16_t*)(ws + WS_V), 1024, 1024, IN(p, I_SC_CONVW), IN(p, I_SC_CONVB), (bf16_t*)(ws + WS_A2) + 1024, 2048, IN(p, I_ST_SCONV), P_OUT(p) + O_P_SCONV, P_OUT(p) + O_S_SCONV);
        break;
    case 3: phase_ssd(cx, p, lds); break;
    case 4: { Gemm g{(const bf16_t*)(ws + WS_A2), (const bf16_t*)(ws + WS_W2), T, 1024, 2048, 2048, 0, 0};
        EpiRes<true> e{IN(p, I_XP), IN(p, I_XS), XN, SSQ + T};
        gemm_phase<EpiRes<true>, true, true>(cx, lds, g, e, SSQ, (float*)(ws + WS_SLAB)); } break;
    case 30: phase_split_finish<true, true>(cx, (const float*)(ws + WS_SLAB), 8, IN(p, I_XS), XN, SSQ + T, SSQ); break;
    case 5: case 15: { const int l = ph == 5 ? 0 : 1;
        Gemm g{XN, (const bf16_t*)(ws + WS_W3) + (size_t)l * 5632 * 1024, T, 5632, 1024, 1024, 0, 0};
        EpiFfnFused e{(bf16_t*)(ws + WS_H), (bf16_t*)(ws + WS_GH), (bf16_t*)(ws + WS_GT), (bf16_t*)(ws + WS_UH), SSQ + (l == 0 ? T : 3 * T), IN(p, I_FFN_CONVW) + l * 3 * DFF, IN(p, I_FFN_CONVB) + l * DFF};
        gemm_phase<EpiFfnFused, false>(cx, lds, g, e, nullptr); } break;
    case 6: case 16: { const int l = ph == 6 ? 0 : 1;
        phase_ffn_fix(cx, (const bf16_t*)(ws + WS_GH), (const bf16_t*)(ws + WS_GT), (const bf16_t*)(ws + WS_UH), (bf16_t*)(ws + WS_H), IN(p, I_FFN_CONVW) + l * 3 * DFF, IN(p, I_FFN_CONVB) + l * DFF,
                      IN(p, I_ST_FFNCONV) + l * 8 * 2 * DFF, P_OUT(p) + O_P_FFNCONV + l * 16 * 2 * DFF, P_OUT(p) + O_S_FFNCONV + l * 8 * 2 * DFF); } break;
    case 7: case 17: { const int l = ph == 7 ? 0 : 1;
        Gemm g{(const bf16_t*)(ws + WS_H), (const bf16_t*)(ws + WS_W4) + (size_t)l * 1024 * DFF, T, 1024, DFF, DFF, 0, 0};
        EpiRes<false> e{nullptr, nullptr, XN, SSQ + (l == 0 ? 2 * T : 4 * T)};
        gemm_phase<EpiRes<false>, false, true>(cx, lds, g, e, nullptr, (float*)(ws + WS_SLAB)); } break;
    case 31: phase_split_finish<false, false>(cx, (const float*)(ws + WS_SLAB), 11, nullptr, XN, SSQ + 2 * T, nullptr); break;
    case 33: phase_split_finish<false, false>(cx, (const float*)(ws + WS_SLAB), 11, nullptr, XN, SSQ + 4 * T, nullptr); break;
    case 8: { Gemm g{XN, (const bf16_t*)(ws + WS_W5), T, 2048, 1024, 1024, 0, 0};
        EpiLruIn e{(bf16_t*)(ws + WS_GATE), (bf16_t*)(ws + WS_XBP), SSQ + 2 * T};
        gemm_phase<EpiLruIn, false>(cx, lds, g, e, nullptr); } break;
    case 9: phase_conv<4, 3>(cx, (const bf16_t*)(ws + WS_XBP), 1024, 1024, IN(p, I_LRU_CONVW), IN(p, I_LRU_CONVB), (bf16_t*)(ws + WS_XBC2), 1024, IN(p, I_ST_LRUCONV), P_OUT(p) + O_P_LRUCONV, P_OUT(p) + O_S_LRUCONV); break;
    case 10: { Gemm g{(const bf16_t*)(ws + WS_XBC2), (const bf16_t*)(ws + WS_W6), T, 2048, 256, 1024, 1, 256};
        EpiLruGate e{(const bf16_t*)(ws + WS_XBC2), (bf16_t*)(ws + WS_LA), (bf16_t*)(ws + WS_UU), IN(p, I_LRU_BA), IN(p, I_LRU_BX), (const float*)(ws + WS_SP)};
        gemm_phase<EpiLruGate, false>(cx, lds, g, e, nullptr); } break;
    case 11: phase_lru_a(cx, (const bf16_t*)(ws + WS_LA), (const bf16_t*)(ws + WS_UU), (float*)(ws + WS_SL), (float*)(ws + WS_HH)); break;
    case 12: phase_lru_b(cx, p, (const float*)(ws + WS_SL), (const float*)(ws + WS_HH), (float*)(ws + WS_CIN)); break;
    case 13: phase_lru_c(cx, (const bf16_t*)(ws + WS_LA), (const bf16_t*)(ws + WS_UU), (const float*)(ws + WS_CIN), (bf16_t*)(ws + WS_GATE)); break;
    case 14: { Gemm g{(const bf16_t*)(ws + WS_GATE), (const bf16_t*)(ws + WS_W7), T, 1024, 1024, 1024, 0, 0};
        EpiRes<false> e{nullptr, nullptr, XN, SSQ + 3 * T};
        gemm_phase<EpiRes<false>, false, true>(cx, lds, g, e, nullptr, (float*)(ws + WS_SLAB)); } break;
    case 32: phase_split_finish<false, false>(cx, (const float*)(ws + WS_SLAB), 4, nullptr, XN, SSQ + 3 * T, nullptr); break;
    case 18: phase_final_norm(cx, XN, SSQ + 4 * T, IN(p, I_NORM_FINAL), Y); break;
    default: break;
    }
}

__global__ void __launch_bounds__(NTHREADS, 2) fwd_mega(Params p, int ph_lo, int ph_hi) {
    extern __shared__ __attribute__((aligned(16))) unsigned char smem[];
    LAS unsigned char* lds = (LAS unsigned char*)smem;
    cg::grid_group grid = cg::this_grid();
    volatile LAS unsigned* bst = (volatile LAS unsigned*)(lds + 131072 + 1024);
    if (threadIdx.x == 0) { bst[0] = 0u; bst[1] = 0u; }
    __syncthreads();
    const XcdBarrier xb = xcd_barrier_post((unsigned*)(IN(p, 35)) + WS_BAR / 4, bst);
#ifndef PROBE_K
#define PROBE_K -1
#endif
    bool first = true;
    for (int i = ph_lo; i < ph_hi; ++i) {
        int ph = i;
        if (i >= 5) ph = (i == 5) ? 30 : (i <= 8) ? i - 1 : (i == 9) ? 31 : (i <= 16) ? i - 2 : (i == 17) ? 32 : (i <= 20) ? i - 3 : (i == 21) ? 33 : 18;
        run_phase(p, ph, lds);
        if (i + 1 < ph_hi) { if (first) { grid.sync(); first = false; } else xcd_barrier(xb); }
    }
}

extern "C" void kernel_launch(void* const* d_in, const int* in_sizes, int n_in, void* d_out, int out_size, void* d_ws, size_t ws_size, hipStream_t stream) {
    static int grid = 0;
    if (grid == 0) {
        if (n_in != 34 || (size_t)out_size != O_END || ws_size < WS_NEED) { fprintf(stderr, "kernel_launch: unexpected shapes (n_in %d out %d ws %zu need %zu)\n", n_in, out_size, ws_size, (size_t)WS_NEED); grid = -1; return; }
        int dev = 0, cus = 0, per_cu = 0;
        (void)hipGetDevice(&dev); (void)hipDeviceGetAttribute(&cus, hipDeviceAttributeMultiprocessorCount, dev);
        if (hipFuncSetAttribute((const void*)fwd_mega, hipFuncAttributeMaxDynamicSharedMemorySize, LDS_BYTES) != hipSuccess) { fprintf(stderr, "kernel_launch: hipFuncSetAttribute failed\n"); grid = -1; return; }
        if (hipOccupancyMaxActiveBlocksPerMultiprocessor(&per_cu, (const void*)fwd_mega, NTHREADS, LDS_BYTES) != hipSuccess || per_cu < 1) { fprintf(stderr, "kernel_launch: occupancy query says %d\n", per_cu); per_cu = 1; }
        (void)hipGetLastError();
        grid = cus;
    }
    if (grid < 0) return;
    (void)hipMemsetAsync((unsigned char*)d_ws + WS_BAR, 0, 16384, stream);
    Params p{};
    for (int i = 0; i < 34; ++i) p.ptr[i] = (const float*)d_in[i];
    p.ptr[34] = (const float*)d_out; p.ptr[35] = (const float*)d_ws;
    int lo = 0, hi = NPHASE; void* args[] = {&p, &lo, &hi};
    hipError_t e = hipLaunchCooperativeKernel((const void*)fwd_mega, dim3(grid), dim3(NTHREADS), args, LDS_BYTES, stream);
    if (e != hipSuccess) fprintf(stderr, "cooperative launch failed: %s (grid %d)\n", hipGetErrorString(e), grid);
}
```

```cpp
#include <hip/hip_runtime.h>
#include <hip/hip_cooperative_groups.h>
#include <cstdio>
namespace cg = cooperative_groups;

#define LAS __attribute__((address_space(3)))
typedef unsigned short bf16_t;
typedef short bf16x8 __attribute__((ext_vector_type(8)));
typedef float f32x4 __attribute__((ext_vector_type(4)));
typedef unsigned u32x4 __attribute__((ext_vector_type(4)));
typedef unsigned u32x2 __attribute__((ext_vector_type(2)));

constexpr int TP = 65536;
constexpr int TS = 512;
constexpr int T = TP + TS;
constexpr int DM = 1024;
constexpr int DFF = 2816;
constexpr int XBC = 1536;
constexpr int N1 = 5888;
constexpr float EPS = 1e-6f;
constexpr int NTHREADS = 512;
constexpr int LDS_BYTES = 131072 + 4096;

constexpr size_t O_Y = 0;
constexpr size_t O_P_SSDCONV = (size_t)T * DM;
constexpr size_t O_P_SSD = O_P_SSDCONV + 16 * 3 * XBC;
constexpr size_t O_P_SCONV = O_P_SSD + (size_t)16 * 16 * 64 * 128;
constexpr size_t O_P_LRUCONV = O_P_SCONV + 16 * 2 * 1024;
constexpr size_t O_P_LRU = O_P_LRUCONV + 16 * 3 * 1024;
constexpr size_t O_P_FFNCONV = O_P_LRU + 16 * 1024;
constexpr size_t O_S_SSDCONV = O_P_FFNCONV + 2 * 16 * 2 * DFF;
constexpr size_t O_S_SSD = O_S_SSDCONV + 8 * 3 * XBC;
constexpr size_t O_S_SCONV = O_S_SSD + (size_t)8 * 16 * 64 * 128;
constexpr size_t O_S_LRUCONV = O_S_SCONV + 8 * 2 * 1024;
constexpr size_t O_S_LRU = O_S_LRUCONV + 8 * 3 * 1024;
constexpr size_t O_S_FFNCONV = O_S_LRU + 8 * 1024;
constexpr size_t O_END = O_S_FFNCONV + 2 * 8 * 2 * DFF;

constexpr size_t al256(size_t x) { return (x + 255) & ~(size_t)255; }
constexpr size_t WS_W1 = 0;
constexpr size_t WS_W2 = WS_W1 + (size_t)N1 * 1024 * 2;
constexpr size_t WS_W3 = WS_W2 + (size_t)1024 * 2048 * 2;
constexpr size_t WS_W4 = WS_W3 + (size_t)2 * 5632 * 1024 * 2;
constexpr size_t WS_W5 = WS_W4 + (size_t)2 * 1024 * 2816 * 2;
constexpr size_t WS_W6 = WS_W5 + (size_t)2048 * 1024 * 2;
constexpr size_t WS_W7 = WS_W6 + (size_t)2048 * 256 * 2;
constexpr size_t WS_SP = WS_W7 + (size_t)1024 * 1024 * 2;
constexpr size_t WS_BAR = WS_SP + 4096;
constexpr size_t WS_SSQ = WS_BAR + 16384;
constexpr size_t WS_SL = al256(WS_SSQ + (size_t)5 * T * 4);
constexpr size_t WS_HH = WS_SL + (size_t)1088 * 1024 * 4;
constexpr size_t WS_CIN = WS_HH + (size_t)1088 * 1024 * 4;
constexpr size_t WS_SLAB = al256(WS_CIN + (size_t)1088 * 1024 * 4);
constexpr size_t WS_XN = al256(WS_SLAB + (size_t)88 * 65536 * 4);
constexpr size_t WS_ARENA = al256(WS_XN + (size_t)T * 1024 * 2);
constexpr size_t WS_A2 = WS_ARENA;
constexpr size_t WS_XBCP = WS_A2 + (size_t)T * 2048 * 2;
constexpr size_t WS_XBCA = WS_XBCP + (size_t)T * XBC * 2;
constexpr size_t WS_V = WS_XBCA + (size_t)T * XBC * 2;
constexpr size_t WS_DT = WS_V + (size_t)T * 1024 * 2;
constexpr size_t WS_END0 = WS_DT + (size_t)T * 16 * 4;
constexpr size_t WS_H = WS_ARENA;
constexpr size_t WS_GH = WS_H + (size_t)T * DFF * 2;
constexpr size_t WS_GT = WS_GH + (size_t)1032 * 2 * DFF * 2;
constexpr size_t WS_UH = WS_GT + (size_t)1032 * 2 * DFF * 2;
constexpr size_t WS_END1 = WS_UH + (size_t)1032 * 2 * DFF * 2;
constexpr size_t WS_GATE = WS_ARENA;
constexpr size_t WS_XBP = WS_GATE + (size_t)T * 1024 * 2;
constexpr size_t WS_XBC2 = WS_XBP + (size_t)T * 1024 * 2;
constexpr size_t WS_LA = WS_XBC2 + (size_t)T * 1024 * 2;
constexpr size_t WS_UU = WS_LA + (size_t)T * 1024 * 2;
constexpr size_t WS_END2 = WS_UU + (size_t)T * 1024 * 2;
constexpr size_t WS_NEED = WS_END0 > WS_END1 ? (WS_END0 > WS_END2 ? WS_END0 : WS_END2) : (WS_END1 > WS_END2 ? WS_END1 : WS_END2);

struct Params {
    const float* ptr[36];
};
__device__ __forceinline__ const float* IN(const Params& p, int i) { asm volatile("" : "+s"(i)); return p.ptr[i]; }
#define P_OUT(p) ((float*)IN(p, 34))
#define P_WS(p) ((unsigned char*)IN(p, 35))
enum { I_XP = 0, I_XS, I_ST_SSDCONV, I_ST_SSD, I_ST_SCONV, I_ST_LRUCONV, I_ST_LRU, I_ST_FFNCONV, I_NORM_MIX, I_NORM_FFN, I_NORM_FINAL,
       I_AB_WIN, I_SSD_CONVW, I_SSD_CONVB, I_DT_BIAS, I_A_LOG, I_SSD_D, I_SSD_NORM, I_SC_CONVW, I_SC_CONVB, I_AB_WOUT, I_LRU_WIN,
       I_LRU_CONVW, I_LRU_CONVB, I_LRU_WA, I_LRU_BA, I_LRU_WX, I_LRU_BX, I_LRU_LAMBDA, I_LRU_WOUT, I_FFN_WIN, I_FFN_CONVW, I_FFN_CONVB, I_FFN_WOUT };

struct Ctx { int bid, nblk, tid; };
__device__ __forceinline__ unsigned cvt_pk_bf16(float lo, float hi) { unsigned r; asm("v_cvt_pk_bf16_f32 %0, %1, %2" : "=v"(r) : "v"(lo), "v"(hi)); return r; }
__device__ __forceinline__ float bf_lo(unsigned w) { return __uint_as_float(w << 16); }
__device__ __forceinline__ float bf_hi(unsigned w) { return __uint_as_float(w & 0xffff0000u); }
__device__ __forceinline__ float sigmoidf_(float x) { return __builtin_amdgcn_rcpf(1.0f + __expf(-x)); }
__device__ __forceinline__ float siluf_(float x) { return x * __builtin_amdgcn_rcpf(1.0f + __expf(-x)); }
__device__ __forceinline__ float geluf_(float x) { const float u = x * (1.5957691216f + 0.0713548163f * x * x); return x * __builtin_amdgcn_rcpf(1.0f + __builtin_amdgcn_exp2f(-1.4426950409f * u)); }
__device__ __forceinline__ float softplusf_(float x) { return fmaxf(x, 0.0f) + log1pf(__expf(-fabsf(x))); }
__device__ __forceinline__ void unpack8(const u32x4 w, float (&f)[8]) {
    f[0] = bf_lo(w.x); f[1] = bf_hi(w.x); f[2] = bf_lo(w.y); f[3] = bf_hi(w.y); f[4] = bf_lo(w.z); f[5] = bf_hi(w.z); f[6] = bf_lo(w.w); f[7] = bf_hi(w.w);
}
__device__ __forceinline__ u32x4 pack8(const float (&f)[8]) {
    u32x4 w; w.x = cvt_pk_bf16(f[0], f[1]); w.y = cvt_pk_bf16(f[2], f[3]); w.z = cvt_pk_bf16(f[4], f[5]); w.w = cvt_pk_bf16(f[6], f[7]); return w;
}
__device__ __forceinline__ u32x4 pack44(const f32x4 a, const f32x4 b) {
    u32x4 w; w.x = cvt_pk_bf16(a[0], a[1]); w.y = cvt_pk_bf16(a[2], a[3]); w.z = cvt_pk_bf16(b[0], b[1]); w.w = cvt_pk_bf16(b[2], b[3]); return w;
}

constexpr int BM = 256, BK = 64, HALF = 128, HTB = HALF * BK * 2, NXCD = 8, WGM = 4;
__device__ __forceinline__ int lds_byte(int r, int c) { const int st = (r >> 4) * 2 + (c >> 5), rr = r & 15, cc = c & 31, ob = rr * 64 + cc * 2; return st * 1024 + (ob ^ (((ob >> 9) & 1) << 5)); }
__device__ __forceinline__ void stage_rc(int b, int& R, int& C) { const int st = b / 1024, sb = b % 1024, swz = sb ^ (((sb >> 9) & 1) << 5); R = (st >> 1) * 16 + swz / 64; C = (st & 1) * 32 + (swz % 64) / 2; }
__device__ __forceinline__ int perm32(int rho) { const int n = rho >> 4, i = rho & 15; return 8 * (i >> 2) + 4 * n + (i & 3); }

struct Unit { int pm, pn, kt0, nkt, slab; };
struct Gemm { const bf16_t* A; const bf16_t* Bt; int M, N, K, lda, a_shift, a_koff; };

struct StaticOrder {
    int nM, nN, nwg, G, c, nt, nsplit, ntail;
    __device__ void init(int M, int N, int G_, int c_, int nt_, bool split) { nM = M / BM; nN = N / BM; G = G_; c = c_; nt = nt_; nsplit = 0; ntail = 0;
        if (split) { nM = TP / BM; nsplit = nt / 4; ntail = 2 * nN * nsplit; } nwg = nM * nN; }
    __device__ bool next(int i, Unit& u) const {
        const long L = (long)i * G + c;
        if (L >= nwg) { const int t = (int)(L - nwg); if (t >= ntail) return false;
            const int tile = t / nsplit, piece = t - tile * nsplit; u.pm = TP / BM + tile / nN; u.pn = tile % nN; u.kt0 = piece * 4; u.nkt = 4; u.slab = t; return true; }
        int wgid = (int)L; { const int q = nwg / NXCD, r = nwg % NXCD, xcd = wgid % NXCD, off = wgid / NXCD; wgid = (xcd < r ? xcd * (q + 1) : r * (q + 1) + (xcd - r) * q) + off; }
        const int nig = WGM * nN, gid = wgid / nig, fm = gid * WGM, gsz = (nM - fm) < WGM ? (nM - fm) : WGM;
        u.pm = fm + ((wgid % nig) % gsz); u.pn = (wgid % nig) / gsz; u.kt0 = 0; u.nkt = nt; u.slab = -1; return true;
    }
};

template <class Epi, bool MIDSCALE, bool SPLIT = false>
__device__ __forceinline__ void gemm_phase(const Ctx cx, LAS unsigned char* lds, const Gemm g, const Epi& E, const float* ssq, float* slabs = nullptr) {
    const int tid = cx.tid, wid = __builtin_amdgcn_readfirstlane(tid >> 6), lane = tid & 63, wr = wid >> 2, wc = wid & 3, fr = lane & 15, fq = lane >> 4;
    int K_ = g.K; asm volatile("" : "+s"(K_));
    const int K = K_, nt = K / BK;
    StaticOrder S; S.init(g.M, g.N, cx.nblk, cx.bid, nt, SPLIT);
    unsigned voffA[2], voffB[2];
#pragma unroll
    for (int i = 0; i < 2; ++i) { int R, C; stage_rc(tid * 16 + i * 8192, R, C); const int Rb = Epi::PERM ? ((R & ~31) + perm32(R & 31)) : R;
        voffA[i] = (unsigned)(R * g.lda + C) * 2u; voffB[i] = (unsigned)(Rb * K + C) * 2u; }
    const size_t kstep = (size_t)(BK * 2);
    const size_t hsA = (size_t)HALF * g.lda * 2, hsB = (size_t)HALF * K * 2;
    const size_t tsA = 2 * hsA, tsB = 2 * hsB;
    const unsigned ldsw = (unsigned)wid * 1024u;
    const int aoff = lds_byte(wr * 64 + fr, fq * 8), boff = lds_byte(wc * 32 + fr, fq * 8);
#define SA_(b, h) (((b) * 2 + (h)) * HTB)
#define SB_(b, h) ((4 + (b) * 2 + (h)) * HTB)
#define STAGE_(bufoff, gbase, voff) do { _Pragma("unroll") for (int _i = 0; _i < 2; ++_i) \
        __builtin_amdgcn_global_load_lds((const unsigned*)((const char*)(gbase) + (voff)[_i]), (LAS unsigned*)(lds + (bufoff) + ldsw + _i * 8192), 16, 0, 0); } while (0)
#define LDA_(dst, b, h) do { _Pragma("unroll") for (int m = 0; m < 4; ++m) _Pragma("unroll") for (int k = 0; k < 2; ++k) dst[m][k] = *(const LAS bf16x8*)(lds + SA_(b, h) + aoff + m * 2048 + k * 1024); } while (0)
#define LDB_(dst, b, h) do { _Pragma("unroll") for (int n = 0; n < 2; ++n) _Pragma("unroll") for (int k = 0; k < 2; ++k) dst[n][k] = *(const LAS bf16x8*)(lds + SB_(b, h) + boff + n * 2048 + k * 1024); } while (0)
#define MMA_(ai, bj, At, Bt) do { __builtin_amdgcn_s_setprio(1); _Pragma("unroll") for (int m = 0; m < 4; ++m) _Pragma("unroll") for (int n = 0; n < 2; ++n) _Pragma("unroll") for (int k = 0; k < 2; ++k) \
        acc[ai][bj][m][n] = __builtin_amdgcn_mfma_f32_16x16x32_bf16(Bt[n][k], At[m][k], acc[ai][bj][m][n], 0, 0, 0); __builtin_amdgcn_s_setprio(0); } while (0)
#define WAIT_V_(n) asm volatile("s_waitcnt vmcnt(" #n ")" ::: "memory")
#define WAIT_L_(n) asm volatile("s_waitcnt lgkmcnt(" #n ")" ::: "memory")
#define BAR_ __builtin_amdgcn_s_barrier()
#define SCHED_ __builtin_amdgcn_sched_barrier(0)
#ifndef STAGGER
#define STAGGER 0
#endif
    if (STAGGER && (cx.bid & 8)) {
        const unsigned long long t0 = __builtin_amdgcn_s_memrealtime(); const unsigned long long dl = 800ull;
        while (__builtin_amdgcn_s_memrealtime() - t0 < dl) __builtin_amdgcn_s_sleep(8);
    }
    Unit cur, nxt; int ui = 0;
    if (!S.next(0, cur)) return;
    f32x4 acc[2][2][4][2];
#pragma unroll
    for (int a = 0; a < 2; ++a)
#pragma unroll
        for (int b = 0; b < 2; ++b)
#pragma unroll
            for (int m = 0; m < 4; ++m)
#pragma unroll
                for (int n = 0; n < 2; ++n) acc[a][b][m][n] = (f32x4){0.f, 0.f, 0.f, 0.f};
    bf16x8 At[4][2], B0[2][2], B1[2][2];
    const char* cA = (const char*)g.A + (size_t)cur.pm * tsA + (size_t)((cur.pn >> g.a_shift) * g.a_koff) * 2 + (size_t)cur.kt0 * kstep;
    const char* cB = (const char*)g.Bt + (size_t)cur.pn * tsB + (size_t)cur.kt0 * kstep;
    STAGE_(SB_(0, 0), cB, voffB); STAGE_(SA_(0, 0), cA, voffA); STAGE_(SB_(0, 1), cB + hsB, voffB); STAGE_(SA_(0, 1), cA + hsA, voffA);
    if (wr == 1) BAR_;
    WAIT_V_(4); BAR_;
    STAGE_(SB_(1, 0), cB + kstep, voffB); STAGE_(SA_(1, 0), cA + kstep, voffA); STAGE_(SB_(1, 1), cB + hsB + kstep, voffB);
    WAIT_V_(6); BAR_;
    for (;;) {
        const bool has_next = S.next(ui + 1, nxt);
        const char* nA = has_next ? (const char*)g.A + (size_t)nxt.pm * tsA + (size_t)((nxt.pn >> g.a_shift) * g.a_koff) * 2 + (size_t)nxt.kt0 * kstep : cA;
        const char* nB = has_next ? (const char*)g.Bt + (size_t)nxt.pn * tsB + (size_t)nxt.kt0 * kstep : cB;
        const int cnt = cur.nkt;
        for (int t = 0; t < cnt; t += 2) {
            const bool last = (t == cnt - 2);
            const char* a1 = cA + (size_t)(t + 1) * kstep;
            const char* a2 = last ? nA : cA + (size_t)(t + 2) * kstep; const char* b2 = last ? nB : cB + (size_t)(t + 2) * kstep;
            const char* a3 = a2 + kstep; const char* b3 = b2 + kstep;
            if (MIDSCALE && t == 16 && cur.slab < 0) {
                int rb = cur.pm * BM + wr * 64 + fr; asm volatile("" : "+v"(rb));
#pragma unroll
                for (int ai = 0; ai < 2; ++ai)
#pragma unroll
                    for (int m = 0; m < 4; ++m) {
                        const float sc = rsqrtf(ssq[rb + ai * HALF + m * 16] * (1.0f / 1024.0f) + EPS);
#pragma unroll
                        for (int bj = 0; bj < 2; ++bj)
#pragma unroll
                            for (int n = 0; n < 2; ++n) acc[ai][bj][m][n] *= sc;
                    }
            }
            LDB_(B0, 0, 0); SCHED_; LDA_(At, 0, 0); STAGE_(SA_(1, 1), a1 + hsA, voffA);
            WAIT_L_(8); BAR_; WAIT_L_(0); MMA_(0, 0, At, B0); BAR_; SCHED_;
            LDB_(B1, 0, 1); STAGE_(SB_(0, 0), b2, voffB);
            BAR_; WAIT_L_(0); MMA_(0, 1, At, B1); BAR_;
            LDA_(At, 0, 1); STAGE_(SA_(0, 0), a2, voffA);
            BAR_; WAIT_L_(0); MMA_(1, 0, At, B0); BAR_; SCHED_;
            STAGE_(SB_(0, 1), b2 + hsB, voffB);
            WAIT_V_(6); BAR_; MMA_(1, 1, At, B1); BAR_;
            LDB_(B0, 1, 0); SCHED_; LDA_(At, 1, 0); STAGE_(SA_(0, 1), a2 + hsA, voffA);
            WAIT_L_(8); BAR_; WAIT_L_(0); MMA_(0, 0, At, B0); BAR_; SCHED_;
            LDB_(B1, 1, 1); STAGE_(SB_(1, 0), b3, voffB);
            BAR_; WAIT_L_(0); MMA_(0, 1, At, B1); BAR_;
            LDA_(At, 1, 1); STAGE_(SA_(1, 0), a3, voffA);
            BAR_; WAIT_L_(0); MMA_(1, 0, At, B0); BAR_; SCHED_;
            STAGE_(SB_(1, 1), b3 + hsB, voffB);
            WAIT_V_(6); BAR_; MMA_(1, 1, At, B1); BAR_;
        }
        if (SPLIT && cur.slab >= 0) {
            float* sb = slabs + (size_t)cur.slab * 65536 + (size_t)(wr * 64 + fr) * 256 + wc * 32 + 8 * fq;
#pragma unroll
            for (int ai = 0; ai < 2; ++ai)
#pragma unroll
                for (int m = 0; m < 4; ++m)
#pragma unroll
                    for (int bj = 0; bj < 2; ++bj) { float* q = sb + (size_t)(ai * HALF + m * 16) * 256 + bj * HALF; *(f32x4*)q = acc[ai][bj][m][0]; *(f32x4*)(q + 4) = acc[ai][bj][m][1]; }
        } else E(acc, cur, wr, wc, fr, fq);
        if (!has_next) break;
#pragma unroll
        for (int a = 0; a < 2; ++a)
#pragma unroll
            for (int b = 0; b < 2; ++b)
#pragma unroll
                for (int m = 0; m < 4; ++m)
#pragma unroll
                    for (int n = 0; n < 2; ++n) acc[a][b][m][n] = (f32x4){0.f, 0.f, 0.f, 0.f};
        cur = nxt; cA = nA; cB = nB; ++ui;
    }
    WAIT_V_(0);
    if (wr == 0) BAR_;
    BAR_;
#undef SA_
#undef SB_
#undef STAGE_
#undef LDA_
#undef LDB_
#undef MMA_
}

struct EpiG1 {
    static constexpr bool PERM = true;
    bf16_t* A2; bf16_t* XBCP; bf16_t* V; float* DT; const float* dt_bias;
    __device__ __forceinline__ void operator()(const f32x4 (&acc)[2][2][4][2], const Unit& u, int wr, int wc, int fr, int fq) const {
        const int row0 = u.pm * BM + wr * 64 + fr, lc = wc * 32 + 8 * fq;
        if (u.pn < 14) {
            bf16_t* base; int ld, colt;
            if (u.pn < 4) { base = A2; ld = 2048; colt = u.pn * 256; }
            else if (u.pn < 10) { base = XBCP; ld = XBC; colt = (u.pn - 4) * 256; }
            else { base = A2; ld = 2048; colt = 1024 + (u.pn - 10) * 256; }
#pragma unroll
            for (int ai = 0; ai < 2; ++ai)
#pragma unroll
                for (int m = 0; m < 4; ++m) { bf16_t* rowp = base + (size_t)(row0 + ai * HALF + m * 16) * ld + colt + lc;
#pragma unroll
                    for (int bj = 0; bj < 2; ++bj) *(u32x4*)(rowp + bj * HALF) = pack44(acc[ai][bj][m][0], acc[ai][bj][m][1]); }
        } else if (u.pn < 22) {
            const int ch0 = (u.pn - 14) * 128 + lc;
#pragma unroll
            for (int ai = 0; ai < 2; ++ai)
#pragma unroll
                for (int m = 0; m < 4; ++m) { bf16_t* rowp = V + (size_t)(row0 + ai * HALF + m * 16) * 1024 + ch0;
                    *(u32x4*)rowp = pack44(acc[ai][0][m][0] * acc[ai][1][m][0], acc[ai][0][m][1] * acc[ai][1][m][1]); }
        } else {
            if (wc == 0 && fq < 2) {
                const f32x4 b0 = *(const f32x4*)(dt_bias + 8 * fq), b1 = *(const f32x4*)(dt_bias + 8 * fq + 4);
#pragma unroll
                for (int ai = 0; ai < 2; ++ai)
#pragma unroll
                    for (int m = 0; m < 4; ++m) { float* rowp = DT + (size_t)(row0 + ai * HALF + m * 16) * 16 + 8 * fq;
                        f32x4 v0 = acc[ai][0][m][0] + b0, v1 = acc[ai][0][m][1] + b1;
#pragma unroll
                        for (int j = 0; j < 4; ++j) { v0[j] = softplusf_(v0[j]); v1[j] = softplusf_(v1[j]); }
                        *(f32x4*)rowp = v0; *(f32x4*)(rowp + 4) = v1; }
            }
        }
    }
};
template <bool SRC_F32> struct EpiRes {
    static constexpr bool PERM = true;
    const float* xp; const float* xs; bf16_t* XN; float* ssq;
    __device__ __forceinline__ void operator()(const f32x4 (&acc)[2][2][4][2], const Unit& u, int wr, int wc, int fr, int fq) const {
        const int row0 = u.pm * BM + wr * 64 + fr, col0 = u.pn * BM + wc * 32 + 8 * fq;
        if (SRC_F32) {
#pragma unroll
            for (int ai = 0; ai < 2; ++ai) {
                f32x4 old[4][2][2];
#pragma unroll
                for (int m = 0; m < 4; ++m) { const int row = row0 + ai * HALF + m * 16;
                    const float* src = (row < TP ? xp + (size_t)row * DM : xs + (size_t)(row - TP) * DM) + col0;
#pragma unroll
                    for (int bj = 0; bj < 2; ++bj) { old[m][bj][0] = *(const f32x4*)(src + bj * HALF); old[m][bj][1] = *(const f32x4*)(src + bj * HALF + 4); } }
#pragma unroll
                for (int m = 0; m < 4; ++m) { const int row = row0 + ai * HALF + m * 16; bf16_t* xnp = XN + (size_t)row * DM + col0; float sq = 0.f;
#pragma unroll
                    for (int bj = 0; bj < 2; ++bj) { const f32x4 v0 = old[m][bj][0] + acc[ai][bj][m][0], v1 = old[m][bj][1] + acc[ai][bj][m][1];
                        *(u32x4*)(xnp + bj * HALF) = pack44(v0, v1);
                        sq += v0[0] * v0[0] + v0[1] * v0[1] + v0[2] * v0[2] + v0[3] * v0[3] + v1[0] * v1[0] + v1[1] * v1[1] + v1[2] * v1[2] + v1[3] * v1[3]; }
                    sq += __shfl_xor(sq, 16); sq += __shfl_xor(sq, 32);
                    if (fq == 0) atomicAdd(ssq + row, sq); }
            }
        } else {
#pragma unroll
            for (int ai = 0; ai < 2; ++ai) {
                u32x4 old[4][2];
#pragma unroll
                for (int m = 0; m < 4; ++m)
#pragma unroll
                    for (int bj = 0; bj < 2; ++bj) old[m][bj] = *(const u32x4*)(XN + (size_t)(row0 + ai * HALF + m * 16) * DM + col0 + bj * HALF);
#pragma unroll
                for (int m = 0; m < 4; ++m) { const int row = row0 + ai * HALF + m * 16; bf16_t* xnp = XN + (size_t)row * DM + col0; float sq = 0.f;
#pragma unroll
                    for (int bj = 0; bj < 2; ++bj) { const u32x4 w = old[m][bj];
                        const f32x4 v0 = (f32x4){bf_lo(w.x), bf_hi(w.x), bf_lo(w.y), bf_hi(w.y)} + acc[ai][bj][m][0], v1 = (f32x4){bf_lo(w.z), bf_hi(w.z), bf_lo(w.w), bf_hi(w.w)} + acc[ai][bj][m][1];
                        *(u32x4*)(xnp + bj * HALF) = pack44(v0, v1);
                        sq += v0[0] * v0[0] + v0[1] * v0[1] + v0[2] * v0[2] + v0[3] * v0[3] + v1[0] * v1[0] + v1[1] * v1[1] + v1[2] * v1[2] + v1[3] * v1[3]; }
                    sq += __shfl_xor(sq, 16); sq += __shfl_xor(sq, 32);
                    if (fq == 0) atomicAdd(ssq + row, sq); }
            }
        }
    }
};
__device__ __forceinline__ float dpp_ror1(float v) { return __int_as_float(__builtin_amdgcn_update_dpp(0, __float_as_int(v), 0x121, 0xf, 0xf, false)); }
__device__ __forceinline__ float dpp_ror2(float v) { return __int_as_float(__builtin_amdgcn_update_dpp(0, __float_as_int(v), 0x122, 0xf, 0xf, false)); }
struct EpiFfnFused {
    static constexpr bool PERM = true;
    bf16_t* H; bf16_t* GH; bf16_t* GT; bf16_t* UH; const float* ssq; const float* cw; const float* cb;
    __device__ __forceinline__ void operator()(const f32x4 (&acc)[2][2][4][2], const Unit& u, int wr, int wc, int fr, int fq) const {
        const int ch0 = u.pn * 128 + wc * 32 + 8 * fq;
        float w0[8], w1[8], w2[8], bb[8];
#pragma unroll
        for (int h = 0; h < 2; ++h) { const f32x4 a = *(const f32x4*)(cw + ch0 + 4 * h), b = *(const f32x4*)(cw + DFF + ch0 + 4 * h), c = *(const f32x4*)(cw + 2 * DFF + ch0 + 4 * h), d = *(const f32x4*)(cb + ch0 + 4 * h);
#pragma unroll
            for (int j = 0; j < 4; ++j) { w0[4 * h + j] = a[j]; w1[4 * h + j] = b[j]; w2[4 * h + j] = c[j]; bb[4 * h + j] = d[j]; } }
        float ssv[2][4];
#pragma unroll
        for (int ai = 0; ai < 2; ++ai)
#pragma unroll
            for (int m = 0; m < 4; ++m) ssv[ai][m] = ssq[u.pm * BM + ai * HALF + wr * 64 + m * 16 + fr];
#pragma unroll
        for (int ai = 0; ai < 2; ++ai) {
            const int grp = 4 * u.pm + 2 * ai + wr;
            float p1[8], p2[8];
#pragma unroll
            for (int q = 0; q < 8; ++q) { p1[q] = 0.f; p2[q] = 0.f; }
#pragma unroll
            for (int m = 0; m < 4; ++m) {
                const int row = u.pm * BM + ai * HALF + wr * 64 + m * 16 + fr;
                const float sc = rsqrtf(ssv[ai][m] * (1.0f / 1024.0f) + EPS);
                float g[8], uu[8], c1[8], c2[8], hh[8];
#pragma unroll
                for (int n = 0; n < 2; ++n)
#pragma unroll
                    for (int j = 0; j < 4; ++j) { g[4 * n + j] = acc[ai][0][m][n][j] * sc; uu[4 * n + j] = acc[ai][1][m][n][j] * sc; }
#pragma unroll
                for (int q = 0; q < 8; ++q) { c1[q] = dpp_ror1(g[q]); c2[q] = dpp_ror2(g[q]); }
                if (m == 0 && fr < 2) { const size_t o = ((size_t)grp * 2 + fr) * DFF + ch0; *(u32x4*)(GH + o) = pack8(g); *(u32x4*)(UH + o) = pack8(uu); }
                if (m == 3 && fr >= 14) { const size_t o = ((size_t)grp * 2 + (fr - 14)) * DFF + ch0; *(u32x4*)(GT + o) = pack8(g); }
#pragma unroll
                for (int q = 0; q < 8; ++q) { const float gm1 = (fr == 0) ? p1[q] : c1[q], gm2 = (fr < 2) ? p2[q] : c2[q];
                    hh[q] = geluf_(bb[q] + w0[q] * gm2 + w1[q] * gm1 + w2[q] * g[q]) * uu[q]; p1[q] = c1[q]; p2[q] = c2[q]; }
                *(u32x4*)(H + (size_t)row * DFF + ch0) = pack8(hh);
            }
        }
    }
};
struct EpiLruIn {
    static constexpr bool PERM = true;
    bf16_t* GATE; bf16_t* XBP; const float* ssq;
    __device__ __forceinline__ void operator()(const f32x4 (&acc)[2][2][4][2], const Unit& u, int wr, int wc, int fr, int fq) const {
        const int row0 = u.pm * BM + wr * 64 + fr, lc = wc * 32 + 8 * fq;
        const bool isgate = u.pn < 4;
        bf16_t* base = isgate ? GATE : XBP; const int colt = (isgate ? u.pn : u.pn - 4) * 256 + lc;
        float ssv[2][4];
#pragma unroll
        for (int ai = 0; ai < 2; ++ai)
#pragma unroll
            for (int m = 0; m < 4; ++m) ssv[ai][m] = ssq[row0 + ai * HALF + m * 16];
#pragma unroll
        for (int ai = 0; ai < 2; ++ai)
#pragma unroll
            for (int m = 0; m < 4; ++m) { bf16_t* rowp = base + (size_t)(row0 + ai * HALF + m * 16) * 1024 + colt;
                const float sc = rsqrtf(ssv[ai][m] * (1.0f / 1024.0f) + EPS);
#pragma unroll
                for (int bj = 0; bj < 2; ++bj) { f32x4 v0 = acc[ai][bj][m][0] * sc, v1 = acc[ai][bj][m][1] * sc;
                    if (isgate) {
#pragma unroll
                        for (int j = 0; j < 4; ++j) { v0[j] = geluf_(v0[j]); v1[j] = geluf_(v1[j]); } }
                    *(u32x4*)(rowp + bj * HALF) = pack44(v0, v1); } }
    }
};
struct EpiLruGate {
    static constexpr bool PERM = true;
    const bf16_t* XBC2; bf16_t* LA; bf16_t* UU; const float* ba; const float* bx; const float* sp;
    __device__ __forceinline__ void operator()(const f32x4 (&acc)[2][2][4][2], const Unit& u, int wr, int wc, int fr, int fq) const {
        const int row0 = u.pm * BM + wr * 64 + fr, ch0 = (u.pn >> 1) * 256 + (u.pn & 1) * 128 + wc * 32 + 8 * fq;
        u32x4 xw[2][4];
#pragma unroll
        for (int ai = 0; ai < 2; ++ai)
#pragma unroll
            for (int m = 0; m < 4; ++m) xw[ai][m] = *(const u32x4*)(XBC2 + (size_t)(row0 + ai * HALF + m * 16) * 1024 + ch0);
        f32x4 vba[2], vbx[2], vsp[2];
#pragma unroll
        for (int n = 0; n < 2; ++n) { vba[n] = *(const f32x4*)(ba + ch0 + 4 * n); vbx[n] = *(const f32x4*)(bx + ch0 + 4 * n); vsp[n] = *(const f32x4*)(sp + ch0 + 4 * n); }
#pragma unroll
        for (int ai = 0; ai < 2; ++ai)
#pragma unroll
            for (int m = 0; m < 4; ++m) { const size_t o = (size_t)(row0 + ai * HALF + m * 16) * 1024 + ch0;
                float xb[8]; unpack8(xw[ai][m], xb);
                float la[8], uu[8];
#pragma unroll
                for (int n = 0; n < 2; ++n)
#pragma unroll
                    for (int j = 0; j < 4; ++j) { const int q = 4 * n + j;
                        const float r = sigmoidf_(acc[ai][0][m][n][j] + vba[n][j]), ig = sigmoidf_(acc[ai][1][m][n][j] + vbx[n][j]);
                        const float l = -8.0f * r * vsp[n][j]; la[q] = l;
                        const float mult = __builtin_amdgcn_sqrtf(fmaxf(0.0f, 1.0f - __expf(2.0f * l)));
                        uu[q] = mult * ig * xb[q]; }
                *(u32x4*)(LA + o) = pack8(la); *(u32x4*)(UU + o) = pack8(uu); }
    }
};

__device__ __forceinline__ void wconv_tile(const Ctx cx, const float* src, int ld_src, int nvalid, const float* gain, int k0, bf16_t* dst, int K, LAS unsigned char* lds) {
    const int lane = cx.tid & 63; LAS bf16_t* L = (LAS bf16_t*)(lds + (cx.tid >> 6) * 8448);
    float v[64];
#pragma unroll
    for (int k = 0; k < 64; ++k) v[k] = (lane < nvalid) ? src[(size_t)k * ld_src + lane] : 0.f;
    if (gain) {
#pragma unroll
        for (int k = 0; k < 64; ++k) v[k] *= gain[k0 + k]; }
#pragma unroll
    for (int k = 0; k < 64; k += 2) *(LAS unsigned*)(L + lane * 66 + k) = cvt_pk_bf16(v[k], v[k + 1]);
    asm volatile("s_waitcnt lgkmcnt(0)" ::: "memory");
#pragma unroll
    for (int i = 0; i < 8; ++i) { const int n = (lane >> 3) + 8 * i, kq = lane & 7; const LAS unsigned* q = (const LAS unsigned*)(L + n * 66 + kq * 8);
        u32x4 w; w.x = q[0]; w.y = q[1]; w.z = q[2]; w.w = q[3];
        *(u32x4*)(dst + (size_t)n * K + kq * 8) = w; }
    asm volatile("s_waitcnt lgkmcnt(0)" ::: "memory");
}
__device__ __forceinline__ void phase_prep(const Ctx cx, const Params& p, LAS unsigned char* lds, const int task_lo, const int task_hi, const int vb, const int nvb, const bool tables) {
    unsigned char* ws = P_WS(p);
    constexpr int NT1 = 92 * 16, NT2 = 16 * 32, NT3 = 88 * 16, NT4 = 16 * 44, NT5 = 32 * 16, NT6 = 32 * 4, NT7 = 16 * 16;
    constexpr int NTASK = NT1 + NT2 + 2 * NT3 + 2 * NT4 + NT5 + NT6 + NT7;
    for (int task = task_lo + vb * 8 + __builtin_amdgcn_readfirstlane(cx.tid >> 6); task < (task_hi < NTASK ? task_hi : NTASK); task += nvb * 8) {
        int id = task;
        if (id < NT1) { const int ntile = id / 16, kt = id % 16, n0 = ntile * 64, k0 = kt * 64, pn = n0 >> 8, lc0 = n0 & 255;
            int col, nv = 64;
            if (pn < 10) col = n0; else if (pn < 14) col = 2576 + (n0 - 2560);
            else if (pn < 22) col = (lc0 < 128 ? 3600 : 4624) + (pn - 14) * 128 + (lc0 & 127);
            else { col = 2560; nv = (lc0 == 0) ? 16 : 0; }
            wconv_tile(cx, IN(p, I_AB_WIN) + (size_t)k0 * 5648 + col, 5648, nv, IN(p, I_NORM_MIX), k0, (bf16_t*)(ws + WS_W1) + (size_t)n0 * 1024 + k0, 1024, lds); continue; }
        id -= NT1;
        if (id < NT2) { const int ntile = id / 32, kt = id % 32, n0 = ntile * 64, k0 = kt * 64;
            wconv_tile(cx, IN(p, I_AB_WOUT) + (size_t)k0 * 1024 + n0, 1024, 64, k0 < 1024 ? IN(p, I_SSD_NORM) : nullptr, k0, (bf16_t*)(ws + WS_W2) + (size_t)n0 * 2048 + k0, 2048, lds); continue; }
        id -= NT2;
        if (id < 2 * NT3) { const int l = id / NT3; id -= l * NT3; const int ntile = id / 16, kt = id % 16, n0 = ntile * 64, k0 = kt * 64, pn = n0 >> 8, lc0 = n0 & 255;
            const int col = (lc0 < 128 ? 0 : DFF) + pn * 128 + (lc0 & 127);
            wconv_tile(cx, IN(p, I_FFN_WIN) + (size_t)l * 1024 * 5632 + (size_t)k0 * 5632 + col, 5632, 64, IN(p, I_NORM_FFN) + l * 1024, k0, (bf16_t*)(ws + WS_W3) + (size_t)l * 5632 * 1024 + (size_t)n0 * 1024 + k0, 1024, lds); continue; }
        id -= 2 * NT3;
        if (id < 2 * NT4) { const int l = id / NT4; id -= l * NT4; const int ntile = id / 44, kt = id % 44, n0 = ntile * 64, k0 = kt * 64;
            wconv_tile(cx, IN(p, I_FFN_WOUT) + (size_t)l * DFF * 1024 + (size_t)k0 * 1024 + n0, 1024, 64, nullptr, k0, (bf16_t*)(ws + WS_W4) + (size_t)l * 1024 * DFF + (size_t)n0 * DFF + k0, DFF, lds); continue; }
        id -= 2 * NT4;
        if (id < NT5) { const int ntile = id / 16, kt = id % 16, n0 = ntile * 64, k0 = kt * 64;
            wconv_tile(cx, IN(p, I_LRU_WIN) + (size_t)k0 * 2048 + n0, 2048, 64, IN(p, I_NORM_MIX) + 1024, k0, (bf16_t*)(ws + WS_W5) + (size_t)n0 * 1024 + k0, 1024, lds); continue; }
        id -= NT5;
        if (id < NT6) { const int ntile = id / 4, kt = id % 4, n0 = ntile * 64, k0 = kt * 64, head = n0 >> 9, within = n0 & 511, pnl = within >> 8, lc0 = within & 255;
            const int ch = pnl * 128 + (lc0 & 127);
            const float* srcm = (lc0 < 128 ? IN(p, I_LRU_WA) : IN(p, I_LRU_WX)) + (size_t)head * 65536;
            wconv_tile(cx, srcm + (size_t)k0 * 256 + ch, 256, 64, nullptr, k0, (bf16_t*)(ws + WS_W6) + (size_t)n0 * 256 + k0, 256, lds); continue; }
        id -= NT6;
        { const int ntile = id / 16, kt = id % 16, n0 = ntile * 64, k0 = kt * 64;
            wconv_tile(cx, IN(p, I_LRU_WOUT) + (size_t)k0 * 1024 + n0, 1024, 64, nullptr, k0, (bf16_t*)(ws + WS_W7) + (size_t)n0 * 1024 + k0, 1024, lds); }
    }
    if (!tables) return;
    const int gt = cx.bid * NTHREADS + cx.tid, gs = cx.nblk * NTHREADS;
    for (int i = gt; i < 1024; i += gs) ((float*)(ws + WS_SP))[i] = softplusf_(-IN(p, I_LRU_LAMBDA)[i]);
    for (int i = gt; i < 5 * T; i += gs) ((float*)(ws + WS_SSQ))[i] = 0.f;
}

__device__ __forceinline__ void phase_norm(const Ctx cx, const float* xp, const float* xs, bf16_t* XN) {
    const int wid = cx.tid >> 6, lane = cx.tid & 63;
    for (int row0 = cx.bid * 8 + wid; row0 < T; row0 += cx.nblk * 32) {
        f32x4 v[4][4];
#pragma unroll
        for (int i = 0; i < 4; ++i) { const int row = row0 + i * cx.nblk * 8;
            if (row < T) { const float* src = row < TP ? xp + (size_t)row * DM : xs + (size_t)(row - TP) * DM;
#pragma unroll
                for (int j = 0; j < 4; ++j) v[i][j] = *(const f32x4*)(src + lane * 4 + j * 256); } }
#pragma unroll
        for (int i = 0; i < 4; ++i) { const int row = row0 + i * cx.nblk * 8;
            if (row < T) { float s = 0.f;
#pragma unroll
                for (int j = 0; j < 4; ++j) s += v[i][j][0] * v[i][j][0] + v[i][j][1] * v[i][j][1] + v[i][j][2] * v[i][j][2] + v[i][j][3] * v[i][j][3];
#pragma unroll
                for (int o = 32; o >= 1; o >>= 1) s += __shfl_xor(s, o);
                const float rs = rsqrtf(s * (1.0f / 1024.0f) + EPS);
#pragma unroll
                for (int j = 0; j < 4; ++j) { u32x2 w; w.x = cvt_pk_bf16(v[i][j][0] * rs, v[i][j][1] * rs); w.y = cvt_pk_bf16(v[i][j][2] * rs, v[i][j][3] * rs);
                    *(u32x2*)(XN + (size_t)row * DM + lane * 4 + j * 256) = w; } } }
    }
}
__device__ __forceinline__ void phase_final_norm(const Ctx cx, const bf16_t* XN, const float* ssq, const float* gain, float* y) {
    const int wid = cx.tid >> 6, lane = cx.tid & 63;
    f32x4 gv[4];
#pragma unroll
    for (int j = 0; j < 4; ++j) gv[j] = *(const f32x4*)(gain + lane * 4 + j * 256);
    for (int row0 = cx.bid * 8 + wid; row0 < T; row0 += cx.nblk * 64) {
        u32x2 w[8][4]; float rs[8];
#pragma unroll
        for (int i = 0; i < 8; ++i) { const int row = row0 + i * cx.nblk * 8;
            if (row < T) {
#pragma unroll
                for (int j = 0; j < 4; ++j) w[i][j] = *(const u32x2*)(XN + (size_t)row * DM + lane * 4 + j * 256);
                rs[i] = rsqrtf(ssq[row] * (1.0f / 1024.0f) + EPS); } }
#pragma unroll
        for (int i = 0; i < 8; ++i) { const int row = row0 + i * cx.nblk * 8;
            if (row < T) { float* dst = y + (size_t)row * DM + lane * 4;
#pragma unroll
                for (int j = 0; j < 4; ++j) *(f32x4*)(dst + j * 256) = (f32x4){bf_lo(w[i][j].x), bf_hi(w[i][j].x), bf_lo(w[i][j].y), bf_hi(w[i][j].y)} * rs[i] * gv[j]; } }
    }
}

template <int KW, int MODE>
__device__ __forceinline__ void phase_conv(const Ctx cx, const bf16_t* src, int ld_src, int NC, const float* w, const float* bias, bf16_t* dst, int ld_dst,
                           const float* st_in, float* out_p, float* out_s) {
    const int ncg = NC >> 3, total = (T / 16) * ncg;
    for (int item = cx.bid * NTHREADS + cx.tid; item < total; item += cx.nblk * NTHREADS) {
        const int cgi = item % ncg, seg = item / ncg, c0 = cgi * 8, r0 = seg * 16;
        int seq, t0, L; if (r0 < TP) { seq = r0 >> 12; t0 = r0 & 4095; L = 4096; } else { seq = 16 + ((r0 - TP) >> 6); t0 = (r0 - TP) & 63; L = 64; }
        float wv[KW][8], bv[8];
#pragma unroll
        for (int k = 0; k < KW; ++k) { const f32x4 a = *(const f32x4*)(w + (size_t)k * NC + c0), b = *(const f32x4*)(w + (size_t)k * NC + c0 + 4);
#pragma unroll
            for (int j = 0; j < 4; ++j) { wv[k][j] = a[j]; wv[k][4 + j] = b[j]; } }
        { const f32x4 a = *(const f32x4*)(bias + c0), b = *(const f32x4*)(bias + c0 + 4);
#pragma unroll
          for (int j = 0; j < 4; ++j) { bv[j] = a[j]; bv[4 + j] = b[j]; } }
        float win[KW - 1][8];
#pragma unroll
        for (int k = 0; k < KW - 1; ++k) {
            if (t0 > 0) unpack8(*(const u32x4*)(src + (size_t)(r0 - (KW - 1) + k) * ld_src + c0), win[k]);
            else if (seq >= 16) { const float* sp_ = st_in + ((size_t)(seq - 16) * (KW - 1) + k) * NC + c0; const f32x4 a = *(const f32x4*)sp_, b = *(const f32x4*)(sp_ + 4);
#pragma unroll
                for (int j = 0; j < 4; ++j) { win[k][j] = a[j]; win[k][4 + j] = b[j]; } }
            else {
#pragma unroll
                for (int j = 0; j < 8; ++j) win[k][j] = 0.f; }
        }
#pragma unroll
        for (int h = 0; h < 2; ++h) {
            u32x4 rows[8], aux[8];
#pragma unroll
            for (int i = 0; i < 8; ++i) { rows[i] = *(const u32x4*)(src + (size_t)(r0 + h * 8 + i) * ld_src + c0);
                if (MODE == 1 || MODE == 2) aux[i] = *(const u32x4*)(dst + (size_t)(r0 + h * 8 + i) * ld_dst + c0); }
#pragma unroll
            for (int i = 0; i < 8; ++i) {
                float cur[8], y[8]; unpack8(rows[i], cur);
#pragma unroll
                for (int j = 0; j < 8; ++j) { float a = bv[j] + wv[KW - 1][j] * cur[j];
#pragma unroll
                    for (int k = 0; k < KW - 1; ++k) a += wv[k][j] * win[k][j];
                    y[j] = a; }
#pragma unroll
                for (int j = 0; j < 8; ++j) {
#pragma unroll
                    for (int k = 0; k < KW - 2; ++k) win[k][j] = win[k + 1][j];
                    win[KW - 2][j] = cur[j]; }
                if (MODE == 0) {
#pragma unroll
                    for (int j = 0; j < 8; ++j) y[j] = siluf_(y[j]); }
                if (MODE == 1) { float gq[8]; unpack8(aux[i], gq);
#pragma unroll
                    for (int j = 0; j < 8; ++j) y[j] = y[j] * gq[j]; }
                if (MODE == 2) { float uq[8]; unpack8(aux[i], uq);
#pragma unroll
                    for (int j = 0; j < 8; ++j) y[j] = geluf_(y[j]) * uq[j]; }
                *(u32x4*)(dst + (size_t)(r0 + h * 8 + i) * ld_dst + c0) = pack8(y);
            }
            if (h == 1 && t0 + 16 == L) {
                float* ob = (seq < 16 ? out_p + (size_t)seq * (KW - 1) * NC : out_s + (size_t)(seq - 16) * (KW - 1) * NC) + c0;
#pragma unroll
                for (int j = 0; j < KW - 1; ++j) { float f[8]; unpack8(rows[8 - (KW - 1) + j], f);
                    *(f32x4*)(ob + (size_t)j * NC) = (f32x4){f[0], f[1], f[2], f[3]}; *(f32x4*)(ob + (size_t)j * NC + 4) = (f32x4){f[4], f[5], f[6], f[7]}; }
            }
        }
    }
}

template <bool SRC_F32, bool GSCALE>
__device__ __forceinline__ void phase_split_finish(const Ctx cx, const float* slabs, int nsplit, const float* xs, bf16_t* XN, float* ssq, const float* gssq) {
    const int wid = cx.tid >> 6, lane = cx.tid & 63;
    for (int r = cx.bid * 8 + wid; r < TS; r += cx.nblk * 8) {
        const int panel = r >> 8, rl = r & 255, pn = lane >> 4, lc = (lane & 15) * 16;
        const float* sb = slabs + (size_t)((panel * 4 + pn) * nsplit) * 65536 + (size_t)rl * 256 + lc;
        f32x4 v[4];
#pragma unroll
        for (int q = 0; q < 4; ++q) v[q] = (f32x4){0.f, 0.f, 0.f, 0.f};
        for (int pc = 0; pc < nsplit; ++pc) {
#pragma unroll
            for (int q = 0; q < 4; ++q) v[q] += *(const f32x4*)(sb + (size_t)pc * 65536 + 4 * q);
            if (GSCALE && pc == 3) { const float sc = rsqrtf(gssq[TP + r] * (1.0f / 1024.0f) + EPS);
#pragma unroll
                for (int q = 0; q < 4; ++q) v[q] *= sc; }
        }
        bf16_t* xnp = XN + (size_t)(TP + r) * DM + lane * 16;
        if (SRC_F32) { const float* src = xs + (size_t)r * DM + lane * 16;
#pragma unroll
            for (int q = 0; q < 4; ++q) v[q] += *(const f32x4*)(src + 4 * q); }
        else { float a[8], b[8]; unpack8(*(const u32x4*)xnp, a); unpack8(*(const u32x4*)(xnp + 8), b);
            v[0] += (f32x4){a[0], a[1], a[2], a[3]}; v[1] += (f32x4){a[4], a[5], a[6], a[7]}; v[2] += (f32x4){b[0], b[1], b[2], b[3]}; v[3] += (f32x4){b[4], b[5], b[6], b[7]}; }
        *(u32x4*)xnp = pack44(v[0], v[1]); *(u32x4*)(xnp + 8) = pack44(v[2], v[3]);
        float sq = 0.f;
#pragma unroll
        for (int q = 0; q < 4; ++q) sq += v[q][0] * v[q][0] + v[q][1] * v[q][1] + v[q][2] * v[q][2] + v[q][3] * v[q][3];
#pragma unroll
        for (int o = 32; o >= 1; o >>= 1) sq += __shfl_xor(sq, o);
        if (lane == 0) ssq[TP + r] = sq;
    }
}

__device__ __forceinline__ void phase_ffn_fix(const Ctx cx, const bf16_t* GH, const bf16_t* GT, const bf16_t* UH, bf16_t* H, const float* cw, const float* cb,
                                              const float* st_in, float* out_p, float* out_s) {
    const int ncg = DFF / 8, total = 1032 * ncg;
    for (int item = cx.bid * NTHREADS + cx.tid; item < total; item += cx.nblk * NTHREADS) {
        const int cgi = item % ncg, G = item / ncg, c0 = cgi * 8;
        int seq; bool first, lastg;
        if (G < 1024) { seq = G >> 6; first = (G & 63) == 0; lastg = (G & 63) == 63; } else { seq = 16 + (G - 1024); first = true; lastg = true; }
        float w0[8], w1[8], w2[8], bb[8], gm2[8], gm1[8], g0[8], g1[8], u0[8], u1[8];
#pragma unroll
        for (int h = 0; h < 2; ++h) { const f32x4 a = *(const f32x4*)(cw + c0 + 4 * h), b = *(const f32x4*)(cw + DFF + c0 + 4 * h), c = *(const f32x4*)(cw + 2 * DFF + c0 + 4 * h), d = *(const f32x4*)(cb + c0 + 4 * h);
#pragma unroll
            for (int j = 0; j < 4; ++j) { w0[4 * h + j] = a[j]; w1[4 * h + j] = b[j]; w2[4 * h + j] = c[j]; bb[4 * h + j] = d[j]; } }
        if (!first) { unpack8(*(const u32x4*)(GT + ((size_t)(G - 1) * 2 + 0) * DFF + c0), gm2); unpack8(*(const u32x4*)(GT + ((size_t)(G - 1) * 2 + 1) * DFF + c0), gm1); }
        else if (seq >= 16) { const float* s0 = st_in + ((size_t)(seq - 16) * 2) * DFF + c0;
#pragma unroll
            for (int h = 0; h < 2; ++h) { const f32x4 a = *(const f32x4*)(s0 + 4 * h), b = *(const f32x4*)(s0 + DFF + 4 * h);
#pragma unroll
                for (int j = 0; j < 4; ++j) { gm2[4 * h + j] = a[j]; gm1[4 * h + j] = b[j]; } } }
        else {
#pragma unroll
            for (int q = 0; q < 8; ++q) { gm2[q] = 0.f; gm1[q] = 0.f; } }
        unpack8(*(const u32x4*)(GH + ((size_t)G * 2 + 0) * DFF + c0), g0); unpack8(*(const u32x4*)(GH + ((size_t)G * 2 + 1) * DFF + c0), g1);
        unpack8(*(const u32x4*)(UH + ((size_t)G * 2 + 0) * DFF + c0), u0); unpack8(*(const u32x4*)(UH + ((size_t)G * 2 + 1) * DFF + c0), u1);
        float h0[8], h1[8];
#pragma unroll
        for (int q = 0; q < 8; ++q) { h0[q] = geluf_(bb[q] + w0[q] * gm2[q] + w1[q] * gm1[q] + w2[q] * g0[q]) * u0[q];
            h1[q] = geluf_(bb[q] + w0[q] * gm1[q] + w1[q] * g0[q] + w2[q] * g1[q]) * u1[q]; }
        *(u32x4*)(H + (size_t)(G * 64) * DFF + c0) = pack8(h0); *(u32x4*)(H + (size_t)(G * 64 + 1) * DFF + c0) = pack8(h1);
        if (lastg) {
            float* ob = (seq < 16 ? out_p + (size_t)seq * 2 * DFF : out_s + (size_t)(seq - 16) * 2 * DFF) + c0;
#pragma unroll
            for (int j = 0; j < 2; ++j) { float f[8]; unpack8(*(const u32x4*)(GT + ((size_t)G * 2 + j) * DFF + c0), f);
                *(f32x4*)(ob + (size_t)j * DFF) = (f32x4){f[0], f[1], f[2], f[3]}; *(f32x4*)(ob + (size_t)j * DFF + 4) = (f32x4){f[4], f[5], f[6], f[7]}; }
        }
    }
}

constexpr int SC_CS = 0, SC_BS = 17408, SC_BTS = 34816, SC_XTS = 53248, SC_XDS = 62464, SC_HS = 71680, SC_MS = 89088, SC_AS = 98304, SC_SQ = 98560;
#define LDS_BARRIER() do { asm volatile("s_waitcnt lgkmcnt(0)" ::: "memory"); __builtin_amdgcn_s_barrier(); asm volatile("" ::: "memory"); } while (0)
template <int N> __device__ __forceinline__ float dpp_shr(float v) { return __int_as_float(__builtin_amdgcn_update_dpp(0, __float_as_int(v), 0x110 + N, 0xf, 0xf, true)); }
__device__ __forceinline__ void ssd_task(const Ctx cx, const Params& p, LAS unsigned char* lds, int seq, int hd) {
    const int tid = cx.tid, wid = tid >> 6, lane = tid & 63, fr = lane & 15, fq = lane >> 4;
    unsigned char* ws = P_WS(p);
    const bf16_t* XBCA = (const bf16_t*)(ws + WS_XBCA); bf16_t* A2 = (bf16_t*)(ws + WS_A2); const float* DT = (const float*)(ws + WS_DT); float* SSQ = (float*)(ws + WS_SSQ);
    const int g = hd >> 3, nchunks = seq < 16 ? 64 : 1;
    const size_t row_base = seq < 16 ? (size_t)seq * 4096 : (size_t)TP + (size_t)(seq - 16) * 64;
    const float Aneg = -__expf(IN(p, I_A_LOG)[hd]), Dh = IN(p, I_SSD_D)[hd];
    LAS float* As = (LAS float*)(lds + SC_AS); LAS float* Sq = (LAS float*)(lds + SC_SQ);
    f32x4 hst[4];
#pragma unroll
    for (int pt = 0; pt < 4; ++pt) {
        if (seq >= 16) hst[pt] = *(const f32x4*)(IN(p, I_ST_SSD) + ((size_t)((seq - 16) * 16 + hd) * 64 + 16 * pt + fr) * 128 + 16 * wid + 4 * fq);
        else hst[pt] = (f32x4){0.f, 0.f, 0.f, 0.f};
    }
    const int lt = wid >> 1, ph = wid & 1;
    float pf_dt; u32x4 pf_b[2], pf_c[2], pf_x, pf_bt[2];
#define SSD_PREFETCH(cc) do { const size_t r0p = row_base + (size_t)(cc) * 64; \
        pf_dt = DT[(r0p + lane) * 16 + hd]; \
        _Pragma("unroll") for (int i = 0; i < 2; ++i) { const int q = tid + i * 512, row = q >> 4, sg = q & 15; \
            const bf16_t* gp = XBCA + (r0p + row) * XBC + 1024 + g * 128 + sg * 8; pf_b[i] = *(const u32x4*)gp; pf_c[i] = *(const u32x4*)(gp + 256); } \
        pf_x = *(const u32x4*)(XBCA + (r0p + lane) * XBC + hd * 64 + wid * 8); \
        _Pragma("unroll") for (int i = 0; i < 2; ++i) pf_bt[i] = *(const u32x4*)(XBCA + (r0p + lane) * XBC + 1024 + g * 128 + (wid + 8 * i) * 8); } while (0)
    SSD_PREFETCH(0);
    for (int c = 0; c < nchunks; ++c) {
        const size_t r0 = row_base + (size_t)c * 64;
        const float dt_l = pf_dt;
        float a = dt_l * Aneg;
        a += dpp_shr<1>(a); a += dpp_shr<2>(a); a += dpp_shr<4>(a); a += dpp_shr<8>(a);
        { const float t0 = __int_as_float(__builtin_amdgcn_readlane(__float_as_int(a), 15)), t1 = __int_as_float(__builtin_amdgcn_readlane(__float_as_int(a), 31)), t2 = __int_as_float(__builtin_amdgcn_readlane(__float_as_int(a), 47));
          a += (fq == 1) ? t0 : (fq == 2) ? (t0 + t1) : (fq == 3) ? (t0 + t1 + t2) : 0.0f; }
        const float a63 = __int_as_float(__builtin_amdgcn_readlane(__float_as_int(a), 63));
        const float wl = dt_l * __expf(a63 - a);
        if (wid == 0) As[lane] = a;
#pragma unroll
        for (int i = 0; i < 2; ++i) { const int q = tid + i * 512, row = q >> 4, sg = q & 15;
            *(LAS u32x4*)(lds + SC_BS + row * 272 + sg * 16) = pf_b[i]; *(LAS u32x4*)(lds + SC_CS + row * 272 + sg * 16) = pf_c[i]; }
        { float f[8]; unpack8(pf_x, f);
          LAS bf16_t* xt = (LAS bf16_t*)(lds + SC_XTS), *xd = (LAS bf16_t*)(lds + SC_XDS);
#pragma unroll
          for (int j = 0; j < 8; ++j) { const unsigned w2 = cvt_pk_bf16(f[j] * dt_l, f[j] * wl); xt[(wid * 8 + j) * 72 + lane] = (bf16_t)(w2 & 0xffffu); xd[(wid * 8 + j) * 72 + lane] = (bf16_t)(w2 >> 16); } }
#pragma unroll
        for (int i = 0; i < 2; ++i) { const int sg = wid + 8 * i; const u32x4 bw = pf_bt[i];
            LAS bf16_t* bt = (LAS bf16_t*)(lds + SC_BTS);
            bt[(sg * 8 + 0) * 72 + lane] = (bf16_t)(bw.x & 0xffffu); bt[(sg * 8 + 1) * 72 + lane] = (bf16_t)(bw.x >> 16);
            bt[(sg * 8 + 2) * 72 + lane] = (bf16_t)(bw.y & 0xffffu); bt[(sg * 8 + 3) * 72 + lane] = (bf16_t)(bw.y >> 16);
            bt[(sg * 8 + 4) * 72 + lane] = (bf16_t)(bw.z & 0xffffu); bt[(sg * 8 + 5) * 72 + lane] = (bf16_t)(bw.z >> 16);
            bt[(sg * 8 + 6) * 72 + lane] = (bf16_t)(bw.w & 0xffffu); bt[(sg * 8 + 7) * 72 + lane] = (bf16_t)(bw.w >> 16); }
#pragma unroll
        for (int pt = 0; pt < 4; ++pt) { u32x2 w2; w2.x = cvt_pk_bf16(hst[pt][0], hst[pt][1]); w2.y = cvt_pk_bf16(hst[pt][2], hst[pt][3]);
            *(LAS u32x2*)(lds + SC_HS + (16 * pt + fr) * 272 + (16 * wid + 4 * fq) * 2) = w2; }
        u32x2 ep_z[2], ep_x[2];
#pragma unroll
        for (int j = 0; j < 2; ++j) { const size_t rowe = r0 + 16 * lt + fr; const int col = hd * 64 + 16 * (2 * ph + j) + 4 * fq;
            ep_z[j] = *(const u32x2*)(A2 + rowe * 2048 + col); ep_x[j] = *(const u32x2*)(XBCA + rowe * XBC + col); }
        if (c + 1 < nchunks) SSD_PREFETCH(c + 1);
        LDS_BARRIER();
        f32x4 yacc[2];
        {
            bf16x8 cf[4];
#pragma unroll
            for (int kk = 0; kk < 4; ++kk) cf[kk] = *(const LAS bf16x8*)(lds + SC_CS + (16 * lt + fr) * 272 + kk * 64 + fq * 16);
            const float a_l = As[16 * lt + fr];
#pragma unroll
            for (int j = 0; j < 2; ++j) {
                const int st = 2 * ph + j;
                f32x4 cb = (f32x4){0.f, 0.f, 0.f, 0.f};
                if (st <= lt) {
#pragma unroll
                    for (int kk = 0; kk < 4; ++kk) { const bf16x8 bf = *(const LAS bf16x8*)(lds + SC_BS + (16 * st + fr) * 272 + kk * 64 + fq * 16);
                        cb = __builtin_amdgcn_mfma_f32_16x16x32_bf16(bf, cf[kk], cb, 0, 0, 0); }
                    const f32x4 as4 = *(const LAS f32x4*)(lds + SC_AS + (16 * st + 4 * fq) * 4);
#pragma unroll
                    for (int r = 0; r < 4; ++r) { const int s = 16 * st + 4 * fq + r, l = 16 * lt + fr; cb[r] = (s <= l) ? cb[r] * __expf(a_l - as4[r]) : 0.f; }
                }
                u32x2 w2; w2.x = cvt_pk_bf16(cb[0], cb[1]); w2.y = cvt_pk_bf16(cb[2], cb[3]);
                *(LAS u32x2*)(lds + SC_MS + (16 * lt + fr) * 144 + (16 * st + 4 * fq) * 2) = w2;
            }
            const float el = __expf(a_l);
#pragma unroll
            for (int j = 0; j < 2; ++j) { const int pt = 2 * ph + j; f32x4 y = (f32x4){0.f, 0.f, 0.f, 0.f};
#pragma unroll
                for (int kk = 0; kk < 4; ++kk) { const bf16x8 hf = *(const LAS bf16x8*)(lds + SC_HS + (16 * pt + fr) * 272 + kk * 64 + fq * 16);
                    y = __builtin_amdgcn_mfma_f32_16x16x32_bf16(hf, cf[kk], y, 0, 0, 0); }
                yacc[j] = y * el; }
        }
        {
            const float dec = __expf(a63);
            bf16x8 btf[2];
#pragma unroll
            for (int kk = 0; kk < 2; ++kk) btf[kk] = *(const LAS bf16x8*)(lds + SC_BTS + (16 * wid + fr) * 144 + kk * 64 + fq * 16);
#pragma unroll
            for (int pt = 0; pt < 4; ++pt) { f32x4 h = hst[pt] * dec;
#pragma unroll
                for (int kk = 0; kk < 2; ++kk) { const bf16x8 xf = *(const LAS bf16x8*)(lds + SC_XDS + (16 * pt + fr) * 144 + kk * 64 + fq * 16);
                    h = __builtin_amdgcn_mfma_f32_16x16x32_bf16(btf[kk], xf, h, 0, 0, 0); }
                hst[pt] = h; }
        }
        LDS_BARRIER();
        {
            bf16x8 mf[2];
#pragma unroll
            for (int kk = 0; kk < 2; ++kk) mf[kk] = *(const LAS bf16x8*)(lds + SC_MS + (16 * lt + fr) * 144 + kk * 64 + fq * 16);
            float sq = 0.f;
            const size_t row = r0 + 16 * lt + fr;
#pragma unroll
            for (int j = 0; j < 2; ++j) { const int pt = 2 * ph + j; f32x4 y = yacc[j];
#pragma unroll
                for (int kk = 0; kk < 2; ++kk) { const bf16x8 xf = *(const LAS bf16x8*)(lds + SC_XTS + (16 * pt + fr) * 144 + kk * 64 + fq * 16);
                    y = __builtin_amdgcn_mfma_f32_16x16x32_bf16(xf, mf[kk], y, 0, 0, 0); }
                const int col = hd * 64 + 16 * pt + 4 * fq;
                const u32x2 zw = ep_z[j], xw = ep_x[j];
                const float z0 = bf_lo(zw.x), z1 = bf_hi(zw.x), z2 = bf_lo(zw.y), z3 = bf_hi(zw.y);
                const float x0 = bf_lo(xw.x), x1 = bf_hi(xw.x), x2 = bf_lo(xw.y), x3 = bf_hi(xw.y);
                const float g0 = (y[0] + Dh * x0) * siluf_(z0), g1 = (y[1] + Dh * x1) * siluf_(z1), g2 = (y[2] + Dh * x2) * siluf_(z2), g3 = (y[3] + Dh * x3) * siluf_(z3);
                sq += g0 * g0 + g1 * g1 + g2 * g2 + g3 * g3;
                u32x2 ow; ow.x = cvt_pk_bf16(g0, g1); ow.y = cvt_pk_bf16(g2, g3);
                *(u32x2*)(A2 + row * 2048 + col) = ow; }
            sq += __shfl_xor(sq, 16); sq += __shfl_xor(sq, 32);
            if (fq == 0) Sq[ph * 64 + 16 * lt + fr] = sq;
        }
        LDS_BARRIER();
        if (tid < 64) atomicAdd(SSQ + r0 + tid, Sq[tid] + Sq[64 + tid]);
    }
    float* so = (seq < 16 ? P_OUT(p) + O_P_SSD + (size_t)(seq * 16 + hd) * 8192 : P_OUT(p) + O_S_SSD + (size_t)((seq - 16) * 16 + hd) * 8192);
#pragma unroll
    for (int pt = 0; pt < 4; ++pt) *(f32x4*)(so + (size_t)(16 * pt + fr) * 128 + 16 * wid + 4 * fq) = hst[pt];
    LDS_BARRIER();
}
__device__ __forceinline__ void phase_ssd(const Ctx cx, const Params& p, LAS unsigned char* lds) {
    for (int task = cx.bid; task < 384; task += cx.nblk) {
        if (task < 256) ssd_task(cx, p, lds, task >> 4, task & 15);
        else ssd_task(cx, p, lds, 16 + ((task - 256) >> 4), (task - 256) & 15);
    }
}

__device__ __forceinline__ void phase_lru_a(const Ctx cx, const bf16_t* LA, const bf16_t* UU, float* SL, float* HH) {
    const int total = 1088 * 128;
    for (int item = cx.bid * NTHREADS + cx.tid; item < total; item += cx.nblk * NTHREADS) {
        const int cgi = item & 127, ch = item >> 7, c0 = cgi * 8; const size_t r0 = ch < 1024 ? (size_t)ch * 64 : (size_t)TP + (size_t)(ch - 1024) * 8; const int nr = ch < 1024 ? 64 : 8;
        float sl[8], h[8];
#pragma unroll
        for (int j = 0; j < 8; ++j) { sl[j] = 0.f; h[j] = 0.f; }
        for (int i0 = 0; i0 < nr; i0 += 8) {
            u32x4 la[8], uu[8];
#pragma unroll
            for (int i = 0; i < 8; ++i) { la[i] = *(const u32x4*)(LA + (r0 + i0 + i) * 1024 + c0); uu[i] = *(const u32x4*)(UU + (r0 + i0 + i) * 1024 + c0); }
#pragma unroll
            for (int i = 0; i < 8; ++i) { float l[8], u[8]; unpack8(la[i], l); unpack8(uu[i], u);
#pragma unroll
                for (int j = 0; j < 8; ++j) { sl[j] += l[j]; h[j] = __expf(l[j]) * h[j] + u[j]; } }
        }
        float* o1 = SL + (size_t)ch * 1024 + c0; float* o2 = HH + (size_t)ch * 1024 + c0;
        *(f32x4*)o1 = (f32x4){sl[0], sl[1], sl[2], sl[3]}; *(f32x4*)(o1 + 4) = (f32x4){sl[4], sl[5], sl[6], sl[7]};
        *(f32x4*)o2 = (f32x4){h[0], h[1], h[2], h[3]}; *(f32x4*)(o2 + 4) = (f32x4){h[4], h[5], h[6], h[7]};
    }
}
__device__ __forceinline__ void phase_lru_b(const Ctx cx, const Params& p, const float* SL, const float* HH, float* CIN) {
    for (int item = cx.bid * NTHREADS + cx.tid; item < 24 * 1024; item += cx.nblk * NTHREADS) {
        const int chn = item & 1023, seq = item >> 10;
        const int nch = seq < 16 ? 64 : 8, ch0 = seq < 16 ? seq * 64 : 1024 + (seq - 16) * 8;
        float c = seq < 16 ? 0.f : IN(p, I_ST_LRU)[(seq - 16) * 1024 + chn];
        for (int i0 = 0; i0 < nch; i0 += 16) {
            float sl[16], hh[16];
#pragma unroll
            for (int i = 0; i < 16; ++i) if (i0 + i < nch) { sl[i] = SL[(size_t)(ch0 + i0 + i) * 1024 + chn]; hh[i] = HH[(size_t)(ch0 + i0 + i) * 1024 + chn]; }
#pragma unroll
            for (int i = 0; i < 16; ++i) if (i0 + i < nch) { CIN[(size_t)(ch0 + i0 + i) * 1024 + chn] = c; c = __expf(sl[i]) * c + hh[i]; }
        }
        (seq < 16 ? P_OUT(p) + O_P_LRU + seq * 1024 : P_OUT(p) + O_S_LRU + (seq - 16) * 1024)[chn] = c;
    }
}
__device__ __forceinline__ void phase_lru_c(const Ctx cx, const bf16_t* LA, const bf16_t* UU, const float* CIN, bf16_t* GATE) {
    const int total = 1088 * 128;
    for (int item = cx.bid * NTHREADS + cx.tid; item < total; item += cx.nblk * NTHREADS) {
        const int cgi = item & 127, ch = item >> 7, c0 = cgi * 8; const size_t r0 = ch < 1024 ? (size_t)ch * 64 : (size_t)TP + (size_t)(ch - 1024) * 8; const int nr = ch < 1024 ? 64 : 8;
        float h[8];
        { const float* ci = CIN + (size_t)ch * 1024 + c0; const f32x4 a = *(const f32x4*)ci, b = *(const f32x4*)(ci + 4);
#pragma unroll
          for (int j = 0; j < 4; ++j) { h[j] = a[j]; h[4 + j] = b[j]; } }
        for (int i0 = 0; i0 < nr; i0 += 8) {
            u32x4 la[8], uu[8], gt[8];
#pragma unroll
            for (int i = 0; i < 8; ++i) { la[i] = *(const u32x4*)(LA + (r0 + i0 + i) * 1024 + c0); uu[i] = *(const u32x4*)(UU + (r0 + i0 + i) * 1024 + c0); gt[i] = *(const u32x4*)(GATE + (r0 + i0 + i) * 1024 + c0); }
#pragma unroll
            for (int i = 0; i < 8; ++i) { float l[8], u[8], gq[8], o[8]; unpack8(la[i], l); unpack8(uu[i], u); unpack8(gt[i], gq);
#pragma unroll
                for (int j = 0; j < 8; ++j) { h[j] = __expf(l[j]) * h[j] + u[j]; o[j] = gq[j] * h[j]; }
                *(u32x4*)(GATE + (r0 + i0 + i) * 1024 + c0) = pack8(o); }
        }
    }
}

#define XB_TMO      128
#define XB_XCNT(j)  (256  + 64 * (j))
#define XB_XSUB(j)  (1280 + 64 * (j))
#define XB_XGEN(j)  (2304 + 64 * (j))
#define XB_TOP      3328
#define XB_TOPGEN   3392
#define XCD_BAR_WORDS 3456
#define XB_SPIN_CAP (1u << 18)
__device__ __forceinline__ unsigned xb_ld(unsigned* p)              { return __hip_atomic_load(p, __ATOMIC_RELAXED, __HIP_MEMORY_SCOPE_AGENT); }
__device__ __forceinline__ unsigned xb_add(unsigned* p, unsigned v) { return __hip_atomic_fetch_add(p, v, __ATOMIC_RELAXED, __HIP_MEMORY_SCOPE_AGENT); }
__device__ __forceinline__ unsigned xb_xcc_id() { return (unsigned)__builtin_amdgcn_s_getreg((3 << 11) | 20) & 0xFu; }
#define XB_SPIN(cond, bar) do { unsigned _sp = 0; while (cond) { __builtin_amdgcn_s_sleep(1); \
    if ((++_sp & 255u) == 0u) { if (xb_ld(&(bar)[XB_TMO])) break; if (_sp > XB_SPIN_CAP) { atomicAdd(&(bar)[XB_TMO], 1u); break; } } } } while (0)
struct XcdBarrier { unsigned* bar; unsigned x; volatile LAS unsigned* st; };
__device__ __forceinline__ XcdBarrier xcd_barrier_post(unsigned* bar, volatile LAS unsigned* st) {
    XcdBarrier b; b.bar = bar; b.x = xb_xcc_id(); b.st = st;
    if (threadIdx.x == 0) (void)xb_add(&bar[XB_XCNT(b.x)], 1u);
    return b;
}
__device__ __forceinline__ void xcd_barrier_complete(unsigned* bar, unsigned x, unsigned& nloc, unsigned& nx) {
    const unsigned G = gridDim.x * gridDim.y * gridDim.z;
    unsigned sum, cnt, mine, sp = 0u;
    for (;;) {
        sum = 0u; cnt = 0u; mine = 0u;
#pragma unroll
        for (unsigned j = 0; j < 16; ++j) { const unsigned c = xb_ld(&bar[XB_XCNT(j)]); sum += c; cnt += (c > 0u) ? 1u : 0u; mine = (j == x) ? c : mine; }
        if (sum == G) break;
        __builtin_amdgcn_s_sleep(1);
        if ((++sp & 255u) == 0u) { if (xb_ld(&bar[XB_TMO])) break; if (sp > XB_SPIN_CAP) { atomicAdd(&bar[XB_TMO], 1u); break; } }
    }
    nloc = mine > 0u ? mine : 1u; nx = cnt > 0u ? cnt : 1u;
}
__device__ __forceinline__ void xcd_barrier(const XcdBarrier& b) {
    asm volatile("s_waitcnt vmcnt(0)" ::: "memory");
    __syncthreads();
    if (threadIdx.x == 0) {
        unsigned* bar = b.bar;
        __builtin_amdgcn_s_waitcnt(0);
        unsigned nloc = b.st[0], nx = b.st[1];
        if (nloc == 0u) { xcd_barrier_complete(bar, b.x, nloc, nx); b.st[0] = nloc; b.st[1] = nx; }
        const unsigned old = xb_add(&bar[XB_XSUB(b.x)], 1u);
        const unsigned gen = old / nloc;
        if (old + 1u == (gen + 1u) * nloc) {
            __builtin_amdgcn_fence(__ATOMIC_RELEASE, "agent");
            asm volatile("s_waitcnt vmcnt(0)" ::: "memory");
            const unsigned og = xb_add(&bar[XB_TOP], 1u);
            const unsigned tg = og / nx;
            if (og + 1u == (tg + 1u) * nx) xb_add(&bar[XB_TOPGEN], 1u);
            else XB_SPIN(xb_ld(&bar[XB_TOPGEN]) == tg, bar);
            __builtin_amdgcn_fence(__ATOMIC_ACQUIRE, "agent");
            xb_add(&bar[XB_XGEN(b.x)], 1u);
            asm volatile("s_waitcnt vmcnt(0)" ::: "memory");
        } else {
            XB_SPIN(xb_ld(&bar[XB_XGEN(b.x)]) == gen, bar);
            __builtin_amdgcn_fence(__ATOMIC_ACQUIRE, "agent");
            asm volatile("s_waitcnt vmcnt(0)" ::: "memory");
        }
    }
    __syncthreads();
}

constexpr int NPHASE = 23;
__device__ __forceinline__ void run_phase(const Params& p, int ph, LAS unsigned char* lds) {
    Ctx cx; { int b = blockIdx.x, n = gridDim.x, t = threadIdx.x; asm volatile("" : "+s"(b), "+s"(n), "+v"(t)); cx.bid = b; cx.nblk = n; cx.tid = t; }
    unsigned char* ws = P_WS(p);
    bf16_t* XN = (bf16_t*)(ws + WS_XN);
    float* Y = P_OUT(p) + O_Y;
    float* SSQ = (float*)(ws + WS_SSQ);
    switch (ph) {
    case 0: phase_prep(cx, p, lds, 0, 92 * 16, cx.bid, cx.nblk, true); phase_norm(cx, IN(p, I_XP), IN(p, I_XS), XN); break;
    case 1: { Gemm g{XN, (const bf16_t*)(ws + WS_W1), T, N1, 1024, 1024, 0, 0};
        EpiG1 e{(bf16_t*)(ws + WS_A2), (bf16_t*)(ws + WS_XBCP), (bf16_t*)(ws + WS_V), (float*)(ws + WS_DT), IN(p, I_DT_BIAS)};
        gemm_phase<EpiG1, false>(cx, lds, g, e, nullptr);
        const int nt1 = (T / BM) * (N1 / BM), nlate = nt1 % cx.nblk;
        if (cx.bid >= nlate) phase_prep(cx, p, lds, 92 * 16, 1 << 30, cx.bid - nlate, cx.nblk - nlate, false); } break;
    case 2:
        phase_conv<4, 0>(cx, (const bf16_t*)(ws + WS_XBCP), XBC, XBC, IN(p, I_SSD_CONVW), IN(p, I_SSD_CONVB), (bf16_t*)(ws + WS_XBCA), XBC, IN(p, I_ST_SSDCONV), P_OUT(p) + O_P_SSDCONV, P_OUT(p) + O_S_SSDCONV);
        phase_conv<3, 1>(cx, (const bf16_t*)(ws + WS_V), 1024, 1024, IN(p, I_SC_CONVW), IN(p, I_SC_CONVB), (bf16_t*)(ws + WS_A2) + 1024, 2048, IN(p, I_ST_SCONV), P_OUT(p) + O_P_SCONV, P_OUT(p) + O_S_SCONV);
        break;
    case 3: phase_ssd(cx, p, lds); break;
    case 4: { Gemm g{(const bf16_t*)(ws + WS_A2), (const bf16_t*)(ws + WS_W2), T, 1024, 2048, 2048, 0, 0};
        EpiRes<true> e{IN(p, I_XP), IN(p, I_XS), XN, SSQ + T};
        gemm_phase<EpiRes<true>, true, true>(cx, lds, g, e, SSQ, (float*)(ws + WS_SLAB)); } break;
    case 30: phase_split_finish<true, true>(cx, (const float*)(ws + WS_SLAB), 8, IN(p, I_XS), XN, SSQ + T, SSQ); break;
    case 5: case 15: { const int l = ph == 5 ? 0 : 1;
        Gemm g{XN, (const bf16_t*)(ws + WS_W3) + (size_t)l * 5632 * 1024, T, 5632, 1024, 1024, 0, 0};
        EpiFfnFused e{(bf16_t*)(ws + WS_H), (bf16_t*)(ws + WS_GH), (bf16_t*)(ws + WS_GT), (bf16_t*)(ws + WS_UH), SSQ + (l == 0 ? T : 3 * T), IN(p, I_FFN_CONVW) + l * 3 * DFF, IN(p, I_FFN_CONVB) + l * DFF};
        gemm_phase<EpiFfnFused, false>(cx, lds, g, e, nullptr); } break;
    case 6: case 16: { const int l = ph == 6 ? 0 : 1;
        phase_ffn_fix(cx, (const bf16_t*)(ws + WS_GH), (const bf16_t*)(ws + WS_GT), (const bf16_t*)(ws + WS_UH), (bf16_t*)(ws + WS_H), IN(p, I_FFN_CONVW) + l * 3 * DFF, IN(p, I_FFN_CONVB) + l * DFF,
                      IN(p, I_ST_FFNCONV) + l * 8 * 2 * DFF, P_OUT(p) + O_P_FFNCONV + l * 16 * 2 * DFF, P_OUT(p) + O_S_FFNCONV + l * 8 * 2 * DFF); } break;
    case 7: case 17: { const int l = ph == 7 ? 0 : 1;
        Gemm g{(const bf16_t*)(ws + WS_H), (const bf16_t*)(ws + WS_W4) + (size_t)l * 1024 * DFF, T, 1024, DFF, DFF, 0, 0};
        EpiRes<false> e{nullptr, nullptr, XN, SSQ + (l == 0 ? 2 * T : 4 * T)};
        gemm_phase<EpiRes<false>, false, true>(cx, lds, g, e, nullptr, (float*)(ws + WS_SLAB)); } break;
    case 31: phase_split_finish<false, false>(cx, (const float*)(ws + WS_SLAB), 11, nullptr, XN, SSQ + 2 * T, nullptr); break;
    case 33: phase_split_finish<false, false>(cx, (const float*)(ws + WS_SLAB), 11, nullptr, XN, SSQ + 4 * T, nullptr); break;
    case 8: { Gemm g{XN, (const bf16_t*)(ws + WS_W5), T, 2048, 1024, 1024, 0, 0};
        EpiLruIn e{(bf16_t*)(ws + WS_GATE), (bf16_t*)(ws + WS_XBP), SSQ + 2 * T};
        gemm_phase<EpiLruIn, false>(cx, lds, g, e, nullptr); } break;
    case 9: phase_conv<4, 3>(cx, (const bf16_t*)(ws + WS_XBP), 1024, 1024, IN(p, I_LRU_CONVW), IN(p, I_LRU_CONVB), (bf16_t*)(ws + WS_XBC2), 1024, IN(p, I_ST_LRUCONV), P_OUT(p) + O_P_LRUCONV, P_OUT(p) + O_S_LRUCONV); break;
    case 10: { Gemm g{(const bf16_t*)(ws + WS_XBC2), (const bf16_t*)(ws + WS_W6), T, 2048, 256, 1024, 1, 256};
        EpiLruGate e{(const bf16_t*)(ws + WS_XBC2), (bf16_t*)(ws + WS_LA), (bf16_t*)(ws + WS_UU), IN(p, I_LRU_BA), IN(p, I_LRU_BX), (const float*)(ws + WS_SP)};
        gemm_phase<EpiLruGate, false>(cx, lds, g, e, nullptr); } break;
    case 11: phase_lru_a(cx, (const bf16_t*)(ws + WS_LA), (const bf16_t*)(ws + WS_UU), (float*)(ws + WS_SL), (float*)(ws + WS_HH)); break;
    case 12: phase_lru_b(cx, p, (const float*)(ws + WS_SL), (const float*)(ws + WS_HH), (float*)(ws + WS_CIN)); break;
    case 13: phase_lru_c(cx, (const bf16_t*)(ws + WS_LA), (const bf16_t*)(ws + WS_UU), (const float*)(ws + WS_CIN), (bf16_t*)(ws + WS_GATE)); break;
    case 14: { Gemm g{(const bf16_t*)(ws + WS_GATE), (const bf16_t*)(ws + WS_W7), T, 1024, 1024, 1024, 0, 0};
        EpiRes<false> e{nullptr, nullptr, XN, SSQ + 3 * T};
        gemm_phase<EpiRes<false>, false, true>(cx, lds, g, e, nullptr, (float*)(ws + WS_SLAB)); } break;
    case 32: phase_split_finish<false, false>(cx, (const float*)(ws + WS_SLAB), 4, nullptr, XN, SSQ + 3 * T, nullptr); break;
    case 18: phase_final_norm(cx, XN, SSQ + 4 * T, IN(p, I_NORM_FINAL), Y); break;
    default: break;
    }
}

__global__ void __launch_bounds__(NTHREADS, 2) fwd_mega(Params p, int ph_lo, int ph_hi) {
    extern __shared__ __attribute__((aligned(16))) unsigned char smem[];
    LAS unsigned char* lds = (LAS unsigned char*)smem;
    cg::grid_group grid = cg::this_grid();
    volatile LAS unsigned* bst = (volatile LAS unsigned*)(lds + 131072 + 1024);
    if (threadIdx.x == 0) { bst[0] = 0u; bst[1] = 0u; }
    __syncthreads();
    const XcdBarrier xb = xcd_barrier_post((unsigned*)(IN(p, 35)) + WS_BAR / 4, bst);
#ifndef PROBE_K
#define PROBE_K -1
#endif
    bool first = true;
    for (int i = ph_lo; i < ph_hi; ++i) {
        int ph = i;
        if (i >= 5) ph = (i == 5) ? 30 : (i <= 8) ? i - 1 : (i == 9) ? 31 : (i <= 16) ? i - 2 : (i == 17) ? 32 : (i <= 20) ? i - 3 : (i == 21) ? 33 : 18;
        run_phase(p, ph, lds);
        if (i + 1 < ph_hi) { if (first) { grid.sync(); first = false; } else xcd_barrier(xb); }
    }
}

extern "C" void kernel_launch(void* const* d_in, const int* in_sizes, int n_in, void* d_out, int out_size, void* d_ws, size_t ws_size, hipStream_t stream) {
    static int grid = 0;
    if (grid == 0) {
        if (n_in != 34 || (size_t)out_size != O_END || ws_size < WS_NEED) { fprintf(stderr, "kernel_launch: unexpected shapes (n_in %d out %d ws %zu need %zu)\n", n_in, out_size, ws_size, (size_t)WS_NEED); grid = -1; return; }
        int dev = 0, cus = 0, per_cu = 0;
        (void)hipGetDevice(&dev); (void)hipDeviceGetAttribute(&cus, hipDeviceAttributeMultiprocessorCount, dev);
        if (hipFuncSetAttribute((const void*)fwd_mega, hipFuncAttributeMaxDynamicSharedMemorySize, LDS_BYTES) != hipSuccess) { fprintf(stderr, "kernel_launch: hipFuncSetAttribute failed\n"); grid = -1; return; }
        if (hipOccupancyMaxActiveBlocksPerMultiprocessor(&per_cu, (const void*)fwd_mega, NTHREADS, LDS_BYTES) != hipSuccess || per_cu < 1) { fprintf(stderr, "kernel_launch: occupancy query says %d\n", per_cu); per_cu = 1; }
        (void)hipGetLastError();
        grid = cus;
    }
    if (grid < 0) return;
    (void)hipMemsetAsync((unsigned char*)d_ws + WS_BAR, 0, 16384, stream);
    Params p{};
    for (int i = 0; i < 34; ++i) p.ptr[i] = (const float*)d_in[i];
    p.ptr[34] = (const float*)d_out; p.ptr[35] = (const float*)d_ws;
    int lo = 0, hi = NPHASE; void* args[] = {&p, &lo, &hi};
    hipError_t e = hipLaunchCooperativeKernel((const void*)fwd_mega, dim3(grid), dim3(NTHREADS), args, LDS_BYTES, stream);
    if (e != hipSuccess) fprintf(stderr, "cooperative launch failed: %s (grid %d)\n", hipGetErrorString(e), grid);
}
```

```cpp
#include <hip/hip_runtime.h>
#include <hip/hip_cooperative_groups.h>
#include <cstdio>
namespace cg = cooperative_groups;

#define LAS __attribute__((address_space(3)))
typedef unsigned short bf16_t;
typedef short bf16x8 __attribute__((ext_vector_type(8)));
typedef float f32x4 __attribute__((ext_vector_type(4)));
typedef unsigned u32x4 __attribute__((ext_vector_type(4)));
typedef unsigned u32x2 __attribute__((ext_vector_type(2)));

constexpr int TP = 65536;
constexpr int TS = 512;
constexpr int T = TP + TS;
constexpr int DM = 1024;
constexpr int DFF = 2816;
constexpr int XBC = 1536;
constexpr int N1 = 5888;
constexpr float EPS = 1e-6f;
constexpr int NTHREADS = 512;
constexpr int LDS_BYTES = 131072 + 4096;

constexpr size_t O_Y = 0;
constexpr size_t O_P_SSDCONV = (size_t)T * DM;
constexpr size_t O_P_SSD = O_P_SSDCONV + 16 * 3 * XBC;
constexpr size_t O_P_SCONV = O_P_SSD + (size_t)16 * 16 * 64 * 128;
constexpr size_t O_P_LRUCONV = O_P_SCONV + 16 * 2 * 1024;
constexpr size_t O_P_LRU = O_P_LRUCONV + 16 * 3 * 1024;
constexpr size_t O_P_FFNCONV = O_P_LRU + 16 * 1024;
constexpr size_t O_S_SSDCONV = O_P_FFNCONV + 2 * 16 * 2 * DFF;
constexpr size_t O_S_SSD = O_S_SSDCONV + 8 * 3 * XBC;
constexpr size_t O_S_SCONV = O_S_SSD + (size_t)8 * 16 * 64 * 128;
constexpr size_t O_S_LRUCONV = O_S_SCONV + 8 * 2 * 1024;
constexpr size_t O_S_LRU = O_S_LRUCONV + 8 * 3 * 1024;
constexpr size_t O_S_FFNCONV = O_S_LRU + 8 * 1024;
constexpr size_t O_END = O_S_FFNCONV + 2 * 8 * 2 * DFF;

constexpr size_t al256(size_t x) { return (x + 255) & ~(size_t)255; }
constexpr size_t WS_W1 = 0;
constexpr size_t WS_W2 = WS_W1 + (size_t)N1 * 1024 * 2;
constexpr size_t WS_W3 = WS_W2 + (size_t)1024 * 2048 * 2;
constexpr size_t WS_W4 = WS_W3 + (size_t)2 * 5632 * 1024 * 2;
constexpr size_t WS_W5 = WS_W4 + (size_t)2 * 1024 * 2816 * 2;
constexpr size_t WS_W6 = WS_W5 + (size_t)2048 * 1024 * 2;
constexpr size_t WS_W7 = WS_W6 + (size_t)2048 * 256 * 2;
constexpr size_t WS_SP = WS_W7 + (size_t)1024 * 1024 * 2;
constexpr size_t WS_BAR = WS_SP + 4096;
constexpr size_t WS_SSQ = WS_BAR + 16384;
constexpr size_t WS_SL = al256(WS_SSQ + (size_t)5 * T * 4);
constexpr size_t WS_HH = WS_SL + (size_t)1088 * 1024 * 4;
constexpr size_t WS_CIN = WS_HH + (size_t)1088 * 1024 * 4;
constexpr size_t WS_SLAB = al256(WS_CIN + (size_t)1088 * 1024 * 4);
constexpr size_t WS_XN = al256(WS_SLAB + (size_t)88 * 65536 * 4);
constexpr size_t WS_ARENA = al256(WS_XN + (size_t)T * 1024 * 2);
constexpr size_t WS_A2 = WS_ARENA;
constexpr size_t WS_XBCP = WS_A2 + (size_t)T * 2048 * 2;
constexpr size_t WS_XBCA = WS_XBCP + (size_t)T * XBC * 2;
constexpr size_t WS_V = WS_XBCA + (size_t)T * XBC * 2;
constexpr size_t WS_DT = WS_V + (size_t)T * 1024 * 2;
constexpr size_t WS_END0 = WS_DT + (size_t)T * 16 * 4;
constexpr size_t WS_H = WS_ARENA;
constexpr size_t WS_GH = WS_H + (size_t)T * DFF * 2;
constexpr size_t WS_GT = WS_GH + (size_t)1032 * 2 * DFF * 2;
constexpr size_t WS_UH = WS_GT + (size_t)1032 * 2 * DFF * 2;
constexpr size_t WS_END1 = WS_UH + (size_t)1032 * 2 * DFF * 2;
constexpr size_t WS_GATE = WS_ARENA;
constexpr size_t WS_XBP = WS_GATE + (size_t)T * 1024 * 2;
constexpr size_t WS_XBC2 = WS_XBP + (size_t)T * 1024 * 2;
constexpr size_t WS_LA = WS_XBC2 + (size_t)T * 1024 * 2;
constexpr size_t WS_UU = WS_LA + (size_t)T * 1024 * 2;
constexpr size_t WS_END2 = WS_UU + (size_t)T * 1024 * 2;
constexpr size_t WS_NEED = WS_END0 > WS_END1 ? (WS_END0 > WS_END2 ? WS_END0 : WS_END2) : (WS_END1 > WS_END2 ? WS_END1 : WS_END2);

struct Params {
    const float* ptr[36];
};
__device__ __forceinline__ const float* IN(const Params& p, int i) { asm volatile("" : "+s"(i)); return p.ptr[i]; }
#define P_OUT(p) ((float*)IN(p, 34))
#define P_WS(p) ((unsigned char*)IN(p, 35))
enum { I_XP = 0, I_XS, I_ST_SSDCONV, I_ST_SSD, I_ST_SCONV, I_ST_LRUCONV, I_ST_LRU, I_ST_FFNCONV, I_NORM_MIX, I_NORM_FFN, I_NORM_FINAL,
       I_AB_WIN, I_SSD_CONVW, I_SSD_CONVB, I_DT_BIAS, I_A_LOG, I_SSD_D, I_SSD_NORM, I_SC_CONVW, I_SC_CONVB, I_AB_WOUT, I_LRU_WIN,
       I_LRU_CONVW, I_LRU_CONVB, I_LRU_WA, I_LRU_BA, I_LRU_WX, I_LRU_BX, I_LRU_LAMBDA, I_LRU_WOUT, I_FFN_WIN, I_FFN_CONVW, I_FFN_CONVB, I_FFN_WOUT };

struct Ctx { int bid, nblk, tid; };
__device__ __forceinline__ unsigned cvt_pk_bf16(float lo, float hi) { unsigned r; asm("v_cvt_pk_bf16_f32 %0, %1, %2" : "=v"(r) : "v"(lo), "v"(hi)); return r; }
__device__ __forceinline__ float bf_lo(unsigned w) { return __uint_as_float(w << 16); }
__device__ __forceinline__ float bf_hi(unsigned w) { return __uint_as_float(w & 0xffff0000u); }
__device__ __forceinline__ float sigmoidf_(float x) { return __builtin_amdgcn_rcpf(1.0f + __expf(-x)); }
__device__ __forceinline__ float siluf_(float x) { return x * __builtin_amdgcn_rcpf(1.0f + __expf(-x)); }
__device__ __forceinline__ float geluf_(float x) { const float u = x * (1.5957691216f + 0.0713548163f * x * x); return x * __builtin_amdgcn_rcpf(1.0f + __builtin_amdgcn_exp2f(-1.4426950409f * u)); }
__device__ __forceinline__ float softplusf_(float x) { return fmaxf(x, 0.0f) + log1pf(__expf(-fabsf(x))); }
__device__ __forceinline__ void unpack8(const u32x4 w, float (&f)[8]) {
    f[0] = bf_lo(w.x); f[1] = bf_hi(w.x); f[2] = bf_lo(w.y); f[3] = bf_hi(w.y); f[4] = bf_lo(w.z); f[5] = bf_hi(w.z); f[6] = bf_lo(w.w); f[7] = bf_hi(w.w);
}
__device__ __forceinline__ u32x4 pack8(const float (&f)[8]) {
    u32x4 w; w.x = cvt_pk_bf16(f[0], f[1]); w.y = cvt_pk_bf16(f[2], f[3]); w.z = cvt_pk_bf16(f[4], f[5]); w.w = cvt_pk_bf16(f[6], f[7]); return w;
}
__device__ __forceinline__ u32x4 pack44(const f32x4 a, const f32x4 b) {
    u32x4 w; w.x = cvt_pk_bf16(a[0], a[1]); w.y = cvt_pk_bf16(a[2], a[3]); w.z = cvt_pk_bf16(b[0], b[1]); w.w = cvt_pk_bf16(b[2], b[3]); return w;
}

constexpr int BM = 256, BK = 64, HALF = 128, HTB = HALF * BK * 2, NXCD = 8, WGM = 4;
__device__ __forceinline__ int lds_byte(int r, int c) { const int st = (r >> 4) * 2 + (c >> 5), rr = r & 15, cc = c & 31, ob = rr * 64 + cc * 2; return st * 1024 + (ob ^ (((ob >> 9) & 1) << 5)); }
__device__ __forceinline__ void stage_rc(int b, int& R, int& C) { const int st = b / 1024, sb = b % 1024, swz = sb ^ (((sb >> 9) & 1) << 5); R = (st >> 1) * 16 + swz / 64; C = (st & 1) * 32 + (swz % 64) / 2; }
__device__ __forceinline__ int perm32(int rho) { const int n = rho >> 4, i = rho & 15; return 8 * (i >> 2) + 4 * n + (i & 3); }

struct Unit { int pm, pn, kt0, nkt, slab; };
struct Gemm { const bf16_t* A; const bf16_t* Bt; int M, N, K, lda, a_shift, a_koff; };

struct StaticOrder {
    int nM, nN, nwg, G, c, nt, nsplit, ntail;
    __device__ void init(int M, int N, int G_, int c_, int nt_, bool split) { nM = M / BM; nN = N / BM; G = G_; c = c_; nt = nt_; nsplit = 0; ntail = 0;
        if (split) { nM = TP / BM; nsplit = nt / 4; ntail = 2 * nN * nsplit; } nwg = nM * nN; }
    __device__ bool next(int i, Unit& u) const {
        const long L = (long)i * G + c;
        if (L >= nwg) { const int t = (int)(L - nwg); if (t >= ntail) return false;
            const int tile = t / nsplit, piece = t - tile * nsplit; u.pm = TP / BM + tile / nN; u.pn = tile % nN; u.kt0 = piece * 4; u.nkt = 4; u.slab = t; return true; }
        int wgid = (int)L; { const int q = nwg / NXCD, r = nwg % NXCD, xcd = wgid % NXCD, off = wgid / NXCD; wgid = (xcd < r ? xcd * (q + 1) : r * (q + 1) + (xcd - r) * q) + off; }
        const int nig = WGM * nN, gid = wgid / nig, fm = gid * WGM, gsz = (nM - fm) < WGM ? (nM - fm) : WGM;
        u.pm = fm + ((wgid % nig) % gsz); u.pn = (wgid % nig) / gsz; u.kt0 = 0; u.nkt = nt; u.slab = -1; return true;
    }
};

template <class Epi, bool MIDSCALE, bool SPLIT = false>
__device__ __forceinline__ void gemm_phase(const Ctx cx, LAS unsigned char* lds, const Gemm g, const Epi& E, const float* ssq, float* slabs = nullptr) {
    const int tid = cx.tid, wid = __builtin_amdgcn_readfirstlane(tid >> 6), lane = tid & 63, wr = wid >> 2, wc = wid & 3, fr = lane & 15, fq = lane >> 4;
    int K_ = g.K; asm volatile("" : "+s"(K_));
    const int K = K_, nt = K / BK;
    StaticOrder S; S.init(g.M, g.N, cx.nblk, cx.bid, nt, SPLIT);
    unsigned voffA[2], voffB[2];
#pragma unroll
    for (int i = 0; i < 2; ++i) { int R, C; stage_rc(tid * 16 + i * 8192, R, C); const int Rb = Epi::PERM ? ((R & ~31) + perm32(R & 31)) : R;
        voffA[i] = (unsigned)(R * g.lda + C) * 2u; voffB[i] = (unsigned)(Rb * K + C) * 2u; }
    const size_t kstep = (size_t)(BK * 2);
    const size_t hsA = (size_t)HALF * g.lda * 2, hsB = (size_t)HALF * K * 2;
    const size_t tsA = 2 * hsA, tsB = 2 * hsB;
    const unsigned ldsw = (unsigned)wid * 1024u;
    const int aoff = lds_byte(wr * 64 + fr, fq * 8), boff = lds_byte(wc * 32 + fr, fq * 8);
#define SA_(b, h) (((b) * 2 + (h)) * HTB)
#define SB_(b, h) ((4 + (b) * 2 + (h)) * HTB)
#define STAGE_(bufoff, gbase, voff) do { _Pragma("unroll") for (int _i = 0; _i < 2; ++_i) \
        __builtin_amdgcn_global_load_lds((const unsigned*)((const char*)(gbase) + (voff)[_i]), (LAS unsigned*)(lds + (bufoff) + ldsw + _i * 8192), 16, 0, 0); } while (0)
#define LDA_(dst, b, h) do { _Pragma("unroll") for (int m = 0; m < 4; ++m) _Pragma("unroll") for (int k = 0; k < 2; ++k) dst[m][k] = *(const LAS bf16x8*)(lds + SA_(b, h) + aoff + m * 2048 + k * 1024); } while (0)
#define LDB_(dst, b, h) do { _Pragma("unroll") for (int n = 0; n < 2; ++n) _Pragma("unroll") for (int k = 0; k < 2; ++k) dst[n][k] = *(const LAS bf16x8*)(lds + SB_(b, h) + boff + n * 2048 + k * 1024); } while (0)
#define MMA_(ai, bj, At, Bt) do { __builtin_amdgcn_s_setprio(1); _Pragma("unroll") for (int m = 0; m < 4; ++m) _Pragma("unroll") for (int n = 0; n < 2; ++n) _Pragma("unroll") for (int k = 0; k < 2; ++k) \
        acc[ai][bj][m][n] = __builtin_amdgcn_mfma_f32_16x16x32_bf16(Bt[n][k], At[m][k], acc[ai][bj][m][n], 0, 0, 0); __builtin_amdgcn_s_setprio(0); } while (0)
#define WAIT_V_(n) asm volatile("s_waitcnt vmcnt(" #n ")" ::: "memory")
#define WAIT_L_(n) asm volatile("s_waitcnt lgkmcnt(" #n ")" ::: "memory")
#define BAR_ __builtin_amdgcn_s_barrier()
#define SCHED_ __builtin_amdgcn_sched_barrier(0)
#ifndef STAGGER
#define STAGGER 0
#endif
    if (STAGGER && (cx.bid & 8)) {
        const unsigned long long t0 = __builtin_amdgcn_s_memrealtime(); const unsigned long long dl = 800ull;
        while (__builtin_amdgcn_s_memrealtime() - t0 < dl) __builtin_amdgcn_s_sleep(8);
    }
    Unit cur, nxt; int ui = 0;
    if (!S.next(0, cur)) return;
    f32x4 acc[2][2][4][2];
#pragma unroll
    for (int a = 0; a < 2; ++a)
#pragma unroll
        for (int b = 0; b < 2; ++b)
#pragma unroll
            for (int m = 0; m < 4; ++m)
#pragma unroll
                for (int n = 0; n < 2; ++n) acc[a][b][m][n] = (f32x4){0.f, 0.f, 0.f, 0.f};
    bf16x8 At[4][2], B0[2][2], B1[2][2];
    const char* cA = (const char*)g.A + (size_t)cur.pm * tsA + (size_t)((cur.pn >> g.a_shift) * g.a_koff) * 2 + (size_t)cur.kt0 * kstep;
    const char* cB = (const char*)g.Bt + (size_t)cur.pn * tsB + (size_t)cur.kt0 * kstep;
    STAGE_(SB_(0, 0), cB, voffB); STAGE_(SA_(0, 0), cA, voffA); STAGE_(SB_(0, 1), cB + hsB, voffB); STAGE_(SA_(0, 1), cA + hsA, voffA);
    if (wr == 1) BAR_;
    WAIT_V_(4); BAR_;
    STAGE_(SB_(1, 0), cB + kstep, voffB); STAGE_(SA_(1, 0), cA + kstep, voffA); STAGE_(SB_(1, 1), cB + hsB + kstep, voffB);
    WAIT_V_(6); BAR_;
    for (;;) {
        const bool has_next = S.next(ui + 1, nxt);
        const char* nA = has_next ? (const char*)g.A + (size_t)nxt.pm * tsA + (size_t)((nxt.pn >> g.a_shift) * g.a_koff) * 2 + (size_t)nxt.kt0 * kstep : cA;
        const char* nB = has_next ? (const char*)g.Bt + (size_t)nxt.pn * tsB + (size_t)nxt.kt0 * kstep : cB;
        const int cnt = cur.nkt;
        for (int t = 0; t < cnt; t += 2) {
            const bool last = (t == cnt - 2);
            const char* a1 = cA + (size_t)(t + 1) * kstep;
            const char* a2 = last ? nA : cA + (size_t)(t + 2) * kstep; const char* b2 = last ? nB : cB + (size_t)(t + 2) * kstep;
            const char* a3 = a2 + kstep; const char* b3 = b2 + kstep;
            if (MIDSCALE && t == 16 && cur.slab < 0) {
                int rb = cur.pm * BM + wr * 64 + fr; asm volatile("" : "+v"(rb));
#pragma unroll
                for (int ai = 0; ai < 2; ++ai)
#pragma unroll
                    for (int m = 0; m < 4; ++m) {
                        const float sc = rsqrtf(ssq[rb + ai * HALF + m * 16] * (1.0f / 1024.0f) + EPS);
#pragma unroll
                        for (int bj = 0; bj < 2; ++bj)
#pragma unroll
                            for (int n = 0; n < 2; ++n) acc[ai][bj][m][n] *= sc;
                    }
            }
            LDB_(B0, 0, 0); SCHED_; LDA_(At, 0, 0); STAGE_(SA_(1, 1), a1 + hsA, voffA);
            WAIT_L_(8); BAR_; WAIT_L_(0); MMA_(0, 0, At, B0); BAR_; SCHED_;
            LDB_(B1, 0, 1); STAGE_(SB_(0, 0), b2, voffB);
            BAR_; WAIT_L_(0); MMA_(0, 1, At, B1); BAR_;
            LDA_(At, 0, 1); STAGE_(SA_(0, 0), a2, voffA);
            BAR_; WAIT_L_(0); MMA_(1, 0, At, B0); BAR_; SCHED_;
            STAGE_(SB_(0, 1), b2 + hsB, voffB);
            WAIT_V_(6); BAR_; MMA_(1, 1, At, B1); BAR_;
            LDB_(B0, 1, 0); SCHED_; LDA_(At, 1, 0); STAGE_(SA_(0, 1), a2 + hsA, voffA);
            WAIT_L_(8); BAR_; WAIT_L_(0); MMA_(0, 0, At, B0); BAR_; SCHED_;
            LDB_(B1, 1, 1); STAGE_(SB_(1, 0), b3, voffB);
            BAR_; WAIT_L_(0); MMA_(0, 1, At, B1); BAR_;
            LDA_(At, 1, 1); STAGE_(SA_(1, 0), a3, voffA);
            BAR_; WAIT_L_(0); MMA_(1, 0, At, B0); BAR_; SCHED_;
            STAGE_(SB_(1, 1), b3 + hsB, voffB);
            WAIT_V_(6); BAR_; MMA_(1, 1, At, B1); BAR_;
        }
        if (SPLIT && cur.slab >= 0) {
            float* sb = slabs + (size_t)cur.slab * 65536 + (size_t)(wr * 64 + fr) * 256 + wc * 64 + 8 * fq;
#pragma unroll
            for (int ai = 0; ai < 2; ++ai)
#pragma unroll
                for (int m = 0; m < 4; ++m)
#pragma unroll
                    for (int bj = 0; bj < 2; ++bj) { float* q = sb + (size_t)(ai * HALF + m * 16) * 256 + bj * 32; *(f32x4*)q = acc[ai][bj][m][0]; *(f32x4*)(q + 4) = acc[ai][bj][m][1]; }
        } else E(acc, cur, wr, wc, fr, fq);
        if (!has_next) break;
#pragma unroll
        for (int a = 0; a < 2; ++a)
#pragma unroll
            for (int b = 0; b < 2; ++b)
#pragma unroll
                for (int m = 0; m < 4; ++m)
#pragma unroll
                    for (int n = 0; n < 2; ++n) acc[a][b][m][n] = (f32x4){0.f, 0.f, 0.f, 0.f};
        cur = nxt; cA = nA; cB = nB; ++ui;
    }
    WAIT_V_(0);
    if (wr == 0) BAR_;
    BAR_;
#undef SA_
#undef SB_
#undef STAGE_
#undef LDA_
#undef LDB_
#undef MMA_
}

struct EpiG1 {
    static constexpr bool PERM = true;
    bf16_t* A2; bf16_t* XBCP; bf16_t* V; float* DT; const float* dt_bias;
    __device__ __forceinline__ void operator()(const f32x4 (&acc)[2][2][4][2], const Unit& u, int wr, int wc, int fr, int fq) const {
        const int row0 = u.pm * BM + wr * 64 + fr, lc = wc * 32 + 8 * fq;
        if (u.pn < 14) {
            bf16_t* base; int ld, colt;
            if (u.pn < 4) { base = A2; ld = 2048; colt = u.pn * 256; }
            else if (u.pn < 10) { base = XBCP; ld = XBC; colt = (u.pn - 4) * 256; }
            else { base = A2; ld = 2048; colt = 1024 + (u.pn - 10) * 256; }
#pragma unroll
            for (int ai = 0; ai < 2; ++ai)
#pragma unroll
                for (int m = 0; m < 4; ++m) { bf16_t* rowp = base + (size_t)(row0 + ai * HALF + m * 16) * ld + colt + wc * 64 + 8 * fq;
#pragma unroll
                    for (int bj = 0; bj < 2; ++bj) *(u32x4*)(rowp + bj * 32) = pack44(acc[ai][bj][m][0], acc[ai][bj][m][1]); }
        } else if (u.pn < 22) {
            const int ch0 = (u.pn - 14) * 128 + lc;
#pragma unroll
            for (int ai = 0; ai < 2; ++ai)
#pragma unroll
                for (int m = 0; m < 4; ++m) { bf16_t* rowp = V + (size_t)(row0 + ai * HALF + m * 16) * 1024 + ch0;
                    *(u32x4*)rowp = pack44(acc[ai][0][m][0] * acc[ai][1][m][0], acc[ai][0][m][1] * acc[ai][1][m][1]); }
        } else {
            if (wc == 0 && fq < 2) {
                const f32x4 b0 = *(const f32x4*)(dt_bias + 8 * fq), b1 = *(const f32x4*)(dt_bias + 8 * fq + 4);
#pragma unroll
                for (int ai = 0; ai < 2; ++ai)
#pragma unroll
                    for (int m = 0; m < 4; ++m) { float* rowp = DT + (size_t)(row0 + ai * HALF + m * 16) * 16 + 8 * fq;
                        f32x4 v0 = acc[ai][0][m][0] + b0, v1 = acc[ai][0][m][1] + b1;
#pragma unroll
                        for (int j = 0; j < 4; ++j) { v0[j] = softplusf_(v0[j]); v1[j] = softplusf_(v1[j]); }
                        *(f32x4*)rowp = v0; *(f32x4*)(rowp + 4) = v1; }
            }
        }
    }
};
template <bool SRC_F32> struct EpiRes {
    static constexpr bool PERM = true;
    const float* xp; const float* xs; bf16_t* XN; float* ssq;
    __device__ __forceinline__ void operator()(const f32x4 (&acc)[2][2][4][2], const Unit& u, int wr, int wc, int fr, int fq) const {
        const int row0 = u.pm * BM + wr * 64 + fr, col0 = u.pn * BM + wc * 64 + 8 * fq;
        if (SRC_F32) {
#pragma unroll
            for (int ai = 0; ai < 2; ++ai) {
                f32x4 old[4][2][2];
#pragma unroll
                for (int m = 0; m < 4; ++m) { const int row = row0 + ai * HALF + m * 16;
                    const float* src = (row < TP ? xp + (size_t)row * DM : xs + (size_t)(row - TP) * DM) + col0;
#pragma unroll
                    for (int bj = 0; bj < 2; ++bj) { old[m][bj][0] = *(const f32x4*)(src + bj * 32); old[m][bj][1] = *(const f32x4*)(src + bj * 32 + 4); } }
#pragma unroll
                for (int m = 0; m < 4; ++m) { const int row = row0 + ai * HALF + m * 16; bf16_t* xnp = XN + (size_t)row * DM + col0; float sq = 0.f;
#pragma unroll
                    for (int bj = 0; bj < 2; ++bj) { const f32x4 v0 = old[m][bj][0] + acc[ai][bj][m][0], v1 = old[m][bj][1] + acc[ai][bj][m][1];
                        *(u32x4*)(xnp + bj * 32) = pack44(v0, v1);
                        sq += v0[0] * v0[0] + v0[1] * v0[1] + v0[2] * v0[2] + v0[3] * v0[3] + v1[0] * v1[0] + v1[1] * v1[1] + v1[2] * v1[2] + v1[3] * v1[3]; }
                    sq += __shfl_xor(sq, 16); sq += __shfl_xor(sq, 32);
                    if (fq == 0) atomicAdd(ssq + row, sq); }
            }
        } else {
#pragma unroll
            for (int ai = 0; ai < 2; ++ai) {
                u32x4 old[4][2];
#pragma unroll
                for (int m = 0; m < 4; ++m)
#pragma unroll
                    for (int bj = 0; bj < 2; ++bj) old[m][bj] = *(const u32x4*)(XN + (size_t)(row0 + ai * HALF + m * 16) * DM + col0 + bj * 32);
#pragma unroll
                for (int m = 0; m < 4; ++m) { const int row = row0 + ai * HALF + m * 16; bf16_t* xnp = XN + (size_t)row * DM + col0; float sq = 0.f;
#pragma unroll
                    for (int bj = 0; bj < 2; ++bj) { const u32x4 w = old[m][bj];
                        const f32x4 v0 = (f32x4){bf_lo(w.x), bf_hi(w.x), bf_lo(w.y), bf_hi(w.y)} + acc[ai][bj][m][0], v1 = (f32x4){bf_lo(w.z), bf_hi(w.z), bf_lo(w.w), bf_hi(w.w)} + acc[ai][bj][m][1];
                        *(u32x4*)(xnp + bj * 32) = pack44(v0, v1);
                        sq += v0[0] * v0[0] + v0[1] * v0[1] + v0[2] * v0[2] + v0[3] * v0[3] + v1[0] * v1[0] + v1[1] * v1[1] + v1[2] * v1[2] + v1[3] * v1[3]; }
                    sq += __shfl_xor(sq, 16); sq += __shfl_xor(sq, 32);
                    if (fq == 0) atomicAdd(ssq + row, sq); }
            }
        }
    }
};
__device__ __forceinline__ float dpp_ror1(float v) { return __int_as_float(__builtin_amdgcn_update_dpp(0, __float_as_int(v), 0x121, 0xf, 0xf, false)); }
__device__ __forceinline__ float dpp_ror2(float v) { return __int_as_float(__builtin_amdgcn_update_dpp(0, __float_as_int(v), 0x122, 0xf, 0xf, false)); }
struct EpiFfnFused {
    static constexpr bool PERM = true;
    bf16_t* H; bf16_t* GH; bf16_t* GT; bf16_t* UH; const float* ssq; const float* cw; const float* cb;
    __device__ __forceinline__ void operator()(const f32x4 (&acc)[2][2][4][2], const Unit& u, int wr, int wc, int fr, int fq) const {
        const int ch0 = u.pn * 128 + wc * 32 + 8 * fq;
        float w0[8], w1[8], w2[8], bb[8];
#pragma unroll
        for (int h = 0; h < 2; ++h) { const f32x4 a = *(const f32x4*)(cw + ch0 + 4 * h), b = *(const f32x4*)(cw + DFF + ch0 + 4 * h), c = *(const f32x4*)(cw + 2 * DFF + ch0 + 4 * h), d = *(const f32x4*)(cb + ch0 + 4 * h);
#pragma unroll
            for (int j = 0; j < 4; ++j) { w0[4 * h + j] = a[j]; w1[4 * h + j] = b[j]; w2[4 * h + j] = c[j]; bb[4 * h + j] = d[j]; } }
        float ssv[2][4];
#pragma unroll
        for (int ai = 0; ai < 2; ++ai)
#pragma unroll
            for (int m = 0; m < 4; ++m) ssv[ai][m] = ssq[u.pm * BM + ai * HALF + wr * 64 + m * 16 + fr];
#pragma unroll
        for (int ai = 0; ai < 2; ++ai) {
            const int grp = 4 * u.pm + 2 * ai + wr;
            float p1[8], p2[8];
#pragma unroll
            for (int q = 0; q < 8; ++q) { p1[q] = 0.f; p2[q] = 0.f; }
#pragma unroll
            for (int m = 0; m < 4; ++m) {
                const int row = u.pm * BM + ai * HALF + wr * 64 + m * 16 + fr;
                const float sc = rsqrtf(ssv[ai][m] * (1.0f / 1024.0f) + EPS);
                float g[8], uu[8], c1[8], c2[8], hh[8];
#pragma unroll
                for (int n = 0; n < 2; ++n)
#pragma unroll
                    for (int j = 0; j < 4; ++j) { g[4 * n + j] = acc[ai][0][m][n][j] * sc; uu[4 * n + j] = acc[ai][1][m][n][j] * sc; }
#pragma unroll
                for (int q = 0; q < 8; ++q) { c1[q] = dpp_ror1(g[q]); c2[q] = dpp_ror2(g[q]); }
                if (m == 0 && fr < 2) { const size_t o = ((size_t)grp * 2 + fr) * DFF + ch0; *(u32x4*)(GH + o) = pack8(g); *(u32x4*)(UH + o) = pack8(uu); }
                if (m == 3 && fr >= 14) { const size_t o = ((size_t)grp * 2 + (fr - 14)) * DFF + ch0; *(u32x4*)(GT + o) = pack8(g); }
#pragma unroll
                for (int q = 0; q < 8; ++q) { const float gm1 = (fr == 0) ? p1[q] : c1[q], gm2 = (fr < 2) ? p2[q] : c2[q];
                    hh[q] = geluf_(bb[q] + w0[q] * gm2 + w1[q] * gm1 + w2[q] * g[q]) * uu[q]; p1[q] = c1[q]; p2[q] = c2[q]; }
                *(u32x4*)(H + (size_t)row * DFF + ch0) = pack8(hh);
            }
        }
    }
};
struct EpiLruIn {
    static constexpr bool PERM = true;
    bf16_t* GATE; bf16_t* XBP; const float* ssq;
    __device__ __forceinline__ void operator()(const f32x4 (&acc)[2][2][4][2], const Unit& u, int wr, int wc, int fr, int fq) const {
        const int row0 = u.pm * BM + wr * 64 + fr, lc = wc * 32 + 8 * fq;
        const bool isgate = u.pn < 4;
        bf16_t* base = isgate ? GATE : XBP; const int colt = (isgate ? u.pn : u.pn - 4) * 256 + wc * 64 + 8 * fq;
        float ssv[2][4];
#pragma unroll
        for (int ai = 0; ai < 2; ++ai)
#pragma unroll
            for (int m = 0; m < 4; ++m) ssv[ai][m] = ssq[row0 + ai * HALF + m * 16];
#pragma unroll
        for (int ai = 0; ai < 2; ++ai)
#pragma unroll
            for (int m = 0; m < 4; ++m) { bf16_t* rowp = base + (size_t)(row0 + ai * HALF + m * 16) * 1024 + colt;
                const float sc = rsqrtf(ssv[ai][m] * (1.0f / 1024.0f) + EPS);
#pragma unroll
                for (int bj = 0; bj < 2; ++bj) { f32x4 v0 = acc[ai][bj][m][0] * sc, v1 = acc[ai][bj][m][1] * sc;
                    if (isgate) {
#pragma unroll
                        for (int j = 0; j < 4; ++j) { v0[j] = geluf_(v0[j]); v1[j] = geluf_(v1[j]); } }
                    *(u32x4*)(rowp + bj * 32) = pack44(v0, v1); } }
    }
};
struct EpiLruGate {
    static constexpr bool PERM = true;
    const bf16_t* XBC2; bf16_t* LA; bf16_t* UU; const float* ba; const float* bx; const float* sp;
    __device__ __forceinline__ void operator()(const f32x4 (&acc)[2][2][4][2], const Unit& u, int wr, int wc, int fr, int fq) const {
        const int row0 = u.pm * BM + wr * 64 + fr, ch0 = (u.pn >> 1) * 256 + (u.pn & 1) * 128 + wc * 32 + 8 * fq;
        u32x4 xw[2][4];
#pragma unroll
        for (int ai = 0; ai < 2; ++ai)
#pragma unroll
            for (int m = 0; m < 4; ++m) xw[ai][m] = *(const u32x4*)(XBC2 + (size_t)(row0 + ai * HALF + m * 16) * 1024 + ch0);
        f32x4 vba[2], vbx[2], vsp[2];
#pragma unroll
        for (int n = 0; n < 2; ++n) { vba[n] = *(const f32x4*)(ba + ch0 + 4 * n); vbx[n] = *(const f32x4*)(bx + ch0 + 4 * n); vsp[n] = *(const f32x4*)(sp + ch0 + 4 * n); }
#pragma unroll
        for (int ai = 0; ai < 2; ++ai)
#pragma unroll
            for (int m = 0; m < 4; ++m) { const size_t o = (size_t)(row0 + ai * HALF + m * 16) * 1024 + ch0;
                float xb[8]; unpack8(xw[ai][m], xb);
                float la[8], uu[8];
#pragma unroll
                for (int n = 0; n < 2; ++n)
#pragma unroll
                    for (int j = 0; j < 4; ++j) { const int q = 4 * n + j;
                        const float r = sigmoidf_(acc[ai][0][m][n][j] + vba[n][j]), ig = sigmoidf_(acc[ai][1][m][n][j] + vbx[n][j]);
                        const float l = -8.0f * r * vsp[n][j]; la[q] = l;
                        const float mult = __builtin_amdgcn_sqrtf(fmaxf(0.0f, 1.0f - __expf(2.0f * l)));
                        uu[q] = mult * ig * xb[q]; }
                *(u32x4*)(LA + o) = pack8(la); *(u32x4*)(UU + o) = pack8(uu); }
    }
};

__device__ __forceinline__ void wconv_tile(const Ctx cx, const float* src, int ld_src, int nvalid, const float* gain, int k0, bf16_t* dst, int K, LAS unsigned char* lds, int delta = 0) {
    const int lane = cx.tid & 63; LAS bf16_t* L = (LAS bf16_t*)(lds + (cx.tid >> 6) * 8448);
    float v[64];
    const int scol = lane + (lane >= 32 ? delta : 0);
#pragma unroll
    for (int k = 0; k < 64; ++k) v[k] = (lane < nvalid) ? src[(size_t)k * ld_src + scol] : 0.f;
    if (gain) {
#pragma unroll
        for (int k = 0; k < 64; ++k) v[k] *= gain[k0 + k]; }
#pragma unroll
    for (int k = 0; k < 64; k += 2) *(LAS unsigned*)(L + lane * 66 + k) = cvt_pk_bf16(v[k], v[k + 1]);
    asm volatile("s_waitcnt lgkmcnt(0)" ::: "memory");
#pragma unroll
    for (int i = 0; i < 8; ++i) { const int n = (lane >> 3) + 8 * i, kq = lane & 7; const LAS unsigned* q = (const LAS unsigned*)(L + n * 66 + kq * 8);
        u32x4 w; w.x = q[0]; w.y = q[1]; w.z = q[2]; w.w = q[3];
        *(u32x4*)(dst + (size_t)n * K + kq * 8) = w; }
    asm volatile("s_waitcnt lgkmcnt(0)" ::: "memory");
}
__device__ __forceinline__ int lcol0(int n0) { const int q = (n0 & 255) >> 6; return (n0 & ~255) + 128 * (q & 1) + 32 * (q >> 1); }
__device__ __forceinline__ void phase_prep(const Ctx cx, const Params& p, LAS unsigned char* lds, const int task_lo, const int task_hi, const int vb, const int nvb, const bool tables) {
    unsigned char* ws = P_WS(p);
    constexpr int NT1 = 92 * 16, NT2 = 16 * 32, NT3 = 88 * 16, NT4 = 16 * 44, NT5 = 32 * 16, NT6 = 32 * 4, NT7 = 16 * 16;
    constexpr int NTASK = NT1 + NT2 + 2 * NT3 + 2 * NT4 + NT5 + NT6 + NT7;
    for (int task = task_lo + vb * 8 + __builtin_amdgcn_readfirstlane(cx.tid >> 6); task < (task_hi < NTASK ? task_hi : NTASK); task += nvb * 8) {
        int id = task;
        if (id < NT1) { const int ntile = id / 16, kt = id % 16, n0 = ntile * 64, k0 = kt * 64, pn = n0 >> 8, lc0 = n0 & 255;
            int col, nv = 64;
            int dl = 0;
            if (pn < 10) { col = lcol0(n0); dl = 32; } else if (pn < 14) { col = 2576 + (lcol0(n0) - 2560); dl = 32; }
            else if (pn < 22) col = (lc0 < 128 ? 3600 : 4624) + (pn - 14) * 128 + (lc0 & 127);
            else { col = 2560; nv = (lc0 == 0) ? 16 : 0; }
            wconv_tile(cx, IN(p, I_AB_WIN) + (size_t)k0 * 5648 + col, 5648, nv, IN(p, I_NORM_MIX), k0, (bf16_t*)(ws + WS_W1) + (size_t)n0 * 1024 + k0, 1024, lds, dl); continue; }
        id -= NT1;
        if (id < NT2) { const int ntile = id / 32, kt = id % 32, n0 = ntile * 64, k0 = kt * 64;
            wconv_tile(cx, IN(p, I_AB_WOUT) + (size_t)k0 * 1024 + lcol0(n0), 1024, 64, k0 < 1024 ? IN(p, I_SSD_NORM) : nullptr, k0, (bf16_t*)(ws + WS_W2) + (size_t)n0 * 2048 + k0, 2048, lds, 32); continue; }
        id -= NT2;
        if (id < 2 * NT3) { const int l = id / NT3; id -= l * NT3; const int ntile = id / 16, kt = id % 16, n0 = ntile * 64, k0 = kt * 64, pn = n0 >> 8, lc0 = n0 & 255;
            const int col = (lc0 < 128 ? 0 : DFF) + pn * 128 + (lc0 & 127);
            wconv_tile(cx, IN(p, I_FFN_WIN) + (size_t)l * 1024 * 5632 + (size_t)k0 * 5632 + col, 5632, 64, IN(p, I_NORM_FFN) + l * 1024, k0, (bf16_t*)(ws + WS_W3) + (size_t)l * 5632 * 1024 + (size_t)n0 * 1024 + k0, 1024, lds); continue; }
        id -= 2 * NT3;
        if (id < 2 * NT4) { const int l = id / NT4; id -= l * NT4; const int ntile = id / 44, kt = id % 44, n0 = ntile * 64, k0 = kt * 64;
            wconv_tile(cx, IN(p, I_FFN_WOUT) + (size_t)l * DFF * 1024 + (size_t)k0 * 1024 + lcol0(n0), 1024, 64, nullptr, k0, (bf16_t*)(ws + WS_W4) + (size_t)l * 1024 * DFF + (size_t)n0 * DFF + k0, DFF, lds, 32); continue; }
        id -= 2 * NT4;
        if (id < NT5) { const int ntile = id / 16, kt = id % 16, n0 = ntile * 64, k0 = kt * 64;
            wconv_tile(cx, IN(p, I_LRU_WIN) + (size_t)k0 * 2048 + lcol0(n0), 2048, 64, IN(p, I_NORM_MIX) + 1024, k0, (bf16_t*)(ws + WS_W5) + (size_t)n0 * 1024 + k0, 1024, lds, 32); continue; }
        id -= NT5;
        if (id < NT6) { const int ntile = id / 4, kt = id % 4, n0 = ntile * 64, k0 = kt * 64, head = n0 >> 9, within = n0 & 511, pnl = within >> 8, lc0 = within & 255;
            const int ch = pnl * 128 + (lc0 & 127);
            const float* srcm = (lc0 < 128 ? IN(p, I_LRU_WA) : IN(p, I_LRU_WX)) + (size_t)head * 65536;
            wconv_tile(cx, srcm + (size_t)k0 * 256 + ch, 256, 64, nullptr, k0, (bf16_t*)(ws + WS_W6) + (size_t)n0 * 256 + k0, 256, lds); continue; }
        id -= NT6;
        { const int ntile = id / 16, kt = id % 16, n0 = ntile * 64, k0 = kt * 64;
            wconv_tile(cx, IN(p, I_LRU_WOUT) + (size_t)k0 * 1024 + lcol0(n0), 1024, 64, nullptr, k0, (bf16_t*)(ws + WS_W7) + (size_t)n0 * 1024 + k0, 1024, lds, 32); }
    }
    if (!tables) return;
    const int gt = cx.bid * NTHREADS + cx.tid, gs = cx.nblk * NTHREADS;
    for (int i = gt; i < 1024; i += gs) ((float*)(ws + WS_SP))[i] = softplusf_(-IN(p, I_LRU_LAMBDA)[i]);
    for (int i = gt; i < 5 * T; i += gs) ((float*)(ws + WS_SSQ))[i] = 0.f;
}

__device__ __forceinline__ void phase_norm(const Ctx cx, const float* xp, const float* xs, bf16_t* XN) {
    const int wid = cx.tid >> 6, lane = cx.tid & 63;
    for (int row0 = cx.bid * 8 + wid; row0 < T; row0 += cx.nblk * 32) {
        f32x4 v[4][4];
#pragma unroll
        for (int i = 0; i < 4; ++i) { const int row = row0 + i * cx.nblk * 8;
            if (row < T) { const float* src = row < TP ? xp + (size_t)row * DM : xs + (size_t)(row - TP) * DM;
#pragma unroll
                for (int j = 0; j < 4; ++j) v[i][j] = *(const f32x4*)(src + lane * 4 + j * 256); } }
#pragma unroll
        for (int i = 0; i < 4; ++i) { const int row = row0 + i * cx.nblk * 8;
            if (row < T) { float s = 0.f;
#pragma unroll
                for (int j = 0; j < 4; ++j) s += v[i][j][0] * v[i][j][0] + v[i][j][1] * v[i][j][1] + v[i][j][2] * v[i][j][2] + v[i][j][3] * v[i][j][3];
#pragma unroll
                for (int o = 32; o >= 1; o >>= 1) s += __shfl_xor(s, o);
                const float rs = rsqrtf(s * (1.0f / 1024.0f) + EPS);
#pragma unroll
                for (int j = 0; j < 4; ++j) { u32x2 w; w.x = cvt_pk_bf16(v[i][j][0] * rs, v[i][j][1] * rs); w.y = cvt_pk_bf16(v[i][j][2] * rs, v[i][j][3] * rs);
                    *(u32x2*)(XN + (size_t)row * DM + lane * 4 + j * 256) = w; } } }
    }
}
__device__ __forceinline__ void phase_final_norm(const Ctx cx, const bf16_t* XN, const float* ssq, const float* gain, float* y) {
    const int wid = cx.tid >> 6, lane = cx.tid & 63;
    f32x4 gv[4];
#pragma unroll
    for (int j = 0; j < 4; ++j) gv[j] = *(const f32x4*)(gain + lane * 4 + j * 256);
    for (int row0 = cx.bid * 8 + wid; row0 < T; row0 += cx.nblk * 64) {
        u32x2 w[8][4]; float rs[8];
#pragma unroll
        for (int i = 0; i < 8; ++i) { const int row = row0 + i * cx.nblk * 8;
            if (row < T) {
#pragma unroll
                for (int j = 0; j < 4; ++j) w[i][j] = *(const u32x2*)(XN + (size_t)row * DM + lane * 4 + j * 256);
                rs[i] = rsqrtf(ssq[row] * (1.0f / 1024.0f) + EPS); } }
#pragma unroll
        for (int i = 0; i < 8; ++i) { const int row = row0 + i * cx.nblk * 8;
            if (row < T) { float* dst = y + (size_t)row * DM + lane * 4;
#pragma unroll
                for (int j = 0; j < 4; ++j) *(f32x4*)(dst + j * 256) = (f32x4){bf_lo(w[i][j].x), bf_hi(w[i][j].x), bf_lo(w[i][j].y), bf_hi(w[i][j].y)} * rs[i] * gv[j]; } }
    }
}

template <int KW, int MODE>
__device__ __forceinline__ void phase_conv(const Ctx cx, const bf16_t* src, int ld_src, int NC, const float* w, const float* bias, bf16_t* dst, int ld_dst,
                           const float* st_in, float* out_p, float* out_s) {
    const int ncg = NC >> 3, total = (T / 16) * ncg;
    for (int item = cx.bid * NTHREADS + cx.tid; item < total; item += cx.nblk * NTHREADS) {
        const int cgi = item % ncg, seg = item / ncg, c0 = cgi * 8, r0 = seg * 16;
        int seq, t0, L; if (r0 < TP) { seq = r0 >> 12; t0 = r0 & 4095; L = 4096; } else { seq = 16 + ((r0 - TP) >> 6); t0 = (r0 - TP) & 63; L = 64; }
        float wv[KW][8], bv[8];
#pragma unroll
        for (int k = 0; k < KW; ++k) { const f32x4 a = *(const f32x4*)(w + (size_t)k * NC + c0), b = *(const f32x4*)(w + (size_t)k * NC + c0 + 4);
#pragma unroll
            for (int j = 0; j < 4; ++j) { wv[k][j] = a[j]; wv[k][4 + j] = b[j]; } }
        { const f32x4 a = *(const f32x4*)(bias + c0), b = *(const f32x4*)(bias + c0 + 4);
#pragma unroll
          for (int j = 0; j < 4; ++j) { bv[j] = a[j]; bv[4 + j] = b[j]; } }
        float win[KW - 1][8];
#pragma unroll
        for (int k = 0; k < KW - 1; ++k) {
            if (t0 > 0) unpack8(*(const u32x4*)(src + (size_t)(r0 - (KW - 1) + k) * ld_src + c0), win[k]);
            else if (seq >= 16) { const float* sp_ = st_in + ((size_t)(seq - 16) * (KW - 1) + k) * NC + c0; const f32x4 a = *(const f32x4*)sp_, b = *(const f32x4*)(sp_ + 4);
#pragma unroll
                for (int j = 0; j < 4; ++j) { win[k][j] = a[j]; win[k][4 + j] = b[j]; } }
            else {
#pragma unroll
                for (int j = 0; j < 8; ++j) win[k][j] = 0.f; }
        }
#pragma unroll
        for (int h = 0; h < 2; ++h) {
            u32x4 rows[8], aux[8];
#pragma unroll
            for (int i = 0; i < 8; ++i) { rows[i] = *(const u32x4*)(src + (size_t)(r0 + h * 8 + i) * ld_src + c0);
                if (MODE == 1 || MODE == 2) aux[i] = *(const u32x4*)(dst + (size_t)(r0 + h * 8 + i) * ld_dst + c0); }
#pragma unroll
            for (int i = 0; i < 8; ++i) {
                float cur[8], y[8]; unpack8(rows[i], cur);
#pragma unroll
                for (int j = 0; j < 8; ++j) { float a = bv[j] + wv[KW - 1][j] * cur[j];
#pragma unroll
                    for (int k = 0; k < KW - 1; ++k) a += wv[k][j] * win[k][j];
                    y[j] = a; }
#pragma unroll
                for (int j = 0; j < 8; ++j) {
#pragma unroll
                    for (int k = 0; k < KW - 2; ++k) win[k][j] = win[k + 1][j];
                    win[KW - 2][j] = cur[j]; }
                if (MODE == 0) {
#pragma unroll
                    for (int j = 0; j < 8; ++j) y[j] = siluf_(y[j]); }
                if (MODE == 1) { float gq[8]; unpack8(aux[i], gq);
#pragma unroll
                    for (int j = 0; j < 8; ++j) y[j] = y[j] * gq[j]; }
                if (MODE == 2) { float uq[8]; unpack8(aux[i], uq);
#pragma unroll
                    for (int j = 0; j < 8; ++j) y[j] = geluf_(y[j]) * uq[j]; }
                *(u32x4*)(dst + (size_t)(r0 + h * 8 + i) * ld_dst + c0) = pack8(y);
            }
            if (h == 1 && t0 + 16 == L) {
                float* ob = (seq < 16 ? out_p + (size_t)seq * (KW - 1) * NC : out_s + (size_t)(seq - 16) * (KW - 1) * NC) + c0;
#pragma unroll
                for (int j = 0; j < KW - 1; ++j) { float f[8]; unpack8(rows[8 - (KW - 1) + j], f);
                    *(f32x4*)(ob + (size_t)j * NC) = (f32x4){f[0], f[1], f[2], f[3]}; *(f32x4*)(ob + (size_t)j * NC + 4) = (f32x4){f[4], f[5], f[6], f[7]}; }
            }
        }
    }
}

template <bool SRC_F32, bool GSCALE>
__device__ __forceinline__ void phase_split_finish(const Ctx cx, const float* slabs, int nsplit, const float* xs, bf16_t* XN, float* ssq, const float* gssq) {
    const int wid = cx.tid >> 6, lane = cx.tid & 63;
    for (int r = cx.bid * 8 + wid; r < TS; r += cx.nblk * 8) {
        const int panel = r >> 8, rl = r & 255, pn = lane >> 4, lc = (lane & 15) * 16;
        const float* sb = slabs + (size_t)((panel * 4 + pn) * nsplit) * 65536 + (size_t)rl * 256 + lc;
        f32x4 v[4];
#pragma unroll
        for (int q = 0; q < 4; ++q) v[q] = (f32x4){0.f, 0.f, 0.f, 0.f};
        for (int pc = 0; pc < nsplit; ++pc) {
#pragma unroll
            for (int q = 0; q < 4; ++q) v[q] += *(const f32x4*)(sb + (size_t)pc * 65536 + 4 * q);
            if (GSCALE && pc == 3) { const float sc = rsqrtf(gssq[TP + r] * (1.0f / 1024.0f) + EPS);
#pragma unroll
                for (int q = 0; q < 4; ++q) v[q] *= sc; }
        }
        bf16_t* xnp = XN + (size_t)(TP + r) * DM + lane * 16;
        if (SRC_F32) { const float* src = xs + (size_t)r * DM + lane * 16;
#pragma unroll
            for (int q = 0; q < 4; ++q) v[q] += *(const f32x4*)(src + 4 * q); }
        else { float a[8], b[8]; unpack8(*(const u32x4*)xnp, a); unpack8(*(const u32x4*)(xnp + 8), b);
            v[0] += (f32x4){a[0], a[1], a[2], a[3]}; v[1] += (f32x4){a[4], a[5], a[6], a[7]}; v[2] += (f32x4){b[0], b[1], b[2], b[3]}; v[3] += (f32x4){b[4], b[5], b[6], b[7]}; }
        *(u32x4*)xnp = pack44(v[0], v[1]); *(u32x4*)(xnp + 8) = pack44(v[2], v[3]);
        float sq = 0.f;
#pragma unroll
        for (int q = 0; q < 4; ++q) sq += v[q][0] * v[q][0] + v[q][1] * v[q][1] + v[q][2] * v[q][2] + v[q][3] * v[q][3];
#pragma unroll
        for (int o = 32; o >= 1; o >>= 1) sq += __shfl_xor(sq, o);
        if (lane == 0) ssq[TP + r] = sq;
    }
}

__device__ __forceinline__ void phase_ffn_fix(const Ctx cx, const bf16_t* GH, const bf16_t* GT, const bf16_t* UH, bf16_t* H, const float* cw, const float* cb,
                                              const float* st_in, float* out_p, float* out_s) {
    const int ncg = DFF / 8, total = 1032 * ncg;
    for (int item = cx.bid * NTHREADS + cx.tid; item < total; item += cx.nblk * NTHREADS) {
        const int cgi = item % ncg, G = item / ncg, c0 = cgi * 8;
        int seq; bool first, lastg;
        if (G < 1024) { seq = G >> 6; first = (G & 63) == 0; lastg = (G & 63) == 63; } else { seq = 16 + (G - 1024); first = true; lastg = true; }
        float w0[8], w1[8], w2[8], bb[8], gm2[8], gm1[8], g0[8], g1[8], u0[8], u1[8];
#pragma unroll
        for (int h = 0; h < 2; ++h) { const f32x4 a = *(const f32x4*)(cw + c0 + 4 * h), b = *(const f32x4*)(cw + DFF + c0 + 4 * h), c = *(const f32x4*)(cw + 2 * DFF + c0 + 4 * h), d = *(const f32x4*)(cb + c0 + 4 * h);
#pragma unroll
            for (int j = 0; j < 4; ++j) { w0[4 * h + j] = a[j]; w1[4 * h + j] = b[j]; w2[4 * h + j] = c[j]; bb[4 * h + j] = d[j]; } }
        if (!first) { unpack8(*(const u32x4*)(GT + ((size_t)(G - 1) * 2 + 0) * DFF + c0), gm2); unpack8(*(const u32x4*)(GT + ((size_t)(G - 1) * 2 + 1) * DFF + c0), gm1); }
        else if (seq >= 16) { const float* s0 = st_in + ((size_t)(seq - 16) * 2) * DFF + c0;
#pragma unroll
            for (int h = 0; h < 2; ++h) { const f32x4 a = *(const f32x4*)(s0 + 4 * h), b = *(const f32x4*)(s0 + DFF + 4 * h);
#pragma unroll
                for (int j = 0; j < 4; ++j) { gm2[4 * h + j] = a[j]; gm1[4 * h + j] = b[j]; } } }
        else {
#pragma unroll
            for (int q = 0; q < 8; ++q) { gm2[q] = 0.f; gm1[q] = 0.f; } }
        unpack8(*(const u32x4*)(GH + ((size_t)G * 2 + 0) * DFF + c0), g0); unpack8(*(const u32x4*)(GH + ((size_t)G * 2 + 1) * DFF + c0), g1);
        unpack8(*(const u32x4*)(UH + ((size_t)G * 2 + 0) * DFF + c0), u0); unpack8(*(const u32x4*)(UH + ((size_t)G * 2 + 1) * DFF + c0), u1);
        float h0[8], h1[8];
#pragma unroll
        for (int q = 0; q < 8; ++q) { h0[q] = geluf_(bb[q] + w0[q] * gm2[q] + w1[q] * gm1[q] + w2[q] * g0[q]) * u0[q];
            h1[q] = geluf_(bb[q] + w0[q] * gm1[q] + w1[q] * g0[q] + w2[q] * g1[q]) * u1[q]; }
        *(u32x4*)(H + (size_t)(G * 64) * DFF + c0) = pack8(h0); *(u32x4*)(H + (size_t)(G * 64 + 1) * DFF + c0) = pack8(h1);
        if (lastg) {
            float* ob = (seq < 16 ? out_p + (size_t)seq * 2 * DFF : out_s + (size_t)(seq - 16) * 2 * DFF) + c0;
#pragma unroll
            for (int j = 0; j < 2; ++j) { float f[8]; unpack8(*(const u32x4*)(GT + ((size_t)G * 2 + j) * DFF + c0), f);
                *(f32x4*)(ob + (size_t)j * DFF) = (f32x4){f[0], f[1], f[2], f[3]}; *(f32x4*)(ob + (size_t)j * DFF + 4) = (f32x4){f[4], f[5], f[6], f[7]}; }
        }
    }
}

constexpr int SC_CS = 0, SC_BS = 17408, SC_BTS = 34816, SC_XTS = 53248, SC_XDS = 62464, SC_HS = 71680, SC_MS = 89088, SC_AS = 98304, SC_SQ = 98560;
#define LDS_BARRIER() do { asm volatile("s_waitcnt lgkmcnt(0)" ::: "memory"); __builtin_amdgcn_s_barrier(); asm volatile("" ::: "memory"); } while (0)
template <int N> __device__ __forceinline__ float dpp_shr(float v) { return __int_as_float(__builtin_amdgcn_update_dpp(0, __float_as_int(v), 0x110 + N, 0xf, 0xf, true)); }
__device__ __forceinline__ void ssd_task(const Ctx cx, const Params& p, LAS unsigned char* lds, int seq, int hd) {
    const int tid = cx.tid, wid = tid >> 6, lane = tid & 63, fr = lane & 15, fq = lane >> 4;
    unsigned char* ws = P_WS(p);
    const bf16_t* XBCA = (const bf16_t*)(ws + WS_XBCA); bf16_t* A2 = (bf16_t*)(ws + WS_A2); const float* DT = (const float*)(ws + WS_DT); float* SSQ = (float*)(ws + WS_SSQ);
    const int g = hd >> 3, nchunks = seq < 16 ? 64 : 1;
    const size_t row_base = seq < 16 ? (size_t)seq * 4096 : (size_t)TP + (size_t)(seq - 16) * 64;
    const float Aneg = -__expf(IN(p, I_A_LOG)[hd]), Dh = IN(p, I_SSD_D)[hd];
    LAS float* As = (LAS float*)(lds + SC_AS); LAS float* Sq = (LAS float*)(lds + SC_SQ);
    f32x4 hst[4];
#pragma unroll
    for (int pt = 0; pt < 4; ++pt) {
        if (seq >= 16) hst[pt] = *(const f32x4*)(IN(p, I_ST_SSD) + ((size_t)((seq - 16) * 16 + hd) * 64 + 16 * pt + fr) * 128 + 16 * wid + 4 * fq);
        else hst[pt] = (f32x4){0.f, 0.f, 0.f, 0.f};
    }
    const int lt = wid >> 1, ph = wid & 1;
    float pf_dt; u32x4 pf_b[2], pf_c[2], pf_x, pf_bt[2];
#define SSD_PREFETCH(cc) do { const size_t r0p = row_base + (size_t)(cc) * 64; \
        pf_dt = DT[(r0p + lane) * 16 + hd]; \
        _Pragma("unroll") for (int i = 0; i < 2; ++i) { const int q = tid + i * 512, row = q >> 4, sg = q & 15; \
            const bf16_t* gp = XBCA + (r0p + row) * XBC + 1024 + g * 128 + sg * 8; pf_b[i] = *(const u32x4*)gp; pf_c[i] = *(const u32x4*)(gp + 256); } \
        pf_x = *(const u32x4*)(XBCA + (r0p + lane) * XBC + hd * 64 + wid * 8); \
        _Pragma("unroll") for (int i = 0; i < 2; ++i) pf_bt[i] = *(const u32x4*)(XBCA + (r0p + lane) * XBC + 1024 + g * 128 + (wid + 8 * i) * 8); } while (0)
    SSD_PREFETCH(0);
    for (int c = 0; c < nchunks; ++c) {
        const size_t r0 = row_base + (size_t)c * 64;
        const float dt_l = pf_dt;
        float a = dt_l * Aneg;
        a += dpp_shr<1>(a); a += dpp_shr<2>(a); a += dpp_shr<4>(a); a += dpp_shr<8>(a);
        { const float t0 = __int_as_float(__builtin_amdgcn_readlane(__float_as_int(a), 15)), t1 = __int_as_float(__builtin_amdgcn_readlane(__float_as_int(a), 31)), t2 = __int_as_float(__builtin_amdgcn_readlane(__float_as_int(a), 47));
          a += (fq == 1) ? t0 : (fq == 2) ? (t0 + t1) : (fq == 3) ? (t0 + t1 + t2) : 0.0f; }
        const float a63 = __int_as_float(__builtin_amdgcn_readlane(__float_as_int(a), 63));
        const float wl = dt_l * __expf(a63 - a);
        if (wid == 0) As[lane] = a;
#pragma unroll
        for (int i = 0; i < 2; ++i) { const int q = tid + i * 512, row = q >> 4, sg = q & 15;
            *(LAS u32x4*)(lds + SC_BS + row * 272 + sg * 16) = pf_b[i]; *(LAS u32x4*)(lds + SC_CS + row * 272 + sg * 16) = pf_c[i]; }
        { float f[8]; unpack8(pf_x, f);
          LAS bf16_t* xt = (LAS bf16_t*)(lds + SC_XTS), *xd = (LAS bf16_t*)(lds + SC_XDS);
#pragma unroll
          for (int j = 0; j < 8; ++j) { const unsigned w2 = cvt_pk_bf16(f[j] * dt_l, f[j] * wl); xt[(wid * 8 + j) * 72 + lane] = (bf16_t)(w2 & 0xffffu); xd[(wid * 8 + j) * 72 + lane] = (bf16_t)(w2 >> 16); } }
#pragma unroll
        for (int i = 0; i < 2; ++i) { const int sg = wid + 8 * i; const u32x4 bw = pf_bt[i];
            LAS bf16_t* bt = (LAS bf16_t*)(lds + SC_BTS);
            bt[(sg * 8 + 0) * 72 + lane] = (bf16_t)(bw.x & 0xffffu); bt[(sg * 8 + 1) * 72 + lane] = (bf16_t)(bw.x >> 16);
            bt[(sg * 8 + 2) * 72 + lane] = (bf16_t)(bw.y & 0xffffu); bt[(sg * 8 + 3) * 72 + lane] = (bf16_t)(bw.y >> 16);
            bt[(sg * 8 + 4) * 72 + lane] = (bf16_t)(bw.z & 0xffffu); bt[(sg * 8 + 5) * 72 + lane] = (bf16_t)(bw.z >> 16);
            bt[(sg * 8 + 6) * 72 + lane] = (bf16_t)(bw.w & 0xffffu); bt[(sg * 8 + 7) * 72 + lane] = (bf16_t)(bw.w >> 16); }
#pragma unroll
        for (int pt = 0; pt < 4; ++pt) { u32x2 w2; w2.x = cvt_pk_bf16(hst[pt][0], hst[pt][1]); w2.y = cvt_pk_bf16(hst[pt][2], hst[pt][3]);
            *(LAS u32x2*)(lds + SC_HS + (16 * pt + fr) * 272 + (16 * wid + 4 * fq) * 2) = w2; }
        u32x2 ep_z[2], ep_x[2];
#pragma unroll
        for (int j = 0; j < 2; ++j) { const size_t rowe = r0 + 16 * lt + fr; const int col = hd * 64 + 16 * (2 * ph + j) + 4 * fq;
            ep_z[j] = *(const u32x2*)(A2 + rowe * 2048 + col); ep_x[j] = *(const u32x2*)(XBCA + rowe * XBC + col); }
        if (c + 1 < nchunks) SSD_PREFETCH(c + 1);
        LDS_BARRIER();
        f32x4 yacc[2];
        {
            bf16x8 cf[4];
#pragma unroll
            for (int kk = 0; kk < 4; ++kk) cf[kk] = *(const LAS bf16x8*)(lds + SC_CS + (16 * lt + fr) * 272 + kk * 64 + fq * 16);
            const float a_l = As[16 * lt + fr];
#pragma unroll
            for (int j = 0; j < 2; ++j) {
                const int st = 2 * ph + j;
                f32x4 cb = (f32x4){0.f, 0.f, 0.f, 0.f};
                if (st <= lt) {
#pragma unroll
                    for (int kk = 0; kk < 4; ++kk) { const bf16x8 bf = *(const LAS bf16x8*)(lds + SC_BS + (16 * st + fr) * 272 + kk * 64 + fq * 16);
                        cb = __builtin_amdgcn_mfma_f32_16x16x32_bf16(bf, cf[kk], cb, 0, 0, 0); }
                    const f32x4 as4 = *(const LAS f32x4*)(lds + SC_AS + (16 * st + 4 * fq) * 4);
#pragma unroll
                    for (int r = 0; r < 4; ++r) { const int s = 16 * st + 4 * fq + r, l = 16 * lt + fr; cb[r] = (s <= l) ? cb[r] * __expf(a_l - as4[r]) : 0.f; }
                }
                u32x2 w2; w2.x = cvt_pk_bf16(cb[0], cb[1]); w2.y = cvt_pk_bf16(cb[2], cb[3]);
                *(LAS u32x2*)(lds + SC_MS + (16 * lt + fr) * 144 + (16 * st + 4 * fq) * 2) = w2;
            }
            const float el = __expf(a_l);
#pragma unroll
            for (int j = 0; j < 2; ++j) { const int pt = 2 * ph + j; f32x4 y = (f32x4){0.f, 0.f, 0.f, 0.f};
#pragma unroll
                for (int kk = 0; kk < 4; ++kk) { const bf16x8 hf = *(const LAS bf16x8*)(lds + SC_HS + (16 * pt + fr) * 272 + kk * 64 + fq * 16);
                    y = __builtin_amdgcn_mfma_f32_16x16x32_bf16(hf, cf[kk], y, 0, 0, 0); }
                yacc[j] = y * el; }
        }
        {
            const float dec = __expf(a63);
            bf16x8 btf[2];
#pragma unroll
            for (int kk = 0; kk < 2; ++kk) btf[kk] = *(const LAS bf16x8*)(lds + SC_BTS + (16 * wid + fr) * 144 + kk * 64 + fq * 16);
#pragma unroll
            for (int pt = 0; pt < 4; ++pt) { f32x4 h = hst[pt] * dec;
#pragma unroll
                for (int kk = 0; kk < 2; ++kk) { const bf16x8 xf = *(const LAS bf16x8*)(lds + SC_XDS + (16 * pt + fr) * 144 + kk * 64 + fq * 16);
                    h = __builtin_amdgcn_mfma_f32_16x16x32_bf16(btf[kk], xf, h, 0, 0, 0); }
                hst[pt] = h; }
        }
        LDS_BARRIER();
        {
            bf16x8 mf[2];
#pragma unroll
            for (int kk = 0; kk < 2; ++kk) mf[kk] = *(const LAS bf16x8*)(lds + SC_MS + (16 * lt + fr) * 144 + kk * 64 + fq * 16);
            float sq = 0.f;
            const size_t row = r0 + 16 * lt + fr;
#pragma unroll
            for (int j = 0; j < 2; ++j) { const int pt = 2 * ph + j; f32x4 y = yacc[j];
#pragma unroll
                for (int kk = 0; kk < 2; ++kk) { const bf16x8 xf = *(const LAS bf16x8*)(lds + SC_XTS + (16 * pt + fr) * 144 + kk * 64 + fq * 16);
                    y = __builtin_amdgcn_mfma_f32_16x16x32_bf16(xf, mf[kk], y, 0, 0, 0); }
                const int col = hd * 64 + 16 * pt + 4 * fq;
                const u32x2 zw = ep_z[j], xw = ep_x[j];
                const float z0 = bf_lo(zw.x), z1 = bf_hi(zw.x), z2 = bf_lo(zw.y), z3 = bf_hi(zw.y);
                const float x0 = bf_lo(xw.x), x1 = bf_hi(xw.x), x2 = bf_lo(xw.y), x3 = bf_hi(xw.y);
                const float g0 = (y[0] + Dh * x0) * siluf_(z0), g1 = (y[1] + Dh * x1) * siluf_(z1), g2 = (y[2] + Dh * x2) * siluf_(z2), g3 = (y[3] + Dh * x3) * siluf_(z3);
                sq += g0 * g0 + g1 * g1 + g2 * g2 + g3 * g3;
                u32x2 ow; ow.x = cvt_pk_bf16(g0, g1); ow.y = cvt_pk_bf16(g2, g3);
                *(u32x2*)(A2 + row * 2048 + col) = ow; }
            sq += __shfl_xor(sq, 16); sq += __shfl_xor(sq, 32);
            if (fq == 0) Sq[ph * 64 + 16 * lt + fr] = sq;
        }
        LDS_BARRIER();
        if (tid < 64) atomicAdd(SSQ + r0 + tid, Sq[tid] + Sq[64 + tid]);
    }
    float* so = (seq < 16 ? P_OUT(p) + O_P_SSD + (size_t)(seq * 16 + hd) * 8192 : P_OUT(p) + O_S_SSD + (size_t)((seq - 16) * 16 + hd) * 8192);
#pragma unroll
    for (int pt = 0; pt < 4; ++pt) *(f32x4*)(so + (size_t)(16 * pt + fr) * 128 + 16 * wid + 4 * fq) = hst[pt];
    LDS_BARRIER();
}
__device__ __forceinline__ void phase_ssd(const Ctx cx, const Params& p, LAS unsigned char* lds) {
    for (int task = cx.bid; task < 384; task += cx.nblk) {
        if (task < 256) ssd_task(cx, p, lds, task >> 4, task & 15);
        else ssd_task(cx, p, lds, 16 + ((task - 256) >> 4), (task - 256) & 15);
    }
}

__device__ __forceinline__ void phase_lru_a(const Ctx cx, const bf16_t* LA, const bf16_t* UU, float* SL, float* HH) {
    const int total = 1088 * 128;
    for (int item = cx.bid * NTHREADS + cx.tid; item < total; item += cx.nblk * NTHREADS) {
        const int cgi = item & 127, ch = item >> 7, c0 = cgi * 8; const size_t r0 = ch < 1024 ? (size_t)ch * 64 : (size_t)TP + (size_t)(ch - 1024) * 8; const int nr = ch < 1024 ? 64 : 8;
        float sl[8], h[8];
#pragma unroll
        for (int j = 0; j < 8; ++j) { sl[j] = 0.f; h[j] = 0.f; }
        for (int i0 = 0; i0 < nr; i0 += 8) {
            u32x4 la[8], uu[8];
#pragma unroll
            for (int i = 0; i < 8; ++i) { la[i] = *(const u32x4*)(LA + (r0 + i0 + i) * 1024 + c0); uu[i] = *(const u32x4*)(UU + (r0 + i0 + i) * 1024 + c0); }
#pragma unroll
            for (int i = 0; i < 8; ++i) { float l[8], u[8]; unpack8(la[i], l); unpack8(uu[i], u);
#pragma unroll
                for (int j = 0; j < 8; ++j) { sl[j] += l[j]; h[j] = __expf(l[j]) * h[j] + u[j]; } }
        }
        float* o1 = SL + (size_t)ch * 1024 + c0; float* o2 = HH + (size_t)ch * 1024 + c0;
        *(f32x4*)o1 = (f32x4){sl[0], sl[1], sl[2], sl[3]}; *(f32x4*)(o1 + 4) = (f32x4){sl[4], sl[5], sl[6], sl[7]};
        *(f32x4*)o2 = (f32x4){h[0], h[1], h[2], h[3]}; *(f32x4*)(o2 + 4) = (f32x4){h[4], h[5], h[6], h[7]};
    }
}
__device__ __forceinline__ void phase_lru_b(const Ctx cx, const Params& p, const float* SL, const float* HH, float* CIN) {
    for (int item = cx.bid * NTHREADS + cx.tid; item < 24 * 1024; item += cx.nblk * NTHREADS) {
        const int chn = item & 1023, seq = item >> 10;
        const int nch = seq < 16 ? 64 : 8, ch0 = seq < 16 ? seq * 64 : 1024 + (seq - 16) * 8;
        float c = seq < 16 ? 0.f : IN(p, I_ST_LRU)[(seq - 16) * 1024 + chn];
        for (int i0 = 0; i0 < nch; i0 += 16) {
            float sl[16], hh[16];
#pragma unroll
            for (int i = 0; i < 16; ++i) if (i0 + i < nch) { sl[i] = SL[(size_t)(ch0 + i0 + i) * 1024 + chn]; hh[i] = HH[(size_t)(ch0 + i0 + i) * 1024 + chn]; }
#pragma unroll
            for (int i = 0; i < 16; ++i) if (i0 + i < nch) { CIN[(size_t)(ch0 + i0 + i) * 1024 + chn] = c; c = __expf(sl[i]) * c + hh[i]; }
        }
        (seq < 16 ? P_OUT(p) + O_P_LRU + seq * 1024 : P_OUT(p) + O_S_LRU + (seq - 16) * 1024)[chn] = c;
    }
}
__device__ __forceinline__ void phase_lru_c(const Ctx cx, const bf16_t* LA, const bf16_t* UU, const float* CIN, bf16_t* GATE) {
    const int total = 1088 * 128;
    for (int item = cx.bid * NTHREADS + cx.tid; item < total; item += cx.nblk * NTHREADS) {
        const int cgi = item & 127, ch = item >> 7, c0 = cgi * 8; const size_t r0 = ch < 1024 ? (size_t)ch * 64 : (size_t)TP + (size_t)(ch - 1024) * 8; const int nr = ch < 1024 ? 64 : 8;
        float h[8];
        { const float* ci = CIN + (size_t)ch * 1024 + c0; const f32x4 a = *(const f32x4*)ci, b = *(const f32x4*)(ci + 4);
#pragma unroll
          for (int j = 0; j < 4; ++j) { h[j] = a[j]; h[4 + j] = b[j]; } }
        for (int i0 = 0; i0 < nr; i0 += 8) {
            u32x4 la[8], uu[8], gt[8];
#pragma unroll
            for (int i = 0; i < 8; ++i) { la[i] = *(const u32x4*)(LA + (r0 + i0 + i) * 1024 + c0); uu[i] = *(const u32x4*)(UU + (r0 + i0 + i) * 1024 + c0); gt[i] = *(const u32x4*)(GATE + (r0 + i0 + i) * 1024 + c0); }
#pragma unroll
            for (int i = 0; i < 8; ++i) { float l[8], u[8], gq[8], o[8]; unpack8(la[i], l); unpack8(uu[i], u); unpack8(gt[i], gq);
#pragma unroll
                for (int j = 0; j < 8; ++j) { h[j] = __expf(l[j]) * h[j] + u[j]; o[j] = gq[j] * h[j]; }
                *(u32x4*)(GATE + (r0 + i0 + i) * 1024 + c0) = pack8(o); }
        }
    }
}

#define XB_TMO      128
#define XB_XCNT(j)  (256  + 64 * (j))
#define XB_XSUB(j)  (1280 + 64 * (j))
#define XB_XGEN(j)  (2304 + 64 * (j))
#define XB_TOP      3328
#define XB_TOPGEN   3392
#define XCD_BAR_WORDS 3456
#define XB_SPIN_CAP (1u << 18)
__device__ __forceinline__ unsigned xb_ld(unsigned* p)              { return __hip_atomic_load(p, __ATOMIC_RELAXED, __HIP_MEMORY_SCOPE_AGENT); }
__device__ __forceinline__ unsigned xb_add(unsigned* p, unsigned v) { return __hip_atomic_fetch_add(p, v, __ATOMIC_RELAXED, __HIP_MEMORY_SCOPE_AGENT); }
__device__ __forceinline__ unsigned xb_xcc_id() { return (unsigned)__builtin_amdgcn_s_getreg((3 << 11) | 20) & 0xFu; }
#define XB_SPIN(cond, bar) do { unsigned _sp = 0; while (cond) { __builtin_amdgcn_s_sleep(1); \
    if ((++_sp & 255u) == 0u) { if (xb_ld(&(bar)[XB_TMO])) break; if (_sp > XB_SPIN_CAP) { atomicAdd(&(bar)[XB_TMO], 1u); break; } } } } while (0)
struct XcdBarrier { unsigned* bar; unsigned x; volatile LAS unsigned* st; };
__device__ __forceinline__ XcdBarrier xcd_barrier_post(unsigned* bar, volatile LAS unsigned* st) {
    XcdBarrier b; b.bar = bar; b.x = xb_xcc_id(); b.st = st;
    if (threadIdx.x == 0) (void)xb_add(&bar[XB_XCNT(b.x)], 1u);
    return b;
}
__device__ __forceinline__ void xcd_barrier_complete(unsigned* bar, unsigned x, unsigned& nloc, unsigned& nx) {
    const unsigned G = gridDim.x * gridDim.y * gridDim.z;
    unsigned sum, cnt, mine, sp = 0u;
    for (;;) {
        sum = 0u; cnt = 0u; mine = 0u;
#pragma unroll
        for (unsigned j = 0; j < 16; ++j) { const unsigned c = xb_ld(&bar[XB_XCNT(j)]); sum += c; cnt += (c > 0u) ? 1u : 0u; mine = (j == x) ? c : mine; }
        if (sum == G) break;
        __builtin_amdgcn_s_sleep(1);
        if ((++sp & 255u) == 0u) { if (xb_ld(&bar[XB_TMO])) break; if (sp > XB_SPIN_CAP) { atomicAdd(&bar[XB_TMO], 1u); break; } }
    }
    nloc = mine > 0u ? mine : 1u; nx = cnt > 0u ? cnt : 1u;
}
__device__ __forceinline__ void xcd_barrier(const XcdBarrier& b) {
    asm volatile("s_waitcnt vmcnt(0)" ::: "memory");
    __syncthreads();
    if (threadIdx.x == 0) {
        unsigned* bar = b.bar;
        __builtin_amdgcn_s_waitcnt(0);
        unsigned nloc = b.st[0], nx = b.st[1];
        if (nloc == 0u) { xcd_barrier_complete(bar, b.x, nloc, nx); b.st[0] = nloc; b.st[1] = nx; }
        const unsigned old = xb_add(&bar[XB_XSUB(b.x)], 1u);
        const unsigned gen = old / nloc;
        if (old + 1u == (gen + 1u) * nloc) {
            __builtin_amdgcn_fence(__ATOMIC_RELEASE, "agent");
            asm volatile("s_waitcnt vmcnt(0)" ::: "memory");
            const unsigned og = xb_add(&bar[XB_TOP], 1u);
            const unsigned tg = og / nx;
            if (og + 1u == (tg + 1u) * nx) xb_add(&bar[XB_TOPGEN], 1u);
            else XB_SPIN(xb_ld(&bar[XB_TOPGEN]) == tg, bar);
            __builtin_amdgcn_fence(__ATOMIC_ACQUIRE, "agent");
            xb_add(&bar[XB_XGEN(b.x)], 1u);
            asm volatile("s_waitcnt vmcnt(0)" ::: "memory");
        } else {
            XB_SPIN(xb_ld(&bar[XB_XGEN(b.x)]) == gen, bar);
            __builtin_amdgcn_fence(__ATOMIC_ACQUIRE, "agent");
            asm volatile("s_waitcnt vmcnt(0)" ::: "memory");
        }
    }
    __syncthreads();
}

constexpr int NPHASE = 23;
__device__ __forceinline__ void run_phase(const Params& p, int ph, LAS unsigned char* lds) {
    Ctx cx; { int b = blockIdx.x, n = gridDim.x, t = threadIdx.x; asm volatile("" : "+s"(b), "+s"(n), "+v"(t)); cx.bid = b; cx.nblk = n; cx.tid = t; }
    unsigned char* ws = P_WS(p);
    bf16_t* XN = (bf16_t*)(ws + WS_XN);
    float* Y = P_OUT(p) + O_Y;
    float* SSQ = (float*)(ws + WS_SSQ);
    switch (ph) {
    case 0: phase_prep(cx, p, lds, 0, 92 * 16, cx.bid, cx.nblk, true); phase_norm(cx, IN(p, I_XP), IN(p, I_XS), XN); break;
    case 1: { Gemm g{XN, (const bf16_t*)(ws + WS_W1), T, N1, 1024, 1024, 0, 0};
        EpiG1 e{(bf16_t*)(ws + WS_A2), (bf16_t*)(ws + WS_XBCP), (bf16_t*)(ws + WS_V), (float*)(ws + WS_DT), IN(p, I_DT_BIAS)};
        gemm_phase<EpiG1, false>(cx, lds, g, e, nullptr);
        const int nt1 = (T / BM) * (N1 / BM), nlate = nt1 % cx.nblk;
        if (cx.bid >= nlate) phase_prep(cx, p, lds, 92 * 16, 1 << 30, cx.bid - nlate, cx.nblk - nlate, false); } break;
    case 2:
        phase_conv<4, 0>(cx, (const bf16_t*)(ws + WS_XBCP), XBC, XBC, IN(p, I_SSD_CONVW), IN(p, I_SSD_CONVB), (bf16_t*)(ws + WS_XBCA), XBC, IN(p, I_ST_SSDCONV), P_OUT(p) + O_P_SSDCONV, P_OUT(p) + O_S_SSDCONV);
        phase_conv<3, 1>(cx, (const bf16_t*)(ws + WS_V), 1024, 1024, IN(p, I_SC_CONVW), IN(p, I_SC_CONVB), (bf16_t*)(ws + WS_A2) + 1024, 2048, IN(p, I_ST_SCONV), P_OUT(p) + O_P_SCONV, P_OUT(p) + O_S_SCONV);
        break;
    case 3: phase_ssd(cx, p, lds); break;
    case 4: { Gemm g{(const bf16_t*)(ws + WS_A2), (const bf16_t*)(ws + WS_W2), T, 1024, 2048, 2048, 0, 0};
        EpiRes<true> e{IN(p, I_XP), IN(p, I_XS), XN, SSQ + T};
        gemm_phase<EpiRes<true>, true, true>(cx, lds, g, e, SSQ, (float*)(ws + WS_SLAB)); } break;
    case 30: phase_split_finish<true, true>(cx, (const float*)(ws + WS_SLAB), 8, IN(p, I_XS), XN, SSQ + T, SSQ); break;
    case 5: case 15: { const int l = ph == 5 ? 0 : 1;
        Gemm g{XN, (const bf16_t*)(ws + WS_W3) + (size_t)l * 5632 * 1024, T, 5632, 1024, 1024, 0, 0};
        EpiFfnFused e{(bf16_t*)(ws + WS_H), (bf16_t*)(ws + WS_GH), (bf16_t*)(ws + WS_GT), (bf16_t*)(ws + WS_UH), SSQ + (l == 0 ? T : 3 * T), IN(p, I_FFN_CONVW) + l * 3 * DFF, IN(p, I_FFN_CONVB) + l * DFF};
        gemm_phase<EpiFfnFused, false>(cx, lds, g, e, nullptr); } break;
    case 6: case 16: { const int l = ph == 6 ? 0 : 1;
        phase_ffn_fix(cx, (const bf16_t*)(ws + WS_GH), (const bf16_t*)(ws + WS_GT), (const bf16_t*)(ws + WS_UH), (bf16_t*)(ws + WS_H), IN(p, I_FFN_CONVW) + l * 3 * DFF, IN(p, I_FFN_CONVB) + l * DFF,
                      IN(p, I_ST_FFNCONV) + l * 8 * 2 * DFF, P_OUT(p) + O_P_FFNCONV + l * 16 * 2 * DFF, P_OUT(p) + O_S_FFNCONV + l * 8 * 2 * DFF); } break;
    case 7: case 17: { const int l = ph == 7 ? 0 : 1;
        Gemm g{(const bf16_t*)(ws + WS_H), (const bf16_t*)(ws + WS_W4) + (size_t)l * 1024 * DFF, T, 1024, DFF, DFF, 0, 0};
        EpiRes<false> e{nullptr, nullptr, XN, SSQ + (l == 0 ? 2 * T : 4 * T)};
        gemm_phase<EpiRes<false>, false, true>(cx, lds, g, e, nullptr, (float*)(ws + WS_SLAB)); } break;
    case 31: phase_split_finish<false, false>(cx, (const float*)(ws + WS_SLAB), 11, nullptr, XN, SSQ + 2 * T, nullptr); break;
    case 33: phase_split_finish<false, false>(cx, (const float*)(ws + WS_SLAB), 11, nullptr, XN, SSQ + 4 * T, nullptr); break;
    case 8: { Gemm g{XN, (const bf16_t*)(ws + WS_W5), T, 2048, 1024, 1024, 0, 0};
        EpiLruIn e{(bf16_t*)(ws + WS_GATE), (bf16_t*)(ws + WS_XBP), SSQ + 2 * T};
        gemm_phase<EpiLruIn, false>(cx, lds, g, e, nullptr); } break;
    case 9: phase_conv<4, 3>(cx, (const bf16_t*)(ws + WS_XBP), 1024, 1024, IN(p, I_LRU_CONVW), IN(p, I_LRU_CONVB), (bf16_t*)(ws + WS_XBC2), 1024, IN(p, I_ST_LRUCONV), P_OUT(p) + O_P_LRUCONV, P_OUT(p) + O_S_LRUCONV); break;
    case 10: { Gemm g{(const bf16_t*)(ws + WS_XBC2), (const bf16_t*)(ws + WS_W6), T, 2048, 256, 1024, 1, 256};
        EpiLruGate e{(const bf16_t*)(ws + WS_XBC2), (bf16_t*)(ws + WS_LA), (bf16_t*)(ws + WS_UU), IN(p, I_LRU_BA), IN(p, I_LRU_BX), (const float*)(ws + WS_SP)};
        gemm_phase<EpiLruGate, false>(cx, lds, g, e, nullptr); } break;
    case 11: phase_lru_a(cx, (const bf16_t*)(ws + WS_LA), (const bf16_t*)(ws + WS_UU), (float*)(ws + WS_SL), (float*)(ws + WS_HH)); break;
    case 12: phase_lru_b(cx, p, (const float*)(ws + WS_SL), (const float*)(ws + WS_HH), (float*)(ws + WS_CIN)); break;
    case 13: phase_lru_c(cx, (const bf16_t*)(ws + WS_LA), (const bf16_t*)(ws + WS_UU), (const float*)(ws + WS_CIN), (bf16_t*)(ws + WS_GATE)); break;
    case 14: { Gemm g{(const bf16_t*)(ws + WS_GATE), (const bf16_t*)(ws + WS_W7), T, 1024, 1024, 1024, 0, 0};
        EpiRes<false> e{nullptr, nullptr, XN, SSQ + 3 * T};
        gemm_phase<EpiRes<false>, false, true>(cx, lds, g, e, nullptr, (float*)(ws + WS_SLAB)); } break;
    case 32: phase_split_finish<false, false>(cx, (const float*)(ws + WS_SLAB), 4, nullptr, XN, SSQ + 3 * T, nullptr); break;
    case 18: phase_final_norm(cx, XN, SSQ + 4 * T, IN(p, I_NORM_FINAL), Y); break;
    default: break;
    }
}

__global__ void __launch_bounds__(NTHREADS, 2) fwd_mega(Params p, int ph_lo, int ph_hi) {
    extern __shared__ __attribute__((aligned(16))) unsigned char smem[];
    LAS unsigned char* lds = (LAS unsigned char*)smem;
    cg::grid_group grid = cg::this_grid();
    volatile LAS unsigned* bst = (volatile LAS unsigned*)(lds + 131072 + 1024);
    if (threadIdx.x == 0) { bst[0] = 0u; bst[1] = 0u; }
    __syncthreads();
    const XcdBarrier xb = xcd_barrier_post((unsigned*)(IN(p, 35)) + WS_BAR / 4, bst);
#ifndef PROBE_K
#define PROBE_K -1
#endif
    bool first = true;
    for (int i = ph_lo; i < ph_hi; ++i) {
        int ph = i;
        if (i >= 5) ph = (i == 5) ? 30 : (i <= 8) ? i - 1 : (i == 9) ? 31 : (i <= 16) ? i - 2 : (i == 17) ? 32 : (i <= 20) ? i - 3 : (i == 21) ? 33 : 18;
        run_phase(p, ph, lds);
        if (i + 1 < ph_hi) { if (first) { grid.sync(); first = false; } else xcd_barrier(xb); }
    }
}

extern "C" void kernel_launch(void* const* d_in, const int* in_sizes, int n_in, void* d_out, int out_size, void* d_ws, size_t ws_size, hipStream_t stream) {
    static int grid = 0;
    if (grid == 0) {
        if (n_in != 34 || (size_t)out_size != O_END || ws_size < WS_NEED) { fprintf(stderr, "kernel_launch: unexpected shapes (n_in %d out %d ws %zu need %zu)\n", n_in, out_size, ws_size, (size_t)WS_NEED); grid = -1; return; }
        int dev = 0, cus = 0, per_cu = 0;
        (void)hipGetDevice(&dev); (void)hipDeviceGetAttribute(&cus, hipDeviceAttributeMultiprocessorCount, dev);
        if (hipFuncSetAttribute((const void*)fwd_mega, hipFuncAttributeMaxDynamicSharedMemorySize, LDS_BYTES) != hipSuccess) { fprintf(stderr, "kernel_launch: hipFuncSetAttribute failed\n"); grid = -1; return; }
        if (hipOccupancyMaxActiveBlocksPerMultiprocessor(&per_cu, (const void*)fwd_mega, NTHREADS, LDS_BYTES) != hipSuccess || per_cu < 1) { fprintf(stderr, "kernel_launch: occupancy query says %d\n", per_cu); per_cu = 1; }
        (void)hipGetLastError();
        grid = cus;
    }
    if (grid < 0) return;
    (void)hipMemsetAsync((unsigned char*)d_ws + WS_BAR, 0, 16384, stream);
    Params p{};
    for (int i = 0; i < 34; ++i) p.ptr[i] = (const float*)d_in[i];
    p.ptr[34] = (const float*)d_out; p.ptr[35] = (const float*)d_ws;
    int lo = 0, hi = NPHASE; void* args[] = {&p, &lo, &hi};
    hipError_t e = hipLaunchCooperativeKernel((const void*)fwd_mega, dim3(grid), dim3(NTHREADS), args, LDS_BYTES, stream);
    if (e != hipSuccess) fprintf(stderr, "cooperative launch failed: %s (grid %d)\n", hipGetErrorString(e), grid);
}
```

```cpp
#include <hip/hip_runtime.h>
#include <hip/hip_cooperative_groups.h>
#include <cstdio>
namespace cg = cooperative_groups;

#define LAS __attribute__((address_space(3)))
typedef unsigned short bf16_t;
typedef short bf16x8 __attribute__((ext_vector_type(8)));
typedef float f32x4 __attribute__((ext_vector_type(4)));
typedef unsigned u32x4 __attribute__((ext_vector_type(4)));
typedef unsigned u32x2 __attribute__((ext_vector_type(2)));

constexpr int TP = 65536;
constexpr int TS = 512;
constexpr int T = TP + TS;
constexpr int DM = 1024;
constexpr int DFF = 2816;
constexpr int XBC = 1536;
constexpr int N1 = 5888;
constexpr float EPS = 1e-6f;
constexpr int NTHREADS = 512;
constexpr int LDS_BYTES = 131072 + 4096;

constexpr size_t O_Y = 0;
constexpr size_t O_P_SSDCONV = (size_t)T * DM;
constexpr size_t O_P_SSD = O_P_SSDCONV + 16 * 3 * XBC;
constexpr size_t O_P_SCONV = O_P_SSD + (size_t)16 * 16 * 64 * 128;
constexpr size_t O_P_LRUCONV = O_P_SCONV + 16 * 2 * 1024;
constexpr size_t O_P_LRU = O_P_LRUCONV + 16 * 3 * 1024;
constexpr size_t O_P_FFNCONV = O_P_LRU + 16 * 1024;
constexpr size_t O_S_SSDCONV = O_P_FFNCONV + 2 * 16 * 2 * DFF;
constexpr size_t O_S_SSD = O_S_SSDCONV + 8 * 3 * XBC;
constexpr size_t O_S_SCONV = O_S_SSD + (size_t)8 * 16 * 64 * 128;
constexpr size_t O_S_LRUCONV = O_S_SCONV + 8 * 2 * 1024;
constexpr size_t O_S_LRU = O_S_LRUCONV + 8 * 3 * 1024;
constexpr size_t O_S_FFNCONV = O_S_LRU + 8 * 1024;
constexpr size_t O_END = O_S_FFNCONV + 2 * 8 * 2 * DFF;

constexpr size_t al256(size_t x) { return (x + 255) & ~(size_t)255; }
constexpr size_t WS_W1 = 0;
constexpr size_t WS_W2 = WS_W1 + (size_t)N1 * 1024 * 2;
constexpr size_t WS_W3 = WS_W2 + (size_t)1024 * 2048 * 2;
constexpr size_t WS_W4 = WS_W3 + (size_t)2 * 5632 * 1024 * 2;
constexpr size_t WS_W5 = WS_W4 + (size_t)2 * 1024 * 2816 * 2;
constexpr size_t WS_W6 = WS_W5 + (size_t)2048 * 1024 * 2;
constexpr size_t WS_W7 = WS_W6 + (size_t)2048 * 256 * 2;
constexpr size_t WS_SP = WS_W7 + (size_t)1024 * 1024 * 2;
constexpr size_t WS_BAR = WS_SP + 4096;
constexpr size_t WS_SSQ = WS_BAR + 16384;
constexpr size_t WS_SL = al256(WS_SSQ + (size_t)5 * T * 4);
constexpr size_t WS_HH = WS_SL + (size_t)1088 * 1024 * 4;
constexpr size_t WS_CIN = WS_HH + (size_t)1088 * 1024 * 4;
constexpr size_t WS_SLAB = al256(WS_CIN + (size_t)1088 * 1024 * 4);
constexpr size_t WS_XN = al256(WS_SLAB + (size_t)88 * 65536 * 4);
constexpr size_t WS_ARENA = al256(WS_XN + (size_t)T * 1024 * 2);
constexpr size_t WS_A2 = WS_ARENA;
constexpr size_t WS_XBCP = WS_A2 + (size_t)T * 2048 * 2;
constexpr size_t WS_XBCA = WS_XBCP + (size_t)T * XBC * 2;
constexpr size_t WS_V = WS_XBCA + (size_t)T * XBC * 2;
constexpr size_t WS_DT = WS_V + (size_t)T * 1024 * 2;
constexpr size_t WS_END0 = WS_DT + (size_t)T * 16 * 4;
constexpr size_t WS_H = WS_ARENA;
constexpr size_t WS_GH = WS_H + (size_t)T * DFF * 2;
constexpr size_t WS_GT = WS_GH + (size_t)1032 * 2 * DFF * 2;
constexpr size_t WS_UH = WS_GT + (size_t)1032 * 2 * DFF * 2;
constexpr size_t WS_END1 = WS_UH + (size_t)1032 * 2 * DFF * 2;
constexpr size_t WS_GATE = WS_ARENA;
constexpr size_t WS_XBP = WS_GATE + (size_t)T * 1024 * 2;
constexpr size_t WS_XBC2 = WS_XBP + (size_t)T * 1024 * 2;
constexpr size_t WS_LA = WS_XBC2 + (size_t)T * 1024 * 2;
constexpr size_t WS_UU = WS_LA + (size_t)T * 1024 * 2;
constexpr size_t WS_END2 = WS_UU + (size_t)T * 1024 * 2;
constexpr size_t WS_NEED = WS_END0 > WS_END1 ? (WS_END0 > WS_END2 ? WS_END0 : WS_END2) : (WS_END1 > WS_END2 ? WS_END1 : WS_END2);

struct Params {
    const float* ptr[36];
};
__device__ __forceinline__ const float* IN(const Params& p, int i) { asm volatile("" : "+s"(i)); return p.ptr[i]; }
#define P_OUT(p) ((float*)IN(p, 34))
#define P_WS(p) ((unsigned char*)IN(p, 35))
enum { I_XP = 0, I_XS, I_ST_SSDCONV, I_ST_SSD, I_ST_SCONV, I_ST_LRUCONV, I_ST_LRU, I_ST_FFNCONV, I_NORM_MIX, I_NORM_FFN, I_NORM_FINAL,
       I_AB_WIN, I_SSD_CONVW, I_SSD_CONVB, I_DT_BIAS, I_A_LOG, I_SSD_D, I_SSD_NORM, I_SC_CONVW, I_SC_CONVB, I_AB_WOUT, I_LRU_WIN,
       I_LRU_CONVW, I_LRU_CONVB, I_LRU_WA, I_LRU_BA, I_LRU_WX, I_LRU_BX, I_LRU_LAMBDA, I_LRU_WOUT, I_FFN_WIN, I_FFN_CONVW, I_FFN_CONVB, I_FFN_WOUT };

struct Ctx { int bid, nblk, tid; };
__device__ __forceinline__ unsigned cvt_pk_bf16(float lo, float hi) { unsigned r; asm("v_cvt_pk_bf16_f32 %0, %1, %2" : "=v"(r) : "v"(lo), "v"(hi)); return r; }
__device__ __forceinline__ float bf_lo(unsigned w) { return __uint_as_float(w << 16); }
__device__ __forceinline__ float bf_hi(unsigned w) { return __uint_as_float(w & 0xffff0000u); }
__device__ __forceinline__ float sigmoidf_(float x) { return __builtin_amdgcn_rcpf(1.0f + __expf(-x)); }
__device__ __forceinline__ float siluf_(float x) { return x * __builtin_amdgcn_rcpf(1.0f + __expf(-x)); }
__device__ __forceinline__ float geluf_(float x) { const float u = x * (1.5957691216f + 0.0713548163f * x * x); return x * __builtin_amdgcn_rcpf(1.0f + __builtin_amdgcn_exp2f(-1.4426950409f * u)); }
__device__ __forceinline__ float softplusf_(float x) { return fmaxf(x, 0.0f) + log1pf(__expf(-fabsf(x))); }
__device__ __forceinline__ void unpack8(const u32x4 w, float (&f)[8]) {
    f[0] = bf_lo(w.x); f[1] = bf_hi(w.x); f[2] = bf_lo(w.y); f[3] = bf_hi(w.y); f[4] = bf_lo(w.z); f[5] = bf_hi(w.z); f[6] = bf_lo(w.w); f[7] = bf_hi(w.w);
}
__device__ __forceinline__ u32x4 pack8(const float (&f)[8]) {
    u32x4 w; w.x = cvt_pk_bf16(f[0], f[1]); w.y = cvt_pk_bf16(f[2], f[3]); w.z = cvt_pk_bf16(f[4], f[5]); w.w = cvt_pk_bf16(f[6], f[7]); return w;
}
__device__ __forceinline__ u32x4 pack44(const f32x4 a, const f32x4 b) {
    u32x4 w; w.x = cvt_pk_bf16(a[0], a[1]); w.y = cvt_pk_bf16(a[2], a[3]); w.z = cvt_pk_bf16(b[0], b[1]); w.w = cvt_pk_bf16(b[2], b[3]); return w;
}

constexpr int BM = 256, BK = 64, HALF = 128, HTB = HALF * BK * 2, NXCD = 8, WGM = 4;
__device__ __forceinline__ int lds_byte(int r, int c) { const int st = (r >> 4) * 2 + (c >> 5), rr = r & 15, cc = c & 31, ob = rr * 64 + cc * 2; return st * 1024 + (ob ^ (((ob >> 9) & 1) << 5)); }
__device__ __forceinline__ void stage_rc(int b, int& R, int& C) { const int st = b / 1024, sb = b % 1024, swz = sb ^ (((sb >> 9) & 1) << 5); R = (st >> 1) * 16 + swz / 64; C = (st & 1) * 32 + (swz % 64) / 2; }
__device__ __forceinline__ int perm32(int rho) { const int n = rho >> 4, i = rho & 15; return 8 * (i >> 2) + 4 * n + (i & 3); }

struct Unit { int pm, pn, kt0, nkt, slab; };
struct Gemm { const bf16_t* A; const bf16_t* Bt; int M, N, K, lda, a_shift, a_koff; };

struct StaticOrder {
    int nM, nN, nwg, G, c, nt, nsplit, ntail;
    __device__ void init(int M, int N, int G_, int c_, int nt_, bool split) { nM = M / BM; nN = N / BM; G = G_; c = c_; nt = nt_; nsplit = 0; ntail = 0;
        if (split) { nM = TP / BM; nsplit = nt / 4; ntail = 2 * nN * nsplit; } nwg = nM * nN; }
    __device__ bool next(int i, Unit& u) const {
        const long L = (long)i * G + c;
        if (L >= nwg) { const int t = (int)(L - nwg); if (t >= ntail) return false;
            const int tile = t / nsplit, piece = t - tile * nsplit; u.pm = TP / BM + tile / nN; u.pn = tile % nN; u.kt0 = piece * 4; u.nkt = 4; u.slab = t; return true; }
        int wgid = (int)L; { const int q = nwg / NXCD, r = nwg % NXCD, xcd = wgid % NXCD, off = wgid / NXCD; wgid = (xcd < r ? xcd * (q + 1) : r * (q + 1) + (xcd - r) * q) + off; }
        const int nig = WGM * nN, gid = wgid / nig, fm = gid * WGM, gsz = (nM - fm) < WGM ? (nM - fm) : WGM;
        u.pm = fm + ((wgid % nig) % gsz); u.pn = (wgid % nig) / gsz; u.kt0 = 0; u.nkt = nt; u.slab = -1; return true;
    }
};

template <class Epi, bool MIDSCALE, bool SPLIT = false>
__device__ __forceinline__ void gemm_phase(const Ctx cx, LAS unsigned char* lds, const Gemm g, const Epi& E, const float* ssq, float* slabs = nullptr) {
    const int tid = cx.tid, wid = __builtin_amdgcn_readfirstlane(tid >> 6), lane = tid & 63, wr = wid >> 2, wc = wid & 3, fr = lane & 15, fq = lane >> 4;
    int K_ = g.K; asm volatile("" : "+s"(K_));
    const int K = K_, nt = K / BK;
    StaticOrder S; S.init(g.M, g.N, cx.nblk, cx.bid, nt, SPLIT);
    unsigned voffA[2], voffB[2];
#pragma unroll
    for (int i = 0; i < 2; ++i) { int R, C; stage_rc(tid * 16 + i * 8192, R, C); const int Rb = Epi::PERM ? ((R & ~31) + perm32(R & 31)) : R;
        voffA[i] = (unsigned)(R * g.lda + C) * 2u; voffB[i] = (unsigned)(Rb * K + C) * 2u; }
    const size_t kstep = (size_t)(BK * 2);
    const size_t hsA = (size_t)HALF * g.lda * 2, hsB = (size_t)HALF * K * 2;
    const size_t tsA = 2 * hsA, tsB = 2 * hsB;
    const unsigned ldsw = (unsigned)wid * 1024u;
    const int aoff = lds_byte(wr * 64 + fr, fq * 8), boff = lds_byte(wc * 32 + fr, fq * 8);
#define SA_(b, h) (((b) * 2 + (h)) * HTB)
#define SB_(b, h) ((4 + (b) * 2 + (h)) * HTB)
#define STAGE_(bufoff, gbase, voff) do { _Pragma("unroll") for (int _i = 0; _i < 2; ++_i) \
        __builtin_amdgcn_global_load_lds((const unsigned*)((const char*)(gbase) + (voff)[_i]), (LAS unsigned*)(lds + (bufoff) + ldsw + _i * 8192), 16, 0, 0); } while (0)
#define LDA_(dst, b, h) do { _Pragma("unroll") for (int m = 0; m < 4; ++m) _Pragma("unroll") for (int k = 0; k < 2; ++k) dst[m][k] = *(const LAS bf16x8*)(lds + SA_(b, h) + aoff + m * 2048 + k * 1024); } while (0)
#define LDB_(dst, b, h) do { _Pragma("unroll") for (int n = 0; n < 2; ++n) _Pragma("unroll") for (int k = 0; k < 2; ++k) dst[n][k] = *(const LAS bf16x8*)(lds + SB_(b, h) + boff + n * 2048 + k * 1024); } while (0)
#define MMA_(ai, bj, At, Bt) do { __builtin_amdgcn_s_setprio(1); _Pragma("unroll") for (int m = 0; m < 4; ++m) _Pragma("unroll") for (int n = 0; n < 2; ++n) _Pragma("unroll") for (int k = 0; k < 2; ++k) \
        acc[ai][bj][m][n] = __builtin_amdgcn_mfma_f32_16x16x32_bf16(Bt[n][k], At[m][k], acc[ai][bj][m][n], 0, 0, 0); __builtin_amdgcn_s_setprio(0); } while (0)
#define WAIT_V_(n) asm volatile("s_waitcnt vmcnt(" #n ")" ::: "memory")
#define WAIT_L_(n) asm volatile("s_waitcnt lgkmcnt(" #n ")" ::: "memory")
#define BAR_ __builtin_amdgcn_s_barrier()
#define SCHED_ __builtin_amdgcn_sched_barrier(0)
#ifndef STAGGER
#define STAGGER 0
#endif
    if (STAGGER && (cx.bid & 8)) {
        const unsigned long long t0 = __builtin_amdgcn_s_memrealtime(); const unsigned long long dl = 800ull;
        while (__builtin_amdgcn_s_memrealtime() - t0 < dl) __builtin_amdgcn_s_sleep(8);
    }
    Unit cur, nxt; int ui = 0;
    if (!S.next(0, cur)) return;
    f32x4 acc[2][2][4][2];
#pragma unroll
    for (int a = 0; a < 2; ++a)
#pragma unroll
        for (int b = 0; b < 2; ++b)
#pragma unroll
            for (int m = 0; m < 4; ++m)
#pragma unroll
                for (int n = 0; n < 2; ++n) acc[a][b][m][n] = (f32x4){0.f, 0.f, 0.f, 0.f};
    bf16x8 At[4][2], B0[2][2], B1[2][2];
    const char* cA = (const char*)g.A + (size_t)cur.pm * tsA + (size_t)((cur.pn >> g.a_shift) * g.a_koff) * 2 + (size_t)cur.kt0 * kstep;
    const char* cB = (const char*)g.Bt + (size_t)cur.pn * tsB + (size_t)cur.kt0 * kstep;
    STAGE_(SB_(0, 0), cB, voffB); STAGE_(SA_(0, 0), cA, voffA); STAGE_(SB_(0, 1), cB + hsB, voffB); STAGE_(SA_(0, 1), cA + hsA, voffA);
    if (wr == 1) BAR_;
    WAIT_V_(4); BAR_;
    STAGE_(SB_(1, 0), cB + kstep, voffB); STAGE_(SA_(1, 0), cA + kstep, voffA); STAGE_(SB_(1, 1), cB + hsB + kstep, voffB);
    WAIT_V_(6); BAR_;
    for (;;) {
        const bool has_next = S.next(ui + 1, nxt);
        const char* nA = has_next ? (const char*)g.A + (size_t)nxt.pm * tsA + (size_t)((nxt.pn >> g.a_shift) * g.a_koff) * 2 + (size_t)nxt.kt0 * kstep : cA;
        const char* nB = has_next ? (const char*)g.Bt + (size_t)nxt.pn * tsB + (size_t)nxt.kt0 * kstep : cB;
        const int cnt = cur.nkt;
        for (int t = 0; t < cnt; t += 2) {
            const bool last = (t == cnt - 2);
            const char* a1 = cA + (size_t)(t + 1) * kstep;
            const char* a2 = last ? nA : cA + (size_t)(t + 2) * kstep; const char* b2 = last ? nB : cB + (size_t)(t + 2) * kstep;
            const char* a3 = a2 + kstep; const char* b3 = b2 + kstep;
            if (MIDSCALE && t == 16 && cur.slab < 0) {
                int rb = cur.pm * BM + wr * 64 + fr; asm volatile("" : "+v"(rb));
#pragma unroll
                for (int ai = 0; ai < 2; ++ai)
#pragma unroll
                    for (int m = 0; m < 4; ++m) {
                        const float sc = rsqrtf(ssq[rb + ai * HALF + m * 16] * (1.0f / 1024.0f) + EPS);
#pragma unroll
                        for (int bj = 0; bj < 2; ++bj)
#pragma unroll
                            for (int n = 0; n < 2; ++n) acc[ai][bj][m][n] *= sc;
                    }
            }
            LDB_(B0, 0, 0); SCHED_; LDA_(At, 0, 0); STAGE_(SA_(1, 1), a1 + hsA, voffA);
            WAIT_L_(8); BAR_; WAIT_L_(0); MMA_(0, 0, At, B0); BAR_; SCHED_;
            LDB_(B1, 0, 1); STAGE_(SB_(0, 0), b2, voffB);
            BAR_; WAIT_L_(0); MMA_(0, 1, At, B1); BAR_;
            LDA_(At, 0, 1); STAGE_(SA_(0, 0), a2, voffA);
            BAR_; WAIT_L_(0); MMA_(1, 0, At, B0); BAR_; SCHED_;
            STAGE_(SB_(0, 1), b2 + hsB, voffB);
            WAIT_V_(6); BAR_; MMA_(1, 1, At, B1); BAR_;
            LDB_(B0, 1, 0); SCHED_; LDA_(At, 1, 0); STAGE_(SA_(0, 1), a2 + hsA, voffA);
            WAIT_L_(8); BAR_; WAIT_L_(0); MMA_(0, 0, At, B0); BAR_; SCHED_;
            LDB_(B1, 1, 1); STAGE_(SB_(1, 0), b3, voffB);
            BAR_; WAIT_L_(0); MMA_(0, 1, At, B1); BAR_;
            LDA_(At, 1, 1); STAGE_(SA_(1, 0), a3, voffA);
            BAR_; WAIT_L_(0); MMA_(1, 0, At, B0); BAR_; SCHED_;
            STAGE_(SB_(1, 1), b3 + hsB, voffB);
            WAIT_V_(6); BAR_; MMA_(1, 1, At, B1); BAR_;
        }
        if (SPLIT && cur.slab >= 0) {
            float* sb = slabs + (size_t)cur.slab * 65536 + (size_t)(wr * 64 + fr) * 256 + wc * 64 + 8 * fq;
#pragma unroll
            for (int ai = 0; ai < 2; ++ai)
#pragma unroll
                for (int m = 0; m < 4; ++m)
#pragma unroll
                    for (int bj = 0; bj < 2; ++bj) { float* q = sb + (size_t)(ai * HALF + m * 16) * 256 + bj * 32; *(f32x4*)q = acc[ai][bj][m][0]; *(f32x4*)(q + 4) = acc[ai][bj][m][1]; }
        } else E(acc, cur, wr, wc, fr, fq);
        if (!has_next) break;
#pragma unroll
        for (int a = 0; a < 2; ++a)
#pragma unroll
            for (int b = 0; b < 2; ++b)
#pragma unroll
                for (int m = 0; m < 4; ++m)
#pragma unroll
                    for (int n = 0; n < 2; ++n) acc[a][b][m][n] = (f32x4){0.f, 0.f, 0.f, 0.f};
        cur = nxt; cA = nA; cB = nB; ++ui;
    }
    WAIT_V_(0);
    if (wr == 0) BAR_;
    BAR_;
#undef SA_
#undef SB_
#undef STAGE_
#undef LDA_
#undef LDB_
#undef MMA_
}

struct EpiG1 {
    static constexpr bool PERM = true;
    bf16_t* A2; bf16_t* XBCP; bf16_t* V; float* DT; const float* dt_bias;
    __device__ __forceinline__ void operator()(const f32x4 (&acc)[2][2][4][2], const Unit& u, int wr, int wc, int fr, int fq) const {
        const int row0 = u.pm * BM + wr * 64 + fr, lc = wc * 32 + 8 * fq;
        if (u.pn < 14) {
            bf16_t* base; int ld, colt;
            if (u.pn < 4) { base = A2; ld = 2048; colt = u.pn * 256; }
            else if (u.pn < 10) { base = XBCP; ld = XBC; colt = (u.pn - 4) * 256; }
            else { base = A2; ld = 2048; colt = 1024 + (u.pn - 10) * 256; }
#pragma unroll
            for (int ai = 0; ai < 2; ++ai)
#pragma unroll
                for (int m = 0; m < 4; ++m) { bf16_t* rowp = base + (size_t)(row0 + ai * HALF + m * 16) * ld + colt + wc * 64 + 8 * fq;
#pragma unroll
                    for (int bj = 0; bj < 2; ++bj) *(u32x4*)(rowp + bj * 32) = pack44(acc[ai][bj][m][0], acc[ai][bj][m][1]); }
        } else if (u.pn < 22) {
            const int ch0 = (u.pn - 14) * 128 + lc;
#pragma unroll
            for (int ai = 0; ai < 2; ++ai)
#pragma unroll
                for (int m = 0; m < 4; ++m) { bf16_t* rowp = V + (size_t)(row0 + ai * HALF + m * 16) * 1024 + ch0;
                    *(u32x4*)rowp = pack44(acc[ai][0][m][0] * acc[ai][1][m][0], acc[ai][0][m][1] * acc[ai][1][m][1]); }
        } else {
            if (wc == 0 && fq < 2) {
                const f32x4 b0 = *(const f32x4*)(dt_bias + 8 * fq), b1 = *(const f32x4*)(dt_bias + 8 * fq + 4);
#pragma unroll
                for (int ai = 0; ai < 2; ++ai)
#pragma unroll
                    for (int m = 0; m < 4; ++m) { float* rowp = DT + (size_t)(row0 + ai * HALF + m * 16) * 16 + 8 * fq;
                        f32x4 v0 = acc[ai][0][m][0] + b0, v1 = acc[ai][0][m][1] + b1;
#pragma unroll
                        for (int j = 0; j < 4; ++j) { v0[j] = softplusf_(v0[j]); v1[j] = softplusf_(v1[j]); }
                        *(f32x4*)rowp = v0; *(f32x4*)(rowp + 4) = v1; }
            }
        }
    }
};
template <bool SRC_F32> struct EpiRes {
    static constexpr bool PERM = true;
    const float* xp; const float* xs; bf16_t* XN; float* ssq;
    __device__ __forceinline__ void operator()(const f32x4 (&acc)[2][2][4][2], const Unit& u, int wr, int wc, int fr, int fq) const {
        const int row0 = u.pm * BM + wr * 64 + fr, col0 = u.pn * BM + wc * 64 + 8 * fq;
        if (SRC_F32) {
#pragma unroll
            for (int ai = 0; ai < 2; ++ai) {
                f32x4 old[4][2][2];
#pragma unroll
                for (int m = 0; m < 4; ++m) { const int row = row0 + ai * HALF + m * 16;
                    const float* src = (row < TP ? xp + (size_t)row * DM : xs + (size_t)(row - TP) * DM) + col0;
#pragma unroll
                    for (int bj = 0; bj < 2; ++bj) { old[m][bj][0] = *(const f32x4*)(src + bj * 32); old[m][bj][1] = *(const f32x4*)(src + bj * 32 + 4); } }
#pragma unroll
                for (int m = 0; m < 4; ++m) { const int row = row0 + ai * HALF + m * 16; bf16_t* xnp = XN + (size_t)row * DM + col0; float sq = 0.f;
#pragma unroll
                    for (int bj = 0; bj < 2; ++bj) { const f32x4 v0 = old[m][bj][0] + acc[ai][bj][m][0], v1 = old[m][bj][1] + acc[ai][bj][m][1];
                        *(u32x4*)(xnp + bj * 32) = pack44(v0, v1);
                        sq += v0[0] * v0[0] + v0[1] * v0[1] + v0[2] * v0[2] + v0[3] * v0[3] + v1[0] * v1[0] + v1[1] * v1[1] + v1[2] * v1[2] + v1[3] * v1[3]; }
                    sq += __shfl_xor(sq, 16); sq += __shfl_xor(sq, 32);
                    if (fq == 0) atomicAdd(ssq + row, sq); }
            }
        } else {
#pragma unroll
            for (int ai = 0; ai < 2; ++ai) {
                u32x4 old[4][2];
#pragma unroll
                for (int m = 0; m < 4; ++m)
#pragma unroll
                    for (int bj = 0; bj < 2; ++bj) old[m][bj] = *(const u32x4*)(XN + (size_t)(row0 + ai * HALF + m * 16) * DM + col0 + bj * 32);
#pragma unroll
                for (int m = 0; m < 4; ++m) { const int row = row0 + ai * HALF + m * 16; bf16_t* xnp = XN + (size_t)row * DM + col0; float sq = 0.f;
#pragma unroll
                    for (int bj = 0; bj < 2; ++bj) { const u32x4 w = old[m][bj];
                        const f32x4 v0 = (f32x4){bf_lo(w.x), bf_hi(w.x), bf_lo(w.y), bf_hi(w.y)} + acc[ai][bj][m][0], v1 = (f32x4){bf_lo(w.z), bf_hi(w.z), bf_lo(w.w), bf_hi(w.w)} + acc[ai][bj][m][1];
                        *(u32x4*)(xnp + bj * 32) = pack44(v0, v1);
                        sq += v0[0] * v0[0] + v0[1] * v0[1] + v0[2] * v0[2] + v0[3] * v0[3] + v1[0] * v1[0] + v1[1] * v1[1] + v1[2] * v1[2] + v1[3] * v1[3]; }
                    sq += __shfl_xor(sq, 16); sq += __shfl_xor(sq, 32);
                    if (fq == 0) atomicAdd(ssq + row, sq); }
            }
        }
    }
};
__device__ __forceinline__ float dpp_ror1(float v) { return __int_as_float(__builtin_amdgcn_update_dpp(0, __float_as_int(v), 0x121, 0xf, 0xf, false)); }
__device__ __forceinline__ float dpp_ror2(float v) { return __int_as_float(__builtin_amdgcn_update_dpp(0, __float_as_int(v), 0x122, 0xf, 0xf, false)); }
struct EpiFfnFused {
    static constexpr bool PERM = true;
    bf16_t* H; bf16_t* GH; bf16_t* GT; bf16_t* UH; const float* ssq; const float* cw; const float* cb;
    __device__ __forceinline__ void operator()(const f32x4 (&acc)[2][2][4][2], const Unit& u, int wr, int wc, int fr, int fq) const {
        const int ch0 = u.pn * 128 + wc * 32 + 8 * fq;
        float w0[8], w1[8], w2[8], bb[8];
#pragma unroll
        for (int h = 0; h < 2; ++h) { const f32x4 a = *(const f32x4*)(cw + ch0 + 4 * h), b = *(const f32x4*)(cw + DFF + ch0 + 4 * h), c = *(const f32x4*)(cw + 2 * DFF + ch0 + 4 * h), d = *(const f32x4*)(cb + ch0 + 4 * h);
#pragma unroll
            for (int j = 0; j < 4; ++j) { w0[4 * h + j] = a[j]; w1[4 * h + j] = b[j]; w2[4 * h + j] = c[j]; bb[4 * h + j] = d[j]; } }
        float ssv[2][4];
#pragma unroll
        for (int ai = 0; ai < 2; ++ai)
#pragma unroll
            for (int m = 0; m < 4; ++m) ssv[ai][m] = ssq[u.pm * BM + ai * HALF + wr * 64 + m * 16 + fr];
#pragma unroll
        for (int ai = 0; ai < 2; ++ai) {
            const int grp = 4 * u.pm + 2 * ai + wr;
            float p1[8], p2[8];
#pragma unroll
            for (int q = 0; q < 8; ++q) { p1[q] = 0.f; p2[q] = 0.f; }
#pragma unroll
            for (int m = 0; m < 4; ++m) {
                const int row = u.pm * BM + ai * HALF + wr * 64 + m * 16 + fr;
                const float sc = rsqrtf(ssv[ai][m] * (1.0f / 1024.0f) + EPS);
                float g[8], uu[8], c1[8], c2[8], hh[8];
#pragma unroll
                for (int n = 0; n < 2; ++n)
#pragma unroll
                    for (int j = 0; j < 4; ++j) { g[4 * n + j] = acc[ai][0][m][n][j] * sc; uu[4 * n + j] = acc[ai][1][m][n][j] * sc; }
#pragma unroll
                for (int q = 0; q < 8; ++q) { c1[q] = dpp_ror1(g[q]); c2[q] = dpp_ror2(g[q]); }
                if (m == 0 && fr < 2) { const size_t o = ((size_t)grp * 2 + fr) * DFF + ch0; *(u32x4*)(GH + o) = pack8(g); *(u32x4*)(UH + o) = pack8(uu); }
                if (m == 3 && fr >= 14) { const size_t o = ((size_t)grp * 2 + (fr - 14)) * DFF + ch0; *(u32x4*)(GT + o) = pack8(g); }
#pragma unroll
                for (int q = 0; q < 8; ++q) { const float gm1 = (fr == 0) ? p1[q] : c1[q], gm2 = (fr < 2) ? p2[q] : c2[q];
                    hh[q] = geluf_(bb[q] + w0[q] * gm2 + w1[q] * gm1 + w2[q] * g[q]) * uu[q]; p1[q] = c1[q]; p2[q] = c2[q]; }
                *(u32x4*)(H + (size_t)row * DFF + ch0) = pack8(hh);
            }
        }
    }
};
struct EpiLruIn {
    static constexpr bool PERM = true;
    bf16_t* GATE; bf16_t* XBP; const float* ssq;
    __device__ __forceinline__ void operator()(const f32x4 (&acc)[2][2][4][2], const Unit& u, int wr, int wc, int fr, int fq) const {
        const int row0 = u.pm * BM + wr * 64 + fr, lc = wc * 32 + 8 * fq;
        const bool isgate = u.pn < 4;
        bf16_t* base = isgate ? GATE : XBP; const int colt = (isgate ? u.pn : u.pn - 4) * 256 + wc * 64 + 8 * fq;
        float ssv[2][4];
#pragma unroll
        for (int ai = 0; ai < 2; ++ai)
#pragma unroll
            for (int m = 0; m < 4; ++m) ssv[ai][m] = ssq[row0 + ai * HALF + m * 16];
#pragma unroll
        for (int ai = 0; ai < 2; ++ai)
#pragma unroll
            for (int m = 0; m < 4; ++m) { bf16_t* rowp = base + (size_t)(row0 + ai * HALF + m * 16) * 1024 + colt;
                const float sc = rsqrtf(ssv[ai][m] * (1.0f / 1024.0f) + EPS);
#pragma unroll
                for (int bj = 0; bj < 2; ++bj) { f32x4 v0 = acc[ai][bj][m][0] * sc, v1 = acc[ai][bj][m][1] * sc;
                    if (isgate) {
#pragma unroll
                        for (int j = 0; j < 4; ++j) { v0[j] = geluf_(v0[j]); v1[j] = geluf_(v1[j]); } }
                    *(u32x4*)(rowp + bj * 32) = pack44(v0, v1); } }
    }
};
struct EpiLruGate {
    static constexpr bool PERM = true;
    const bf16_t* XBC2; bf16_t* LA; bf16_t* UU; const float* ba; const float* bx; const float* sp;
    __device__ __forceinline__ void operator()(const f32x4 (&acc)[2][2][4][2], const Unit& u, int wr, int wc, int fr, int fq) const {
        const int row0 = u.pm * BM + wr * 64 + fr, ch0 = (u.pn >> 1) * 256 + (u.pn & 1) * 128 + wc * 32 + 8 * fq;
        u32x4 xw[2][4];
#pragma unroll
        for (int ai = 0; ai < 2; ++ai)
#pragma unroll
            for (int m = 0; m < 4; ++m) xw[ai][m] = *(const u32x4*)(XBC2 + (size_t)(row0 + ai * HALF + m * 16) * 1024 + ch0);
        f32x4 vba[2], vbx[2], vsp[2];
#pragma unroll
        for (int n = 0; n < 2; ++n) { vba[n] = *(const f32x4*)(ba + ch0 + 4 * n); vbx[n] = *(const f32x4*)(bx + ch0 + 4 * n); vsp[n] = *(const f32x4*)(sp + ch0 + 4 * n); }
#pragma unroll
        for (int ai = 0; ai < 2; ++ai)
#pragma unroll
            for (int m = 0; m < 4; ++m) { const size_t o = (size_t)(row0 + ai * HALF + m * 16) * 1024 + ch0;
                float xb[8]; unpack8(xw[ai][m], xb);
                float la[8], uu[8];
#pragma unroll
                for (int n = 0; n < 2; ++n)
#pragma unroll
                    for (int j = 0; j < 4; ++j) { const int q = 4 * n + j;
                        const float r = sigmoidf_(acc[ai][0][m][n][j] + vba[n][j]), ig = sigmoidf_(acc[ai][1][m][n][j] + vbx[n][j]);
                        const float l = -8.0f * r * vsp[n][j]; la[q] = l;
                        const float mult = __builtin_amdgcn_sqrtf(fmaxf(0.0f, 1.0f - __expf(2.0f * l)));
                        uu[q] = mult * ig * xb[q]; }
                *(u32x4*)(LA + o) = pack8(la); *(u32x4*)(UU + o) = pack8(uu); }
    }
};

__device__ __forceinline__ void wconv_tile(const Ctx cx, const float* src, int ld_src, int nvalid, const float* gain, int k0, bf16_t* dst, int K, LAS unsigned char* lds, int delta = 0) {
    const int lane = cx.tid & 63; LAS bf16_t* L = (LAS bf16_t*)(lds + (cx.tid >> 6) * 8448);
    float v[64];
    const int scol = lane + (lane >= 32 ? delta : 0);
#pragma unroll
    for (int k = 0; k < 64; ++k) v[k] = (lane < nvalid) ? src[(size_t)k * ld_src + scol] : 0.f;
    if (gain) {
#pragma unroll
        for (int k = 0; k < 64; ++k) v[k] *= gain[k0 + k]; }
#pragma unroll
    for (int k = 0; k < 64; k += 2) *(LAS unsigned*)(L + lane * 66 + k) = cvt_pk_bf16(v[k], v[k + 1]);
    asm volatile("s_waitcnt lgkmcnt(0)" ::: "memory");
#pragma unroll
    for (int i = 0; i < 8; ++i) { const int n = (lane >> 3) + 8 * i, kq = lane & 7; const LAS unsigned* q = (const LAS unsigned*)(L + n * 66 + kq * 8);
        u32x4 w; w.x = q[0]; w.y = q[1]; w.z = q[2]; w.w = q[3];
        *(u32x4*)(dst + (size_t)n * K + kq * 8) = w; }
    asm volatile("s_waitcnt lgkmcnt(0)" ::: "memory");
}
__device__ __forceinline__ int lcol0(int n0) { const int q = (n0 & 255) >> 6; return (n0 & ~255) + 128 * (q & 1) + 32 * (q >> 1); }
__device__ __forceinline__ void phase_prep(const Ctx cx, const Params& p, LAS unsigned char* lds, const int task_lo, const int task_hi, const int vb, const int nvb, const bool tables) {
    unsigned char* ws = P_WS(p);
    constexpr int NT1 = 92 * 16, NT2 = 16 * 32, NT3 = 88 * 16, NT4 = 16 * 44, NT5 = 32 * 16, NT6 = 32 * 4, NT7 = 16 * 16;
    constexpr int NTASK = NT1 + NT2 + 2 * NT3 + 2 * NT4 + NT5 + NT6 + NT7;
    for (int task = task_lo + vb * 8 + __builtin_amdgcn_readfirstlane(cx.tid >> 6); task < (task_hi < NTASK ? task_hi : NTASK); task += nvb * 8) {
        int id = task;
        if (id < NT1) { const int ntile = id / 16, kt = id % 16, n0 = ntile * 64, k0 = kt * 64, pn = n0 >> 8, lc0 = n0 & 255;
            int col, nv = 64;
            int dl = 0;
            if (pn < 10) { col = lcol0(n0); dl = 32; } else if (pn < 14) { col = 2576 + (lcol0(n0) - 2560); dl = 32; }
            else if (pn < 22) col = (lc0 < 128 ? 3600 : 4624) + (pn - 14) * 128 + (lc0 & 127);
            else { col = 2560; nv = (lc0 == 0) ? 16 : 0; }
            wconv_tile(cx, IN(p, I_AB_WIN) + (size_t)k0 * 5648 + col, 5648, nv, IN(p, I_NORM_MIX), k0, (bf16_t*)(ws + WS_W1) + (size_t)n0 * 1024 + k0, 1024, lds, dl); continue; }
        id -= NT1;
        if (id < NT2) { const int ntile = id / 32, kt = id % 32, n0 = ntile * 64, k0 = kt * 64;
            wconv_tile(cx, IN(p, I_AB_WOUT) + (size_t)k0 * 1024 + lcol0(n0), 1024, 64, k0 < 1024 ? IN(p, I_SSD_NORM) : nullptr, k0, (bf16_t*)(ws + WS_W2) + (size_t)n0 * 2048 + k0, 2048, lds, 32); continue; }
        id -= NT2;
        if (id < 2 * NT3) { const int l = id / NT3; id -= l * NT3; const int ntile = id / 16, kt = id % 16, n0 = ntile * 64, k0 = kt * 64, pn = n0 >> 8, lc0 = n0 & 255;
            const int col = (lc0 < 128 ? 0 : DFF) + pn * 128 + (lc0 & 127);
            wconv_tile(cx, IN(p, I_FFN_WIN) + (size_t)l * 1024 * 5632 + (size_t)k0 * 5632 + col, 5632, 64, IN(p, I_NORM_FFN) + l * 1024, k0, (bf16_t*)(ws + WS_W3) + (size_t)l * 5632 * 1024 + (size_t)n0 * 1024 + k0, 1024, lds); continue; }
        id -= 2 * NT3;
        if (id < 2 * NT4) { const int l = id / NT4; id -= l * NT4; const int ntile = id / 44, kt = id % 44, n0 = ntile * 64, k0 = kt * 64;
            wconv_tile(cx, IN(p, I_FFN_WOUT) + (size_t)l * DFF * 1024 + (size_t)k0 * 1024 + lcol0(n0), 1024, 64, nullptr, k0, (bf16_t*)(ws + WS_W4) + (size_t)l * 1024 * DFF + (size_t)n0 * DFF + k0, DFF, lds, 32); continue; }
        id -= 2 * NT4;
        if (id < NT5) { const int ntile = id / 16, kt = id % 16, n0 = ntile * 64, k0 = kt * 64;
            wconv_tile(cx, IN(p, I_LRU_WIN) + (size_t)k0 * 2048 + lcol0(n0), 2048, 64, IN(p, I_NORM_MIX) + 1024, k0, (bf16_t*)(ws + WS_W5) + (size_t)n0 * 1024 + k0, 1024, lds, 32); continue; }
        id -= NT5;
        if (id < NT6) { const int ntile = id / 4, kt = id % 4, n0 = ntile * 64, k0 = kt * 64, head = n0 >> 9, within = n0 & 511, pnl = within >> 8, lc0 = within & 255;
            const int ch = pnl * 128 + (lc0 & 127);
            const float* srcm = (lc0 < 128 ? IN(p, I_LRU_WA) : IN(p, I_LRU_WX)) + (size_t)head * 65536;
            wconv_tile(cx, srcm + (size_t)k0 * 256 + ch, 256, 64, nullptr, k0, (bf16_t*)(ws + WS_W6) + (size_t)n0 * 256 + k0, 256, lds); continue; }
        id -= NT6;
        { const int ntile = id / 16, kt = id % 16, n0 = ntile * 64, k0 = kt * 64;
            wconv_tile(cx, IN(p, I_LRU_WOUT) + (size_t)k0 * 1024 + lcol0(n0), 1024, 64, nullptr, k0, (bf16_t*)(ws + WS_W7) + (size_t)n0 * 1024 + k0, 1024, lds, 32); }
    }
    if (!tables) return;
    const int gt = cx.bid * NTHREADS + cx.tid, gs = cx.nblk * NTHREADS;
    for (int i = gt; i < 1024; i += gs) ((float*)(ws + WS_SP))[i] = softplusf_(-IN(p, I_LRU_LAMBDA)[i]);
    for (int i = gt; i < 5 * T; i += gs) ((float*)(ws + WS_SSQ))[i] = 0.f;
}

__device__ __forceinline__ void phase_norm(const Ctx cx, const float* xp, const float* xs, bf16_t* XN) {
    const int wid = cx.tid >> 6, lane = cx.tid & 63;
    for (int row0 = cx.bid * 8 + wid; row0 < T; row0 += cx.nblk * 32) {
        f32x4 v[4][4];
#pragma unroll
        for (int i = 0; i < 4; ++i) { const int row = row0 + i * cx.nblk * 8;
            if (row < T) { const float* src = row < TP ? xp + (size_t)row * DM : xs + (size_t)(row - TP) * DM;
#pragma unroll
                for (int j = 0; j < 4; ++j) v[i][j] = *(const f32x4*)(src + lane * 4 + j * 256); } }
#pragma unroll
        for (int i = 0; i < 4; ++i) { const int row = row0 + i * cx.nblk * 8;
            if (row < T) { float s = 0.f;
#pragma unroll
                for (int j = 0; j < 4; ++j) s += v[i][j][0] * v[i][j][0] + v[i][j][1] * v[i][j][1] + v[i][j][2] * v[i][j][2] + v[i][j][3] * v[i][j][3];
#pragma unroll
                for (int o = 32; o >= 1; o >>= 1) s += __shfl_xor(s, o);
                const float rs = rsqrtf(s * (1.0f / 1024.0f) + EPS);
#pragma unroll
                for (int j = 0; j < 4; ++j) { u32x2 w; w.x = cvt_pk_bf16(v[i][j][0] * rs, v[i][j][1] * rs); w.y = cvt_pk_bf16(v[i][j][2] * rs, v[i][j][3] * rs);
                    *(u32x2*)(XN + (size_t)row * DM + lane * 4 + j * 256) = w; } } }
    }
}
__device__ __forceinline__ void phase_final_norm(const Ctx cx, const bf16_t* XN, const float* ssq, const float* gain, float* y) {
    const int wid = cx.tid >> 6, lane = cx.tid & 63;
    f32x4 gv[4];
#pragma unroll
    for (int j = 0; j < 4; ++j) gv[j] = *(const f32x4*)(gain + lane * 4 + j * 256);
    for (int row0 = cx.bid * 8 + wid; row0 < T; row0 += cx.nblk * 64) {
        u32x2 w[8][4]; float rs[8];
#pragma unroll
        for (int i = 0; i < 8; ++i) { const int row = row0 + i * cx.nblk * 8;
            if (row < T) {
#pragma unroll
                for (int j = 0; j < 4; ++j) w[i][j] = *(const u32x2*)(XN + (size_t)row * DM + lane * 4 + j * 256);
                rs[i] = rsqrtf(ssq[row] * (1.0f / 1024.0f) + EPS); } }
#pragma unroll
        for (int i = 0; i < 8; ++i) { const int row = row0 + i * cx.nblk * 8;
            if (row < T) { float* dst = y + (size_t)row * DM + lane * 4;
#pragma unroll
                for (int j = 0; j < 4; ++j) *(f32x4*)(dst + j * 256) = (f32x4){bf_lo(w[i][j].x), bf_hi(w[i][j].x), bf_lo(w[i][j].y), bf_hi(w[i][j].y)} * rs[i] * gv[j]; } }
    }
}

template <int KW, int MODE>
__device__ __forceinline__ void phase_conv(const Ctx cx, const bf16_t* src, int ld_src, int NC, const float* w, const float* bias, bf16_t* dst, int ld_dst,
                           const float* st_in, float* out_p, float* out_s) {
    const int ncg = NC >> 3, total = (T / 16) * ncg;
    for (int item = cx.bid * NTHREADS + cx.tid; item < total; item += cx.nblk * NTHREADS) {
        const int cgi = item % ncg, seg = item / ncg, c0 = cgi * 8, r0 = seg * 16;
        int seq, t0, L; if (r0 < TP) { seq = r0 >> 12; t0 = r0 & 4095; L = 4096; } else { seq = 16 + ((r0 - TP) >> 6); t0 = (r0 - TP) & 63; L = 64; }
        float wv[KW][8], bv[8];
#pragma unroll
        for (int k = 0; k < KW; ++k) { const f32x4 a = *(const f32x4*)(w + (size_t)k * NC + c0), b = *(const f32x4*)(w + (size_t)k * NC + c0 + 4);
#pragma unroll
            for (int j = 0; j < 4; ++j) { wv[k][j] = a[j]; wv[k][4 + j] = b[j]; } }
        { const f32x4 a = *(const f32x4*)(bias + c0), b = *(const f32x4*)(bias + c0 + 4);
#pragma unroll
          for (int j = 0; j < 4; ++j) { bv[j] = a[j]; bv[4 + j] = b[j]; } }
        float win[KW - 1][8];
#pragma unroll
        for (int k = 0; k < KW - 1; ++k) {
            if (t0 > 0) unpack8(*(const u32x4*)(src + (size_t)(r0 - (KW - 1) + k) * ld_src + c0), win[k]);
            else if (seq >= 16) { const float* sp_ = st_in + ((size_t)(seq - 16) * (KW - 1) + k) * NC + c0; const f32x4 a = *(const f32x4*)sp_, b = *(const f32x4*)(sp_ + 4);
#pragma unroll
                for (int j = 0; j < 4; ++j) { win[k][j] = a[j]; win[k][4 + j] = b[j]; } }
            else {
#pragma unroll
                for (int j = 0; j < 8; ++j) win[k][j] = 0.f; }
        }
#pragma unroll
        for (int h = 0; h < 2; ++h) {
            u32x4 rows[8], aux[8];
#pragma unroll
            for (int i = 0; i < 8; ++i) { rows[i] = *(const u32x4*)(src + (size_t)(r0 + h * 8 + i) * ld_src + c0);
                if (MODE == 1 || MODE == 2) aux[i] = *(const u32x4*)(dst + (size_t)(r0 + h * 8 + i) * ld_dst + c0); }
#pragma unroll
            for (int i = 0; i < 8; ++i) {
                float cur[8], y[8]; unpack8(rows[i], cur);
#pragma unroll
                for (int j = 0; j < 8; ++j) { float a = bv[j] + wv[KW - 1][j] * cur[j];
#pragma unroll
                    for (int k = 0; k < KW - 1; ++k) a += wv[k][j] * win[k][j];
                    y[j] = a; }
#pragma unroll
                for (int j = 0; j < 8; ++j) {
#pragma unroll
                    for (int k = 0; k < KW - 2; ++k) win[k][j] = win[k + 1][j];
                    win[KW - 2][j] = cur[j]; }
                if (MODE == 0) {
#pragma unroll
                    for (int j = 0; j < 8; ++j) y[j] = siluf_(y[j]); }
                if (MODE == 1) { float gq[8]; unpack8(aux[i], gq);
#pragma unroll
                    for (int j = 0; j < 8; ++j) y[j] = y[j] * gq[j]; }
                if (MODE == 2) { float uq[8]; unpack8(aux[i], uq);
#pragma unroll
                    for (int j = 0; j < 8; ++j) y[j] = geluf_(y[j]) * uq[j]; }
                *(u32x4*)(dst + (size_t)(r0 + h * 8 + i) * ld_dst + c0) = pack8(y);
            }
            if (h == 1 && t0 + 16 == L) {
                float* ob = (seq < 16 ? out_p + (size_t)seq * (KW - 1) * NC : out_s + (size_t)(seq - 16) * (KW - 1) * NC) + c0;
#pragma unroll
                for (int j = 0; j < KW - 1; ++j) { float f[8]; unpack8(rows[8 - (KW - 1) + j], f);
                    *(f32x4*)(ob + (size_t)j * NC) = (f32x4){f[0], f[1], f[2], f[3]}; *(f32x4*)(ob + (size_t)j * NC + 4) = (f32x4){f[4], f[5], f[6], f[7]}; }
            }
        }
    }
}

template <bool SRC_F32, bool GSCALE>
__device__ __forceinline__ void phase_split_finish(const Ctx cx, const float* slabs, int nsplit, const float* xs, bf16_t* XN, float* ssq, const float* gssq) {
    const int wid = cx.tid >> 6, lane = cx.tid & 63;
    for (int r = cx.bid * 8 + wid; r < TS; r += cx.nblk * 8) {
        const int panel = r >> 8, rl = r & 255, pn = lane >> 4, lc = (lane & 15) * 16;
        const float* sb = slabs + (size_t)((panel * 4 + pn) * nsplit) * 65536 + (size_t)rl * 256 + lc;
        f32x4 v[4];
#pragma unroll
        for (int q = 0; q < 4; ++q) v[q] = (f32x4){0.f, 0.f, 0.f, 0.f};
        for (int pc = 0; pc < nsplit; ++pc) {
#pragma unroll
            for (int q = 0; q < 4; ++q) v[q] += *(const f32x4*)(sb + (size_t)pc * 65536 + 4 * q);
            if (GSCALE && pc == 3) { const float sc = rsqrtf(gssq[TP + r] * (1.0f / 1024.0f) + EPS);
#pragma unroll
                for (int q = 0; q < 4; ++q) v[q] *= sc; }
        }
        bf16_t* xnp = XN + (size_t)(TP + r) * DM + lane * 16;
        if (SRC_F32) { const float* src = xs + (size_t)r * DM + lane * 16;
#pragma unroll
            for (int q = 0; q < 4; ++q) v[q] += *(const f32x4*)(src + 4 * q); }
        else { float a[8], b[8]; unpack8(*(const u32x4*)xnp, a); unpack8(*(const u32x4*)(xnp + 8), b);
            v[0] += (f32x4){a[0], a[1], a[2], a[3]}; v[1] += (f32x4){a[4], a[5], a[6], a[7]}; v[2] += (f32x4){b[0], b[1], b[2], b[3]}; v[3] += (f32x4){b[4], b[5], b[6], b[7]}; }
        *(u32x4*)xnp = pack44(v[0], v[1]); *(u32x4*)(xnp + 8) = pack44(v[2], v[3]);
        float sq = 0.f;
#pragma unroll
        for (int q = 0; q < 4; ++q) sq += v[q][0] * v[q][0] + v[q][1] * v[q][1] + v[q][2] * v[q][2] + v[q][3] * v[q][3];
#pragma unroll
        for (int o = 32; o >= 1; o >>= 1) sq += __shfl_xor(sq, o);
        if (lane == 0) ssq[TP + r] = sq;
    }
}

__device__ __forceinline__ void phase_ffn_fix(const Ctx cx, const bf16_t* GH, const bf16_t* GT, const bf16_t* UH, bf16_t* H, const float* cw, const float* cb,
                                              const float* st_in, float* out_p, float* out_s) {
    const int ncg = DFF / 8, total = 1032 * ncg;
    for (int item = cx.bid * NTHREADS + cx.tid; item < total; item += cx.nblk * NTHREADS) {
        const int cgi = item % ncg, G = item / ncg, c0 = cgi * 8;
        int seq; bool first, lastg;
        if (G < 1024) { seq = G >> 6; first = (G & 63) == 0; lastg = (G & 63) == 63; } else { seq = 16 + (G - 1024); first = true; lastg = true; }
        float w0[8], w1[8], w2[8], bb[8], gm2[8], gm1[8], g0[8], g1[8], u0[8], u1[8];
#pragma unroll
        for (int h = 0; h < 2; ++h) { const f32x4 a = *(const f32x4*)(cw + c0 + 4 * h), b = *(const f32x4*)(cw + DFF + c0 + 4 * h), c = *(const f32x4*)(cw + 2 * DFF + c0 + 4 * h), d = *(const f32x4*)(cb + c0 + 4 * h);
#pragma unroll
            for (int j = 0; j < 4; ++j) { w0[4 * h + j] = a[j]; w1[4 * h + j] = b[j]; w2[4 * h + j] = c[j]; bb[4 * h + j] = d[j]; } }
        if (!first) { unpack8(*(const u32x4*)(GT + ((size_t)(G - 1) * 2 + 0) * DFF + c0), gm2); unpack8(*(const u32x4*)(GT + ((size_t)(G - 1) * 2 + 1) * DFF + c0), gm1); }
        else if (seq >= 16) { const float* s0 = st_in + ((size_t)(seq - 16) * 2) * DFF + c0;
#pragma unroll
            for (int h = 0; h < 2; ++h) { const f32x4 a = *(const f32x4*)(s0 + 4 * h), b = *(const f32x4*)(s0 + DFF + 4 * h);
#pragma unroll
                for (int j = 0; j < 4; ++j) { gm2[4 * h + j] = a[j]; gm1[4 * h + j] = b[j]; } } }
        else {
#pragma unroll
            for (int q = 0; q < 8; ++q) { gm2[q] = 0.f; gm1[q] = 0.f; } }
        unpack8(*(const u32x4*)(GH + ((size_t)G * 2 + 0) * DFF + c0), g0); unpack8(*(const u32x4*)(GH + ((size_t)G * 2 + 1) * DFF + c0), g1);
        unpack8(*(const u32x4*)(UH + ((size_t)G * 2 + 0) * DFF + c0), u0); unpack8(*(const u32x4*)(UH + ((size_t)G * 2 + 1) * DFF + c0), u1);
        float h0[8], h1[8];
#pragma unroll
        for (int q = 0; q < 8; ++q) { h0[q] = geluf_(bb[q] + w0[q] * gm2[q] + w1[q] * gm1[q] + w2[q] * g0[q]) * u0[q];
            h1[q] = geluf_(bb[q] + w0[q] * gm1[q] + w1[q] * g0[q] + w2[q] * g1[q]) * u1[q]; }
        *(u32x4*)(H + (size_t)(G * 64) * DFF + c0) = pack8(h0); *(u32x4*)(H + (size_t)(G * 64 + 1) * DFF + c0) = pack8(h1);
        if (lastg) {
            float* ob = (seq < 16 ? out_p + (size_t)seq * 2 * DFF : out_s + (size_t)(seq - 16) * 2 * DFF) + c0;
#pragma unroll
            for (int j = 0; j < 2; ++j) { float f[8]; unpack8(*(const u32x4*)(GT + ((size_t)G * 2 + j) * DFF + c0), f);
                *(f32x4*)(ob + (size_t)j * DFF) = (f32x4){f[0], f[1], f[2], f[3]}; *(f32x4*)(ob + (size_t)j * DFF + 4) = (f32x4){f[4], f[5], f[6], f[7]}; }
        }
    }
}

constexpr int SC_CS = 0, SC_BS = 17408, SC_BTS = 34816, SC_XTS = 53248, SC_XDS = 62464, SC_HS = 71680, SC_MS = 89088, SC_AS = 98304, SC_SQ = 98560;
#define LDS_BARRIER() do { asm volatile("s_waitcnt lgkmcnt(0)" ::: "memory"); __builtin_amdgcn_s_barrier(); asm volatile("" ::: "memory"); } while (0)
template <int N> __device__ __forceinline__ float dpp_shr(float v) { return __int_as_float(__builtin_amdgcn_update_dpp(0, __float_as_int(v), 0x110 + N, 0xf, 0xf, true)); }
__device__ __forceinline__ void ssd_task(const Ctx cx, const Params& p, LAS unsigned char* lds, int seq, int hd) {
    const int tid = cx.tid, wid = tid >> 6, lane = tid & 63, fr = lane & 15, fq = lane >> 4;
    unsigned char* ws = P_WS(p);
    const bf16_t* XBCA = (const bf16_t*)(ws + WS_XBCA); bf16_t* A2 = (bf16_t*)(ws + WS_A2); const float* DT = (const float*)(ws + WS_DT); float* SSQ = (float*)(ws + WS_SSQ);
    const int g = hd >> 3, nchunks = seq < 16 ? 64 : 1;
    const size_t row_base = seq < 16 ? (size_t)seq * 4096 : (size_t)TP + (size_t)(seq - 16) * 64;
    const float Aneg = -__expf(IN(p, I_A_LOG)[hd]), Dh = IN(p, I_SSD_D)[hd];
    LAS float* As = (LAS float*)(lds + SC_AS); LAS float* Sq = (LAS float*)(lds + SC_SQ);
    f32x4 hst[4];
#pragma unroll
    for (int pt = 0; pt < 4; ++pt) {
        if (seq >= 16) hst[pt] = *(const f32x4*)(IN(p, I_ST_SSD) + ((size_t)((seq - 16) * 16 + hd) * 64 + 16 * pt + fr) * 128 + 16 * wid + 4 * fq);
        else hst[pt] = (f32x4){0.f, 0.f, 0.f, 0.f};
    }
    const int lt = wid >> 1, ph = wid & 1;
    float pf_dt; u32x4 pf_b[2], pf_c[2], pf_x, pf_bt[2];
#define SSD_PREFETCH(cc) do { const size_t r0p = row_base + (size_t)(cc) * 64; \
        pf_dt = DT[(r0p + lane) * 16 + hd]; \
        _Pragma("unroll") for (int i = 0; i < 2; ++i) { const int q = tid + i * 512, row = q >> 4, sg = q & 15; \
            const bf16_t* gp = XBCA + (r0p + row) * XBC + 1024 + g * 128 + sg * 8; pf_b[i] = *(const u32x4*)gp; pf_c[i] = *(const u32x4*)(gp + 256); } \
        pf_x = *(const u32x4*)(XBCA + (r0p + lane) * XBC + hd * 64 + wid * 8); \
        _Pragma("unroll") for (int i = 0; i < 2; ++i) pf_bt[i] = *(const u32x4*)(XBCA + (r0p + lane) * XBC + 1024 + g * 128 + (wid + 8 * i) * 8); } while (0)
    SSD_PREFETCH(0);
    for (int c = 0; c < nchunks; ++c) {
        const size_t r0 = row_base + (size_t)c * 64;
        const float dt_l = pf_dt;
        float a = dt_l * Aneg;
        a += dpp_shr<1>(a); a += dpp_shr<2>(a); a += dpp_shr<4>(a); a += dpp_shr<8>(a);
        { const float t0 = __int_as_float(__builtin_amdgcn_readlane(__float_as_int(a), 15)), t1 = __int_as_float(__builtin_amdgcn_readlane(__float_as_int(a), 31)), t2 = __int_as_float(__builtin_amdgcn_readlane(__float_as_int(a), 47));
          a += (fq == 1) ? t0 : (fq == 2) ? (t0 + t1) : (fq == 3) ? (t0 + t1 + t2) : 0.0f; }
        const float a63 = __int_as_float(__builtin_amdgcn_readlane(__float_as_int(a), 63));
        const float wl = dt_l * __expf(a63 - a);
        if (wid == 0) As[lane] = a;
#pragma unroll
        for (int i = 0; i < 2; ++i) { const int q = tid + i * 512, row = q >> 4, sg = q & 15;
            *(LAS u32x4*)(lds + SC_BS + row * 272 + sg * 16) = pf_b[i]; *(LAS u32x4*)(lds + SC_CS + row * 272 + sg * 16) = pf_c[i]; }
        { float f[8]; unpack8(pf_x, f);
          LAS bf16_t* xt = (LAS bf16_t*)(lds + SC_XTS), *xd = (LAS bf16_t*)(lds + SC_XDS);
#pragma unroll
          for (int j = 0; j < 8; ++j) { const unsigned w2 = cvt_pk_bf16(f[j] * dt_l, f[j] * wl); xt[(wid * 8 + j) * 72 + lane] = (bf16_t)(w2 & 0xffffu); xd[(wid * 8 + j) * 72 + lane] = (bf16_t)(w2 >> 16); } }
#pragma unroll
        for (int i = 0; i < 2; ++i) { const int sg = wid + 8 * i; const u32x4 bw = pf_bt[i];
            LAS bf16_t* bt = (LAS bf16_t*)(lds + SC_BTS);
            bt[(sg * 8 + 0) * 72 + lane] = (bf16_t)(bw.x & 0xffffu); bt[(sg * 8 + 1) * 72 + lane] = (bf16_t)(bw.x >> 16);
            bt[(sg * 8 + 2) * 72 + lane] = (bf16_t)(bw.y & 0xffffu); bt[(sg * 8 + 3) * 72 + lane] = (bf16_t)(bw.y >> 16);
            bt[(sg * 8 + 4) * 72 + lane] = (bf16_t)(bw.z & 0xffffu); bt[(sg * 8 + 5) * 72 + lane] = (bf16_t)(bw.z >> 16);
            bt[(sg * 8 + 6) * 72 + lane] = (bf16_t)(bw.w & 0xffffu); bt[(sg * 8 + 7) * 72 + lane] = (bf16_t)(bw.w >> 16); }
#pragma unroll
        for (int pt = 0; pt < 4; ++pt) { u32x2 w2; w2.x = cvt_pk_bf16(hst[pt][0], hst[pt][1]); w2.y = cvt_pk_bf16(hst[pt][2], hst[pt][3]);
            *(LAS u32x2*)(lds + SC_HS + (16 * pt + fr) * 272 + (16 * wid + 4 * fq) * 2) = w2; }
        u32x2 ep_z[2], ep_x[2];
#pragma unroll
        for (int j = 0; j < 2; ++j) { const size_t rowe = r0 + 16 * lt + fr; const int col = hd * 64 + 16 * (2 * ph + j) + 4 * fq;
            ep_z[j] = *(const u32x2*)(A2 + rowe * 2048 + col); ep_x[j] = *(const u32x2*)(XBCA + rowe * XBC + col); }
        if (c + 1 < nchunks) SSD_PREFETCH(c + 1);
        LDS_BARRIER();
        f32x4 yacc[2];
        {
            bf16x8 cf[4];
#pragma unroll
            for (int kk = 0; kk < 4; ++kk) cf[kk] = *(const LAS bf16x8*)(lds + SC_CS + (16 * lt + fr) * 272 + kk * 64 + fq * 16);
            const float a_l = As[16 * lt + fr];
#pragma unroll
            for (int j = 0; j < 2; ++j) {
                const int st = 2 * ph + j;
                f32x4 cb = (f32x4){0.f, 0.f, 0.f, 0.f};
                if (st <= lt) {
#pragma unroll
                    for (int kk = 0; kk < 4; ++kk) { const bf16x8 bf = *(const LAS bf16x8*)(lds + SC_BS + (16 * st + fr) * 272 + kk * 64 + fq * 16);
                        cb = __builtin_amdgcn_mfma_f32_16x16x32_bf16(bf, cf[kk], cb, 0, 0, 0); }
                    const f32x4 as4 = *(const LAS f32x4*)(lds + SC_AS + (16 * st + 4 * fq) * 4);
#pragma unroll
                    for (int r = 0; r < 4; ++r) { const int s = 16 * st + 4 * fq + r, l = 16 * lt + fr; cb[r] = (s <= l) ? cb[r] * __expf(a_l - as4[r]) : 0.f; }
                }
                u32x2 w2; w2.x = cvt_pk_bf16(cb[0], cb[1]); w2.y = cvt_pk_bf16(cb[2], cb[3]);
                *(LAS u32x2*)(lds + SC_MS + (16 * lt + fr) * 144 + (16 * st + 4 * fq) * 2) = w2;
            }
            const float el = __expf(a_l);
#pragma unroll
            for (int j = 0; j < 2; ++j) { const int pt = 2 * ph + j; f32x4 y = (f32x4){0.f, 0.f, 0.f, 0.f};
#pragma unroll
                for (int kk = 0; kk < 4; ++kk) { const bf16x8 hf = *(const LAS bf16x8*)(lds + SC_HS + (16 * pt + fr) * 272 + kk * 64 + fq * 16);
                    y = __builtin_amdgcn_mfma_f32_16x16x32_bf16(hf, cf[kk], y, 0, 0, 0); }
                yacc[j] = y * el; }
        }
        {
            const float dec = __expf(a63);
            bf16x8 btf[2];
#pragma unroll
            for (int kk = 0; kk < 2; ++kk) btf[kk] = *(const LAS bf16x8*)(lds + SC_BTS + (16 * wid + fr) * 144 + kk * 64 + fq * 16);
#pragma unroll
            for (int pt = 0; pt < 4; ++pt) { f32x4 h = hst[pt] * dec;
#pragma unroll
                for (int kk = 0; kk < 2; ++kk) { const bf16x8 xf = *(const LAS bf16x8*)(lds + SC_XDS + (16 * pt + fr) * 144 + kk * 64 + fq * 16);
                    h = __builtin_amdgcn_mfma_f32_16x16x32_bf16(btf[kk], xf, h, 0, 0, 0); }
                hst[pt] = h; }
        }
        LDS_BARRIER();
        {
            bf16x8 mf[2];
#pragma unroll
            for (int kk = 0; kk < 2; ++kk) mf[kk] = *(const LAS bf16x8*)(lds + SC_MS + (16 * lt + fr) * 144 + kk * 64 + fq * 16);
            float sq = 0.f;
            const size_t row = r0 + 16 * lt + fr;
#pragma unroll
            for (int j = 0; j < 2; ++j) { const int pt = 2 * ph + j; f32x4 y = yacc[j];
#pragma unroll
                for (int kk = 0; kk < 2; ++kk) { const bf16x8 xf = *(const LAS bf16x8*)(lds + SC_XTS + (16 * pt + fr) * 144 + kk * 64 + fq * 16);
                    y = __builtin_amdgcn_mfma_f32_16x16x32_bf16(xf, mf[kk], y, 0, 0, 0); }
                const int col = hd * 64 + 16 * pt + 4 * fq;
                const u32x2 zw = ep_z[j], xw = ep_x[j];
                const float z0 = bf_lo(zw.x), z1 = bf_hi(zw.x), z2 = bf_lo(zw.y), z3 = bf_hi(zw.y);
                const float x0 = bf_lo(xw.x), x1 = bf_hi(xw.x), x2 = bf_lo(xw.y), x3 = bf_hi(xw.y);
                const float g0 = (y[0] + Dh * x0) * siluf_(z0), g1 = (y[1] + Dh * x1) * siluf_(z1), g2 = (y[2] + Dh * x2) * siluf_(z2), g3 = (y[3] + Dh * x3) * siluf_(z3);
                sq += g0 * g0 + g1 * g1 + g2 * g2 + g3 * g3;
                u32x2 ow; ow.x = cvt_pk_bf16(g0, g1); ow.y = cvt_pk_bf16(g2, g3);
                *(u32x2*)(A2 + row * 2048 + col) = ow; }
            sq += __shfl_xor(sq, 16); sq += __shfl_xor(sq, 32);
            if (fq == 0) Sq[ph * 64 + 16 * lt + fr] = sq;
        }
        LDS_BARRIER();
        if (tid < 64) atomicAdd(SSQ + r0 + tid, Sq[tid] + Sq[64 + tid]);
    }
    float* so = (seq < 16 ? P_OUT(p) + O_P_SSD + (size_t)(seq * 16 + hd) * 8192 : P_OUT(p) + O_S_SSD + (size_t)((seq - 16) * 16 + hd) * 8192);
#pragma unroll
    for (int pt = 0; pt < 4; ++pt) *(f32x4*)(so + (size_t)(16 * pt + fr) * 128 + 16 * wid + 4 * fq) = hst[pt];
    LDS_BARRIER();
}
__device__ __forceinline__ void phase_ssd(const Ctx cx, const Params& p, LAS unsigned char* lds) {
    for (int task = cx.bid; task < 384; task += cx.nblk) {
        if (task < 256) ssd_task(cx, p, lds, task >> 4, task & 15);
        else ssd_task(cx, p, lds, 16 + ((task - 256) >> 4), (task - 256) & 15);
    }
}

__device__ __forceinline__ void phase_lru_a(const Ctx cx, const bf16_t* LA, const bf16_t* UU, float* SL, float* HH) {
    const int total = 1088 * 128;
    for (int item = cx.bid * NTHREADS + cx.tid; item < total; item += cx.nblk * NTHREADS) {
        const int cgi = item & 127, ch = item >> 7, c0 = cgi * 8; const size_t r0 = ch < 1024 ? (size_t)ch * 64 : (size_t)TP + (size_t)(ch - 1024) * 8; const int nr = ch < 1024 ? 64 : 8;
        float sl[8], h[8];
#pragma unroll
        for (int j = 0; j < 8; ++j) { sl[j] = 0.f; h[j] = 0.f; }
        for (int i0 = 0; i0 < nr; i0 += 8) {
            u32x4 la[8], uu[8];
#pragma unroll
            for (int i = 0; i < 8; ++i) { la[i] = *(const u32x4*)(LA + (r0 + i0 + i) * 1024 + c0); uu[i] = *(const u32x4*)(UU + (r0 + i0 + i) * 1024 + c0); }
#pragma unroll
            for (int i = 0; i < 8; ++i) { float l[8], u[8]; unpack8(la[i], l); unpack8(uu[i], u);
#pragma unroll
                for (int j = 0; j < 8; ++j) { sl[j] += l[j]; h[j] = __expf(l[j]) * h[j] + u[j]; } }
        }
        float* o1 = SL + (size_t)ch * 1024 + c0; float* o2 = HH + (size_t)ch * 1024 + c0;
        *(f32x4*)o1 = (f32x4){sl[0], sl[1], sl[2], sl[3]}; *(f32x4*)(o1 + 4) = (f32x4){sl[4], sl[5], sl[6], sl[7]};
        *(f32x4*)o2 = (f32x4){h[0], h[1], h[2], h[3]}; *(f32x4*)(o2 + 4) = (f32x4){h[4], h[5], h[6], h[7]};
    }
}
__device__ __forceinline__ void phase_lru_b(const Ctx cx, const Params& p, const float* SL, const float* HH, float* CIN) {
    for (int item = cx.bid * NTHREADS + cx.tid; item < 24 * 1024; item += cx.nblk * NTHREADS) {
        const int chn = item & 1023, seq = item >> 10;
        const int nch = seq < 16 ? 64 : 8, ch0 = seq < 16 ? seq * 64 : 1024 + (seq - 16) * 8;
        float c = seq < 16 ? 0.f : IN(p, I_ST_LRU)[(seq - 16) * 1024 + chn];
        for (int i0 = 0; i0 < nch; i0 += 16) {
            float sl[16], hh[16];
#pragma unroll
            for (int i = 0; i < 16; ++i) if (i0 + i < nch) { sl[i] = SL[(size_t)(ch0 + i0 + i) * 1024 + chn]; hh[i] = HH[(size_t)(ch0 + i0 + i) * 1024 + chn]; }
#pragma unroll
            for (int i = 0; i < 16; ++i) if (i0 + i < nch) { CIN[(size_t)(ch0 + i0 + i) * 1024 + chn] = c; c = __expf(sl[i]) * c + hh[i]; }
        }
        (seq < 16 ? P_OUT(p) + O_P_LRU + seq * 1024 : P_OUT(p) + O_S_LRU + (seq - 16) * 1024)[chn] = c;
    }
}
__device__ __forceinline__ void phase_lru_c(const Ctx cx, const bf16_t* LA, const bf16_t* UU, const float* CIN, bf16_t* GATE) {
    const int total = 1088 * 128;
    for (int item = cx.bid * NTHREADS + cx.tid; item < total; item += cx.nblk * NTHREADS) {
        const int cgi = item & 127, ch = item >> 7, c0 = cgi * 8; const size_t r0 = ch < 1024 ? (size_t)ch * 64 : (size_t)TP + (size_t)(ch - 1024) * 8; const int nr = ch < 1024 ? 64 : 8;
        float h[8];
        { const float* ci = CIN + (size_t)ch * 1024 + c0; const f32x4 a = *(const f32x4*)ci, b = *(const f32x4*)(ci + 4);
#pragma unroll
          for (int j = 0; j < 4; ++j) { h[j] = a[j]; h[4 + j] = b[j]; } }
        for (int i0 = 0; i0 < nr; i0 += 8) {
            u32x4 la[8], uu[8], gt[8];
#pragma unroll
            for (int i = 0; i < 8; ++i) { la[i] = *(const u32x4*)(LA + (r0 + i0 + i) * 1024 + c0); uu[i] = *(const u32x4*)(UU + (r0 + i0 + i) * 1024 + c0); gt[i] = *(const u32x4*)(GATE + (r0 + i0 + i) * 1024 + c0); }
#pragma unroll
            for (int i = 0; i < 8; ++i) { float l[8], u[8], gq[8], o[8]; unpack8(la[i], l); unpack8(uu[i], u); unpack8(gt[i], gq);
#pragma unroll
                for (int j = 0; j < 8; ++j) { h[j] = __expf(l[j]) * h[j] + u[j]; o[j] = gq[j] * h[j]; }
                *(u32x4*)(GATE + (r0 + i0 + i) * 1024 + c0) = pack8(o); }
        }
    }
}

#define XB_TMO      128
#define XB_XCNT(j)  (256  + 64 * (j))
#define XB_XSUB(j)  (1280 + 64 * (j))
#define XB_XGEN(j)  (2304 + 64 * (j))
#define XB_TOP      3328
#define XB_TOPGEN   3392
#define XCD_BAR_WORDS 3456
#define XB_SPIN_CAP (1u << 18)
__device__ __forceinline__ unsigned xb_ld(unsigned* p)              { return __hip_atomic_load(p, __ATOMIC_RELAXED, __HIP_MEMORY_SCOPE_AGENT); }
__device__ __forceinline__ unsigned xb_add(unsigned* p, unsigned v) { return __hip_atomic_fetch_add(p, v, __ATOMIC_RELAXED, __HIP_MEMORY_SCOPE_AGENT); }
__device__ __forceinline__ unsigned xb_xcc_id() { return (unsigned)__builtin_amdgcn_s_getreg((3 << 11) | 20) & 0xFu; }
#define XB_SPIN(cond, bar) do { unsigned _sp = 0; while (cond) { __builtin_amdgcn_s_sleep(1); \
    if ((++_sp & 255u) == 0u) { if (xb_ld(&(bar)[XB_TMO])) break; if (_sp > XB_SPIN_CAP) { atomicAdd(&(bar)[XB_TMO], 1u); break; } } } } while (0)
struct XcdBarrier { unsigned* bar; unsigned x; volatile LAS unsigned* st; };
__device__ __forceinline__ XcdBarrier xcd_barrier_post(unsigned* bar, volatile LAS unsigned* st) {
    XcdBarrier b; b.bar = bar; b.x = xb_xcc_id(); b.st = st;
    if (threadIdx.x == 0) (void)xb_add(&bar[XB_XCNT(b.x)], 1u);
    return b;
}
__device__ __forceinline__ void xcd_barrier_complete(unsigned* bar, unsigned x, unsigned& nloc, unsigned& nx) {
    const unsigned G = gridDim.x * gridDim.y * gridDim.z;
    unsigned sum, cnt, mine, sp = 0u;
    for (;;) {
        sum = 0u; cnt = 0u; mine = 0u;
#pragma unroll
        for (unsigned j = 0; j < 16; ++j) { const unsigned c = xb_ld(&bar[XB_XCNT(j)]); sum += c; cnt += (c > 0u) ? 1u : 0u; mine = (j == x) ? c : mine; }
        if (sum == G) break;
        __builtin_amdgcn_s_sleep(1);
        if ((++sp & 255u) == 0u) { if (xb_ld(&bar[XB_TMO])) break; if (sp > XB_SPIN_CAP) { atomicAdd(&bar[XB_TMO], 1u); break; } }
    }
    nloc = mine > 0u ? mine : 1u; nx = cnt > 0u ? cnt : 1u;
}
__device__ __forceinline__ void xcd_barrier(const XcdBarrier& b) {
    asm volatile("s_waitcnt vmcnt(0)" ::: "memory");
    __syncthreads();
    if (threadIdx.x == 0) {
        unsigned* bar = b.bar;
        __builtin_amdgcn_s_waitcnt(0);
        unsigned nloc = b.st[0], nx = b.st[1];
        if (nloc == 0u) { xcd_barrier_complete(bar, b.x, nloc, nx); b.st[0] = nloc; b.st[1] = nx; }
        const unsigned old = xb_add(&bar[XB_XSUB(b.x)], 1u);
        const unsigned gen = old / nloc;
        if (old + 1u == (gen + 1u) * nloc) {
            __builtin_amdgcn_fence(__ATOMIC_RELEASE, "agent");
            asm volatile("s_waitcnt vmcnt(0)" ::: "memory");
            const unsigned og = xb_add(&bar[XB_TOP], 1u);
            const unsigned tg = og / nx;
            if (og + 1u == (tg + 1u) * nx) xb_add(&bar[XB_TOPGEN], 1u);
            else XB_SPIN(xb_ld(&bar[XB_TOPGEN]) == tg, bar);
            __builtin_amdgcn_fence(__ATOMIC_ACQUIRE, "agent");
            xb_add(&bar[XB_XGEN(b.x)], 1u);
            asm volatile("s_waitcnt vmcnt(0)" ::: "memory");
        } else {
            XB_SPIN(xb_ld(&bar[XB_XGEN(b.x)]) == gen, bar);
            __builtin_amdgcn_fence(__ATOMIC_ACQUIRE, "agent");
            asm volatile("s_waitcnt vmcnt(0)" ::: "memory");
        }
    }
    __syncthreads();
}

constexpr int NPHASE = 23;
__device__ __forceinline__ void run_phase(const Params& p, int ph, LAS unsigned char* lds) {
    Ctx cx; { int b = blockIdx.x, n = gridDim.x, t = threadIdx.x; asm volatile("" : "+s"(b), "+s"(n), "+v"(t)); cx.bid = b; cx.nblk = n; cx.tid = t; }
    unsigned char* ws = P_WS(p);
    bf16_t* XN = (bf16_t*)(ws + WS_XN);
    float* Y = P_OUT(p) + O_Y;
    float* SSQ = (float*)(ws + WS_SSQ);
    switch (ph) {
    case 0: phase_prep(cx, p, lds, 0, 92 * 16, cx.bid, cx.nblk, true); phase_norm(cx, IN(p, I_XP), IN(p, I_XS), XN); break;
    case 1: { Gemm g{XN, (const bf16_t*)(ws + WS_W1), T, N1, 1024, 1024, 0, 0};
        EpiG1 e{(bf16_t*)(ws + WS_A2), (bf16_t*)(ws + WS_XBCP), (bf16_t*)(ws + WS_V), (float*)(ws + WS_DT), IN(p, I_DT_BIAS)};
        gemm_phase<EpiG1, false>(cx, lds, g, e, nullptr);
        const int nt1 = (T / BM) * (N1 / BM), nlate = nt1 % cx.nblk;
        if (cx.bid >= nlate) phase_prep(cx, p, lds, 92 * 16, 1 << 30, cx.bid - nlate, cx.nblk - nlate, false); } break;
    case 2:
        phase_conv<4, 0>(cx, (const bf16_t*)(ws + WS_XBCP), XBC, XBC, IN(p, I_SSD_CONVW), IN(p, I_SSD_CONVB), (bf16_t*)(ws + WS_XBCA), XBC, IN(p, I_ST_SSDCONV), P_OUT(p) + O_P_SSDCONV, P_OUT(p) + O_S_SSDCONV);
        phase_conv<3, 1>(cx, (const bf16_t*)(ws + WS_V), 1024, 1024, IN(p, I_SC_CONVW), IN(p, I_SC_CONVB), (bf16_t*)(ws + WS_A2) + 1024, 2048, IN(p, I_ST_SCONV), P_OUT(p) + O_P_SCONV, P_OUT(p) + O_S_SCONV);
        break;
    case 3: phase_ssd(cx, p, lds); break;
    case 4: { Gemm g{(const bf16_t*)(ws + WS_A2), (const bf16_t*)(ws + WS_W2), T, 1024, 2048, 2048, 0, 0};
        EpiRes<true> e{IN(p, I_XP), IN(p, I_XS), XN, SSQ + T};
        gemm_phase<EpiRes<true>, true, true>(cx, lds, g, e, SSQ, (float*)(ws + WS_SLAB)); } break;
    case 30: phase_split_finish<true, true>(cx, (const float*)(ws + WS_SLAB), 8, IN(p, I_XS), XN, SSQ + T, SSQ); break;
    case 5: case 15: { const int l = ph == 5 ? 0 : 1;
        Gemm g{XN, (const bf16_t*)(ws + WS_W3) + (size_t)l * 5632 * 1024, T, 5632, 1024, 1024, 0, 0};
        EpiFfnFused e{(bf16_t*)(ws + WS_H), (bf16_t*)(ws + WS_GH), (bf16_t*)(ws + WS_GT), (bf16_t*)(ws + WS_UH), SSQ + (l == 0 ? T : 3 * T), IN(p, I_FFN_CONVW) + l * 3 * DFF, IN(p, I_FFN_CONVB) + l * DFF};
        gemm_phase<EpiFfnFused, false>(cx, lds, g, e, nullptr); } break;
    case 6: case 16: { const int l = ph == 6 ? 0 : 1;
        phase_ffn_fix(cx, (const bf16_t*)(ws + WS_GH), (const bf16_t*)(ws + WS_GT), (const bf16_t*)(ws + WS_UH), (bf16_t*)(ws + WS_H), IN(p, I_FFN_CONVW) + l * 3 * DFF, IN(p, I_FFN_CONVB) + l * DFF,
                      IN(p, I_ST_FFNCONV) + l * 8 * 2 * DFF, P_OUT(p) + O_P_FFNCONV + l * 16 * 2 * DFF, P_OUT(p) + O_S_FFNCONV + l * 8 * 2 * DFF); } break;
    case 7: case 17: { const int l = ph == 7 ? 0 : 1;
        Gemm g{(const bf16_t*)(ws + WS_H), (const bf16_t*)(ws + WS_W4) + (size_t)l * 1024 * DFF, T, 1024, DFF, DFF, 0, 0};
        EpiRes<false> e{nullptr, nullptr, XN, SSQ + (l == 0 ? 2 * T : 4 * T)};
        gemm_phase<EpiRes<false>, false, true>(cx, lds, g, e, nullptr, (float*)(ws + WS_SLAB)); } break;
    case 31: phase_split_finish<false, false>(cx, (const float*)(ws + WS_SLAB), 11, nullptr, XN, SSQ + 2 * T, nullptr); break;
    case 33: phase_split_finish<false, false>(cx, (const float*)(ws + WS_SLAB), 11, nullptr, XN, SSQ + 4 * T, nullptr); break;
    case 8: { Gemm g{XN, (const bf16_t*)(ws + WS_W5), T, 2048, 1024, 1024, 0, 0};
        EpiLruIn e{(bf16_t*)(ws + WS_GATE), (bf16_t*)(ws + WS_XBP), SSQ + 2 * T};
        gemm_phase<EpiLruIn, false>(cx, lds, g, e, nullptr); } break;
    case 9: phase_conv<4, 3>(cx, (const bf16_t*)(ws + WS_XBP), 1024, 1024, IN(p, I_LRU_CONVW), IN(p, I_LRU_CONVB), (bf16_t*)(ws + WS_XBC2), 1024, IN(p, I_ST_LRUCONV), P_OUT(p) + O_P_LRUCONV, P_OUT(p) + O_S_LRUCONV); break;
    case 10: { Gemm g{(const bf16_t*)(ws + WS_XBC2), (const bf16_t*)(ws + WS_W6), T, 2048, 256, 1024, 1, 256};
        EpiLruGate e{(const bf16_t*)(ws + WS_XBC2), (bf16_t*)(ws + WS_LA), (bf16_t*)(ws + WS_UU), IN(p, I_LRU_BA), IN(p, I_LRU_BX), (const float*)(ws + WS_SP)};
        gemm_phase<EpiLruGate, false>(cx, lds, g, e, nullptr); } break;
    case 11: phase_lru_a(cx, (const bf16_t*)(ws + WS_LA), (const bf16_t*)(ws + WS_UU), (float*)(ws + WS_SL), (float*)(ws + WS_HH)); break;
    case 12: phase_lru_b(cx, p, (const float*)(ws + WS_SL), (const float*)(ws + WS_HH), (float*)(ws + WS_CIN)); break;
    case 13: phase_lru_c(cx, (const bf16_t*)(ws + WS_LA), (const bf16_t*)(ws + WS_UU), (const float*)(ws + WS_CIN), (bf16_t*)(ws + WS_GATE)); break;
    case 14: { Gemm g{(const bf16_t*)(ws + WS_GATE), (const bf16_t*)(ws + WS_W7), T, 1024, 1024, 1024, 0, 0};
        EpiRes<false> e{nullptr, nullptr, XN, SSQ + 3 * T};
        gemm_phase<EpiRes<false>, false, true>(cx, lds, g, e, nullptr, (float*)(ws + WS_SLAB)); } break;
    case 32: phase_split_finish<false, false>(cx, (const float*)(ws + WS_SLAB), 4, nullptr, XN, SSQ + 3 * T, nullptr); break;
    case 18: phase_final_norm(cx, XN, SSQ + 4 * T, IN(p, I_NORM_FINAL), Y); break;
    default: break;
    }
}

__global__ void __launch_bounds__(NTHREADS, 2) fwd_mega(Params p, int ph_lo, int ph_hi) {
    extern __shared__ __attribute__((aligned(16))) unsigned char smem[];
    LAS unsigned char* lds = (LAS unsigned char*)smem;
    cg::grid_group grid = cg::this_grid();
    volatile LAS unsigned* bst = (volatile LAS unsigned*)(lds + 131072 + 1024);
    if (threadIdx.x == 0) { bst[0] = 0u; bst[1] = 0u; }
    __syncthreads();
    const XcdBarrier xb = xcd_barrier_post((unsigned*)(IN(p, 35)) + WS_BAR / 4, bst);
#ifndef PROBE_K
#define PROBE_K -1
#endif
    for (int i = ph_lo; i < ph_hi; ++i) {
        int ph = i;
        if (i >= 5) ph = (i == 5) ? 30 : (i <= 8) ? i - 1 : (i == 9) ? 31 : (i <= 16) ? i - 2 : (i == 17) ? 32 : (i <= 20) ? i - 3 : (i == 21) ? 33 : 18;
        run_phase(p, ph, lds);
        if (i + 1 < ph_hi) { if (ph_hi > 1000) grid.sync(); else xcd_barrier(xb); }
    }
}

extern "C" void kernel_launch(void* const* d_in, const int* in_sizes, int n_in, void* d_out, int out_size, void* d_ws, size_t ws_size, hipStream_t stream) {
    static int grid = 0;
    if (grid == 0) {
        if (n_in != 34 || (size_t)out_size != O_END || ws_size < WS_NEED) { fprintf(stderr, "kernel_launch: unexpected shapes (n_in %d out %d ws %zu need %zu)\n", n_in, out_size, ws_size, (size_t)WS_NEED); grid = -1; return; }
        int dev = 0, cus = 0, per_cu = 0;
        (void)hipGetDevice(&dev); (void)hipDeviceGetAttribute(&cus, hipDeviceAttributeMultiprocessorCount, dev);
        if (hipFuncSetAttribute((const void*)fwd_mega, hipFuncAttributeMaxDynamicSharedMemorySize, LDS_BYTES) != hipSuccess) { fprintf(stderr, "kernel_launch: hipFuncSetAttribute failed\n"); grid = -1; return; }
        if (hipOccupancyMaxActiveBlocksPerMultiprocessor(&per_cu, (const void*)fwd_mega, NTHREADS, LDS_BYTES) != hipSuccess || per_cu < 1) { fprintf(stderr, "kernel_launch: occupancy query says %d\n", per_cu); per_cu = 1; }
        (void)hipGetLastError();
        grid = cus;
    }
    if (grid < 0) return;
    (void)hipMemsetAsync((unsigned char*)d_ws + WS_BAR, 0, 16384, stream);
    Params p{};
    for (int i = 0; i < 34; ++i) p.ptr[i] = (const float*)d_in[i];
    p.ptr[34] = (const float*)d_out; p.ptr[35] = (const float*)d_ws;
    int lo = 0, hi = NPHASE; void* args[] = {&p, &lo, &hi};
    hipError_t e = hipLaunchCooperativeKernel((const void*)fwd_mega, dim3(grid), dim3(NTHREADS), args, LDS_BYTES, stream);
    if (e != hipSuccess) fprintf(stderr, "cooperative launch failed: %s (grid %d)\n", hipGetErrorString(e), grid);
}
```

```cpp
#include <hip/hip_runtime.h>
#include <hip/hip_cooperative_groups.h>
#include <cstdio>
namespace cg = cooperative_groups;

#define LAS __attribute__((address_space(3)))
typedef unsigned short bf16_t;
typedef short bf16x8 __attribute__((ext_vector_type(8)));
typedef float f32x4 __attribute__((ext_vector_type(4)));
typedef unsigned u32x4 __attribute__((ext_vector_type(4)));
typedef unsigned u32x2 __attribute__((ext_vector_type(2)));

constexpr int TP = 65536;
constexpr int TS = 512;
constexpr int T = TP + TS;
constexpr int DM = 1024;
constexpr int DFF = 2816;
constexpr int XBC = 1536;
constexpr int N1 = 5888;
constexpr float EPS = 1e-6f;
constexpr int NTHREADS = 512;
constexpr int LDS_BYTES = 131072 + 4096;

constexpr size_t O_Y = 0;
constexpr size_t O_P_SSDCONV = (size_t)T * DM;
constexpr size_t O_P_SSD = O_P_SSDCONV + 16 * 3 * XBC;
constexpr size_t O_P_SCONV = O_P_SSD + (size_t)16 * 16 * 64 * 128;
constexpr size_t O_P_LRUCONV = O_P_SCONV + 16 * 2 * 1024;
constexpr size_t O_P_LRU = O_P_LRUCONV + 16 * 3 * 1024;
constexpr size_t O_P_FFNCONV = O_P_LRU + 16 * 1024;
constexpr size_t O_S_SSDCONV = O_P_FFNCONV + 2 * 16 * 2 * DFF;
constexpr size_t O_S_SSD = O_S_SSDCONV + 8 * 3 * XBC;
constexpr size_t O_S_SCONV = O_S_SSD + (size_t)8 * 16 * 64 * 128;
constexpr size_t O_S_LRUCONV = O_S_SCONV + 8 * 2 * 1024;
constexpr size_t O_S_LRU = O_S_LRUCONV + 8 * 3 * 1024;
constexpr size_t O_S_FFNCONV = O_S_LRU + 8 * 1024;
constexpr size_t O_END = O_S_FFNCONV + 2 * 8 * 2 * DFF;

constexpr size_t al256(size_t x) { return (x + 255) & ~(size_t)255; }
constexpr size_t WS_W1 = 0;
constexpr size_t WS_W2 = WS_W1 + (size_t)N1 * 1024 * 2;
constexpr size_t WS_W3 = WS_W2 + (size_t)1024 * 2048 * 2;
constexpr size_t WS_W4 = WS_W3 + (size_t)2 * 5632 * 1024 * 2;
constexpr size_t WS_W5 = WS_W4 + (size_t)2 * 1024 * 2816 * 2;
constexpr size_t WS_W6 = WS_W5 + (size_t)2048 * 1024 * 2;
constexpr size_t WS_W7 = WS_W6 + (size_t)2048 * 256 * 2;
constexpr size_t WS_SP = WS_W7 + (size_t)1024 * 1024 * 2;
constexpr size_t WS_BAR = WS_SP + 4096;
constexpr size_t WS_SSQ = WS_BAR + 16384;
constexpr size_t WS_SL = al256(WS_SSQ + (size_t)5 * T * 4);
constexpr size_t WS_HH = WS_SL + (size_t)1088 * 1024 * 4;
constexpr size_t WS_CIN = WS_HH + (size_t)1088 * 1024 * 4;
constexpr size_t WS_SLAB = al256(WS_CIN + (size_t)1088 * 1024 * 4);
constexpr size_t WS_XN = al256(WS_SLAB + (size_t)88 * 65536 * 4);
constexpr size_t WS_ARENA = al256(WS_XN + (size_t)T * 1024 * 2);
constexpr size_t WS_A2 = WS_ARENA;
constexpr size_t WS_XBCP = WS_A2 + (size_t)T * 2048 * 2;
constexpr size_t WS_XBCA = WS_XBCP + (size_t)T * XBC * 2;
constexpr size_t WS_V = WS_XBCA + (size_t)T * XBC * 2;
constexpr size_t WS_DT = WS_V + (size_t)T * 1024 * 2;
constexpr size_t WS_END0 = WS_DT + (size_t)T * 16 * 4;
constexpr size_t WS_H = WS_ARENA;
constexpr size_t WS_GH = WS_H + (size_t)T * DFF * 2;
constexpr size_t WS_GT = WS_GH + (size_t)1032 * 2 * DFF * 2;
constexpr size_t WS_UH = WS_GT + (size_t)1032 * 2 * DFF * 2;
constexpr size_t WS_END1 = WS_UH + (size_t)1032 * 2 * DFF * 2;
constexpr size_t WS_GATE = WS_ARENA;
constexpr size_t WS_XBP = WS_GATE + (size_t)T * 1024 * 2;
constexpr size_t WS_XBC2 = WS_XBP + (size_t)T * 1024 * 2;
constexpr size_t WS_LA = WS_XBC2 + (size_t)T * 1024 * 2;
constexpr size_t WS_UU = WS_LA + (size_t)T * 1024 * 2;
constexpr size_t WS_END2 = WS_UU + (size_t)T * 1024 * 2;
constexpr size_t WS_NEED = WS_END0 > WS_END1 ? (WS_END0 > WS_END2 ? WS_END0 : WS_END2) : (WS_END1 > WS_END2 ? WS_END1 : WS_END2);

struct Params {
    const float* ptr[36];
};
__device__ __forceinline__ const float* IN(const Params& p, int i) { asm volatile("" : "+s"(i)); return p.ptr[i]; }
#define P_OUT(p) ((float*)IN(p, 34))
#define P_WS(p) ((unsigned char*)IN(p, 35))
enum { I_XP = 0, I_XS, I_ST_SSDCONV, I_ST_SSD, I_ST_SCONV, I_ST_LRUCONV, I_ST_LRU, I_ST_FFNCONV, I_NORM_MIX, I_NORM_FFN, I_NORM_FINAL,
       I_AB_WIN, I_SSD_CONVW, I_SSD_CONVB, I_DT_BIAS, I_A_LOG, I_SSD_D, I_SSD_NORM, I_SC_CONVW, I_SC_CONVB, I_AB_WOUT, I_LRU_WIN,
       I_LRU_CONVW, I_LRU_CONVB, I_LRU_WA, I_LRU_BA, I_LRU_WX, I_LRU_BX, I_LRU_LAMBDA, I_LRU_WOUT, I_FFN_WIN, I_FFN_CONVW, I_FFN_CONVB, I_FFN_WOUT };

struct Ctx { int bid, nblk, tid; };
__device__ __forceinline__ unsigned cvt_pk_bf16(float lo, float hi) { unsigned r; asm("v_cvt_pk_bf16_f32 %0, %1, %2" : "=v"(r) : "v"(lo), "v"(hi)); return r; }
__device__ __forceinline__ float bf_lo(unsigned w) { return __uint_as_float(w << 16); }
__device__ __forceinline__ float bf_hi(unsigned w) { return __uint_as_float(w & 0xffff0000u); }
__device__ __forceinline__ float sigmoidf_(float x) { return __builtin_amdgcn_rcpf(1.0f + __expf(-x)); }
__device__ __forceinline__ float siluf_(float x) { return x * __builtin_amdgcn_rcpf(1.0f + __expf(-x)); }
__device__ __forceinline__ float geluf_(float x) { const float u = x * (1.5957691216f + 0.0713548163f * x * x); return x * __builtin_amdgcn_rcpf(1.0f + __builtin_amdgcn_exp2f(-1.4426950409f * u)); }
__device__ __forceinline__ float softplusf_(float x) { return fmaxf(x, 0.0f) + log1pf(__expf(-fabsf(x))); }
__device__ __forceinline__ void unpack8(const u32x4 w, float (&f)[8]) {
    f[0] = bf_lo(w.x); f[1] = bf_hi(w.x); f[2] = bf_lo(w.y); f[3] = bf_hi(w.y); f[4] = bf_lo(w.z); f[5] = bf_hi(w.z); f[6] = bf_lo(w.w); f[7] = bf_hi(w.w);
}
__device__ __forceinline__ u32x4 pack8(const float (&f)[8]) {
    u32x4 w; w.x = cvt_pk_bf16(f[0], f[1]); w.y = cvt_pk_bf16(f[2], f[3]); w.z = cvt_pk_bf16(f[4], f[5]); w.w = cvt_pk_bf16(f[6], f[7]); return w;
}
__device__ __forceinline__ u32x4 pack44(const f32x4 a, const f32x4 b) {
    u32x4 w; w.x = cvt_pk_bf16(a[0], a[1]); w.y = cvt_pk_bf16(a[2], a[3]); w.z = cvt_pk_bf16(b[0], b[1]); w.w = cvt_pk_bf16(b[2], b[3]); return w;
}

constexpr int BM = 256, BK = 64, HALF = 128, HTB = HALF * BK * 2, NXCD = 8, WGM = 4;
__device__ __forceinline__ int lds_byte(int r, int c) { const int st = (r >> 4) * 2 + (c >> 5), rr = r & 15, cc = c & 31, ob = rr * 64 + cc * 2; return st * 1024 + (ob ^ (((ob >> 9) & 1) << 5)); }
__device__ __forceinline__ void stage_rc(int b, int& R, int& C) { const int st = b / 1024, sb = b % 1024, swz = sb ^ (((sb >> 9) & 1) << 5); R = (st >> 1) * 16 + swz / 64; C = (st & 1) * 32 + (swz % 64) / 2; }
__device__ __forceinline__ int perm32(int rho) { const int n = rho >> 4, i = rho & 15; return 8 * (i >> 2) + 4 * n + (i & 3); }

struct Unit { int pm, pn, kt0, nkt, slab; };
struct Gemm { const bf16_t* A; const bf16_t* Bt; int M, N, K, lda, a_shift, a_koff; };

struct StaticOrder {
    int nM, nN, nwg, G, c, nt, nsplit, ntail;
    __device__ void init(int M, int N, int G_, int c_, int nt_, bool split) { nM = M / BM; nN = N / BM; G = G_; c = c_; nt = nt_; nsplit = 0; ntail = 0;
        if (split) { nM = TP / BM; nsplit = nt / 4; ntail = 2 * nN * nsplit; } nwg = nM * nN; }
    __device__ bool next(int i, Unit& u) const {
        const long L = (long)i * G + c;
        if (L >= nwg) { const int t = (int)(L - nwg); if (t >= ntail) return false;
            const int tile = t / nsplit, piece = t - tile * nsplit; u.pm = TP / BM + tile / nN; u.pn = tile % nN; u.kt0 = piece * 4; u.nkt = 4; u.slab = t; return true; }
        int wgid = (int)L; { const int q = nwg / NXCD, r = nwg % NXCD, xcd = wgid % NXCD, off = wgid / NXCD; wgid = (xcd < r ? xcd * (q + 1) : r * (q + 1) + (xcd - r) * q) + off; }
        const int nig = WGM * nN, gid = wgid / nig, fm = gid * WGM, gsz = (nM - fm) < WGM ? (nM - fm) : WGM;
        u.pm = fm + ((wgid % nig) % gsz); u.pn = (wgid % nig) / gsz; u.kt0 = 0; u.nkt = nt; u.slab = -1; return true;
    }
};

template <class Epi, bool MIDSCALE, bool SPLIT = false>
__device__ __forceinline__ void gemm_phase(const Ctx cx, LAS unsigned char* lds, const Gemm g, const Epi& E, const float* ssq, float* slabs = nullptr) {
    const int tid = cx.tid, wid = __builtin_amdgcn_readfirstlane(tid >> 6), lane = tid & 63, wr = wid >> 2, wc = wid & 3, fr = lane & 15, fq = lane >> 4;
    int K_ = g.K; asm volatile("" : "+s"(K_));
    const int K = K_, nt = K / BK;
    StaticOrder S; S.init(g.M, g.N, cx.nblk, cx.bid, nt, SPLIT);
    unsigned voffA[2], voffB[2];
#pragma unroll
    for (int i = 0; i < 2; ++i) { int R, C; stage_rc(tid * 16 + i * 8192, R, C); const int Rb = Epi::PERM ? ((R & ~31) + perm32(R & 31)) : R;
        voffA[i] = (unsigned)(R * g.lda + C) * 2u; voffB[i] = (unsigned)(Rb * K + C) * 2u; }
    const size_t kstep = (size_t)(BK * 2);
    const size_t hsA = (size_t)HALF * g.lda * 2, hsB = (size_t)HALF * K * 2;
    const size_t tsA = 2 * hsA, tsB = 2 * hsB;
    const unsigned ldsw = (unsigned)wid * 1024u;
    const int aoff = lds_byte(wr * 64 + fr, fq * 8), boff = lds_byte(wc * 32 + fr, fq * 8);
#define SA_(b, h) (((b) * 2 + (h)) * HTB)
#define SB_(b, h) ((4 + (b) * 2 + (h)) * HTB)
#define STAGE_(bufoff, gbase, voff) do { _Pragma("unroll") for (int _i = 0; _i < 2; ++_i) \
        __builtin_amdgcn_global_load_lds((const unsigned*)((const char*)(gbase) + (voff)[_i]), (LAS unsigned*)(lds + (bufoff) + ldsw + _i * 8192), 16, 0, 0); } while (0)
#define LDA_(dst, b, h) do { _Pragma("unroll") for (int m = 0; m < 4; ++m) _Pragma("unroll") for (int k = 0; k < 2; ++k) dst[m][k] = *(const LAS bf16x8*)(lds + SA_(b, h) + aoff + m * 2048 + k * 1024); } while (0)
#define LDB_(dst, b, h) do { _Pragma("unroll") for (int n = 0; n < 2; ++n) _Pragma("unroll") for (int k = 0; k < 2; ++k) dst[n][k] = *(const LAS bf16x8*)(lds + SB_(b, h) + boff + n * 2048 + k * 1024); } while (0)
#define MMA_(ai, bj, At, Bt) do { __builtin_amdgcn_s_setprio(1); _Pragma("unroll") for (int m = 0; m < 4; ++m) _Pragma("unroll") for (int n = 0; n < 2; ++n) _Pragma("unroll") for (int k = 0; k < 2; ++k) \
        acc[ai][bj][m][n] = __builtin_amdgcn_mfma_f32_16x16x32_bf16(Bt[n][k], At[m][k], acc[ai][bj][m][n], 0, 0, 0); __builtin_amdgcn_s_setprio(0); } while (0)
#define WAIT_V_(n) asm volatile("s_waitcnt vmcnt(" #n ")" ::: "memory")
#define WAIT_L_(n) asm volatile("s_waitcnt lgkmcnt(" #n ")" ::: "memory")
#define BAR_ __builtin_amdgcn_s_barrier()
#define SCHED_ __builtin_amdgcn_sched_barrier(0)
#ifndef STAGGER
#define STAGGER 0
#endif
    if (STAGGER && (cx.bid & 8)) {
        const unsigned long long t0 = __builtin_amdgcn_s_memrealtime(); const unsigned long long dl = 800ull;
        while (__builtin_amdgcn_s_memrealtime() - t0 < dl) __builtin_amdgcn_s_sleep(8);
    }
    Unit cur, nxt; int ui = 0;
    if (!S.next(0, cur)) return;
    f32x4 acc[2][2][4][2];
#pragma unroll
    for (int a = 0; a < 2; ++a)
#pragma unroll
        for (int b = 0; b < 2; ++b)
#pragma unroll
            for (int m = 0; m < 4; ++m)
#pragma unroll
                for (int n = 0; n < 2; ++n) acc[a][b][m][n] = (f32x4){0.f, 0.f, 0.f, 0.f};
    bf16x8 At[4][2], B0[2][2], B1[2][2];
    const char* cA = (const char*)g.A + (size_t)cur.pm * tsA + (size_t)((cur.pn >> g.a_shift) * g.a_koff) * 2 + (size_t)cur.kt0 * kstep;
    const char* cB = (const char*)g.Bt + (size_t)cur.pn * tsB + (size_t)cur.kt0 * kstep;
    STAGE_(SB_(0, 0), cB, voffB); STAGE_(SA_(0, 0), cA, voffA); STAGE_(SB_(0, 1), cB + hsB, voffB); STAGE_(SA_(0, 1), cA + hsA, voffA);
    if (wr == 1) BAR_;
    WAIT_V_(4); BAR_;
    STAGE_(SB_(1, 0), cB + kstep, voffB); STAGE_(SA_(1, 0), cA + kstep, voffA); STAGE_(SB_(1, 1), cB + hsB + kstep, voffB);
    WAIT_V_(6); BAR_;
    for (;;) {
        const bool has_next = S.next(ui + 1, nxt);
        const char* nA = has_next ? (const char*)g.A + (size_t)nxt.pm * tsA + (size_t)((nxt.pn >> g.a_shift) * g.a_koff) * 2 + (size_t)nxt.kt0 * kstep : cA;
        const char* nB = has_next ? (const char*)g.Bt + (size_t)nxt.pn * tsB + (size_t)nxt.kt0 * kstep : cB;
        const int cnt = cur.nkt;
        for (int t = 0; t < cnt; t += 2) {
            const bool last = (t == cnt - 2);
            const char* a1 = cA + (size_t)(t + 1) * kstep;
            const char* a2 = last ? nA : cA + (size_t)(t + 2) * kstep; const char* b2 = last ? nB : cB + (size_t)(t + 2) * kstep;
            const char* a3 = a2 + kstep; const char* b3 = b2 + kstep;
            if (MIDSCALE && t == 16 && cur.slab < 0) {
                int rb = cur.pm * BM + wr * 64 + fr; asm volatile("" : "+v"(rb));
#pragma unroll
                for (int ai = 0; ai < 2; ++ai)
#pragma unroll
                    for (int m = 0; m < 4; ++m) {
                        const float sc = rsqrtf(ssq[rb + ai * HALF + m * 16] * (1.0f / 1024.0f) + EPS);
#pragma unroll
                        for (int bj = 0; bj < 2; ++bj)
#pragma unroll
                            for (int n = 0; n < 2; ++n) acc[ai][bj][m][n] *= sc;
                    }
            }
            LDB_(B0, 0, 0); SCHED_; LDA_(At, 0, 0); STAGE_(SA_(1, 1), a1 + hsA, voffA);
            WAIT_L_(8); BAR_; WAIT_L_(0); MMA_(0, 0, At, B0); BAR_; SCHED_;
            LDB_(B1, 0, 1); STAGE_(SB_(0, 0), b2, voffB);
            BAR_; WAIT_L_(0); MMA_(0, 1, At, B1); BAR_;
            LDA_(At, 0, 1); STAGE_(SA_(0, 0), a2, voffA);
            BAR_; WAIT_L_(0); MMA_(1, 0, At, B0); BAR_; SCHED_;
            STAGE_(SB_(0, 1), b2 + hsB, voffB);
            WAIT_V_(6); BAR_; MMA_(1, 1, At, B1); BAR_;
            LDB_(B0, 1, 0); SCHED_; LDA_(At, 1, 0); STAGE_(SA_(0, 1), a2 + hsA, voffA);
            WAIT_L_(8); BAR_; WAIT_L_(0); MMA_(0, 0, At, B0); BAR_; SCHED_;
            LDB_(B1, 1, 1); STAGE_(SB_(1, 0), b3, voffB);
            BAR_; WAIT_L_(0); MMA_(0, 1, At, B1); BAR_;
            LDA_(At, 1, 1); STAGE_(SA_(1, 0), a3, voffA);
            BAR_; WAIT_L_(0); MMA_(1, 0, At, B0); BAR_; SCHED_;
            STAGE_(SB_(1, 1), b3 + hsB, voffB);
            WAIT_V_(6); BAR_; MMA_(1, 1, At, B1); BAR_;
        }
        if (SPLIT && cur.slab >= 0) {
            float* sb = slabs + (size_t)cur.slab * 65536 + (size_t)(wr * 64 + fr) * 256 + wc * 64 + 8 * fq;
#pragma unroll
            for (int ai = 0; ai < 2; ++ai)
#pragma unroll
                for (int m = 0; m < 4; ++m)
#pragma unroll
                    for (int bj = 0; bj < 2; ++bj) { float* q = sb + (size_t)(ai * HALF + m * 16) * 256 + bj * 32; *(f32x4*)q = acc[ai][bj][m][0]; *(f32x4*)(q + 4) = acc[ai][bj][m][1]; }
        } else E(acc, cur, wr, wc, fr, fq);
        if (!has_next) break;
#pragma unroll
        for (int a = 0; a < 2; ++a)
#pragma unroll
            for (int b = 0; b < 2; ++b)
#pragma unroll
                for (int m = 0; m < 4; ++m)
#pragma unroll
                    for (int n = 0; n < 2; ++n) acc[a][b][m][n] = (f32x4){0.f, 0.f, 0.f, 0.f};
        cur = nxt; cA = nA; cB = nB; ++ui;
    }
    WAIT_V_(0);
    if (wr == 0) BAR_;
    BAR_;
#undef SA_
#undef SB_
#undef STAGE_
#undef LDA_
#undef LDB_
#undef MMA_
}

struct EpiG1 {
    static constexpr bool PERM = true;
    bf16_t* A2; bf16_t* XBCP; bf16_t* V; float* DT; const float* dt_bias;
    __device__ __forceinline__ void operator()(const f32x4 (&acc)[2][2][4][2], const Unit& u, int wr, int wc, int fr, int fq) const {
        const int row0 = u.pm * BM + wr * 64 + fr, lc = wc * 32 + 8 * fq;
        if (u.pn < 14) {
            bf16_t* base; int ld, colt;
            if (u.pn < 4) { base = A2; ld = 2048; colt = u.pn * 256; }
            else if (u.pn < 10) { base = XBCP; ld = XBC; colt = (u.pn - 4) * 256; }
            else { base = A2; ld = 2048; colt = 1024 + (u.pn - 10) * 256; }
#pragma unroll
            for (int ai = 0; ai < 2; ++ai)
#pragma unroll
                for (int m = 0; m < 4; ++m) { bf16_t* rowp = base + (size_t)(row0 + ai * HALF + m * 16) * ld + colt + wc * 64 + 8 * fq;
#pragma unroll
                    for (int bj = 0; bj < 2; ++bj) *(u32x4*)(rowp + bj * 32) = pack44(acc[ai][bj][m][0], acc[ai][bj][m][1]); }
        } else if (u.pn < 22) {
            const int ch0 = (u.pn - 14) * 128 + lc;
#pragma unroll
            for (int ai = 0; ai < 2; ++ai)
#pragma unroll
                for (int m = 0; m < 4; ++m) { bf16_t* rowp = V + (size_t)(row0 + ai * HALF + m * 16) * 1024 + ch0;
                    *(u32x4*)rowp = pack44(acc[ai][0][m][0] * acc[ai][1][m][0], acc[ai][0][m][1] * acc[ai][1][m][1]); }
        } else {
            if (wc == 0 && fq < 2) {
                const f32x4 b0 = *(const f32x4*)(dt_bias + 8 * fq), b1 = *(const f32x4*)(dt_bias + 8 * fq + 4);
#pragma unroll
                for (int ai = 0; ai < 2; ++ai)
#pragma unroll
                    for (int m = 0; m < 4; ++m) { float* rowp = DT + (size_t)(row0 + ai * HALF + m * 16) * 16 + 8 * fq;
                        f32x4 v0 = acc[ai][0][m][0] + b0, v1 = acc[ai][0][m][1] + b1;
#pragma unroll
                        for (int j = 0; j < 4; ++j) { v0[j] = softplusf_(v0[j]); v1[j] = softplusf_(v1[j]); }
                        *(f32x4*)rowp = v0; *(f32x4*)(rowp + 4) = v1; }
            }
        }
    }
};
template <bool SRC_F32> struct EpiRes {
    static constexpr bool PERM = true;
    const float* xp; const float* xs; bf16_t* XN; float* ssq;
    __device__ __forceinline__ void operator()(const f32x4 (&acc)[2][2][4][2], const Unit& u, int wr, int wc, int fr, int fq) const {
        const int row0 = u.pm * BM + wr * 64 + fr, col0 = u.pn * BM + wc * 64 + 8 * fq;
        if (SRC_F32) {
#pragma unroll
            for (int ai = 0; ai < 2; ++ai) {
                f32x4 old[4][2][2];
#pragma unroll
                for (int m = 0; m < 4; ++m) { const int row = row0 + ai * HALF + m * 16;
                    const float* src = (row < TP ? xp + (size_t)row * DM : xs + (size_t)(row - TP) * DM) + col0;
#pragma unroll
                    for (int bj = 0; bj < 2; ++bj) { old[m][bj][0] = *(const f32x4*)(src + bj * 32); old[m][bj][1] = *(const f32x4*)(src + bj * 32 + 4); } }
#pragma unroll
                for (int m = 0; m < 4; ++m) { const int row = row0 + ai * HALF + m * 16; bf16_t* xnp = XN + (size_t)row * DM + col0; float sq = 0.f;
#pragma unroll
                    for (int bj = 0; bj < 2; ++bj) { const f32x4 v0 = old[m][bj][0] + acc[ai][bj][m][0], v1 = old[m][bj][1] + acc[ai][bj][m][1];
                        *(u32x4*)(xnp + bj * 32) = pack44(v0, v1);
                        sq += v0[0] * v0[0] + v0[1] * v0[1] + v0[2] * v0[2] + v0[3] * v0[3] + v1[0] * v1[0] + v1[1] * v1[1] + v1[2] * v1[2] + v1[3] * v1[3]; }
                    sq += __shfl_xor(sq, 16); sq += __shfl_xor(sq, 32);
                    if (fq == 0) atomicAdd(ssq + row, sq); }
            }
        } else {
#pragma unroll
            for (int ai = 0; ai < 2; ++ai) {
                u32x4 old[4][2];
#pragma unroll
                for (int m = 0; m < 4; ++m)
#pragma unroll
                    for (int bj = 0; bj < 2; ++bj) old[m][bj] = *(const u32x4*)(XN + (size_t)(row0 + ai * HALF + m * 16) * DM + col0 + bj * 32);
#pragma unroll
                for (int m = 0; m < 4; ++m) { const int row = row0 + ai * HALF + m * 16; bf16_t* xnp = XN + (size_t)row * DM + col0; float sq = 0.f;
#pragma unroll
                    for (int bj = 0; bj < 2; ++bj) { const u32x4 w = old[m][bj];
                        const f32x4 v0 = (f32x4){bf_lo(w.x), bf_hi(w.x), bf_lo(w.y), bf_hi(w.y)} + acc[ai][bj][m][0], v1 = (f32x4){bf_lo(w.z), bf_hi(w.z), bf_lo(w.w), bf_hi(w.w)} + acc[ai][bj][m][1];
                        *(u32x4*)(xnp + bj * 32) = pack44(v0, v1);
                        sq += v0[0] * v0[0] + v0[1] * v0[1] + v0[2] * v0[2] + v0[3] * v0[3] + v1[0] * v1[0] + v1[1] * v1[1] + v1[2] * v1[2] + v1[3] * v1[3]; }
                    sq += __shfl_xor(sq, 16); sq += __shfl_xor(sq, 32);
                    if (fq == 0) atomicAdd(ssq + row, sq); }
            }
        }
    }
};
__device__ __forceinline__ float dpp_ror1(float v) { return __int_as_float(__builtin_amdgcn_update_dpp(0, __float_as_int(v), 0x121, 0xf, 0xf, false)); }
__device__ __forceinline__ float dpp_ror2(float v) { return __int_as_float(__builtin_amdgcn_update_dpp(0, __float_as_int(v), 0x122, 0xf, 0xf, false)); }
struct EpiFfnFused {
    static constexpr bool PERM = true;
    bf16_t* H; bf16_t* GH; bf16_t* GT; bf16_t* UH; const float* ssq; const float* cw; const float* cb;
    __device__ __forceinline__ void operator()(const f32x4 (&acc)[2][2][4][2], const Unit& u, int wr, int wc, int fr, int fq) const {
        const int ch0 = u.pn * 128 + wc * 32 + 8 * fq;
        float w0[8], w1[8], w2[8], bb[8];
#pragma unroll
        for (int h = 0; h < 2; ++h) { const f32x4 a = *(const f32x4*)(cw + ch0 + 4 * h), b = *(const f32x4*)(cw + DFF + ch0 + 4 * h), c = *(const f32x4*)(cw + 2 * DFF + ch0 + 4 * h), d = *(const f32x4*)(cb + ch0 + 4 * h);
#pragma unroll
            for (int j = 0; j < 4; ++j) { w0[4 * h + j] = a[j]; w1[4 * h + j] = b[j]; w2[4 * h + j] = c[j]; bb[4 * h + j] = d[j]; } }
        float ssv[2][4];
#pragma unroll
        for (int ai = 0; ai < 2; ++ai)
#pragma unroll
            for (int m = 0; m < 4; ++m) ssv[ai][m] = ssq[u.pm * BM + ai * HALF + wr * 64 + m * 16 + fr];
#pragma unroll
        for (int ai = 0; ai < 2; ++ai) {
            const int grp = 4 * u.pm + 2 * ai + wr;
            float p1[8], p2[8];
#pragma unroll
            for (int q = 0; q < 8; ++q) { p1[q] = 0.f; p2[q] = 0.f; }
#pragma unroll
            for (int m = 0; m < 4; ++m) {
                const int row = u.pm * BM + ai * HALF + wr * 64 + m * 16 + fr;
                const float sc = rsqrtf(ssv[ai][m] * (1.0f / 1024.0f) + EPS);
                float g[8], uu[8], c1[8], c2[8], hh[8];
#pragma unroll
                for (int n = 0; n < 2; ++n)
#pragma unroll
                    for (int j = 0; j < 4; ++j) { g[4 * n + j] = acc[ai][0][m][n][j] * sc; uu[4 * n + j] = acc[ai][1][m][n][j] * sc; }
#pragma unroll
                for (int q = 0; q < 8; ++q) { c1[q] = dpp_ror1(g[q]); c2[q] = dpp_ror2(g[q]); }
                if (m == 0 && fr < 2) { const size_t o = ((size_t)grp * 2 + fr) * DFF + ch0; *(u32x4*)(GH + o) = pack8(g); *(u32x4*)(UH + o) = pack8(uu); }
                if (m == 3 && fr >= 14) { const size_t o = ((size_t)grp * 2 + (fr - 14)) * DFF + ch0; *(u32x4*)(GT + o) = pack8(g); }
#pragma unroll
                for (int q = 0; q < 8; ++q) { const float gm1 = (fr == 0) ? p1[q] : c1[q], gm2 = (fr < 2) ? p2[q] : c2[q];
                    hh[q] = geluf_(bb[q] + w0[q] * gm2 + w1[q] * gm1 + w2[q] * g[q]) * uu[q]; p1[q] = c1[q]; p2[q] = c2[q]; }
                *(u32x4*)(H + (size_t)row * DFF + ch0) = pack8(hh);
            }
        }
    }
};
struct EpiLruIn {
    static constexpr bool PERM = true;
    bf16_t* GATE; bf16_t* XBP; const float* ssq;
    __device__ __forceinline__ void operator()(const f32x4 (&acc)[2][2][4][2], const Unit& u, int wr, int wc, int fr, int fq) const {
        const int row0 = u.pm * BM + wr * 64 + fr, lc = wc * 32 + 8 * fq;
        const bool isgate = u.pn < 4;
        bf16_t* base = isgate ? GATE : XBP; const int colt = (isgate ? u.pn : u.pn - 4) * 256 + wc * 64 + 8 * fq;
        float ssv[2][4];
#pragma unroll
        for (int ai = 0; ai < 2; ++ai)
#pragma unroll
            for (int m = 0; m < 4; ++m) ssv[ai][m] = ssq[row0 + ai * HALF + m * 16];
#pragma unroll
        for (int ai = 0; ai < 2; ++ai)
#pragma unroll
            for (int m = 0; m < 4; ++m) { bf16_t* rowp = base + (size_t)(row0 + ai * HALF + m * 16) * 1024 + colt;
                const float sc = rsqrtf(ssv[ai][m] * (1.0f / 1024.0f) + EPS);
#pragma unroll
                for (int bj = 0; bj < 2; ++bj) { f32x4 v0 = acc[ai][bj][m][0] * sc, v1 = acc[ai][bj][m][1] * sc;
                    if (isgate) {
#pragma unroll
                        for (int j = 0; j < 4; ++j) { v0[j] = geluf_(v0[j]); v1[j] = geluf_(v1[j]); } }
                    *(u32x4*)(rowp + bj * 32) = pack44(v0, v1); } }
    }
};
struct EpiLruGate {
    static constexpr bool PERM = true;
    const bf16_t* XBC2; bf16_t* LA; bf16_t* UU; const float* ba; const float* bx; const float* sp;
    __device__ __forceinline__ void operator()(const f32x4 (&acc)[2][2][4][2], const Unit& u, int wr, int wc, int fr, int fq) const {
        const int row0 = u.pm * BM + wr * 64 + fr, ch0 = (u.pn >> 1) * 256 + (u.pn & 1) * 128 + wc * 32 + 8 * fq;
        u32x4 xw[2][4];
#pragma unroll
        for (int ai = 0; ai < 2; ++ai)
#pragma unroll
            for (int m = 0; m < 4; ++m) xw[ai][m] = *(const u32x4*)(XBC2 + (size_t)(row0 + ai * HALF + m * 16) * 1024 + ch0);
        f32x4 vba[2], vbx[2], vsp[2];
#pragma unroll
        for (int n = 0; n < 2; ++n) { vba[n] = *(const f32x4*)(ba + ch0 + 4 * n); vbx[n] = *(const f32x4*)(bx + ch0 + 4 * n); vsp[n] = *(const f32x4*)(sp + ch0 + 4 * n); }
#pragma unroll
        for (int ai = 0; ai < 2; ++ai)
#pragma unroll
            for (int m = 0; m < 4; ++m) { const size_t o = (size_t)(row0 + ai * HALF + m * 16) * 1024 + ch0;
                float xb[8]; unpack8(xw[ai][m], xb);
                float la[8], uu[8];
#pragma unroll
                for (int n = 0; n < 2; ++n)
#pragma unroll
                    for (int j = 0; j < 4; ++j) { const int q = 4 * n + j;
                        const float r = sigmoidf_(acc[ai][0][m][n][j] + vba[n][j]), ig = sigmoidf_(acc[ai][1][m][n][j] + vbx[n][j]);
                        const float l = -8.0f * r * vsp[n][j]; la[q] = l;
                        const float mult = __builtin_amdgcn_sqrtf(fmaxf(0.0f, 1.0f - __expf(2.0f * l)));
                        uu[q] = mult * ig * xb[q]; }
                *(u32x4*)(LA + o) = pack8(la); *(u32x4*)(UU + o) = pack8(uu); }
    }
};

__device__ __forceinline__ void wconv_tile(const Ctx cx, const float* src, int ld_src, int nvalid, const float* gain, int k0, bf16_t* dst, int K, LAS unsigned char* lds, int delta = 0) {
    const int lane = cx.tid & 63; LAS bf16_t* L = (LAS bf16_t*)(lds + (cx.tid >> 6) * 8448);
    float v[64];
    const int scol = lane + (lane >= 32 ? delta : 0);
#pragma unroll
    for (int k = 0; k < 64; ++k) v[k] = (lane < nvalid) ? src[(size_t)k * ld_src + scol] : 0.f;
    if (gain) {
#pragma unroll
        for (int k = 0; k < 64; ++k) v[k] *= gain[k0 + k]; }
#pragma unroll
    for (int k = 0; k < 64; k += 2) *(LAS unsigned*)(L + lane * 66 + k) = cvt_pk_bf16(v[k], v[k + 1]);
    asm volatile("s_waitcnt lgkmcnt(0)" ::: "memory");
#pragma unroll
    for (int i = 0; i < 8; ++i) { const int n = (lane >> 3) + 8 * i, kq = lane & 7; const LAS unsigned* q = (const LAS unsigned*)(L + n * 66 + kq * 8);
        u32x4 w; w.x = q[0]; w.y = q[1]; w.z = q[2]; w.w = q[3];
        *(u32x4*)(dst + (size_t)n * K + kq * 8) = w; }
    asm volatile("s_waitcnt lgkmcnt(0)" ::: "memory");
}
__device__ __forceinline__ int lcol0(int n0) { const int q = (n0 & 255) >> 6; return (n0 & ~255) + 128 * (q & 1) + 32 * (q >> 1); }
__device__ __forceinline__ void phase_prep(const Ctx cx, const Params& p, LAS unsigned char* lds, const int task_lo, const int task_hi, const int vb, const int nvb, const bool tables) {
    unsigned char* ws = P_WS(p);
    constexpr int NT1 = 92 * 16, NT2 = 16 * 32, NT3 = 88 * 16, NT4 = 16 * 44, NT5 = 32 * 16, NT6 = 32 * 4, NT7 = 16 * 16;
    constexpr int NTASK = NT1 + NT2 + 2 * NT3 + 2 * NT4 + NT5 + NT6 + NT7;
    for (int task = task_lo + vb * 8 + __builtin_amdgcn_readfirstlane(cx.tid >> 6); task < (task_hi < NTASK ? task_hi : NTASK); task += nvb * 8) {
        int id = task;
        if (id < NT1) { const int ntile = id / 16, kt = id % 16, n0 = ntile * 64, k0 = kt * 64, pn = n0 >> 8, lc0 = n0 & 255;
            int col, nv = 64;
            int dl = 0;
            if (pn < 10) { col = lcol0(n0); dl = 32; } else if (pn < 14) { col = 2576 + (lcol0(n0) - 2560); dl = 32; }
            else if (pn < 22) col = (lc0 < 128 ? 3600 : 4624) + (pn - 14) * 128 + (lc0 & 127);
            else { col = 2560; nv = (lc0 == 0) ? 16 : 0; }
            wconv_tile(cx, IN(p, I_AB_WIN) + (size_t)k0 * 5648 + col, 5648, nv, IN(p, I_NORM_MIX), k0, (bf16_t*)(ws + WS_W1) + (size_t)n0 * 1024 + k0, 1024, lds, dl); continue; }
        id -= NT1;
        if (id < NT2) { const int ntile = id / 32, kt = id % 32, n0 = ntile * 64, k0 = kt * 64;
            wconv_tile(cx, IN(p, I_AB_WOUT) + (size_t)k0 * 1024 + lcol0(n0), 1024, 64, k0 < 1024 ? IN(p, I_SSD_NORM) : nullptr, k0, (bf16_t*)(ws + WS_W2) + (size_t)n0 * 2048 + k0, 2048, lds, 32); continue; }
        id -= NT2;
        if (id < 2 * NT3) { const int l = id / NT3; id -= l * NT3; const int ntile = id / 16, kt = id % 16, n0 = ntile * 64, k0 = kt * 64, pn = n0 >> 8, lc0 = n0 & 255;
            const int col = (lc0 < 128 ? 0 : DFF) + pn * 128 + (lc0 & 127);
            wconv_tile(cx, IN(p, I_FFN_WIN) + (size_t)l * 1024 * 5632 + (size_t)k0 * 5632 + col, 5632, 64, IN(p, I_NORM_FFN) + l * 1024, k0, (bf16_t*)(ws + WS_W3) + (size_t)l * 5632 * 1024 + (size_t)n0 * 1024 + k0, 1024, lds); continue; }
        id -= 2 * NT3;
        if (id < 2 * NT4) { const int l = id / NT4; id -= l * NT4; const int ntile = id / 44, kt = id % 44, n0 = ntile * 64, k0 = kt * 64;
            wconv_tile(cx, IN(p, I_FFN_WOUT) + (size_t)l * DFF * 1024 + (size_t)k0 * 1024 + lcol0(n0), 1024, 64, nullptr, k0, (bf16_t*)(ws + WS_W4) + (size_t)l * 1024 * DFF + (size_t)n0 * DFF + k0, DFF, lds, 32); continue; }
        id -= 2 * NT4;
        if (id < NT5) { const int ntile = id / 16, kt = id % 16, n0 = ntile * 64, k0 = kt * 64;
            wconv_tile(cx, IN(p, I_LRU_WIN) + (size_t)k0 * 2048 + lcol0(n0), 2048, 64, IN(p, I_NORM_MIX) + 1024, k0, (bf16_t*)(ws + WS_W5) + (size_t)n0 * 1024 + k0, 1024, lds, 32); continue; }
        id -= NT5;
        if (id < NT6) { const int ntile = id / 4, kt = id % 4, n0 = ntile * 64, k0 = kt * 64, head = n0 >> 9, within = n0 & 511, pnl = within >> 8, lc0 = within & 255;
            const int ch = pnl * 128 + (lc0 & 127);
            const float* srcm = (lc0 < 128 ? IN(p, I_LRU_WA) : IN(p, I_LRU_WX)) + (size_t)head * 65536;
            wconv_tile(cx, srcm + (size_t)k0 * 256 + ch, 256, 64, nullptr, k0, (bf16_t*)(ws + WS_W6) + (size_t)n0 * 256 + k0, 256, lds); continue; }
        id -= NT6;
        { const int ntile = id / 16, kt = id % 16, n0 = ntile * 64, k0 = kt * 64;
            wconv_tile(cx, IN(p, I_LRU_WOUT) + (size_t)k0 * 1024 + lcol0(n0), 1024, 64, nullptr, k0, (bf16_t*)(ws + WS_W7) + (size_t)n0 * 1024 + k0, 1024, lds, 32); }
    }
    if (!tables) return;
    const int gt = cx.bid * NTHREADS + cx.tid, gs = cx.nblk * NTHREADS;
    for (int i = gt; i < 1024; i += gs) ((float*)(ws + WS_SP))[i] = softplusf_(-IN(p, I_LRU_LAMBDA)[i]);
    for (int i = gt; i < 5 * T; i += gs) ((float*)(ws + WS_SSQ))[i] = 0.f;
}

__device__ __forceinline__ void phase_norm(const Ctx cx, const float* xp, const float* xs, bf16_t* XN) {
    const int wid = cx.tid >> 6, lane = cx.tid & 63;
    for (int row0 = cx.bid * 8 + wid; row0 < T; row0 += cx.nblk * 32) {
        f32x4 v[4][4];
#pragma unroll
        for (int i = 0; i < 4; ++i) { const int row = row0 + i * cx.nblk * 8;
            if (row < T) { const float* src = row < TP ? xp + (size_t)row * DM : xs + (size_t)(row - TP) * DM;
#pragma unroll
                for (int j = 0; j < 4; ++j) v[i][j] = *(const f32x4*)(src + lane * 4 + j * 256); } }
#pragma unroll
        for (int i = 0; i < 4; ++i) { const int row = row0 + i * cx.nblk * 8;
            if (row < T) { float s = 0.f;
#pragma unroll
                for (int j = 0; j < 4; ++j) s += v[i][j][0] * v[i][j][0] + v[i][j][1] * v[i][j][1] + v[i][j][2] * v[i][j][2] + v[i][j][3] * v[i][j][3];
#pragma unroll
                for (int o = 32; o >= 1; o >>= 1) s += __shfl_xor(s, o);
                const float rs = rsqrtf(s * (1.0f / 1024.0f) + EPS);
#pragma unroll
                for (int j = 0; j < 4; ++j) { u32x2 w; w.x = cvt_pk_bf16(v[i][j][0] * rs, v[i][j][1] * rs); w.y = cvt_pk_bf16(v[i][j][2] * rs, v[i][j][3] * rs);
                    *(u32x2*)(XN + (size_t)row * DM + lane * 4 + j * 256) = w; } } }
    }
}
__device__ __forceinline__ void phase_final_norm(const Ctx cx, const bf16_t* XN, const float* ssq, const float* gain, float* y) {
    const int wid = cx.tid >> 6, lane = cx.tid & 63;
    f32x4 gv[4];
#pragma unroll
    for (int j = 0; j < 4; ++j) gv[j] = *(const f32x4*)(gain + lane * 4 + j * 256);
    for (int row0 = cx.bid * 8 + wid; row0 < T; row0 += cx.nblk * 64) {
        u32x2 w[8][4]; float rs[8];
#pragma unroll
        for (int i = 0; i < 8; ++i) { const int row = row0 + i * cx.nblk * 8;
            if (row < T) {
#pragma unroll
                for (int j = 0; j < 4; ++j) w[i][j] = *(const u32x2*)(XN + (size_t)row * DM + lane * 4 + j * 256);
                rs[i] = rsqrtf(ssq[row] * (1.0f / 1024.0f) + EPS); } }
#pragma unroll
        for (int i = 0; i < 8; ++i) { const int row = row0 + i * cx.nblk * 8;
            if (row < T) { float* dst = y + (size_t)row * DM + lane * 4;
#pragma unroll
                for (int j = 0; j < 4; ++j) *(f32x4*)(dst + j * 256) = (f32x4){bf_lo(w[i][j].x), bf_hi(w[i][j].x), bf_lo(w[i][j].y), bf_hi(w[i][j].y)} * rs[i] * gv[j]; } }
    }
}

template <int KW, int MODE>
__device__ __forceinline__ void phase_conv(const Ctx cx, const bf16_t* src, int ld_src, int NC, const float* w, const float* bias, bf16_t* dst, int ld_dst,
                           const float* st_in, float* out_p, float* out_s) {
    const int ncg = NC >> 3, total = (T / 16) * ncg;
    for (int item = cx.bid * NTHREADS + cx.tid; item < total; item += cx.nblk * NTHREADS) {
        const int cgi = item % ncg, seg = item / ncg, c0 = cgi * 8, r0 = seg * 16;
        int seq, t0, L; if (r0 < TP) { seq = r0 >> 12; t0 = r0 & 4095; L = 4096; } else { seq = 16 + ((r0 - TP) >> 6); t0 = (r0 - TP) & 63; L = 64; }
        float wv[KW][8], bv[8];
#pragma unroll
        for (int k = 0; k < KW; ++k) { const f32x4 a = *(const f32x4*)(w + (size_t)k * NC + c0), b = *(const f32x4*)(w + (size_t)k * NC + c0 + 4);
#pragma unroll
            for (int j = 0; j < 4; ++j) { wv[k][j] = a[j]; wv[k][4 + j] = b[j]; } }
        { const f32x4 a = *(const f32x4*)(bias + c0), b = *(const f32x4*)(bias + c0 + 4);
#pragma unroll
          for (int j = 0; j < 4; ++j) { bv[j] = a[j]; bv[4 + j] = b[j]; } }
        float win[KW - 1][8];
#pragma unroll
        for (int k = 0; k < KW - 1; ++k) {
            if (t0 > 0) unpack8(*(const u32x4*)(src + (size_t)(r0 - (KW - 1) + k) * ld_src + c0), win[k]);
            else if (seq >= 16) { const float* sp_ = st_in + ((size_t)(seq - 16) * (KW - 1) + k) * NC + c0; const f32x4 a = *(const f32x4*)sp_, b = *(const f32x4*)(sp_ + 4);
#pragma unroll
                for (int j = 0; j < 4; ++j) { win[k][j] = a[j]; win[k][4 + j] = b[j]; } }
            else {
#pragma unroll
                for (int j = 0; j < 8; ++j) win[k][j] = 0.f; }
        }
#pragma unroll
        for (int h = 0; h < 2; ++h) {
            u32x4 rows[8], aux[8];
#pragma unroll
            for (int i = 0; i < 8; ++i) { rows[i] = *(const u32x4*)(src + (size_t)(r0 + h * 8 + i) * ld_src + c0);
                if (MODE == 1 || MODE == 2) aux[i] = *(const u32x4*)(dst + (size_t)(r0 + h * 8 + i) * ld_dst + c0); }
#pragma unroll
            for (int i = 0; i < 8; ++i) {
                float cur[8], y[8]; unpack8(rows[i], cur);
#pragma unroll
                for (int j = 0; j < 8; ++j) { float a = bv[j] + wv[KW - 1][j] * cur[j];
#pragma unroll
                    for (int k = 0; k < KW - 1; ++k) a += wv[k][j] * win[k][j];
                    y[j] = a; }
#pragma unroll
                for (int j = 0; j < 8; ++j) {
#pragma unroll
                    for (int k = 0; k < KW - 2; ++k) win[k][j] = win[k + 1][j];
                    win[KW - 2][j] = cur[j]; }
                if (MODE == 0) {
#pragma unroll
                    for (int j = 0; j < 8; ++j) y[j] = siluf_(y[j]); }
                if (MODE == 1) { float gq[8]; unpack8(aux[i], gq);
#pragma unroll
                    for (int j = 0; j < 8; ++j) y[j] = y[j] * gq[j]; }
                if (MODE == 2) { float uq[8]; unpack8(aux[i], uq);
#pragma unroll
                    for (int j = 0; j < 8; ++j) y[j] = geluf_(y[j]) * uq[j]; }
                *(u32x4*)(dst + (size_t)(r0 + h * 8 + i) * ld_dst + c0) = pack8(y);
            }
            if (h == 1 && t0 + 16 == L) {
                float* ob = (seq < 16 ? out_p + (size_t)seq * (KW - 1) * NC : out_s + (size_t)(seq - 16) * (KW - 1) * NC) + c0;
#pragma unroll
                for (int j = 0; j < KW - 1; ++j) { float f[8]; unpack8(rows[8 - (KW - 1) + j], f);
                    *(f32x4*)(ob + (size_t)j * NC) = (f32x4){f[0], f[1], f[2], f[3]}; *(f32x4*)(ob + (size_t)j * NC + 4) = (f32x4){f[4], f[5], f[6], f[7]}; }
            }
        }
    }
}

template <bool SRC_F32, bool GSCALE>
__device__ __forceinline__ void phase_split_finish(const Ctx cx, const float* slabs, int nsplit, const float* xs, bf16_t* XN, float* ssq, const float* gssq) {
    const int wid = cx.tid >> 6, lane = cx.tid & 63;
    for (int r = cx.bid * 8 + wid; r < TS; r += cx.nblk * 8) {
        const int panel = r >> 8, rl = r & 255, pn = lane >> 4, lc = (lane & 15) * 16;
        const float* sb = slabs + (size_t)((panel * 4 + pn) * nsplit) * 65536 + (size_t)rl * 256 + lc;
        f32x4 v[4];
#pragma unroll
        for (int q = 0; q < 4; ++q) v[q] = (f32x4){0.f, 0.f, 0.f, 0.f};
        for (int pc = 0; pc < nsplit; ++pc) {
#pragma unroll
            for (int q = 0; q < 4; ++q) v[q] += *(const f32x4*)(sb + (size_t)pc * 65536 + 4 * q);
            if (GSCALE && pc == 3) { const float sc = rsqrtf(gssq[TP + r] * (1.0f / 1024.0f) + EPS);
#pragma unroll
                for (int q = 0; q < 4; ++q) v[q] *= sc; }
        }
        bf16_t* xnp = XN + (size_t)(TP + r) * DM + lane * 16;
        if (SRC_F32) { const float* src = xs + (size_t)r * DM + lane * 16;
#pragma unroll
            for (int q = 0; q < 4; ++q) v[q] += *(const f32x4*)(src + 4 * q); }
        else { float a[8], b[8]; unpack8(*(const u32x4*)xnp, a); unpack8(*(const u32x4*)(xnp + 8), b);
            v[0] += (f32x4){a[0], a[1], a[2], a[3]}; v[1] += (f32x4){a[4], a[5], a[6], a[7]}; v[2] += (f32x4){b[0], b[1], b[2], b[3]}; v[3] += (f32x4){b[4], b[5], b[6], b[7]}; }
        *(u32x4*)xnp = pack44(v[0], v[1]); *(u32x4*)(xnp + 8) = pack44(v[2], v[3]);
        float sq = 0.f;
#pragma unroll
        for (int q = 0; q < 4; ++q) sq += v[q][0] * v[q][0] + v[q][1] * v[q][1] + v[q][2] * v[q][2] + v[q][3] * v[q][3];
#pragma unroll
        for (int o = 32; o >= 1; o >>= 1) sq += __shfl_xor(sq, o);
        if (lane == 0) ssq[TP + r] = sq;
    }
}

__device__ __forceinline__ void phase_ffn_fix(const Ctx cx, const bf16_t* GH, const bf16_t* GT, const bf16_t* UH, bf16_t* H, const float* cw, const float* cb,
                                              const float* st_in, float* out_p, float* out_s) {
    const int ncg = DFF / 8, total = 1032 * ncg;
    for (int item = cx.bid * NTHREADS + cx.tid; item < total; item += cx.nblk * NTHREADS) {
        const int cgi = item % ncg, G = item / ncg, c0 = cgi * 8;
        int seq; bool first, lastg;
        if (G < 1024) { seq = G >> 6; first = (G & 63) == 0; lastg = (G & 63) == 63; } else { seq = 16 + (G - 1024); first = true; lastg = true; }
        float w0[8], w1[8], w2[8], bb[8], gm2[8], gm1[8], g0[8], g1[8], u0[8], u1[8];
#pragma unroll
        for (int h = 0; h < 2; ++h) { const f32x4 a = *(const f32x4*)(cw + c0 + 4 * h), b = *(const f32x4*)(cw + DFF + c0 + 4 * h), c = *(const f32x4*)(cw + 2 * DFF + c0 + 4 * h), d = *(const f32x4*)(cb + c0 + 4 * h);
#pragma unroll
            for (int j = 0; j < 4; ++j) { w0[4 * h + j] = a[j]; w1[4 * h + j] = b[j]; w2[4 * h + j] = c[j]; bb[4 * h + j] = d[j]; } }
        if (!first) { unpack8(*(const u32x4*)(GT + ((size_t)(G - 1) * 2 + 0) * DFF + c0), gm2); unpack8(*(const u32x4*)(GT + ((size_t)(G - 1) * 2 + 1) * DFF + c0), gm1); }
        else if (seq >= 16) { const float* s0 = st_in + ((size_t)(seq - 16) * 2) * DFF + c0;
#pragma unroll
            for (int h = 0; h < 2; ++h) { const f32x4 a = *(const f32x4*)(s0 + 4 * h), b = *(const f32x4*)(s0 + DFF + 4 * h);
#pragma unroll
                for (int j = 0; j < 4; ++j) { gm2[4 * h + j] = a[j]; gm1[4 * h + j] = b[j]; } } }
        else {
#pragma unroll
            for (int q = 0; q < 8; ++q) { gm2[q] = 0.f; gm1[q] = 0.f; } }
        unpack8(*(const u32x4*)(GH + ((size_t)G * 2 + 0) * DFF + c0), g0); unpack8(*(const u32x4*)(GH + ((size_t)G * 2 + 1) * DFF + c0), g1);
        unpack8(*(const u32x4*)(UH + ((size_t)G * 2 + 0) * DFF + c0), u0); unpack8(*(const u32x4*)(UH + ((size_t)G * 2 + 1) * DFF + c0), u1);
        float h0[8], h1[8];
#pragma unroll
        for (int q = 0; q < 8; ++q) { h0[q] = geluf_(bb[q] + w0[q] * gm2[q] + w1[q] * gm1[q] + w2[q] * g0[q]) * u0[q];
            h1[q] = geluf_(bb[q] + w0[q] * gm1[q] + w1[q] * g0[q] + w2[q] * g1[q]) * u1[q]; }
        *(u32x4*)(H + (size_t)(G * 64) * DFF + c0) = pack8(h0); *(u32x4*)(H + (size_t)(G * 64 + 1) * DFF + c0) = pack8(h1);
        if (lastg) {
            float* ob = (seq < 16 ? out_p + (size_t)seq * 2 * DFF : out_s + (size_t)(seq - 16) * 2 * DFF) + c0;
#pragma unroll
            for (int j = 0; j < 2; ++j) { float f[8]; unpack8(*(const u32x4*)(GT + ((size_t)G * 2 + j) * DFF + c0), f);
                *(f32x4*)(ob + (size_t)j * DFF) = (f32x4){f[0], f[1], f[2], f[3]}; *(f32x4*)(ob + (size_t)j * DFF + 4) = (f32x4){f[4], f[5], f[6], f[7]}; }
        }
    }
}

constexpr int SC_CS = 0, SC_BS = 17408, SC_BTS = 34816, SC_XTS = 53248, SC_XDS = 62464, SC_HS = 71680, SC_MS = 89088, SC_AS = 98304, SC_SQ = 98560, SC_XTS2 = 99328;
#define LDS_BARRIER() do { asm volatile("s_waitcnt lgkmcnt(0)" ::: "memory"); __builtin_amdgcn_s_barrier(); asm volatile("" ::: "memory"); } while (0)
template <int N> __device__ __forceinline__ float dpp_shr(float v) { return __int_as_float(__builtin_amdgcn_update_dpp(0, __float_as_int(v), 0x110 + N, 0xf, 0xf, true)); }
__device__ __forceinline__ void ssd_task(const Ctx cx, const Params& p, LAS unsigned char* lds, int seq, int hd) {
    const int tid = cx.tid, wid = tid >> 6, lane = tid & 63, fr = lane & 15, fq = lane >> 4;
    unsigned char* ws = P_WS(p);
    const bf16_t* XBCA = (const bf16_t*)(ws + WS_XBCA); bf16_t* A2 = (bf16_t*)(ws + WS_A2); const float* DT = (const float*)(ws + WS_DT); float* SSQ = (float*)(ws + WS_SSQ);
    const int g = hd >> 3, nchunks = seq < 16 ? 64 : 1;
    const size_t row_base = seq < 16 ? (size_t)seq * 4096 : (size_t)TP + (size_t)(seq - 16) * 64;
    const float Aneg = -__expf(IN(p, I_A_LOG)[hd]), Dh = IN(p, I_SSD_D)[hd];
    LAS float* As = (LAS float*)(lds + SC_AS); LAS float* Sq = (LAS float*)(lds + SC_SQ);
    f32x4 hst[4];
#pragma unroll
    for (int pt = 0; pt < 4; ++pt) {
        if (seq >= 16) hst[pt] = *(const f32x4*)(IN(p, I_ST_SSD) + ((size_t)((seq - 16) * 16 + hd) * 64 + 16 * pt + fr) * 128 + 16 * wid + 4 * fq);
        else hst[pt] = (f32x4){0.f, 0.f, 0.f, 0.f};
    }
    const int lt = wid >> 1, ph = wid & 1;
    float pf_dt; u32x4 pf_b[2], pf_c[2], pf_x, pf_bt[2];
#define SSD_PREFETCH(cc) do { const size_t r0p = row_base + (size_t)(cc) * 64; \
        pf_dt = DT[(r0p + lane) * 16 + hd]; \
        _Pragma("unroll") for (int i = 0; i < 2; ++i) { const int q = tid + i * 512, row = q >> 4, sg = q & 15; \
            const bf16_t* gp = XBCA + (r0p + row) * XBC + 1024 + g * 128 + sg * 8; pf_b[i] = *(const u32x4*)gp; pf_c[i] = *(const u32x4*)(gp + 256); } \
        pf_x = *(const u32x4*)(XBCA + (r0p + lane) * XBC + hd * 64 + wid * 8); \
        _Pragma("unroll") for (int i = 0; i < 2; ++i) pf_bt[i] = *(const u32x4*)(XBCA + (r0p + lane) * XBC + 1024 + g * 128 + (wid + 8 * i) * 8); } while (0)
    SSD_PREFETCH(0);
    for (int c = 0; c < nchunks; ++c) {
        const size_t r0 = row_base + (size_t)c * 64;
        const float dt_l = pf_dt;
        float a = dt_l * Aneg;
        a += dpp_shr<1>(a); a += dpp_shr<2>(a); a += dpp_shr<4>(a); a += dpp_shr<8>(a);
        { const float t0 = __int_as_float(__builtin_amdgcn_readlane(__float_as_int(a), 15)), t1 = __int_as_float(__builtin_amdgcn_readlane(__float_as_int(a), 31)), t2 = __int_as_float(__builtin_amdgcn_readlane(__float_as_int(a), 47));
          a += (fq == 1) ? t0 : (fq == 2) ? (t0 + t1) : (fq == 3) ? (t0 + t1 + t2) : 0.0f; }
        const float a63 = __int_as_float(__builtin_amdgcn_readlane(__float_as_int(a), 63));
        const float wl = dt_l * __expf(a63 - a);
        if (wid == 0) As[lane] = a;
#pragma unroll
        for (int i = 0; i < 2; ++i) { const int q = tid + i * 512, row = q >> 4, sg = q & 15;
            *(LAS u32x4*)(lds + SC_BS + row * 272 + sg * 16) = pf_b[i]; *(LAS u32x4*)(lds + SC_CS + row * 272 + sg * 16) = pf_c[i]; }
        { float f[8]; unpack8(pf_x, f);
          LAS bf16_t* xt = (LAS bf16_t*)(lds + ((c & 1) ? SC_XTS2 : SC_XTS)), *xd = (LAS bf16_t*)(lds + SC_XDS);
#pragma unroll
          for (int j = 0; j < 8; ++j) { const unsigned w2 = cvt_pk_bf16(f[j] * dt_l, f[j] * wl); xt[(wid * 8 + j) * 72 + lane] = (bf16_t)(w2 & 0xffffu); xd[(wid * 8 + j) * 72 + lane] = (bf16_t)(w2 >> 16); } }
#pragma unroll
        for (int i = 0; i < 2; ++i) { const int sg = wid + 8 * i; const u32x4 bw = pf_bt[i];
            LAS bf16_t* bt = (LAS bf16_t*)(lds + SC_BTS);
            bt[(sg * 8 + 0) * 72 + lane] = (bf16_t)(bw.x & 0xffffu); bt[(sg * 8 + 1) * 72 + lane] = (bf16_t)(bw.x >> 16);
            bt[(sg * 8 + 2) * 72 + lane] = (bf16_t)(bw.y & 0xffffu); bt[(sg * 8 + 3) * 72 + lane] = (bf16_t)(bw.y >> 16);
            bt[(sg * 8 + 4) * 72 + lane] = (bf16_t)(bw.z & 0xffffu); bt[(sg * 8 + 5) * 72 + lane] = (bf16_t)(bw.z >> 16);
            bt[(sg * 8 + 6) * 72 + lane] = (bf16_t)(bw.w & 0xffffu); bt[(sg * 8 + 7) * 72 + lane] = (bf16_t)(bw.w >> 16); }
#pragma unroll
        for (int pt = 0; pt < 4; ++pt) { u32x2 w2; w2.x = cvt_pk_bf16(hst[pt][0], hst[pt][1]); w2.y = cvt_pk_bf16(hst[pt][2], hst[pt][3]);
            *(LAS u32x2*)(lds + SC_HS + (16 * pt + fr) * 272 + (16 * wid + 4 * fq) * 2) = w2; }
        u32x2 ep_z[2], ep_x[2];
#pragma unroll
        for (int j = 0; j < 2; ++j) { const size_t rowe = r0 + 16 * lt + fr; const int col = hd * 64 + 16 * (2 * ph + j) + 4 * fq;
            ep_z[j] = *(const u32x2*)(A2 + rowe * 2048 + col); ep_x[j] = *(const u32x2*)(XBCA + rowe * XBC + col); }
        if (c + 1 < nchunks) SSD_PREFETCH(c + 1);
        LDS_BARRIER();
        if (c > 0 && tid < 64) atomicAdd(SSQ + (r0 - 64) + tid, Sq[tid] + Sq[64 + tid]);
        f32x4 yacc[2];
        {
            bf16x8 cf[4];
#pragma unroll
            for (int kk = 0; kk < 4; ++kk) cf[kk] = *(const LAS bf16x8*)(lds + SC_CS + (16 * lt + fr) * 272 + kk * 64 + fq * 16);
            const float a_l = As[16 * lt + fr];
#pragma unroll
            for (int j = 0; j < 2; ++j) {
                const int st = 2 * ph + j;
                f32x4 cb = (f32x4){0.f, 0.f, 0.f, 0.f};
                if (st <= lt) {
#pragma unroll
                    for (int kk = 0; kk < 4; ++kk) { const bf16x8 bf = *(const LAS bf16x8*)(lds + SC_BS + (16 * st + fr) * 272 + kk * 64 + fq * 16);
                        cb = __builtin_amdgcn_mfma_f32_16x16x32_bf16(bf, cf[kk], cb, 0, 0, 0); }
                    const f32x4 as4 = *(const LAS f32x4*)(lds + SC_AS + (16 * st + 4 * fq) * 4);
#pragma unroll
                    for (int r = 0; r < 4; ++r) { const int s = 16 * st + 4 * fq + r, l = 16 * lt + fr; cb[r] = (s <= l) ? cb[r] * __expf(a_l - as4[r]) : 0.f; }
                }
                u32x2 w2; w2.x = cvt_pk_bf16(cb[0], cb[1]); w2.y = cvt_pk_bf16(cb[2], cb[3]);
                *(LAS u32x2*)(lds + SC_MS + (16 * lt + fr) * 144 + (16 * st + 4 * fq) * 2) = w2;
            }
            const float el = __expf(a_l);
#pragma unroll
            for (int j = 0; j < 2; ++j) { const int pt = 2 * ph + j; f32x4 y = (f32x4){0.f, 0.f, 0.f, 0.f};
#pragma unroll
                for (int kk = 0; kk < 4; ++kk) { const bf16x8 hf = *(const LAS bf16x8*)(lds + SC_HS + (16 * pt + fr) * 272 + kk * 64 + fq * 16);
                    y = __builtin_amdgcn_mfma_f32_16x16x32_bf16(hf, cf[kk], y, 0, 0, 0); }
                yacc[j] = y * el; }
        }
        {
            const float dec = __expf(a63);
            bf16x8 btf[2];
#pragma unroll
            for (int kk = 0; kk < 2; ++kk) btf[kk] = *(const LAS bf16x8*)(lds + SC_BTS + (16 * wid + fr) * 144 + kk * 64 + fq * 16);
#pragma unroll
            for (int pt = 0; pt < 4; ++pt) { f32x4 h = hst[pt] * dec;
#pragma unroll
                for (int kk = 0; kk < 2; ++kk) { const bf16x8 xf = *(const LAS bf16x8*)(lds + SC_XDS + (16 * pt + fr) * 144 + kk * 64 + fq * 16);
                    h = __builtin_amdgcn_mfma_f32_16x16x32_bf16(btf[kk], xf, h, 0, 0, 0); }
                hst[pt] = h; }
        }
        LDS_BARRIER();
        {
            bf16x8 mf[2];
#pragma unroll
            for (int kk = 0; kk < 2; ++kk) mf[kk] = *(const LAS bf16x8*)(lds + SC_MS + (16 * lt + fr) * 144 + kk * 64 + fq * 16);
            float sq = 0.f;
            const size_t row = r0 + 16 * lt + fr;
#pragma unroll
            for (int j = 0; j < 2; ++j) { const int pt = 2 * ph + j; f32x4 y = yacc[j];
#pragma unroll
                for (int kk = 0; kk < 2; ++kk) { const bf16x8 xf = *(const LAS bf16x8*)(lds + ((c & 1) ? SC_XTS2 : SC_XTS) + (16 * pt + fr) * 144 + kk * 64 + fq * 16);
                    y = __builtin_amdgcn_mfma_f32_16x16x32_bf16(xf, mf[kk], y, 0, 0, 0); }
                const int col = hd * 64 + 16 * pt + 4 * fq;
                const u32x2 zw = ep_z[j], xw = ep_x[j];
                const float z0 = bf_lo(zw.x), z1 = bf_hi(zw.x), z2 = bf_lo(zw.y), z3 = bf_hi(zw.y);
                const float x0 = bf_lo(xw.x), x1 = bf_hi(xw.x), x2 = bf_lo(xw.y), x3 = bf_hi(xw.y);
                const float g0 = (y[0] + Dh * x0) * siluf_(z0), g1 = (y[1] + Dh * x1) * siluf_(z1), g2 = (y[2] + Dh * x2) * siluf_(z2), g3 = (y[3] + Dh * x3) * siluf_(z3);
                sq += g0 * g0 + g1 * g1 + g2 * g2 + g3 * g3;
                u32x2 ow; ow.x = cvt_pk_bf16(g0, g1); ow.y = cvt_pk_bf16(g2, g3);
                *(u32x2*)(A2 + row * 2048 + col) = ow; }
            sq += __shfl_xor(sq, 16); sq += __shfl_xor(sq, 32);
            if (fq == 0) Sq[ph * 64 + 16 * lt + fr] = sq;
        }
    }
    float* so = (seq < 16 ? P_OUT(p) + O_P_SSD + (size_t)(seq * 16 + hd) * 8192 : P_OUT(p) + O_S_SSD + (size_t)((seq - 16) * 16 + hd) * 8192);
#pragma unroll
    for (int pt = 0; pt < 4; ++pt) *(f32x4*)(so + (size_t)(16 * pt + fr) * 128 + 16 * wid + 4 * fq) = hst[pt];
    LDS_BARRIER();
    if (tid < 64) atomicAdd(SSQ + row_base + (size_t)(nchunks - 1) * 64 + tid, Sq[tid] + Sq[64 + tid]);
    LDS_BARRIER();
}
__device__ __forceinline__ void phase_ssd(const Ctx cx, const Params& p, LAS unsigned char* lds) {
    for (int task = cx.bid; task < 384; task += cx.nblk) {
        if (task < 256) ssd_task(cx, p, lds, task >> 4, task & 15);
        else ssd_task(cx, p, lds, 16 + ((task - 256) >> 4), (task - 256) & 15);
    }
}

__device__ __forceinline__ void phase_lru_a(const Ctx cx, const bf16_t* LA, const bf16_t* UU, float* SL, float* HH) {
    const int total = 1088 * 128;
    for (int item = cx.bid * NTHREADS + cx.tid; item < total; item += cx.nblk * NTHREADS) {
        const int cgi = item & 127, ch = item >> 7, c0 = cgi * 8; const size_t r0 = ch < 1024 ? (size_t)ch * 64 : (size_t)TP + (size_t)(ch - 1024) * 8; const int nr = ch < 1024 ? 64 : 8;
        float sl[8], h[8];
#pragma unroll
        for (int j = 0; j < 8; ++j) { sl[j] = 0.f; h[j] = 0.f; }
        for (int i0 = 0; i0 < nr; i0 += 8) {
            u32x4 la[8], uu[8];
#pragma unroll
            for (int i = 0; i < 8; ++i) { la[i] = *(const u32x4*)(LA + (r0 + i0 + i) * 1024 + c0); uu[i] = *(const u32x4*)(UU + (r0 + i0 + i) * 1024 + c0); }
#pragma unroll
            for (int i = 0; i < 8; ++i) { float l[8], u[8]; unpack8(la[i], l); unpack8(uu[i], u);
#pragma unroll
                for (int j = 0; j < 8; ++j) { sl[j] += l[j]; h[j] = __expf(l[j]) * h[j] + u[j]; } }
        }
        float* o1 = SL + (size_t)ch * 1024 + c0; float* o2 = HH + (size_t)ch * 1024 + c0;
        *(f32x4*)o1 = (f32x4){sl[0], sl[1], sl[2], sl[3]}; *(f32x4*)(o1 + 4) = (f32x4){sl[4], sl[5], sl[6], sl[7]};
        *(f32x4*)o2 = (f32x4){h[0], h[1], h[2], h[3]}; *(f32x4*)(o2 + 4) = (f32x4){h[4], h[5], h[6], h[7]};
    }
}
__device__ __forceinline__ void phase_lru_b(const Ctx cx, const Params& p, const float* SL, const float* HH, float* CIN) {
    for (int item = cx.bid * NTHREADS + cx.tid; item < 24 * 1024; item += cx.nblk * NTHREADS) {
        const int chn = item & 1023, seq = item >> 10;
        const int nch = seq < 16 ? 64 : 8, ch0 = seq < 16 ? seq * 64 : 1024 + (seq - 16) * 8;
        float c = seq < 16 ? 0.f : IN(p, I_ST_LRU)[(seq - 16) * 1024 + chn];
        for (int i0 = 0; i0 < nch; i0 += 16) {
            float sl[16], hh[16];
#pragma unroll
            for (int i = 0; i < 16; ++i) if (i0 + i < nch) { sl[i] = SL[(size_t)(ch0 + i0 + i) * 1024 + chn]; hh[i] = HH[(size_t)(ch0 + i0 + i) * 1024 + chn]; }
#pragma unroll
            for (int i = 0; i < 16; ++i) if (i0 + i < nch) { CIN[(size_t)(ch0 + i0 + i) * 1024 + chn] = c; c = __expf(sl[i]) * c + hh[i]; }
        }
        (seq < 16 ? P_OUT(p) + O_P_LRU + seq * 1024 : P_OUT(p) + O_S_LRU + (seq - 16) * 1024)[chn] = c;
    }
}
__device__ __forceinline__ void phase_lru_c(const Ctx cx, const bf16_t* LA, const bf16_t* UU, const float* CIN, bf16_t* GATE) {
    const int total = 1088 * 128;
    for (int item = cx.bid * NTHREADS + cx.tid; item < total; item += cx.nblk * NTHREADS) {
        const int cgi = item & 127, ch = item >> 7, c0 = cgi * 8; const size_t r0 = ch < 1024 ? (size_t)ch * 64 : (size_t)TP + (size_t)(ch - 1024) * 8; const int nr = ch < 1024 ? 64 : 8;
        float h[8];
        { const float* ci = CIN + (size_t)ch * 1024 + c0; const f32x4 a = *(const f32x4*)ci, b = *(const f32x4*)(ci + 4);
#pragma unroll
          for (int j = 0; j < 4; ++j) { h[j] = a[j]; h[4 + j] = b[j]; } }
        for (int i0 = 0; i0 < nr; i0 += 8) {
            u32x4 la[8], uu[8], gt[8];
#pragma unroll
            for (int i = 0; i < 8; ++i) { la[i] = *(const u32x4*)(LA + (r0 + i0 + i) * 1024 + c0); uu[i] = *(const u32x4*)(UU + (r0 + i0 + i) * 1024 + c0); gt[i] = *(const u32x4*)(GATE + (r0 + i0 + i) * 1024 + c0); }
#pragma unroll
            for (int i = 0; i < 8; ++i) { float l[8], u[8], gq[8], o[8]; unpack8(la[i], l); unpack8(uu[i], u); unpack8(gt[i], gq);
#pragma unroll
                for (int j = 0; j < 8; ++j) { h[j] = __expf(l[j]) * h[j] + u[j]; o[j] = gq[j] * h[j]; }
                *(u32x4*)(GATE + (r0 + i0 + i) * 1024 + c0) = pack8(o); }
        }
    }
}

#define XB_TMO      128
#define XB_XCNT(j)  (256  + 64 * (j))
#define XB_XSUB(j)  (1280 + 64 * (j))
#define XB_XGEN(j)  (2304 + 64 * (j))
#define XB_TOP      3328
#define XB_TOPGEN   3392
#define XCD_BAR_WORDS 3456
#define XB_SPIN_CAP (1u << 18)
__device__ __forceinline__ unsigned xb_ld(unsigned* p)              { return __hip_atomic_load(p, __ATOMIC_RELAXED, __HIP_MEMORY_SCOPE_AGENT); }
__device__ __forceinline__ unsigned xb_add(unsigned* p, unsigned v) { return __hip_atomic_fetch_add(p, v, __ATOMIC_RELAXED, __HIP_MEMORY_SCOPE_AGENT); }
__device__ __forceinline__ unsigned xb_xcc_id() { return (unsigned)__builtin_amdgcn_s_getreg((3 << 11) | 20) & 0xFu; }
#define XB_SPIN(cond, bar) do { unsigned _sp = 0; while (cond) { __builtin_amdgcn_s_sleep(1); \
    if ((++_sp & 255u) == 0u) { if (xb_ld(&(bar)[XB_TMO])) break; if (_sp > XB_SPIN_CAP) { atomicAdd(&(bar)[XB_TMO], 1u); break; } } } } while (0)
struct XcdBarrier { unsigned* bar; unsigned x; volatile LAS unsigned* st; };
__device__ __forceinline__ XcdBarrier xcd_barrier_post(unsigned* bar, volatile LAS unsigned* st) {
    XcdBarrier b; b.bar = bar; b.x = xb_xcc_id(); b.st = st;
    if (threadIdx.x == 0) (void)xb_add(&bar[XB_XCNT(b.x)], 1u);
    return b;
}
__device__ __forceinline__ void xcd_barrier_complete(unsigned* bar, unsigned x, unsigned& nloc, unsigned& nx) {
    const unsigned G = gridDim.x * gridDim.y * gridDim.z;
    unsigned sum, cnt, mine, sp = 0u;
    for (;;) {
        sum = 0u; cnt = 0u; mine = 0u;
#pragma unroll
        for (unsigned j = 0; j < 16; ++j) { const unsigned c = xb_ld(&bar[XB_XCNT(j)]); sum += c; cnt += (c > 0u) ? 1u : 0u; mine = (j == x) ? c : mine; }
        if (sum == G) break;
        __builtin_amdgcn_s_sleep(1);
        if ((++sp & 255u) == 0u) { if (xb_ld(&bar[XB_TMO])) break; if (sp > XB_SPIN_CAP) { atomicAdd(&bar[XB_TMO], 1u); break; } }
    }
    nloc = mine > 0u ? mine : 1u; nx = cnt > 0u ? cnt : 1u;
}
__device__ __forceinline__ void xcd_barrier(const XcdBarrier& b) {
    asm volatile("s_waitcnt vmcnt(0)" ::: "memory");
    __syncthreads();
    if (threadIdx.x == 0) {
        unsigned* bar = b.bar;
        __builtin_amdgcn_s_waitcnt(0);
        unsigned nloc = b.st[0], nx = b.st[1];
        if (nloc == 0u) { xcd_barrier_complete(bar, b.x, nloc, nx); b.st[0] = nloc; b.st[1] = nx; }
        const unsigned old = xb_add(&bar[XB_XSUB(b.x)], 1u);
        const unsigned gen = old / nloc;
        if (old + 1u == (gen + 1u) * nloc) {
            __builtin_amdgcn_fence(__ATOMIC_RELEASE, "agent");
            asm volatile("s_waitcnt vmcnt(0)" ::: "memory");
            const unsigned og = xb_add(&bar[XB_TOP], 1u);
            const unsigned tg = og / nx;
            if (og + 1u == (tg + 1u) * nx) xb_add(&bar[XB_TOPGEN], 1u);
            else XB_SPIN(xb_ld(&bar[XB_TOPGEN]) == tg, bar);
            __builtin_amdgcn_fence(__ATOMIC_ACQUIRE, "agent");
            xb_add(&bar[XB_XGEN(b.x)], 1u);
            asm volatile("s_waitcnt vmcnt(0)" ::: "memory");
        } else {
            XB_SPIN(xb_ld(&bar[XB_XGEN(b.x)]) == gen, bar);
            __builtin_amdgcn_fence(__ATOMIC_ACQUIRE, "agent");
            asm volatile("s_waitcnt vmcnt(0)" ::: "memory");
        }
    }
    __syncthreads();
}

constexpr int NPHASE = 23;
__device__ __forceinline__ void run_phase(const Params& p, int ph, LAS unsigned char* lds) {
    Ctx cx; { int b = blockIdx.x, n = gridDim.x, t = threadIdx.x; asm volatile("" : "+s"(b), "+s"(n), "+v"(t)); cx.bid = b; cx.nblk = n; cx.tid = t; }
    unsigned char* ws = P_WS(p);
    bf16_t* XN = (bf16_t*)(ws + WS_XN);
    float* Y = P_OUT(p) + O_Y;
    float* SSQ = (float*)(ws + WS_SSQ);
    switch (ph) {
    case 0: phase_prep(cx, p, lds, 0, 92 * 16, cx.bid, cx.nblk, true); phase_norm(cx, IN(p, I_XP), IN(p, I_XS), XN); break;
    case 1: { Gemm g{XN, (const bf16_t*)(ws + WS_W1), T, N1, 1024, 1024, 0, 0};
        EpiG1 e{(bf16_t*)(ws + WS_A2), (bf16_t*)(ws + WS_XBCP), (bf16_t*)(ws + WS_V), (float*)(ws + WS_DT), IN(p, I_DT_BIAS)};
        gemm_phase<EpiG1, false>(cx, lds, g, e, nullptr);
        const int nt1 = (T / BM) * (N1 / BM), nlate = nt1 % cx.nblk;
        if (cx.bid >= nlate) phase_prep(cx, p, lds, 92 * 16, 1 << 30, cx.bid - nlate, cx.nblk - nlate, false); } break;
    case 2:
        phase_conv<4, 0>(cx, (const bf16_t*)(ws + WS_XBCP), XBC, XBC, IN(p, I_SSD_CONVW), IN(p, I_SSD_CONVB), (bf16_t*)(ws + WS_XBCA), XBC, IN(p, I_ST_SSDCONV), P_OUT(p) + O_P_SSDCONV, P_OUT(p) + O_S_SSDCONV);
        phase_conv<3, 1>(cx, (const bf16_t*)(ws + WS_V), 1024, 1024, IN(p, I_SC_CONVW), IN(p, I_SC_CONVB), (bf16_t*)(ws + WS_A2) + 1024, 2048, IN(p, I_ST_SCONV), P_OUT(p) + O_P_SCONV, P_OUT(p) + O_S_SCONV);
        break;
    case 3: phase_ssd(cx, p, lds); break;
    case 4: { Gemm g{(const bf16_t*)(ws + WS_A2), (const bf16_t*)(ws + WS_W2), T, 1024, 2048, 2048, 0, 0};
        EpiRes<true> e{IN(p, I_XP), IN(p, I_XS), XN, SSQ + T};
        gemm_phase<EpiRes<true>, true, true>(cx, lds, g, e, SSQ, (float*)(ws + WS_SLAB)); } break;
    case 30: phase_split_finish<true, true>(cx, (const float*)(ws + WS_SLAB), 8, IN(p, I_XS), XN, SSQ + T, SSQ); break;
    case 5: case 15: { const int l = ph == 5 ? 0 : 1;
        Gemm g{XN, (const bf16_t*)(ws + WS_W3) + (size_t)l * 5632 * 1024, T, 5632, 1024, 1024, 0, 0};
        EpiFfnFused e{(bf16_t*)(ws + WS_H), (bf16_t*)(ws + WS_GH), (bf16_t*)(ws + WS_GT), (bf16_t*)(ws + WS_UH), SSQ + (l == 0 ? T : 3 * T), IN(p, I_FFN_CONVW) + l * 3 * DFF, IN(p, I_FFN_CONVB) + l * DFF};
        gemm_phase<EpiFfnFused, false>(cx, lds, g, e, nullptr); } break;
    case 6: case 16: { const int l = ph == 6 ? 0 : 1;
        phase_ffn_fix(cx, (const bf16_t*)(ws + WS_GH), (const bf16_t*)(ws + WS_GT), (const bf16_t*)(ws + WS_UH), (bf16_t*)(ws + WS_H), IN(p, I_FFN_CONVW) + l * 3 * DFF, IN(p, I_FFN_CONVB) + l * DFF,
                      IN(p, I_ST_FFNCONV) + l * 8 * 2 * DFF, P_OUT(p) + O_P_FFNCONV + l * 16 * 2 * DFF, P_OUT(p) + O_S_FFNCONV + l * 8 * 2 * DFF); } break;
    case 7: case 17: { const int l = ph == 7 ? 0 : 1;
        Gemm g{(const bf16_t*)(ws + WS_H), (const bf16_t*)(ws + WS_W4) + (size_t)l * 1024 * DFF, T, 1024, DFF, DFF, 0, 0};
        EpiRes<false> e{nullptr, nullptr, XN, SSQ + (l == 0 ? 2 * T : 4 * T)};
        gemm_phase<EpiRes<false>, false, true>(cx, lds, g, e, nullptr, (float*)(ws + WS_SLAB)); } break;
    case 31: phase_split_finish<false, false>(cx, (const float*)(ws + WS_SLAB), 11, nullptr, XN, SSQ + 2 * T, nullptr); break;
    case 33: phase_split_finish<false, false>(cx, (const float*)(ws + WS_SLAB), 11, nullptr, XN, SSQ + 4 * T, nullptr); break;
    case 8: { Gemm g{XN, (const bf16_t*)(ws + WS_W5), T, 2048, 1024, 1024, 0, 0};
        EpiLruIn e{(bf16_t*)(ws + WS_GATE), (bf16_t*)(ws + WS_XBP), SSQ + 2 * T};
        gemm_phase<EpiLruIn, false>(cx, lds, g, e, nullptr); } break;
    case 9: phase_conv<4, 3>(cx, (const bf16_t*)(ws + WS_XBP), 1024, 1024, IN(p, I_LRU_CONVW), IN(p, I_LRU_CONVB), (bf16_t*)(ws + WS_XBC2), 1024, IN(p, I_ST_LRUCONV), P_OUT(p) + O_P_LRUCONV, P_OUT(p) + O_S_LRUCONV); break;
    case 10: { Gemm g{(const bf16_t*)(ws + WS_XBC2), (const bf16_t*)(ws + WS_W6), T, 2048, 256, 1024, 1, 256};
        EpiLruGate e{(const bf16_t*)(ws + WS_XBC2), (bf16_t*)(ws + WS_LA), (bf16_t*)(ws + WS_UU), IN(p, I_LRU_BA), IN(p, I_LRU_BX), (const float*)(ws + WS_SP)};
        gemm_phase<EpiLruGate, false>(cx, lds, g, e, nullptr); } break;
    case 11: phase_lru_a(cx, (const bf16_t*)(ws + WS_LA), (const bf16_t*)(ws + WS_UU), (float*)(ws + WS_SL), (float*)(ws + WS_HH)); break;
    case 12: phase_lru_b(cx, p, (const float*)(ws + WS_SL), (const float*)(ws + WS_HH), (float*)(ws + WS_CIN)); break;
    case 13: phase_lru_c(cx, (const bf16_t*)(ws + WS_LA), (const bf16_t*)(ws + WS_UU), (const float*)(ws + WS_CIN), (bf16_t*)(ws + WS_GATE)); break;
    case 14: { Gemm g{(const bf16_t*)(ws + WS_GATE), (const bf16_t*)(ws + WS_W7), T, 1024, 1024, 1024, 0, 0};
        EpiRes<false> e{nullptr, nullptr, XN, SSQ + 3 * T};
        gemm_phase<EpiRes<false>, false, true>(cx, lds, g, e, nullptr, (float*)(ws + WS_SLAB)); } break;
    case 32: phase_split_finish<false, false>(cx, (const float*)(ws + WS_SLAB), 4, nullptr, XN, SSQ + 3 * T, nullptr); break;
    case 18: phase_final_norm(cx, XN, SSQ + 4 * T, IN(p, I_NORM_FINAL), Y); break;
    default: break;
    }
}

__global__ void __launch_bounds__(NTHREADS, 2) fwd_mega(Params p, int ph_lo, int ph_hi) {
    extern __shared__ __attribute__((aligned(16))) unsigned char smem[];
    LAS unsigned char* lds = (LAS unsigned char*)smem;
    cg::grid_group grid = cg::this_grid();
    volatile LAS unsigned* bst = (volatile LAS unsigned*)(lds + 131072 + 1024);
    if (threadIdx.x == 0) { bst[0] = 0u; bst[1] = 0u; }
    __syncthreads();
    const XcdBarrier xb = xcd_barrier_post((unsigned*)(IN(p, 35)) + WS_BAR / 4, bst);
#ifndef PROBE_K
#define PROBE_K -1
#endif
    for (int i = ph_lo; i < ph_hi; ++i) {
        int ph = i;
        if (i >= 5) ph = (i == 5) ? 30 : (i <= 8) ? i - 1 : (i == 9) ? 31 : (i <= 16) ? i - 2 : (i == 17) ? 32 : (i <= 20) ? i - 3 : (i == 21) ? 33 : 18;
        run_phase(p, ph, lds);
        if (i + 1 < ph_hi) { if (ph_hi > 1000) grid.sync(); else xcd_barrier(xb); }
    }
}

extern "C" void kernel_launch(void* const* d_in, const int* in_sizes, int n_in, void* d_out, int out_size, void* d_ws, size_t ws_size, hipStream_t stream) {
    static int grid = 0;
    if (grid == 0) {
        if (n_in != 34 || (size_t)out_size != O_END || ws_size < WS_NEED) { fprintf(stderr, "kernel_launch: unexpected shapes (n_in %d out %d ws %zu need %zu)\n", n_in, out_size, ws_size, (size_t)WS_NEED); grid = -1; return; }
        int dev = 0, cus = 0, per_cu = 0;
        (void)hipGetDevice(&dev); (void)hipDeviceGetAttribute(&cus, hipDeviceAttributeMultiprocessorCount, dev);
        if (hipFuncSetAttribute((const void*)fwd_mega, hipFuncAttributeMaxDynamicSharedMemorySize, LDS_BYTES) != hipSuccess) { fprintf(stderr, "kernel_launch: hipFuncSetAttribute failed\n"); grid = -1; return; }
        if (hipOccupancyMaxActiveBlocksPerMultiprocessor(&per_cu, (const void*)fwd_mega, NTHREADS, LDS_BYTES) != hipSuccess || per_cu < 1) { fprintf(stderr, "kernel_launch: occupancy query says %d\n", per_cu); per_cu = 1; }
        (void)hipGetLastError();
        grid = cus;
    }
    if (grid < 0) return;
    (void)hipMemsetAsync((unsigned char*)d_ws + WS_BAR, 0, 16384, stream);
    Params p{};
    for (int i = 0; i < 34; ++i) p.ptr[i] = (const float*)d_in[i];
    p.ptr[34] = (const float*)d_out; p.ptr[35] = (const float*)d_ws;
    int lo = 0, hi = NPHASE; void* args[] = {&p, &lo, &hi};
    hipError_t e = hipLaunchCooperativeKernel((const void*)fwd_mega, dim3(grid), dim3(NTHREADS), args, LDS_BYTES, stream);
    if (e != hipSuccess) fprintf(stderr, "cooperative launch failed: %s (grid %d)\n", hipGetErrorString(e), grid);
}
```
